# Optimizing an MI355X kernel written in HIP

```python
import jax, jax.numpy as jnp
from jax import lax
import numpy as np

D_MODEL = 1024
BATCH = 2
SEQ = 8192
DEPTH = 1
DEC_BATCH = 128
DEC_SEQ = 8
PAST_LEN = 16384
PAGE_SIZE = 128

ATT_HEADS = 8
ATT_KV_HEADS = 2
ATT_GROUP = ATT_HEADS // ATT_KV_HEADS
ATT_HEAD_DIM = 64
ATT_WIDTH = ATT_HEADS * ATT_HEAD_DIM
KV_WIDTH = ATT_KV_HEADS * ATT_HEAD_DIM
WINDOW = 128
ATT_BLOCK = 128
ROPE_THETA = 10000.0
GLA_HEADS = 4
GLA_WIDTH = D_MODEL // 2
GLA_DV = GLA_WIDTH // GLA_HEADS
GLA_KEY_WIDTH = GLA_WIDTH // 2
GLA_DK = GLA_KEY_WIDTH // GLA_HEADS
GLA_GATE_RANK = 16
GLA_GATE_TAU = 16.0
GLA_CHUNK = 16
EPS = 1e-6
NEG = -1e30
IN_COLS = 2 * ATT_WIDTH + 2 * KV_WIDTH + 2 * GLA_KEY_WIDTH + 2 * GLA_WIDTH + GLA_GATE_RANK + 2 * D_MODEL

kernel_name = "hybrid_swa_sink_gla_parallel_adaln_step"


def rms_norm(x, g):
    xf = x.astype(jnp.float32)
    y = xf * lax.rsqrt(jnp.mean(xf * xf, axis=-1, keepdims=True) + EPS)
    return (y * g.astype(jnp.float32)).astype(x.dtype)


def rope(x, pos):
    half = ATT_HEAD_DIM // 2
    inv = 1.0 / (ROPE_THETA ** (jnp.arange(half, dtype=jnp.float32) / half))
    ang = pos.astype(jnp.float32)[:, None] * inv[None, :]
    cos = jnp.cos(ang)[:, None, :]
    sin = jnp.sin(ang)[:, None, :]
    xf = x.astype(jnp.float32)
    x1, x2 = xf[..., :half], xf[..., half:]
    return jnp.concatenate([x1 * cos - x2 * sin, x2 * cos + x1 * sin], axis=-1).astype(x.dtype)


def split_proj(p):
    sizes = (ATT_WIDTH, KV_WIDTH, KV_WIDTH, ATT_WIDTH, GLA_KEY_WIDTH, GLA_KEY_WIDTH,
             GLA_WIDTH, GLA_GATE_RANK, GLA_WIDTH, D_MODEL, D_MODEL)
    idx = np.cumsum(sizes)[:-1].tolist()
    return jnp.split(p, idx, axis=-1)


def sink_attention(q, k, v, mask, sinks):
    s = jnp.einsum('...qhgd,...khd->...hgqk', q, k).astype(jnp.float32) * (ATT_HEAD_DIM ** -0.5)
    s = jnp.where(mask, s, NEG)
    sink = jnp.broadcast_to(sinks.astype(jnp.float32).reshape(ATT_KV_HEADS, ATT_GROUP, 1, 1),
                            s.shape[:-1] + (1,))
    p = jax.nn.softmax(jnp.concatenate([s, sink], axis=-1), axis=-1)[..., :-1]
    return jnp.einsum('...hgqk,...khd->...qhgd', p.astype(v.dtype), v)


def swa_prompt(q, k, v, sinks):
    B, S = q.shape[:2]
    nb = S // ATT_BLOCK
    qb = q.reshape(B, nb, ATT_BLOCK, ATT_KV_HEADS, ATT_GROUP, ATT_HEAD_DIM)
    kb = k.reshape(B, nb, ATT_BLOCK, ATT_KV_HEADS, ATT_HEAD_DIM)
    vb = v.reshape(B, nb, ATT_BLOCK, ATT_KV_HEADS, ATT_HEAD_DIM)
    pad = ((0, 0), (1, 0), (0, 0), (0, 0), (0, 0))
    kk = jnp.concatenate([jnp.pad(kb, pad)[:, :-1], kb], axis=2)
    vv = jnp.concatenate([jnp.pad(vb, pad)[:, :-1], vb], axis=2)
    qpos = jnp.arange(ATT_BLOCK)[:, None] + ATT_BLOCK
    kpos = jnp.arange(2 * ATT_BLOCK)[None, :]
    d = qpos - kpos
    band = (d >= 0) & (d <= WINDOW)
    blk = jnp.arange(nb)[:, None, None]
    mask = band[None] & ((kpos[None] >= ATT_BLOCK) | (blk > 0))
    o = sink_attention(qb, kk, vv, mask[None, :, None, None], sinks)
    return o.reshape(B, S, ATT_HEADS, ATT_HEAD_DIM)


def swa_sample(q, k_new, v_new, k_cache, v_cache, sinks):
    B, L = q.shape[:2]
    W = k_cache.shape[1]
    kk = jnp.concatenate([k_cache.astype(k_new.dtype), k_new], axis=1)
    vv = jnp.concatenate([v_cache.astype(v_new.dtype), v_new], axis=1)
    d = (W + jnp.arange(L))[:, None] - jnp.arange(W + L)[None, :]
    mask = (d >= 0) & (d <= WINDOW)
    qg = q.reshape(B, L, ATT_KV_HEADS, ATT_GROUP, ATT_HEAD_DIM)
    o = sink_attention(qg, kk, vv, mask, sinks).reshape(B, L, ATT_HEADS, ATT_HEAD_DIM)
    return o, kk[:, -W:], vv[:, -W:]


def gla_recurrence(q, k, v, log_a, S0):
    B, L = q.shape[:2]
    C = GLA_CHUNK
    pad = (-L) % C
    nc = (L + pad) // C

    def chunks(t):
        t = jnp.pad(t.astype(jnp.float32), ((0, 0), (0, pad), (0, 0), (0, 0)))
        return t.reshape(B, nc, C, t.shape[2], t.shape[3]).transpose(1, 0, 2, 3, 4)

    tri = (jnp.arange(C)[:, None] >= jnp.arange(C)[None, :])[None, :, :, None, None]

    def step(S, inp):
        qc, kc, vc, ac = inp
        b = jnp.cumsum(ac, axis=1)
        o_inter = jnp.einsum('bthk,bhkv->bthv', qc * jnp.exp(b), S)
        diff = jnp.where(tri, b[:, :, None] - b[:, None, :], NEG)
        A = jnp.einsum('bthk,bshk,btshk->bhts', qc, kc, jnp.exp(diff))
        o_intra = jnp.einsum('bhts,bshv->bthv', A, vc)
        b_last = b[:, -1]
        k_dec = kc * jnp.exp(b_last[:, None] - b)
        S_new = jnp.exp(b_last)[..., None] * S + jnp.einsum('bshk,bshv->bhkv', k_dec, vc)
        return S_new, o_inter + o_intra

    S_fin, o = lax.scan(step, S0.astype(jnp.float32), (chunks(q), chunks(k), chunks(v), chunks(log_a)))
    o = o.transpose(1, 0, 2, 3, 4).reshape(B, nc * C, GLA_HEADS, GLA_DV)[:, :L]
    return o, S_fin


def trunk_layer(x, c, pos0, win_k, win_v, gla_s, norm_g, w_ada, b_ada, w_in, q_norm_g, k_norm_g,
                attn_sinks, w_gla_gate, b_gla_gate, gla_norm_g, w_branch_att, w_branch_gla, w_out):
    B, L, _ = x.shape
    mod = jnp.einsum('bd,de->be', jax.nn.silu(c), w_ada) + b_ada
    shift, scale, gate = jnp.split(mod, 3, axis=-1)
    h = rms_norm(x, norm_g) * (1.0 + scale[:, None]) + shift[:, None]
    proj = jnp.einsum('bld,de->ble', h, w_in)
    q_a, k_a, v_a, z_a, q_g, k_g, v_g, lr_g, z_g, m_a, m_g = split_proj(proj)

    pos = pos0 + jnp.arange(L, dtype=jnp.int32)
    q_a = rope(rms_norm(q_a.reshape(B, L, ATT_HEADS, ATT_HEAD_DIM), q_norm_g), pos)
    k_a = rope(rms_norm(k_a.reshape(B, L, ATT_KV_HEADS, ATT_HEAD_DIM), k_norm_g), pos)
    v_a = v_a.reshape(B, L, ATT_KV_HEADS, ATT_HEAD_DIM)
    if win_k is None:
        o_a = swa_prompt(q_a, k_a, v_a, attn_sinks)
        new_k, new_v = k_a[:, -WINDOW:], v_a[:, -WINDOW:]
    else:
        o_a, new_k, new_v = swa_sample(q_a, k_a, v_a, win_k, win_v, attn_sinks)
    o_a = o_a.reshape(B, L, ATT_WIDTH) * jax.nn.silu(z_a)

    log_a = jax.nn.log_sigmoid((jnp.einsum('blr,rk->blk', lr_g, w_gla_gate) + b_gla_gate).astype(jnp.float32)) / GLA_GATE_TAU
    q_g = q_g.reshape(B, L, GLA_HEADS, GLA_DK) * (GLA_DK ** -0.5)
    k_g = k_g.reshape(B, L, GLA_HEADS, GLA_DK)
    v_g = v_g.reshape(B, L, GLA_HEADS, GLA_DV)
    o_g, new_s = gla_recurrence(q_g, k_g, v_g, log_a.reshape(B, L, GLA_HEADS, GLA_DK), gla_s)
    o_g = rms_norm(o_g, gla_norm_g).astype(x.dtype).reshape(B, L, GLA_WIDTH) * jax.nn.silu(z_g)

    merged = (jax.nn.sigmoid(m_a) * jnp.einsum('ble,ed->bld', o_a, w_branch_att)
              + jax.nn.sigmoid(m_g) * jnp.einsum('ble,ed->bld', o_g, w_branch_gla))
    y = x + gate[:, None] * jnp.einsum('bld,de->ble', merged, w_out)
    return y, new_k, new_v, new_s


def setup_inputs(seed: int = 0) -> dict:
    key = jax.random.key(seed)
    ks = jax.random.split(key, 24)
    f32 = jnp.float32
    win = min(WINDOW, PAST_LEN)

    def nrm(k, shape, s=1.0):
        return jax.random.normal(k, shape, f32) * s

    return {
        'x_prompt': nrm(ks[0], (BATCH, SEQ, D_MODEL)),
        'x_sample': nrm(ks[1], (DEC_BATCH, DEC_SEQ, D_MODEL)),
        'cache_win_k': nrm(ks[2], (DEPTH, DEC_BATCH, win, ATT_KV_HEADS, ATT_HEAD_DIM)),
        'cache_win_v': nrm(ks[3], (DEPTH, DEC_BATCH, win, ATT_KV_HEADS, ATT_HEAD_DIM)),
        'state_gla': nrm(ks[4], (DEPTH, DEC_BATCH, GLA_HEADS, GLA_DK, GLA_DV)),
        'c_prompt': nrm(ks[5], (BATCH, D_MODEL)),
        'c_sample': nrm(ks[6], (DEC_BATCH, D_MODEL)),
        'norm_g': 1.0 + nrm(ks[7], (DEPTH, D_MODEL), 0.02),
        'w_ada': nrm(ks[8], (DEPTH, D_MODEL, 3 * D_MODEL), D_MODEL ** -0.5),
        'b_ada': nrm(ks[9], (DEPTH, 3 * D_MODEL), 0.02),
        'w_in': nrm(ks[10], (DEPTH, D_MODEL, IN_COLS), D_MODEL ** -0.5),
        'q_norm_g': 1.0 + nrm(ks[11], (DEPTH, ATT_HEAD_DIM), 0.02),
        'k_norm_g': 1.0 + nrm(ks[12], (DEPTH, ATT_HEAD_DIM), 0.02),
        'attn_sinks': nrm(ks[13], (DEPTH, ATT_HEADS), 0.5),
        'w_gla_gate': nrm(ks[14], (DEPTH, GLA_GATE_RANK, GLA_KEY_WIDTH), GLA_GATE_RANK ** -0.5),
        'b_gla_gate': nrm(ks[15], (DEPTH, GLA_KEY_WIDTH), 0.02),
        'gla_norm_g': 1.0 + nrm(ks[16], (DEPTH, GLA_DV), 0.02),
        'w_branch_att': nrm(ks[17], (DEPTH, ATT_WIDTH, D_MODEL), ATT_WIDTH ** -0.5),
        'w_branch_gla': nrm(ks[18], (DEPTH, GLA_WIDTH, D_MODEL), GLA_WIDTH ** -0.5),
        'w_out': nrm(ks[19], (DEPTH, D_MODEL, D_MODEL), D_MODEL ** -0.5),
    }


def reference(x_prompt, x_sample, cache_win_k, cache_win_v, state_gla, c_prompt, c_sample,
              norm_g, w_ada, b_ada, w_in, q_norm_g, k_norm_g, attn_sinks, w_gla_gate, b_gla_gate,
              gla_norm_g, w_branch_att, w_branch_gla, w_out):
    y_prompt, y_sample = x_prompt, x_sample
    pk, pv, ps, sk, sv, ss = [], [], [], [], [], []
    for l in range(DEPTH):
        weights = (norm_g[l], w_ada[l], b_ada[l], w_in[l], q_norm_g[l], k_norm_g[l], attn_sinks[l],
                   w_gla_gate[l], b_gla_gate[l], gla_norm_g[l], w_branch_att[l], w_branch_gla[l], w_out[l])
        s0 = jnp.zeros((BATCH, GLA_HEADS, GLA_DK, GLA_DV), jnp.float32)
        y_prompt, k1, v1, s1 = trunk_layer(y_prompt, c_prompt, 0, None, None, s0, *weights)
        y_sample, k2, v2, s2 = trunk_layer(y_sample, c_sample, PAST_LEN, cache_win_k[l], cache_win_v[l],
                                           state_gla[l], *weights)
        pk.append(k1); pv.append(v1); ps.append(s1)
        sk.append(k2); sv.append(v2); ss.append(s2)
    prompt_win_k = jnp.stack(pk)
    prompt_win_v = jnp.stack(pv)
    prompt_gla_state = jnp.stack(ps)
    sample_win_k = jnp.stack(sk)
    sample_win_v = jnp.stack(sv)
    sample_gla_state = jnp.stack(ss)
    return (y_prompt, y_sample, prompt_win_k, prompt_win_v, prompt_gla_state, sample_win_k, sample_win_v, sample_gla_state)
```

```cpp
#include <hip/hip_runtime.h>
#include <hip/hip_cooperative_groups.h>
#include <cstdio>
#include <cstdint>
#include <cmath>
namespace cg = cooperative_groups;
namespace pg8 {
#define PG8_LAS __attribute__((address_space(3)))
typedef unsigned short bf16_t;
typedef short bf16x8 __attribute__((ext_vector_type(8)));
typedef float f32x4 __attribute__((ext_vector_type(4)));
typedef unsigned u32x4 __attribute__((ext_vector_type(4)));
constexpr int BM = 256, BK = 64, HALF = 128, HTB = HALF * BK * 2  , STAGE_BYTES = 8 * HTB, NXCD = 8, WGM = 8;

__host__ __device__ __forceinline__ int lds_byte(int r, int c) { const int st = (r >> 4) * 2 + (c >> 5), rr = r & 15, cc = c & 31, ob = rr * 64 + cc * 2; return st * 1024 + (ob ^ (((ob >> 9) & 1) << 5)); }
__host__ __device__ __forceinline__ void stage_rc(int b, int& R, int& C) { const int st = b / 1024, sb = b % 1024, swz = sb ^ (((sb >> 9) & 1) << 5); R = (st >> 1) * 16 + swz / 64; C = (st & 1) * 32 + (swz % 64) / 2; }
__host__ __device__ __forceinline__ int perm32(int rho) { const int n = rho >> 4, i = rho & 15; return 8 * (i >> 2) + 4 * n + (i & 3); }

struct Unit { int pm, pn; };
struct Gemm { const bf16_t* A; const bf16_t* Bt; int M, N, K; };

struct StaticOrder {
    int nM, nN, nwg, G, c;
    __host__ __device__ void init(int M, int N, int G_, int c_) { nM = M / BM; nN = N / BM; nwg = nM * nN; G = G_; c = c_; }
    __host__ __device__ bool next(int i, Unit& u) const {
        const long L = (long)i * G + c; if (L >= nwg) return false;
        int wgid = (int)L; { const int q = nwg / NXCD, r = nwg % NXCD, xcd = wgid % NXCD, off = wgid / NXCD; wgid = (xcd < r ? xcd * (q + 1) : r * (q + 1) + (xcd - r) * q) + off; }
        const int nig = WGM * nN, gid = wgid / nig, fm = gid * WGM, gsz = (nM - fm) < WGM ? (nM - fm) : WGM;
        u.pm = fm + ((wgid % nig) % gsz); u.pn = (wgid % nig) / gsz; return true;
    }
    __device__ __forceinline__ void a_ready(const Unit&) const {}
    __device__ __forceinline__ void done(const Unit&) const {}
};
__device__ __forceinline__ unsigned cvt_pk_bf16(float lo, float hi) { unsigned r; asm volatile("v_cvt_pk_bf16_f32 %0, %1, %2" : "=v"(r) : "v"(lo), "v"(hi)); return r; }
typedef float f32x2 __attribute__((ext_vector_type(2)));
template <class Epi, class Sched, bool ALIGN_EPI = false, bool SP2 = false>
__device__ __forceinline__ void gemm_phase(PG8_LAS unsigned char* lds, const Gemm g, const Sched& S, const Epi& E) {
    const int tid = threadIdx.x, wid = __builtin_amdgcn_readfirstlane(tid >> 6), lane = tid & 63, wr = wid >> 2, wc = wid & 3, fr = lane & 15, fq = lane >> 4;
    const int K = g.K, nt = K / BK;
    unsigned voffA[2], voffB[2];
#pragma unroll
    for (int i = 0; i < 2; ++i) { int R, C; stage_rc(tid * 16 + i * 8192, R, C); const int Rb = Epi::PERM ? ((R & ~31) + perm32(R & 31)) : R;
        voffA[i] = (unsigned)(R * K + C) * 2u; voffB[i] = (unsigned)(Rb * K + C) * 2u; }
    const size_t kstep = (size_t)(BK * 2);
    const size_t hstep = (size_t)HALF * K * 2;
    const size_t tstep = 2 * hstep;
    const unsigned ldsw = (unsigned)wid * 1024u;
    const int aoff = lds_byte(wr * 64 + fr, fq * 8), boff = lds_byte(wc * 32 + fr, fq * 8);
#define PG8_SA(b, h) (((b) * 2 + (h)) * HTB)
#define PG8_SB(b, h) ((4 + (b) * 2 + (h)) * HTB)
#define PG8_STAGE(bufoff, gbase, voff) do { _Pragma("unroll") for (int _i = 0; _i < 2; ++_i) \
        __builtin_amdgcn_global_load_lds((const unsigned*)((const char*)(gbase) + (voff)[_i]), (PG8_LAS unsigned*)(lds + (bufoff) + ldsw + _i * 8192), 16, 0, 0); } while (0)
#define PG8_LDA(dst, b, h) do { _Pragma("unroll") for (int m = 0; m < 4; ++m) _Pragma("unroll") for (int k = 0; k < 2; ++k) dst[m][k] = *(const PG8_LAS bf16x8*)(lds + PG8_SA(b, h) + aoff + m * 2048 + k * 1024); } while (0)
#define PG8_LDB(dst, b, h) do { _Pragma("unroll") for (int n = 0; n < 2; ++n) _Pragma("unroll") for (int k = 0; k < 2; ++k) dst[n][k] = *(const PG8_LAS bf16x8*)(lds + PG8_SB(b, h) + boff + n * 2048 + k * 1024); } while (0)
#define PG8_MMA(ai, bj, At, Bt) do { __builtin_amdgcn_s_setprio(1); _Pragma("unroll") for (int m = 0; m < 4; ++m) _Pragma("unroll") for (int n = 0; n < 2; ++n) _Pragma("unroll") for (int k = 0; k < 2; ++k) \
        acc[ai][bj][m][n] = __builtin_amdgcn_mfma_f32_16x16x32_bf16(Bt[n][k], At[m][k], acc[ai][bj][m][n], 0, 0, 0); __builtin_amdgcn_s_setprio(0); } while (0)
#define PG8_WAIT_V(n) asm volatile("s_waitcnt vmcnt(" #n ")" ::: "memory")
#define PG8_WAIT_L(n) asm volatile("s_waitcnt lgkmcnt(" #n ")" ::: "memory")
#define PG8_BAR __builtin_amdgcn_s_barrier()
#define PG8_SCHED __builtin_amdgcn_sched_barrier(0)
    Unit cur, nxt; int ui = 0;
    if (!S.next(0, cur)) return;
    f32x4 acc[2][2][4][2];
#pragma unroll
    for (int a = 0; a < 2; ++a)
#pragma unroll
        for (int b = 0; b < 2; ++b)
#pragma unroll
            for (int m = 0; m < 4; ++m)
#pragma unroll
                for (int n = 0; n < 2; ++n) acc[a][b][m][n] = (f32x4){0.f, 0.f, 0.f, 0.f};
    bf16x8 At[4][2], B0[2][2], B1[2][2];
    const char* cA = (const char*)g.A + (size_t)cur.pm * tstep; const char* cB = (const char*)g.Bt + (size_t)cur.pn * tstep;
    S.a_ready(cur);
    if constexpr (SP2) {
        PG8_STAGE(PG8_SB(0, 0), cB, voffB); PG8_STAGE(PG8_SB(0, 1), cB + hstep, voffB); PG8_STAGE(PG8_SA(0, 0), cA, voffA); PG8_STAGE(PG8_SA(0, 1), cA + hstep, voffA);
        if (wr == 1) PG8_BAR;
        PG8_WAIT_V(2); PG8_BAR;
        PG8_STAGE(PG8_SB(1, 0), cB + kstep, voffB); PG8_STAGE(PG8_SA(1, 0), cA + kstep, voffA); PG8_STAGE(PG8_SB(1, 1), cB + hstep + kstep, voffB);
        PG8_WAIT_V(6); PG8_BAR;
    } else {
        PG8_STAGE(PG8_SB(0, 0), cB, voffB); PG8_STAGE(PG8_SA(0, 0), cA, voffA); PG8_STAGE(PG8_SB(0, 1), cB + hstep, voffB); PG8_STAGE(PG8_SA(0, 1), cA + hstep, voffA);
        if (wr == 1) PG8_BAR;
        PG8_WAIT_V(4); PG8_BAR;
        PG8_STAGE(PG8_SB(1, 0), cB + kstep, voffB); PG8_STAGE(PG8_SA(1, 0), cA + kstep, voffA); PG8_STAGE(PG8_SB(1, 1), cB + hstep + kstep, voffB);
        PG8_WAIT_V(6); PG8_BAR;
    }
    for (;;) {
        const bool has_next = S.next(ui + 1, nxt);
        const char* nA = has_next ? (const char*)g.A + (size_t)nxt.pm * tstep : cA; const char* nB = has_next ? (const char*)g.Bt + (size_t)nxt.pn * tstep : cB;
        for (int t = 0; t < nt; t += 2) {
            const bool last = (t == nt - 2);
            const char* a1 = cA + (size_t)(t + 1) * kstep;
            const char* a2 = last ? nA : cA + (size_t)(t + 2) * kstep; const char* b2 = last ? nB : cB + (size_t)(t + 2) * kstep;
            const char* a3 = a2 + kstep; const char* b3 = b2 + kstep;
            if (last && has_next) S.a_ready(nxt);
            if constexpr (SP2) {
            PG8_LDB(B0, 0, 0); PG8_LDB(B1, 0, 1); PG8_SCHED; PG8_LDA(At, 0, 0); PG8_STAGE(PG8_SA(1, 1), a1 + hstep, voffA);
            PG8_WAIT_V(8); PG8_WAIT_L(0); PG8_BAR; PG8_MMA(0, 0, At, B0); PG8_MMA(0, 1, At, B1); PG8_BAR; PG8_SCHED;
            PG8_LDA(At, 0, 1); PG8_STAGE(PG8_SB(0, 0), b2, voffB); PG8_STAGE(PG8_SB(0, 1), b2 + hstep, voffB); PG8_STAGE(PG8_SA(0, 0), a2, voffA);
            PG8_WAIT_V(8); PG8_WAIT_L(0); PG8_BAR; PG8_MMA(1, 0, At, B0); PG8_MMA(1, 1, At, B1); PG8_BAR; PG8_SCHED;
            PG8_LDB(B0, 1, 0); PG8_LDB(B1, 1, 1); PG8_SCHED; PG8_LDA(At, 1, 0); PG8_STAGE(PG8_SA(0, 1), a2 + hstep, voffA);
            PG8_WAIT_V(8); PG8_WAIT_L(0); PG8_BAR; PG8_MMA(0, 0, At, B0); PG8_MMA(0, 1, At, B1); PG8_BAR; PG8_SCHED;
            PG8_LDA(At, 1, 1); PG8_STAGE(PG8_SB(1, 0), b3, voffB); PG8_STAGE(PG8_SB(1, 1), b3 + hstep, voffB); PG8_STAGE(PG8_SA(1, 0), a3, voffA);
            PG8_WAIT_V(8); PG8_WAIT_L(0); PG8_BAR; PG8_MMA(1, 0, At, B0); PG8_MMA(1, 1, At, B1); PG8_BAR; PG8_SCHED;
            } else {
            PG8_LDB(B0, 0, 0); PG8_SCHED; PG8_LDA(At, 0, 0); PG8_STAGE(PG8_SA(1, 1), a1 + hstep, voffA);
            PG8_WAIT_L(8); PG8_BAR; PG8_WAIT_L(0); PG8_MMA(0, 0, At, B0); PG8_BAR; PG8_SCHED;
            PG8_LDB(B1, 0, 1); PG8_STAGE(PG8_SB(0, 0), b2, voffB);
            PG8_BAR; PG8_WAIT_L(0); PG8_MMA(0, 1, At, B1); PG8_BAR;
            PG8_LDA(At, 0, 1); PG8_STAGE(PG8_SA(0, 0), a2, voffA);
            PG8_BAR; PG8_WAIT_L(0); PG8_MMA(1, 0, At, B0); PG8_BAR; PG8_SCHED;
            PG8_STAGE(PG8_SB(0, 1), b2 + hstep, voffB);
            PG8_WAIT_V(6); PG8_BAR; PG8_MMA(1, 1, At, B1); PG8_BAR;
            PG8_LDB(B0, 1, 0); PG8_SCHED; PG8_LDA(At, 1, 0); PG8_STAGE(PG8_SA(0, 1), a2 + hstep, voffA);
            PG8_WAIT_L(8); PG8_BAR; PG8_WAIT_L(0); PG8_MMA(0, 0, At, B0); PG8_BAR; PG8_SCHED;
            PG8_LDB(B1, 1, 1); PG8_STAGE(PG8_SB(1, 0), b3, voffB);
            PG8_BAR; PG8_WAIT_L(0); PG8_MMA(0, 1, At, B1); PG8_BAR;
            PG8_LDA(At, 1, 1); PG8_STAGE(PG8_SA(1, 0), a3, voffA);
            PG8_BAR; PG8_WAIT_L(0); PG8_MMA(1, 0, At, B0); PG8_BAR; PG8_SCHED;
            PG8_STAGE(PG8_SB(1, 1), b3 + hstep, voffB);
            PG8_WAIT_V(6); PG8_BAR; PG8_MMA(1, 1, At, B1); PG8_BAR;
            }
        }
        if constexpr (ALIGN_EPI) { if (wr == 0) PG8_BAR; }
        if constexpr (!Epi::AFTER_DRAIN) { E(acc, cur, wr, wc, fr, fq); S.done(cur); }
        if (!has_next) break;
#pragma unroll
        for (int a = 0; a < 2; ++a)
#pragma unroll
            for (int b = 0; b < 2; ++b)
#pragma unroll
                for (int m = 0; m < 4; ++m)
#pragma unroll
                    for (int n = 0; n < 2; ++n) acc[a][b][m][n] = (f32x4){0.f, 0.f, 0.f, 0.f};
        cur = nxt; cA = nA; cB = nB; ++ui;
        if constexpr (ALIGN_EPI) { if (wr == 1) PG8_BAR; }
    }
    PG8_WAIT_V(0);
    if constexpr (!ALIGN_EPI) { if (wr == 0) PG8_BAR; }
    PG8_BAR;
    if constexpr (Epi::AFTER_DRAIN) { E.fused(acc, cur, wr, wc, fr, fq, lds, wid, lane); S.done(cur); }
#undef PG8_SA
#undef PG8_SB
#undef PG8_STAGE
#undef PG8_LDA
#undef PG8_LDB
#undef PG8_MMA
#undef PG8_WAIT_V
#undef PG8_WAIT_L
#undef PG8_BAR
#undef PG8_SCHED
}
}

using pg8::bf16_t; using pg8::bf16x8; using pg8::f32x4; using pg8::u32x4; using pg8::Unit;
typedef unsigned u32x2 __attribute__((ext_vector_type(2)));
typedef float f32x2v __attribute__((ext_vector_type(2)));
typedef __bf16 bf16x2v __attribute__((ext_vector_type(2)));

constexpr int DM = 1024, SEQ = 8192, MP = 16384, MS = 1024, MT = MP + MS;
constexpr int NIN = 4880, NINP = 5120;
constexpr float EPS = 1e-6f;
constexpr float LOG2E = 1.4426950408889634f;

constexpr size_t WS_MOD = 0;
constexpr size_t WS_ROPE = WS_MOD + 1597440;
constexpr size_t WS_WIN = WS_ROPE + 2099200;
constexpr size_t WS_WBA = WS_WIN + 10485760;
constexpr size_t WS_WBG = WS_WBA + 1048576;
constexpr size_t WS_WOUT = WS_WBG + 1048576;
constexpr size_t WS_H = WS_WOUT + 2097152;
constexpr size_t WS_OA = WS_H;
constexpr size_t WS_OG = WS_H + 17825792;
constexpr size_t WS_QA = WS_H + 35651584;
constexpr size_t WS_KA = WS_QA + 17825792;
constexpr size_t WS_VA = WS_KA + 4456448;
constexpr size_t WS_QG = WS_VA + 4456448;
constexpr size_t WS_TMP = WS_QA;
constexpr size_t WS_KG = WS_QG + 8912896;
constexpr size_t WS_VG = WS_KG + 8912896;
constexpr size_t WS_ZG = WS_VG + 17825792;
constexpr size_t WS_MRG = WS_KG;
constexpr size_t WS_ZA = WS_ZG + 17825792;
constexpr size_t WS_MA = WS_ZA + 17825792;
constexpr size_t WS_MG = WS_MA + 35651584;
constexpr size_t WS_LR = WS_MG + 35651584;
constexpr size_t WS_DS = WS_LR + 4456448;
constexpr size_t WS_DEC = WS_DS + 33554432;
constexpr size_t WS_END = WS_DEC + 262144;

constexpr size_t O_Y = 0;
constexpr size_t O_PWK = 17825792;
constexpr size_t O_PWV = O_PWK + 32768;
constexpr size_t O_PGS = O_PWV + 32768;
constexpr size_t O_SWK = O_PGS + 65536;
constexpr size_t O_SWV = O_SWK + 2097152;
constexpr size_t O_SGS = O_SWV + 2097152;

struct Params {
    const float* in[20];
    float* out; unsigned char* ws;
    float inv[32];
    int ph_lo, ph_hi;
};

__device__ __forceinline__ unsigned pk2(float lo, float hi) { f32x2v v = {lo, hi}; bf16x2v b = __builtin_convertvector(v, bf16x2v); return __builtin_bit_cast(unsigned, b); }
__device__ __forceinline__ float bflo(unsigned w) { return __uint_as_float(w << 16); }
__device__ __forceinline__ float bfhi(unsigned w) { return __uint_as_float(w & 0xffff0000u); }
__device__ __forceinline__ float bf2f(bf16_t h) { return __uint_as_float((unsigned)h << 16); }
__device__ __forceinline__ float fast_rcp(float x) { return __builtin_amdgcn_rcpf(x); }
__device__ __forceinline__ float sigmoidf_(float x) { return fast_rcp(1.f + __expf(-x)); }
__device__ __forceinline__ float siluf_(float x) { return x * fast_rcp(1.f + __expf(-x)); }
__device__ __forceinline__ float wave_sum(float v) {
#pragma unroll
    for (int o = 1; o < 64; o <<= 1) v += __shfl_xor(v, o);
    return v;
}
__device__ __forceinline__ f32x4 mfma16(bf16x8 a, bf16x8 b, f32x4 c) { return __builtin_amdgcn_mfma_f32_16x16x32_bf16(a, b, c, 0, 0, 0); }
__device__ __forceinline__ int mod_row(int r) { return r < MP ? (r >> 13) : 2 + ((r - MP) >> 3); }

struct EpiProj {
    static constexpr bool PERM = true, AFTER_DRAIN = false;
    unsigned char* ws;
    __device__ __forceinline__ void operator()(const f32x4 (&acc)[2][2][4][2], const Unit& u, int wr, int wc, int fr, int fq) const {
        const int row0 = u.pm * 256 + wr * 64 + fr;
#pragma unroll
        for (int bj = 0; bj < 2; ++bj) {
            const int cb = u.pn * 2 + bj;
            size_t off; int ld, cbase, act;
            if (cb < 4) { off = WS_QA; ld = 512; cbase = cb * 128; act = 0; }
            else if (cb == 4) { off = WS_KA; ld = 128; cbase = 0; act = 0; }
            else if (cb == 5) { off = WS_VA; ld = 128; cbase = 0; act = 0; }
            else if (cb < 10) { off = WS_ZA; ld = 512; cbase = (cb - 6) * 128; act = 1; }
            else if (cb < 12) { off = WS_QG; ld = 256; cbase = (cb - 10) * 128; act = 3; }
            else if (cb < 14) { off = WS_KG; ld = 256; cbase = (cb - 12) * 128; act = 0; }
            else if (cb < 18) { off = WS_VG; ld = 512; cbase = (cb - 14) * 128; act = 0; }
            else if (cb < 22) { off = WS_ZG; ld = 512; cbase = (cb - 18) * 128; act = 1; }
            else if (cb < 30) { off = WS_MA; ld = 1024; cbase = (cb - 22) * 128; act = 2; }
            else if (cb < 38) { off = WS_MG; ld = 1024; cbase = (cb - 30) * 128; act = 2; }
            else if (cb == 38) { off = WS_LR; ld = 128; cbase = 0; act = 0; }
            else continue;
            bf16_t* base = (bf16_t*)(ws + off) + cbase + wc * 32 + 8 * fq;
#pragma unroll
            for (int ai = 0; ai < 2; ++ai)
#pragma unroll
                for (int m = 0; m < 4; ++m) {
                    f32x4 v0 = acc[ai][bj][m][0], v1 = acc[ai][bj][m][1];
                    if (act == 1) { for (int j = 0; j < 4; ++j) { v0[j] = siluf_(v0[j]); v1[j] = siluf_(v1[j]); } }
                    else if (act == 2) { for (int j = 0; j < 4; ++j) { v0[j] = sigmoidf_(v0[j]); v1[j] = sigmoidf_(v1[j]); } }
                    else if (act == 3) { v0 = v0 * 0.125f; v1 = v1 * 0.125f; }
                    u32x4 w; w.x = pk2(v0[0], v0[1]); w.y = pk2(v0[2], v0[3]); w.z = pk2(v1[0], v1[1]); w.w = pk2(v1[2], v1[3]);
                    *(u32x4*)(base + (size_t)(row0 + ai * 128 + m * 16) * ld) = w;
                }
        }
    }
};
template <int MODE> struct EpiBranch {
    static constexpr bool PERM = true, AFTER_DRAIN = false;
    const bf16_t* gate; const bf16_t* prev; bf16_t* dst;
    __device__ __forceinline__ void operator()(const f32x4 (&acc)[2][2][4][2], const Unit& u, int wr, int wc, int fr, int fq) const {
        const int row0 = u.pm * 256 + wr * 64 + fr, col0 = u.pn * 256 + wc * 32 + 8 * fq;
#pragma unroll
        for (int ai = 0; ai < 2; ++ai)
#pragma unroll
            for (int m = 0; m < 4; ++m)
#pragma unroll
                for (int bj = 0; bj < 2; ++bj) {
                    const size_t o = (size_t)(row0 + ai * 128 + m * 16) * 1024 + col0 + bj * 128;
                    const u32x4 g = *(const u32x4*)(gate + o);
                    f32x4 v0 = acc[ai][bj][m][0], v1 = acc[ai][bj][m][1];
                    v0[0] *= bflo(g.x); v0[1] *= bfhi(g.x); v0[2] *= bflo(g.y); v0[3] *= bfhi(g.y);
                    v1[0] *= bflo(g.z); v1[1] *= bfhi(g.z); v1[2] *= bflo(g.w); v1[3] *= bfhi(g.w);
                    if (MODE == 1) { const u32x4 t = *(const u32x4*)(prev + o);
                        v0[0] += bflo(t.x); v0[1] += bfhi(t.x); v0[2] += bflo(t.y); v0[3] += bfhi(t.y);
                        v1[0] += bflo(t.z); v1[1] += bfhi(t.z); v1[2] += bflo(t.w); v1[3] += bfhi(t.w); }
                    u32x4 w; w.x = pk2(v0[0], v0[1]); w.y = pk2(v0[2], v0[3]); w.z = pk2(v1[0], v1[1]); w.w = pk2(v1[2], v1[3]);
                    *(u32x4*)(dst + o) = w;
                }
    }
};
struct EpiOut {
    static constexpr bool PERM = false, AFTER_DRAIN = false;
    const float* xp; const float* xs; const float* mod; float* out;
    __device__ __forceinline__ void operator()(const f32x4 (&acc)[2][2][4][2], const Unit& u, int wr, int wc, int fr, int fq) const {
        const int col0 = u.pn * 256 + wc * 32 + 4 * fq;
#pragma unroll
        for (int ai = 0; ai < 2; ++ai)
#pragma unroll
            for (int m = 0; m < 4; ++m) {
                const int row = u.pm * 256 + ai * 128 + wr * 64 + m * 16 + fr;
                const float* xrow = row < MP ? xp + (size_t)row * 1024 : xs + (size_t)(row - MP) * 1024;
                const float* grow = mod + (size_t)mod_row(row) * 3072 + 2048;
                float* orow = out + (size_t)row * 1024;
#pragma unroll
                for (int bj = 0; bj < 2; ++bj)
#pragma unroll
                    for (int n = 0; n < 2; ++n) { const int c = col0 + bj * 128 + n * 16;
                        const f32x4 x4 = *(const f32x4*)(xrow + c), g4 = *(const f32x4*)(grow + c);
                        *(f32x4*)(orow + c) = x4 + g4 * acc[ai][bj][m][n]; }
            }
    }
};

__device__ __forceinline__ void p0_ada(const Params& p, unsigned char* lds, int unit) {
    float* sc = (float*)lds;
    const int tid = threadIdx.x, col = tid & 31, rg = tid >> 5;
    const int c0 = unit * 32;
    const float* w = p.in[8];
    float acc[9];
#pragma unroll
    for (int i = 0; i < 9; ++i) acc[i] = 0.f;
    for (int kc = 0; kc < 8; ++kc) {
        __syncthreads();
        for (int e = tid; e < 130 * 128; e += 512) { const int r = e >> 7, k = e & 127;
            const float* cp = r < 2 ? p.in[5] + r * 1024 : p.in[6] + (r - 2) * 1024;
            const float v = cp[kc * 128 + k]; sc[r * 132 + k] = v / (1.f + __expf(-v)); }
        __syncthreads();
        for (int k4 = 0; k4 < 32; ++k4) {
            const float* wp = w + (size_t)(kc * 128 + k4 * 4) * 3072 + c0 + col;
            const float w0 = wp[0], w1 = wp[3072], w2 = wp[6144], w3 = wp[9216];
#pragma unroll
            for (int i = 0; i < 9; ++i) { const int r = min(rg + 16 * i, 129); const f32x4 s = *(const f32x4*)(sc + r * 132 + k4 * 4);
                acc[i] += s.x * w0 + s.y * w1 + s.z * w2 + s.w * w3; }
        }
    }
    float* mod = (float*)(p.ws + WS_MOD);
    const float bias = p.in[9][c0 + col];
#pragma unroll
    for (int i = 0; i < 9; ++i) { const int r = rg + 16 * i; if (r < 130) mod[(size_t)r * 3072 + c0 + col] = acc[i] + bias; }
    __syncthreads();
}
__device__ __forceinline__ void p0_transpose(const float* src, int N, int n0, int nvalid, bf16_t* dst, int K, int n0p, int k0, unsigned char* lds) {
    float* t = (float*)lds;
    const int tid = threadIdx.x;
#pragma unroll
    for (int i = 0; i < 2; ++i) { const int idx = tid + 512 * i, r = idx >> 4, c4 = (idx & 15) * 4;
        f32x4 v = {0.f, 0.f, 0.f, 0.f};
        if (c4 < nvalid) v = *(const f32x4*)(src + (size_t)(k0 + r) * N + n0 + c4);
        t[r * 65 + c4] = v.x; t[r * 65 + c4 + 1] = v.y; t[r * 65 + c4 + 2] = v.z; t[r * 65 + c4 + 3] = v.w; }
    __syncthreads();
    { const int c = tid >> 3, r8 = (tid & 7) * 8; const float* s = t + r8 * 65 + c;
      u32x4 o; o.x = pk2(s[0], s[65]); o.y = pk2(s[130], s[195]); o.z = pk2(s[260], s[325]); o.w = pk2(s[390], s[455]);
      *(u32x4*)(dst + (size_t)(n0p + c) * K + k0 + r8) = o; }
    __syncthreads();
}
__device__ __forceinline__ void p0_rope(const Params& p, int unit) {
    float* rope = (float*)(p.ws + WS_ROPE);
#pragma unroll
    for (int q = 0; q < 4; ++q) { const int e = unit * 2048 + q * 512 + threadIdx.x;
        if (e < 8200 * 32) { const int pp = e >> 5, i = e & 31; const int pos = pp < 8192 ? pp : pp + 8192;
            const float ang = (float)pos * p.inv[i];
            const double a = (double)ang; const double n = rint(a * 0.15915494309189535);
            const float r = (float)fma(-n, 6.283185307179586, a);
            rope[(size_t)pp * 64 + i] = __cosf(r); rope[(size_t)pp * 64 + 32 + i] = __sinf(r); } }
}
__device__ __forceinline__ void phase0(const Params& p, unsigned char* lds) {
    constexpr int N_ADA = 96, N_TIN = 1280, N_TB = 128, N_TO = 256, N_ROPE = 129;
    constexpr int TOT = N_ADA + N_TIN + 2 * N_TB + N_TO + N_ROPE;
    for (int it = blockIdx.x; it < TOT; it += gridDim.x) {
        int r = it;
        if (r < N_ADA) { p0_ada(p, lds, r); continue; } r -= N_ADA;
        if (r < N_TIN) { const int kt = r / 80, nt = r % 80; int n0, nv;
            if (nt < 36) { n0 = nt * 64; nv = 64; } else if (nt < 76) { n0 = nt * 64 + 16; nv = 64; } else if (nt == 76) { n0 = 2304; nv = 16; } else { n0 = 0; nv = 0; }
            p0_transpose(p.in[10], NIN, n0, nv, (bf16_t*)(p.ws + WS_WIN), 1024, nt * 64, kt * 64, lds); continue; } r -= N_TIN;
        if (r < N_TB) { p0_transpose(p.in[17], 1024, (r % 16) * 64, 64, (bf16_t*)(p.ws + WS_WBA), 512, (r % 16) * 64, (r / 16) * 64, lds); continue; } r -= N_TB;
        if (r < N_TB) { p0_transpose(p.in[18], 1024, (r % 16) * 64, 64, (bf16_t*)(p.ws + WS_WBG), 512, (r % 16) * 64, (r / 16) * 64, lds); continue; } r -= N_TB;
        if (r < N_TO) { p0_transpose(p.in[19], 1024, (r % 16) * 64, 64, (bf16_t*)(p.ws + WS_WOUT), 1024, (r % 16) * 64, (r / 16) * 64, lds); continue; } r -= N_TO;
        p0_rope(p, r);
    }
}

__device__ __forceinline__ void phase1(const Params& p) {
    const int lane = threadIdx.x & 63, wave = threadIdx.x >> 6;
    const float* mod = (const float*)(p.ws + WS_MOD);
    bf16_t* H = (bf16_t*)(p.ws + WS_H);
    for (int r = blockIdx.x * 8 + wave; r < MT; r += gridDim.x * 8) {
        const float* xrow = r < MP ? p.in[0] + (size_t)r * 1024 : p.in[1] + (size_t)(r - MP) * 1024;
        const float* mr = mod + (size_t)mod_row(r) * 3072;
        f32x4 v[4]; float ss = 0.f;
#pragma unroll
        for (int j = 0; j < 4; ++j) { v[j] = *(const f32x4*)(xrow + 4 * lane + 256 * j); ss += (v[j].x * v[j].x + v[j].y * v[j].y) + (v[j].z * v[j].z + v[j].w * v[j].w); }
        const float rstd = rsqrtf(wave_sum(ss) * (1.f / 1024.f) + EPS);
#pragma unroll
        for (int j = 0; j < 4; ++j) { const int c = 4 * lane + 256 * j;
            const f32x4 g = *(const f32x4*)(p.in[7] + c), sh = *(const f32x4*)(mr + c), sc = *(const f32x4*)(mr + 1024 + c);
            const f32x4 h = v[j] * rstd * g * (sc + 1.f) + sh;
            u32x2 w; w.x = pk2(h.x, h.y); w.y = pk2(h.z, h.w);
            *(u32x2*)(H + (size_t)r * 1024 + c) = w; }
    }
}

constexpr int KS_STRIDE = 72, VT_STRIDE = 264, ATT_VT_OFF = 256 * 72 * 2;
constexpr float QSCALE = 0.125f * LOG2E;

__device__ __forceinline__ void attn_group(const bf16_t* Ks, const bf16_t* Vt, int kt0, int lo, int hi, bf16x8 qf0, bf16x8 qf1, float sinkv, f32x4 (&o)[4], int lane) {
    const int fr = lane & 15, fq = lane >> 4;
    f32x4 s[9];
#pragma unroll
    for (int t = 0; t < 9; ++t) {
        const bf16_t* kp = Ks + ((kt0 + t) * 16 + fr) * KS_STRIDE + fq * 8;
        const bf16x8 k0 = *(const bf16x8*)kp, k1 = *(const bf16x8*)(kp + 32);
        f32x4 a = {0.f, 0.f, 0.f, 0.f};
        a = mfma16(k0, qf0, a); a = mfma16(k1, qf1, a);
        s[t] = a;
    }
    float m = sinkv;
#pragma unroll
    for (int t = 0; t < 9; ++t)
#pragma unroll
        for (int r = 0; r < 4; ++r) { const int j = (kt0 + t) * 16 + fq * 4 + r; const float v = (j >= lo && j <= hi) ? s[t][r] : -1e30f; s[t][r] = v; m = fmaxf(m, v); }
    m = fmaxf(m, __shfl_xor(m, 16)); m = fmaxf(m, __shfl_xor(m, 32));
    float l = 0.f;
#pragma unroll
    for (int t = 0; t < 9; ++t)
#pragma unroll
        for (int r = 0; r < 4; ++r) { const float pv = exp2f(s[t][r] - m); l += pv; s[t][r] = pv; }
    l += __shfl_xor(l, 16); l += __shfl_xor(l, 32);
    l += exp2f(sinkv - m);
#pragma unroll
    for (int dt = 0; dt < 4; ++dt) o[dt] = (f32x4){0.f, 0.f, 0.f, 0.f};
#pragma unroll
    for (int ks = 0; ks < 5; ++ks) {
        u32x4 pw; pw.x = pk2(s[2 * ks][0], s[2 * ks][1]); pw.y = pk2(s[2 * ks][2], s[2 * ks][3]);
        if (ks < 4) { pw.z = pk2(s[2 * ks + 1][0], s[2 * ks + 1][1]); pw.w = pk2(s[2 * ks + 1][2], s[2 * ks + 1][3]); } else { pw.z = 0u; pw.w = 0u; }
        const bf16x8 pb = __builtin_bit_cast(bf16x8, pw);
#pragma unroll
        for (int dt = 0; dt < 4; ++dt) {
            const bf16_t* vp = Vt + (dt * 16 + fr) * VT_STRIDE + (kt0 + 2 * ks) * 16 + fq * 4;
            const u32x2 a0 = *(const u32x2*)vp; u32x2 a1 = {0u, 0u};
            if (ks < 4) a1 = *(const u32x2*)(vp + 16);
            u32x4 aw; aw.x = a0.x; aw.y = a0.y; aw.z = a1.x; aw.w = a1.y;
            o[dt] = mfma16(__builtin_bit_cast(bf16x8, aw), pb, o[dt]);
        }
    }
    const float inv = 1.f / l;
#pragma unroll
    for (int dt = 0; dt < 4; ++dt) o[dt] = o[dt] * inv;
}
__device__ __forceinline__ void norm_rope16(float (&a)[8], float (&b)[8], const float* g, const float* rp, int f, int sx1, int sx2) {
    float ss = 0.f;
#pragma unroll
    for (int j = 0; j < 8; ++j) ss += a[j] * a[j] + b[j] * b[j];
    ss += __shfl_xor(ss, sx1); ss += __shfl_xor(ss, sx2);
    const float rstd = rsqrtf(ss * (1.f / 64.f) + EPS);
#pragma unroll
    for (int j = 0; j < 8; ++j) {
        const float y1 = a[j] * rstd * g[f * 8 + j], y2 = b[j] * rstd * g[32 + f * 8 + j];
        const float c = rp[f * 8 + j], s = rp[32 + f * 8 + j];
        a[j] = y1 * c - y2 * s; b[j] = y2 * c + y1 * s;
    }
}
__device__ __forceinline__ void unpack8(const u32x4 w, float (&a)[8]) {
    a[0] = bflo(w.x); a[1] = bfhi(w.x); a[2] = bflo(w.y); a[3] = bfhi(w.y); a[4] = bflo(w.z); a[5] = bfhi(w.z); a[6] = bflo(w.w); a[7] = bfhi(w.w);
}
__device__ __forceinline__ u32x4 pack8(const float (&a)[8]) { u32x4 w; w.x = pk2(a[0], a[1]); w.y = pk2(a[2], a[3]); w.z = pk2(a[4], a[5]); w.w = pk2(a[6], a[7]); return w; }
__device__ __forceinline__ u32x4 pack8s(const float (&a)[8], float sc) { u32x4 w; w.x = pk2(a[0] * sc, a[1] * sc); w.y = pk2(a[2] * sc, a[3] * sc); w.z = pk2(a[4] * sc, a[5] * sc); w.w = pk2(a[6] * sc, a[7] * sc); return w; }

__device__ __forceinline__ void attn_rows(const Params& p, const bf16_t* Ks, const bf16_t* Vt, size_t tok, int head, int prow, int kt0, int lo, int hi, bool store, int lane) {
    const int fq = lane >> 4;
    const bf16_t* qp = (const bf16_t*)(p.ws + WS_QA) + tok * 512 + head * 64 + fq * 8;
    float a[8], b[8];
    unpack8(*(const u32x4*)qp, a); unpack8(*(const u32x4*)(qp + 32), b);
    norm_rope16(a, b, p.in[11], (const float*)(p.ws + WS_ROPE) + (size_t)prow * 64, fq, 16, 32);
    const bf16x8 qf0 = __builtin_bit_cast(bf16x8, pack8s(a, QSCALE)), qf1 = __builtin_bit_cast(bf16x8, pack8s(b, QSCALE));
    f32x4 o[4];
    attn_group(Ks, Vt, kt0, lo, hi, qf0, qf1, p.in[13][head] * LOG2E, o, lane);
    if (store) {
        const bf16_t* zp = (const bf16_t*)(p.ws + WS_ZA) + tok * 512 + head * 64 + fq * 4;
        bf16_t* op = (bf16_t*)(p.ws + WS_OA) + tok * 512 + head * 64 + fq * 4;
#pragma unroll
        for (int dt = 0; dt < 4; ++dt) { const u32x2 z = *(const u32x2*)(zp + dt * 16);
            u32x2 w; w.x = pk2(o[dt][0] * bflo(z.x), o[dt][1] * bfhi(z.x)); w.y = pk2(o[dt][2] * bflo(z.y), o[dt][3] * bfhi(z.y));
            *(u32x2*)(op + dt * 16) = w; }
    }
}

__device__ __forceinline__ void attn_prompt_unit(const Params& p, unsigned char* lds, int u) {
    bf16_t* Ks = (bf16_t*)lds; bf16_t* Vt = (bf16_t*)(lds + ATT_VT_OFF);
    const int tid = threadIdx.x, lane = tid & 63, w = tid >> 6;
    const int b = u >> 7, qb = (u & 127) >> 1, kvh = u & 1;
    const bf16_t* KA = (const bf16_t*)(p.ws + WS_KA); const bf16_t* VA = (const bf16_t*)(p.ws + WS_VA);
    const float* rope = (const float*)(p.ws + WS_ROPE);
#pragma unroll
    for (int it = 0; it < 2; ++it) {
        const int j = it * 128 + w * 16 + (lane >> 2), f = lane & 3;
        const int t = (qb - 1) * 128 + j; const int tc = t < 0 ? 0 : t;
        const bf16_t* kp = KA + ((size_t)b * SEQ + tc) * 128 + kvh * 64 + f * 8;
        float a[8], c[8];
        unpack8(*(const u32x4*)kp, a); unpack8(*(const u32x4*)(kp + 32), c);
        norm_rope16(a, c, p.in[12], rope + (size_t)tc * 64, f, 1, 2);
        if (t < 0) {
#pragma unroll
            for (int q = 0; q < 8; ++q) { a[q] = 0.f; c[q] = 0.f; } }
        *(u32x4*)(Ks + j * KS_STRIDE + f * 8) = pack8(a); *(u32x4*)(Ks + j * KS_STRIDE + 32 + f * 8) = pack8(c);
        if (t >= SEQ - 128) { float* op = p.out + O_PWK + (((size_t)b * 128 + (t - (SEQ - 128))) * 2 + kvh) * 64 + f * 8;
            *(f32x4*)op = (f32x4){a[0], a[1], a[2], a[3]}; *(f32x4*)(op + 4) = (f32x4){a[4], a[5], a[6], a[7]};
            *(f32x4*)(op + 32) = (f32x4){c[0], c[1], c[2], c[3]}; *(f32x4*)(op + 36) = (f32x4){c[4], c[5], c[6], c[7]}; }
    }
#pragma unroll
    for (int it = 0; it < 4; ++it) {
        const int idx = tid + 512 * it, j = idx >> 3, ch = idx & 7;
        const int t = (qb - 1) * 128 + j; const int tc = t < 0 ? 0 : t;
        u32x4 v = *(const u32x4*)(VA + ((size_t)b * SEQ + tc) * 128 + kvh * 64 + ch * 8);
        if (t < 0) v = (u32x4){0u, 0u, 0u, 0u};
        bf16_t* vp = Vt + (ch * 8) * VT_STRIDE + j;
        vp[0] = (bf16_t)(v.x & 0xffff); vp[VT_STRIDE] = (bf16_t)(v.x >> 16); vp[2 * VT_STRIDE] = (bf16_t)(v.y & 0xffff); vp[3 * VT_STRIDE] = (bf16_t)(v.y >> 16);
        vp[4 * VT_STRIDE] = (bf16_t)(v.z & 0xffff); vp[5 * VT_STRIDE] = (bf16_t)(v.z >> 16); vp[6 * VT_STRIDE] = (bf16_t)(v.w & 0xffff); vp[7 * VT_STRIDE] = (bf16_t)(v.w >> 16);
        if (t >= SEQ - 128) { float* op = p.out + O_PWV + (((size_t)b * 128 + (t - (SEQ - 128))) * 2 + kvh) * 64 + ch * 8;
            *(f32x4*)op = (f32x4){bflo(v.x), bfhi(v.x), bflo(v.y), bfhi(v.y)}; *(f32x4*)(op + 4) = (f32x4){bflo(v.z), bfhi(v.z), bflo(v.w), bfhi(v.w)}; }
    }
    __syncthreads();
    const int head = kvh * 4 + (w >> 1), half = w & 1;
    for (int g = 0; g < 4; ++g) {
        const int i0 = half * 64 + g * 16, i = i0 + (lane & 15), t = qb * 128 + i;
        attn_rows(p, Ks, Vt, (size_t)b * SEQ + t, head, t, i0 >> 4, qb == 0 ? 128 : i, i + 128, true, lane);
    }
    __syncthreads();
}

__device__ __forceinline__ void attn_sample_unit(const Params& p, unsigned char* lds, int u) {
    bf16_t* Ks = (bf16_t*)lds; bf16_t* Vt = (bf16_t*)(lds + ATT_VT_OFF);
    const int tid = threadIdx.x, lane = tid & 63, w = tid >> 6;
    const int sb = u >> 1, kvh = u & 1;
    const bf16_t* KA = (const bf16_t*)(p.ws + WS_KA); const bf16_t* VA = (const bf16_t*)(p.ws + WS_VA);
    const float* rope = (const float*)(p.ws + WS_ROPE);
#pragma unroll
    for (int it = 0; it < 2; ++it) {
        const int j = it * 128 + w * 16 + (lane >> 2), f = lane & 3;
        if (j < 144) {
            const int l = (j >= 128 && j < 136) ? j - 128 : 0;
            const bf16_t* kp = KA + ((size_t)MP + sb * 8 + l) * 128 + kvh * 64 + f * 8;
            float a[8], c[8];
            unpack8(*(const u32x4*)kp, a); unpack8(*(const u32x4*)(kp + 32), c);
            norm_rope16(a, c, p.in[12], rope + (size_t)(8192 + l) * 64, f, 1, 2);
            if (j < 128) { const float* cp = p.in[2] + (((size_t)sb * 128 + j) * 2 + kvh) * 64 + f * 8;
                const f32x4 c0 = *(const f32x4*)cp, c1 = *(const f32x4*)(cp + 4), c2 = *(const f32x4*)(cp + 32), c3 = *(const f32x4*)(cp + 36);
                a[0] = c0.x; a[1] = c0.y; a[2] = c0.z; a[3] = c0.w; a[4] = c1.x; a[5] = c1.y; a[6] = c1.z; a[7] = c1.w;
                c[0] = c2.x; c[1] = c2.y; c[2] = c2.z; c[3] = c2.w; c[4] = c3.x; c[5] = c3.y; c[6] = c3.z; c[7] = c3.w; }
            else if (j >= 136) {
#pragma unroll
                for (int q = 0; q < 8; ++q) { a[q] = 0.f; c[q] = 0.f; } }
            *(u32x4*)(Ks + j * KS_STRIDE + f * 8) = pack8(a); *(u32x4*)(Ks + j * KS_STRIDE + 32 + f * 8) = pack8(c);
            if (j >= 8 && j < 136) { float* op = p.out + O_SWK + (((size_t)sb * 128 + (j - 8)) * 2 + kvh) * 64 + f * 8;
                *(f32x4*)op = (f32x4){a[0], a[1], a[2], a[3]}; *(f32x4*)(op + 4) = (f32x4){a[4], a[5], a[6], a[7]};
                *(f32x4*)(op + 32) = (f32x4){c[0], c[1], c[2], c[3]}; *(f32x4*)(op + 36) = (f32x4){c[4], c[5], c[6], c[7]}; }
        }
    }
#pragma unroll
    for (int it = 0; it < 3; ++it) {
        const int idx = tid + 512 * it, j = idx >> 3, ch = idx & 7;
        if (j < 144) {
            float v[8];
            if (j < 128) { const float* cp = p.in[3] + (((size_t)sb * 128 + j) * 2 + kvh) * 64 + ch * 8;
                const f32x4 c0 = *(const f32x4*)cp, c1 = *(const f32x4*)(cp + 4);
                v[0] = c0.x; v[1] = c0.y; v[2] = c0.z; v[3] = c0.w; v[4] = c1.x; v[5] = c1.y; v[6] = c1.z; v[7] = c1.w; }
            else if (j < 136) unpack8(*(const u32x4*)(VA + ((size_t)MP + sb * 8 + (j - 128)) * 128 + kvh * 64 + ch * 8), v);
            else {
#pragma unroll
                for (int q = 0; q < 8; ++q) v[q] = 0.f; }
            const u32x4 pv = pack8(v);
            bf16_t* vp = Vt + (ch * 8) * VT_STRIDE + j;
            vp[0] = (bf16_t)(pv.x & 0xffff); vp[VT_STRIDE] = (bf16_t)(pv.x >> 16); vp[2 * VT_STRIDE] = (bf16_t)(pv.y & 0xffff); vp[3 * VT_STRIDE] = (bf16_t)(pv.y >> 16);
            vp[4 * VT_STRIDE] = (bf16_t)(pv.z & 0xffff); vp[5 * VT_STRIDE] = (bf16_t)(pv.z >> 16); vp[6 * VT_STRIDE] = (bf16_t)(pv.w & 0xffff); vp[7 * VT_STRIDE] = (bf16_t)(pv.w >> 16);
            if (j >= 8 && j < 136) { float* op = p.out + O_SWV + (((size_t)sb * 128 + (j - 8)) * 2 + kvh) * 64 + ch * 8;
                *(f32x4*)op = (f32x4){v[0], v[1], v[2], v[3]}; *(f32x4*)(op + 4) = (f32x4){v[4], v[5], v[6], v[7]}; }
        }
    }
    __syncthreads();
    if (w < 2) {
        const int q = lane & 15, l = q & 7, head = kvh * 4 + w * 2 + (q >> 3);
        attn_rows(p, Ks, Vt, (size_t)MP + sb * 8 + l, head, 8192 + l, 0, l, l + 128, true, lane);
    }
    __syncthreads();
}

constexpr int G_BC = 0, G_TOT = 16640, G_QT = 18688, G_KT = 27904, G_VT = 37120, G_ST = 55552, G_AM = 73984, G_RED = 83200;
constexpr int GS = 72;

__device__ __forceinline__ void gla_compute_b(const Params& p, unsigned char* lds, size_t tok0, int L, int h) {
    float* Bc = (float*)(lds + G_BC); float* TOT = (float*)(lds + G_TOT);
    const int tid = threadIdx.x, k = tid & 63, tg = tid >> 6;
    const float* wg = p.in[14] + h * 64 + k;
    float wr[16];
#pragma unroll
    for (int r = 0; r < 16; ++r) wr[r] = wg[r * 256];
    const float bias = p.in[15][h * 64 + k];
    const bf16_t* LR = (const bf16_t*)(p.ws + WS_LR);
    float cs[8]; float run = 0.f;
#pragma unroll
    for (int i = 0; i < 8; ++i) {
        const int tt = tg * 8 + i; float la = 0.f;
        if (tt < L) {
            const u32x4 l0 = *(const u32x4*)(LR + (tok0 + tt) * 128), l1 = *(const u32x4*)(LR + (tok0 + tt) * 128 + 8);
            float g = bias;
            g += bflo(l0.x) * wr[0] + bfhi(l0.x) * wr[1] + bflo(l0.y) * wr[2] + bfhi(l0.y) * wr[3] + bflo(l0.z) * wr[4] + bfhi(l0.z) * wr[5] + bflo(l0.w) * wr[6] + bfhi(l0.w) * wr[7];
            g += bflo(l1.x) * wr[8] + bfhi(l1.x) * wr[9] + bflo(l1.y) * wr[10] + bfhi(l1.y) * wr[11] + bflo(l1.z) * wr[12] + bfhi(l1.z) * wr[13] + bflo(l1.w) * wr[14] + bfhi(l1.w) * wr[15];
            la = (fminf(g, 0.f) - __logf(1.f + __expf(-fabsf(g)))) * (1.f / 16.f);
        }
        run += la; cs[i] = run;
    }
    TOT[tg * 64 + k] = run;
    __syncthreads();
    float pre = 0.f;
#pragma unroll
    for (int j = 0; j < 8; ++j) if (j < tg) pre += TOT[j * 64 + k];
#pragma unroll
    for (int i = 0; i < 8; ++i) Bc[(tg * 8 + i) * 65 + k] = pre + cs[i];
    __syncthreads();
}
__device__ __forceinline__ void gla_stage_vt(const Params& p, unsigned char* lds, size_t tok0, int L, int h) {
    const int tid = threadIdx.x, dv = tid & 127, t4 = tid >> 7;
    const bf16_t* VG = (const bf16_t*)(p.ws + WS_VG) + h * 128 + dv;
    unsigned w[8];
#pragma unroll
    for (int i = 0; i < 8; ++i) { const int t0 = t4 * 16 + 2 * i;
        const unsigned lo = t0 < L ? (unsigned)VG[(tok0 + t0) * 512] : 0u, hi = t0 + 1 < L ? (unsigned)VG[(tok0 + t0 + 1) * 512] : 0u;
        w[i] = lo | (hi << 16); }
    bf16_t* VT = (bf16_t*)(lds + G_VT) + dv * GS + t4 * 16;
    *(u32x4*)VT = (u32x4){w[0], w[1], w[2], w[3]}; *(u32x4*)(VT + 8) = (u32x4){w[4], w[5], w[6], w[7]};
}
__device__ __forceinline__ void gla_unit_info(int u, size_t& tok0, int& L, int& h) {
    if (u < 1024) { const int b = u >> 9, c = (u >> 2) & 127; h = u & 3; tok0 = (size_t)b * SEQ + c * 64; L = 64; }
    else { const int v = u - 1024; h = v & 3; tok0 = (size_t)MP + (v >> 2) * 8; L = 8; }
}
__device__ __forceinline__ void gla_delta_unit(const Params& p, unsigned char* lds, int u) {
    size_t tok0; int L, h; gla_unit_info(u, tok0, L, h);
    gla_compute_b(p, lds, tok0, L, h);
    const float* Bc = (const float*)(lds + G_BC);
    const int tid = threadIdx.x, lane = tid & 63, w = tid >> 6, fr = lane & 15, fq = lane >> 4;
    { const int k = tid & 63, tg = tid >> 6; const float bl = Bc[63 * 65 + k];
      const bf16_t* KG = (const bf16_t*)(p.ws + WS_KG) + h * 64 + k;
      float v[8];
#pragma unroll
      for (int i = 0; i < 8; ++i) { const int tt = tg * 8 + i; const float kv = tt < L ? bf2f(KG[(tok0 + tt) * 256]) : 0.f; v[i] = kv * __expf(bl - Bc[tt * 65 + k]); }
      *(u32x4*)((bf16_t*)(lds + G_KT) + k * GS + tg * 8) = pack8(v); }
    gla_stage_vt(p, lds, tok0, L, h);
    __syncthreads();
    const bf16_t* VT = (const bf16_t*)(lds + G_VT) + (w * 16 + fr) * GS + fq * 8;
    const bf16x8 a0 = *(const bf16x8*)VT, a1 = *(const bf16x8*)(VT + 32);
#pragma unroll
    for (int kt = 0; kt < 4; ++kt) {
        const bf16_t* KT = (const bf16_t*)(lds + G_KT) + (kt * 16 + fr) * GS + fq * 8;
        f32x4 acc = {0.f, 0.f, 0.f, 0.f};
        acc = mfma16(a0, *(const bf16x8*)KT, acc); acc = mfma16(a1, *(const bf16x8*)(KT + 32), acc);
        const int kk = kt * 16 + fr, dv = w * 16 + fq * 4;
        if (u < 1024) *(f32x4*)((float*)(p.ws + WS_DS) + (size_t)u * 8192 + kk * 128 + dv) = acc;
        else { const int v = u - 1024; const size_t so = ((size_t)v * 64 + kk) * 128 + dv;
            const float d = __expf(Bc[63 * 65 + kk]); const f32x4 s0 = *(const f32x4*)(p.in[4] + so);
            *(f32x4*)(p.out + O_SGS + so) = s0 * d + acc; }
    }
    if (u < 1024 && tid < 64) ((float*)(p.ws + WS_DEC))[(size_t)u * 64 + tid] = __expf(Bc[63 * 65 + tid]);
    __syncthreads();
}
__device__ __forceinline__ void gla_scan(const Params& p) {
    if (threadIdx.x >= 256) return;
    const int e = blockIdx.x * 256 + threadIdx.x;
    if (e >= 65536) return;
    const int b = e >> 15, h = (e >> 13) & 3, k = (e >> 7) & 63, dv = e & 127;
    float* DS = (float*)(p.ws + WS_DS); const float* DEC = (const float*)(p.ws + WS_DEC);
    float S = 0.f;
#pragma unroll 8
    for (int c = 0; c < 128; ++c) { const size_t u = (size_t)b * 512 + c * 4 + h;
        const float d = DEC[u * 64 + k]; float* sp = DS + u * 8192 + k * 128 + dv; const float ds = *sp; *sp = S; S = d * S + ds; }
    p.out[O_PGS + e] = S;
}
__device__ __forceinline__ void gla_out_unit(const Params& p, unsigned char* lds, int u) {
    size_t tok0; int L, h; gla_unit_info(u, tok0, L, h);
    gla_compute_b(p, lds, tok0, L, h);
    const float* Bc = (const float*)(lds + G_BC);
    const int tid = threadIdx.x, lane = tid & 63, w = tid >> 6, fr = lane & 15, fq = lane >> 4;
    { const int k = tid & 63, tg = tid >> 6; const float bm = Bc[31 * 65 + k];
      const bf16_t* QG = (const bf16_t*)(p.ws + WS_QG) + h * 64 + k; const bf16_t* KG = (const bf16_t*)(p.ws + WS_KG) + h * 64 + k;
      bf16_t* QT = (bf16_t*)(lds + G_QT) + k; bf16_t* KT = (bf16_t*)(lds + G_KT) + k;
#pragma unroll
      for (int i = 0; i < 8; ++i) { const int tt = tg * 8 + i; const float bb = Bc[tt * 65 + k];
          const float qv = tt < L ? bf2f(QG[(tok0 + tt) * 256]) : 0.f, kv = tt < L ? bf2f(KG[(tok0 + tt) * 256]) : 0.f;
          QT[tt * GS] = (bf16_t)(pk2(qv * __expf(bb - bm), 0.f) & 0xffff); KT[tt * GS] = (bf16_t)(pk2(kv * __expf(bm - bb), 0.f) & 0xffff); } }
    gla_stage_vt(p, lds, tok0, L, h);
    { const int dv = tid & 127, kg = tid >> 7;
      const float* Sp = (u < 1024 ? (const float*)(p.ws + WS_DS) + (size_t)u * 8192 : p.in[4] + (size_t)(u - 1024) * 8192) + dv;
      float v[16];
#pragma unroll
      for (int i = 0; i < 16; ++i) { const int kk = kg * 16 + i; v[i] = Sp[kk * 128] * __expf(Bc[31 * 65 + kk]); }
      bf16_t* ST = (bf16_t*)(lds + G_ST) + dv * GS + kg * 16;
      u32x4 w0, w1; w0.x = pk2(v[0], v[1]); w0.y = pk2(v[2], v[3]); w0.z = pk2(v[4], v[5]); w0.w = pk2(v[6], v[7]);
      w1.x = pk2(v[8], v[9]); w1.y = pk2(v[10], v[11]); w1.z = pk2(v[12], v[13]); w1.w = pk2(v[14], v[15]);
      *(u32x4*)ST = w0; *(u32x4*)(ST + 8) = w1; }
    __syncthreads();
    const int tt = w & 3, hh = w >> 2;
    const bf16_t* QTr = (const bf16_t*)(lds + G_QT) + (tt * 16 + fr) * GS + fq * 8;
    const bf16x8 bq0 = *(const bf16x8*)QTr, bq1 = *(const bf16x8*)(QTr + 32);
#pragma unroll
    for (int q = 0; q < 2; ++q) { const int st = hh * 2 + q;
        const bf16_t* KTr = (const bf16_t*)(lds + G_KT) + (st * 16 + fr) * GS + fq * 8;
        f32x4 acc = {0.f, 0.f, 0.f, 0.f};
        acc = mfma16(*(const bf16x8*)KTr, bq0, acc); acc = mfma16(*(const bf16x8*)(KTr + 32), bq1, acc);
        const int ti = tt * 16 + fr, s0 = st * 16 + fq * 4;
        u32x2 wv; wv.x = pk2(s0 <= ti ? acc[0] : 0.f, s0 + 1 <= ti ? acc[1] : 0.f); wv.y = pk2(s0 + 2 <= ti ? acc[2] : 0.f, s0 + 3 <= ti ? acc[3] : 0.f);
        *(u32x2*)((bf16_t*)(lds + G_AM) + ti * GS + s0) = wv; }
    __syncthreads();
    const bf16_t* AMr = (const bf16_t*)(lds + G_AM) + (tt * 16 + fr) * GS + fq * 8;
    const bf16x8 ba0 = *(const bf16x8*)AMr, ba1 = *(const bf16x8*)(AMr + 32);
    f32x4 o[4]; float ss = 0.f;
#pragma unroll
    for (int d4 = 0; d4 < 4; ++d4) { const int row = (hh * 4 + d4) * 16 + fr;
        const bf16_t* VT = (const bf16_t*)(lds + G_VT) + row * GS + fq * 8; const bf16_t* ST = (const bf16_t*)(lds + G_ST) + row * GS + fq * 8;
        f32x4 acc = {0.f, 0.f, 0.f, 0.f};
        acc = mfma16(*(const bf16x8*)VT, ba0, acc); acc = mfma16(*(const bf16x8*)(VT + 32), ba1, acc);
        acc = mfma16(*(const bf16x8*)ST, bq0, acc); acc = mfma16(*(const bf16x8*)(ST + 32), bq1, acc);
        o[d4] = acc; ss += (acc[0] * acc[0] + acc[1] * acc[1]) + (acc[2] * acc[2] + acc[3] * acc[3]); }
    ss += __shfl_xor(ss, 16); ss += __shfl_xor(ss, 32);
    float* RED = (float*)(lds + G_RED);
    if (fq == 0) RED[hh * 64 + tt * 16 + fr] = ss;
    __syncthreads();
    const float rstd = rsqrtf((RED[tt * 16 + fr] + RED[64 + tt * 16 + fr]) * (1.f / 128.f) + EPS);
    const int ti = tt * 16 + fr;
    if (ti < L) {
        const size_t tok = tok0 + ti;
#pragma unroll
        for (int d4 = 0; d4 < 4; ++d4) { const int dv = (hh * 4 + d4) * 16 + fq * 4;
            const f32x4 g = *(const f32x4*)(p.in[16] + dv);
            const u32x2 z = *(const u32x2*)((const bf16_t*)(p.ws + WS_ZG) + tok * 512 + h * 128 + dv);
            u32x2 wv; wv.x = pk2(o[d4][0] * rstd * g.x * bflo(z.x), o[d4][1] * rstd * g.y * bfhi(z.x));
            wv.y = pk2(o[d4][2] * rstd * g.z * bflo(z.y), o[d4][3] * rstd * g.w * bfhi(z.y));
            *(u32x2*)((bf16_t*)(p.ws + WS_OG) + tok * 512 + h * 128 + dv) = wv; }
    }
    __syncthreads();
}

__global__ void __launch_bounds__(512) mega_fwd(Params p) {
    extern __shared__ __attribute__((aligned(16))) unsigned char lds[];
    cg::grid_group grid = cg::this_grid();
    const int lo = p.ph_lo, hi = p.ph_hi;
#define IN(k) (lo <= (k) && (k) < hi)
#define SEAM(k) do { if (IN(k) && IN((k) + 1)) grid.sync(); } while (0)
    PG8_LAS unsigned char* glds = (PG8_LAS unsigned char*)lds;
    if (IN(0)) phase0(p, lds);
    SEAM(0);
    if (IN(1)) phase1(p);
    SEAM(1);
    if (IN(2)) { pg8::Gemm g{(const bf16_t*)(p.ws + WS_H), (const bf16_t*)(p.ws + WS_WIN), MT, NINP, 1024}; pg8::StaticOrder S; S.init(MT, NINP, gridDim.x, blockIdx.x);
        EpiProj E{p.ws}; pg8::gemm_phase<EpiProj, pg8::StaticOrder, true, true>(glds, g, S, E); }
    SEAM(2);
    if (IN(3)) {
        for (int u = blockIdx.x; u < 2048; u += gridDim.x) {
            if (u < 256) attn_prompt_unit(p, lds, u);
            else if (u < 512) attn_sample_unit(p, lds, u - 256);
            else gla_delta_unit(p, lds, u - 512);
        }
    }
    SEAM(3);
    if (IN(4)) gla_scan(p);
    SEAM(4);
    if (IN(5)) { for (int u = blockIdx.x; u < 1536; u += gridDim.x) gla_out_unit(p, lds, u); }
    SEAM(5);
    if (IN(6)) {
        pg8::StaticOrder S; S.init(MT, 1024, gridDim.x, blockIdx.x);
        { pg8::Gemm g{(const bf16_t*)(p.ws + WS_OA), (const bf16_t*)(p.ws + WS_WBA), MT, 1024, 512};
          EpiBranch<0> E{(const bf16_t*)(p.ws + WS_MA), nullptr, (bf16_t*)(p.ws + WS_TMP)};
          pg8::gemm_phase<EpiBranch<0>, pg8::StaticOrder, true, true>(glds, g, S, E); }
        { pg8::Gemm g{(const bf16_t*)(p.ws + WS_OG), (const bf16_t*)(p.ws + WS_WBG), MT, 1024, 512};
          EpiBranch<1> E{(const bf16_t*)(p.ws + WS_MG), (const bf16_t*)(p.ws + WS_TMP), (bf16_t*)(p.ws + WS_MRG)};
          pg8::gemm_phase<EpiBranch<1>, pg8::StaticOrder, true, true>(glds, g, S, E); }
    }
    SEAM(6);
    if (IN(7)) { pg8::Gemm g{(const bf16_t*)(p.ws + WS_MRG), (const bf16_t*)(p.ws + WS_WOUT), MT, 1024, 1024}; pg8::StaticOrder S; S.init(MT, 1024, gridDim.x, blockIdx.x);
        EpiOut E{p.in[0], p.in[1], (const float*)(p.ws + WS_MOD), p.out + O_Y};
        pg8::gemm_phase<EpiOut, pg8::StaticOrder, true, true>(glds, g, S, E); }
#undef IN
#undef SEAM
}

constexpr int LDS_BYTES = 131072;
#ifndef N_LAUNCH_MODE
#define N_LAUNCH_MODE 8
#endif

extern "C" void kernel_launch(void* const* d_in, const int* in_sizes, int n_in, void* d_out, int out_size, void* d_ws, size_t ws_size, hipStream_t stream) {
    static int grid = 0;
    if (grid == 0) {
        if (n_in != 20 || ws_size < WS_END) { fprintf(stderr, "kernel_launch: unexpected n_in %d / ws_size %zu (need %zu)\n", n_in, ws_size, (size_t)WS_END); grid = -1; return; }
        int dev = 0, cus = 0, per_cu = 0;
        hipGetDevice(&dev);
        hipDeviceGetAttribute(&cus, hipDeviceAttributeMultiprocessorCount, dev);
        if (hipFuncSetAttribute((const void*)mega_fwd, hipFuncAttributeMaxDynamicSharedMemorySize, LDS_BYTES) != hipSuccess) { fprintf(stderr, "kernel_launch: hipFuncSetAttribute failed\n"); grid = -1; return; }
        if (hipOccupancyMaxActiveBlocksPerMultiprocessor(&per_cu, (const void*)mega_fwd, 512, LDS_BYTES) != hipSuccess || per_cu < 1) { fprintf(stderr, "kernel_launch: occupancy query gives %d\n", per_cu); per_cu = 1; }
        (void)hipGetLastError();
        grid = cus * 1;
        if (grid > cus * per_cu) grid = cus * per_cu;
    }
    if (grid < 0) return;
    Params p{};
    for (int i = 0; i < 20; ++i) p.in[i] = (const float*)d_in[i];
    p.out = (float*)d_out; p.ws = (unsigned char*)d_ws;
    for (int i = 0; i < 32; ++i) { const float e = (float)i / 32.0f; const float pw = powf(10000.0f, e); p.inv[i] = 1.0f / pw; }
#if N_LAUNCH_MODE == 1
    p.ph_lo = 0; p.ph_hi = 8;
    void* args[] = {&p};
    hipError_t e = hipLaunchCooperativeKernel((const void*)mega_fwd, dim3(grid), dim3(512), args, LDS_BYTES, stream);
    if (e != hipSuccess) fprintf(stderr, "cooperative launch failed: %s (grid %d)\n", hipGetErrorString(e), grid);
#else
    for (int ph = 0; ph < 8; ++ph) { p.ph_lo = ph; p.ph_hi = ph + 1;
        hipLaunchKernelGGL(mega_fwd, dim3(grid), dim3(512), LDS_BYTES, stream, p); }
#endif
}
```

```cpp
#include <hip/hip_runtime.h>
#include <hip/hip_cooperative_groups.h>
#include <cstdio>
#include <cstdint>
#include <cmath>
namespace cg = cooperative_groups;
namespace pg8 {
#define PG8_LAS __attribute__((address_space(3)))
typedef unsigned short bf16_t;
typedef short bf16x8 __attribute__((ext_vector_type(8)));
typedef float f32x4 __attribute__((ext_vector_type(4)));
typedef unsigned u32x4 __attribute__((ext_vector_type(4)));
constexpr int BM = 256, BK = 64, HALF = 128, HTB = HALF * BK * 2  , STAGE_BYTES = 8 * HTB, NXCD = 8, WGM = 8;

__host__ __device__ __forceinline__ int lds_byte(int r, int c) { const int st = (r >> 4) * 2 + (c >> 5), rr = r & 15, cc = c & 31, ob = rr * 64 + cc * 2; return st * 1024 + (ob ^ (((ob >> 9) & 1) << 5)); }
__host__ __device__ __forceinline__ void stage_rc(int b, int& R, int& C) { const int st = b / 1024, sb = b % 1024, swz = sb ^ (((sb >> 9) & 1) << 5); R = (st >> 1) * 16 + swz / 64; C = (st & 1) * 32 + (swz % 64) / 2; }
__host__ __device__ __forceinline__ int perm32(int rho) { const int n = rho >> 4, i = rho & 15; return 8 * (i >> 2) + 4 * n + (i & 3); }

struct Unit { int pm, pn; };
struct Gemm { const bf16_t* A; const bf16_t* Bt; int M, N, K; };

struct StaticOrder {
    int nM, nN, nwg, G, c;
    __host__ __device__ void init(int M, int N, int G_, int c_) { nM = M / BM; nN = N / BM; nwg = nM * nN; G = G_; c = c_; }
    __host__ __device__ bool next(int i, Unit& u) const {
        const long L = (long)i * G + c; if (L >= nwg) return false;
        int wgid = (int)L; { const int q = nwg / NXCD, r = nwg % NXCD, xcd = wgid % NXCD, off = wgid / NXCD; wgid = (xcd < r ? xcd * (q + 1) : r * (q + 1) + (xcd - r) * q) + off; }
        const int nig = WGM * nN, gid = wgid / nig, fm = gid * WGM, gsz = (nM - fm) < WGM ? (nM - fm) : WGM;
        u.pm = fm + ((wgid % nig) % gsz); u.pn = (wgid % nig) / gsz; return true;
    }
    __device__ __forceinline__ void a_ready(const Unit&) const {}
    __device__ __forceinline__ void done(const Unit&) const {}
};
__device__ __forceinline__ unsigned cvt_pk_bf16(float lo, float hi) { unsigned r; asm volatile("v_cvt_pk_bf16_f32 %0, %1, %2" : "=v"(r) : "v"(lo), "v"(hi)); return r; }
typedef float f32x2 __attribute__((ext_vector_type(2)));
template <class Epi, class Sched, bool ALIGN_EPI = false, bool SP2 = false>
__device__ __forceinline__ void gemm_phase(PG8_LAS unsigned char* lds, const Gemm g, const Sched& S, const Epi& E) {
    const int tid = threadIdx.x, wid = __builtin_amdgcn_readfirstlane(tid >> 6), lane = tid & 63, wr = wid >> 2, wc = wid & 3, fr = lane & 15, fq = lane >> 4;
    const int K = g.K, nt = K / BK;
    unsigned voffA[2], voffB[2];
#pragma unroll
    for (int i = 0; i < 2; ++i) { int R, C; stage_rc(tid * 16 + i * 8192, R, C); const int Rb = Epi::PERM ? ((R & ~31) + perm32(R & 31)) : R;
        voffA[i] = (unsigned)(R * K + C) * 2u; voffB[i] = (unsigned)(Rb * K + C) * 2u; }
    const size_t kstep = (size_t)(BK * 2);
    const size_t hstep = (size_t)HALF * K * 2;
    const size_t tstep = 2 * hstep;
    const unsigned ldsw = (unsigned)wid * 1024u;
    const int aoff = lds_byte(wr * 64 + fr, fq * 8), boff = lds_byte(wc * 32 + fr, fq * 8);
#define PG8_SA(b, h) (((b) * 2 + (h)) * HTB)
#define PG8_SB(b, h) ((4 + (b) * 2 + (h)) * HTB)
#define PG8_STAGE(bufoff, gbase, voff) do { _Pragma("unroll") for (int _i = 0; _i < 2; ++_i) \
        __builtin_amdgcn_global_load_lds((const unsigned*)((const char*)(gbase) + (voff)[_i]), (PG8_LAS unsigned*)(lds + (bufoff) + ldsw + _i * 8192), 16, 0, 0); } while (0)
#define PG8_LDA(dst, b, h) do { _Pragma("unroll") for (int m = 0; m < 4; ++m) _Pragma("unroll") for (int k = 0; k < 2; ++k) dst[m][k] = *(const PG8_LAS bf16x8*)(lds + PG8_SA(b, h) + aoff + m * 2048 + k * 1024); } while (0)
#define PG8_LDB(dst, b, h) do { _Pragma("unroll") for (int n = 0; n < 2; ++n) _Pragma("unroll") for (int k = 0; k < 2; ++k) dst[n][k] = *(const PG8_LAS bf16x8*)(lds + PG8_SB(b, h) + boff + n * 2048 + k * 1024); } while (0)
#define PG8_MMA(ai, bj, At, Bt) do { __builtin_amdgcn_s_setprio(1); _Pragma("unroll") for (int m = 0; m < 4; ++m) _Pragma("unroll") for (int n = 0; n < 2; ++n) _Pragma("unroll") for (int k = 0; k < 2; ++k) \
        acc[ai][bj][m][n] = __builtin_amdgcn_mfma_f32_16x16x32_bf16(Bt[n][k], At[m][k], acc[ai][bj][m][n], 0, 0, 0); __builtin_amdgcn_s_setprio(0); } while (0)
#define PG8_WAIT_V(n) asm volatile("s_waitcnt vmcnt(" #n ")" ::: "memory")
#define PG8_WAIT_L(n) asm volatile("s_waitcnt lgkmcnt(" #n ")" ::: "memory")
#define PG8_BAR __builtin_amdgcn_s_barrier()
#define PG8_SCHED __builtin_amdgcn_sched_barrier(0)
    Unit cur, nxt; int ui = 0;
    if (!S.next(0, cur)) return;
    f32x4 acc[2][2][4][2];
#pragma unroll
    for (int a = 0; a < 2; ++a)
#pragma unroll
        for (int b = 0; b < 2; ++b)
#pragma unroll
            for (int m = 0; m < 4; ++m)
#pragma unroll
                for (int n = 0; n < 2; ++n) acc[a][b][m][n] = (f32x4){0.f, 0.f, 0.f, 0.f};
    bf16x8 At[4][2], B0[2][2], B1[2][2];
    const char* cA = (const char*)g.A + (size_t)cur.pm * tstep; const char* cB = (const char*)g.Bt + (size_t)cur.pn * tstep;
    S.a_ready(cur);
    if constexpr (SP2) {
        PG8_STAGE(PG8_SB(0, 0), cB, voffB); PG8_STAGE(PG8_SB(0, 1), cB + hstep, voffB); PG8_STAGE(PG8_SA(0, 0), cA, voffA); PG8_STAGE(PG8_SA(0, 1), cA + hstep, voffA);
        if (wr == 1) PG8_BAR;
        PG8_WAIT_V(2); PG8_BAR;
        PG8_STAGE(PG8_SB(1, 0), cB + kstep, voffB); PG8_STAGE(PG8_SA(1, 0), cA + kstep, voffA); PG8_STAGE(PG8_SB(1, 1), cB + hstep + kstep, voffB);
        PG8_WAIT_V(6); PG8_BAR;
    } else {
        PG8_STAGE(PG8_SB(0, 0), cB, voffB); PG8_STAGE(PG8_SA(0, 0), cA, voffA); PG8_STAGE(PG8_SB(0, 1), cB + hstep, voffB); PG8_STAGE(PG8_SA(0, 1), cA + hstep, voffA);
        if (wr == 1) PG8_BAR;
        PG8_WAIT_V(4); PG8_BAR;
        PG8_STAGE(PG8_SB(1, 0), cB + kstep, voffB); PG8_STAGE(PG8_SA(1, 0), cA + kstep, voffA); PG8_STAGE(PG8_SB(1, 1), cB + hstep + kstep, voffB);
        PG8_WAIT_V(6); PG8_BAR;
    }
    for (;;) {
        const bool has_next = S.next(ui + 1, nxt);
        const char* nA = has_next ? (const char*)g.A + (size_t)nxt.pm * tstep : cA; const char* nB = has_next ? (const char*)g.Bt + (size_t)nxt.pn * tstep : cB;
        for (int t = 0; t < nt; t += 2) {
            const bool last = (t == nt - 2);
            const char* a1 = cA + (size_t)(t + 1) * kstep;
            const char* a2 = last ? nA : cA + (size_t)(t + 2) * kstep; const char* b2 = last ? nB : cB + (size_t)(t + 2) * kstep;
            const char* a3 = a2 + kstep; const char* b3 = b2 + kstep;
            if (last && has_next) S.a_ready(nxt);
            if constexpr (SP2) {
            PG8_LDB(B0, 0, 0); PG8_LDB(B1, 0, 1); PG8_SCHED; PG8_LDA(At, 0, 0); PG8_STAGE(PG8_SA(1, 1), a1 + hstep, voffA);
            PG8_WAIT_V(8); PG8_WAIT_L(0); PG8_BAR; PG8_MMA(0, 0, At, B0); PG8_MMA(0, 1, At, B1); PG8_BAR; PG8_SCHED;
            PG8_LDA(At, 0, 1); PG8_STAGE(PG8_SB(0, 0), b2, voffB); PG8_STAGE(PG8_SB(0, 1), b2 + hstep, voffB); PG8_STAGE(PG8_SA(0, 0), a2, voffA);
            PG8_WAIT_V(8); PG8_WAIT_L(0); PG8_BAR; PG8_MMA(1, 0, At, B0); PG8_MMA(1, 1, At, B1); PG8_BAR; PG8_SCHED;
            PG8_LDB(B0, 1, 0); PG8_LDB(B1, 1, 1); PG8_SCHED; PG8_LDA(At, 1, 0); PG8_STAGE(PG8_SA(0, 1), a2 + hstep, voffA);
            PG8_WAIT_V(8); PG8_WAIT_L(0); PG8_BAR; PG8_MMA(0, 0, At, B0); PG8_MMA(0, 1, At, B1); PG8_BAR; PG8_SCHED;
            PG8_LDA(At, 1, 1); PG8_STAGE(PG8_SB(1, 0), b3, voffB); PG8_STAGE(PG8_SB(1, 1), b3 + hstep, voffB); PG8_STAGE(PG8_SA(1, 0), a3, voffA);
            PG8_WAIT_V(8); PG8_WAIT_L(0); PG8_BAR; PG8_MMA(1, 0, At, B0); PG8_MMA(1, 1, At, B1); PG8_BAR; PG8_SCHED;
            } else {
            PG8_LDB(B0, 0, 0); PG8_SCHED; PG8_LDA(At, 0, 0); PG8_STAGE(PG8_SA(1, 1), a1 + hstep, voffA);
            PG8_WAIT_L(8); PG8_BAR; PG8_WAIT_L(0); PG8_MMA(0, 0, At, B0); PG8_BAR; PG8_SCHED;
            PG8_LDB(B1, 0, 1); PG8_STAGE(PG8_SB(0, 0), b2, voffB);
            PG8_BAR; PG8_WAIT_L(0); PG8_MMA(0, 1, At, B1); PG8_BAR;
            PG8_LDA(At, 0, 1); PG8_STAGE(PG8_SA(0, 0), a2, voffA);
            PG8_BAR; PG8_WAIT_L(0); PG8_MMA(1, 0, At, B0); PG8_BAR; PG8_SCHED;
            PG8_STAGE(PG8_SB(0, 1), b2 + hstep, voffB);
            PG8_WAIT_V(6); PG8_BAR; PG8_MMA(1, 1, At, B1); PG8_BAR;
            PG8_LDB(B0, 1, 0); PG8_SCHED; PG8_LDA(At, 1, 0); PG8_STAGE(PG8_SA(0, 1), a2 + hstep, voffA);
            PG8_WAIT_L(8); PG8_BAR; PG8_WAIT_L(0); PG8_MMA(0, 0, At, B0); PG8_BAR; PG8_SCHED;
            PG8_LDB(B1, 1, 1); PG8_STAGE(PG8_SB(1, 0), b3, voffB);
            PG8_BAR; PG8_WAIT_L(0); PG8_MMA(0, 1, At, B1); PG8_BAR;
            PG8_LDA(At, 1, 1); PG8_STAGE(PG8_SA(1, 0), a3, voffA);
            PG8_BAR; PG8_WAIT_L(0); PG8_MMA(1, 0, At, B0); PG8_BAR; PG8_SCHED;
            PG8_STAGE(PG8_SB(1, 1), b3 + hstep, voffB);
            PG8_WAIT_V(6); PG8_BAR; PG8_MMA(1, 1, At, B1); PG8_BAR;
            }
        }
        if constexpr (ALIGN_EPI) { if (wr == 0) PG8_BAR; }
        if constexpr (!Epi::AFTER_DRAIN) { E(acc, cur, wr, wc, fr, fq); S.done(cur); }
        if (!has_next) break;
#pragma unroll
        for (int a = 0; a < 2; ++a)
#pragma unroll
            for (int b = 0; b < 2; ++b)
#pragma unroll
                for (int m = 0; m < 4; ++m)
#pragma unroll
                    for (int n = 0; n < 2; ++n) acc[a][b][m][n] = (f32x4){0.f, 0.f, 0.f, 0.f};
        cur = nxt; cA = nA; cB = nB; ++ui;
        if constexpr (ALIGN_EPI) { if (wr == 1) PG8_BAR; }
    }
    PG8_WAIT_V(0);
    if constexpr (!ALIGN_EPI) { if (wr == 0) PG8_BAR; }
    PG8_BAR;
    if constexpr (Epi::AFTER_DRAIN) { E.fused(acc, cur, wr, wc, fr, fq, lds, wid, lane); S.done(cur); }
#undef PG8_SA
#undef PG8_SB
#undef PG8_STAGE
#undef PG8_LDA
#undef PG8_LDB
#undef PG8_MMA
#undef PG8_WAIT_V
#undef PG8_WAIT_L
#undef PG8_BAR
#undef PG8_SCHED
}
}

using pg8::bf16_t; using pg8::bf16x8; using pg8::f32x4; using pg8::u32x4; using pg8::Unit;
typedef unsigned u32x2 __attribute__((ext_vector_type(2)));
typedef float f32x2v __attribute__((ext_vector_type(2)));
typedef __bf16 bf16x2v __attribute__((ext_vector_type(2)));

constexpr int DM = 1024, SEQ = 8192, MP = 16384, MS = 1024, MT = MP + MS;
constexpr int NIN = 4880, NINP = 5120;
constexpr float EPS = 1e-6f;
constexpr float LOG2E = 1.4426950408889634f;

constexpr size_t WS_MOD = 0;
constexpr size_t WS_ROPE = WS_MOD + 1597440;
constexpr size_t WS_WIN = WS_ROPE + 2099200;
constexpr size_t WS_WBA = WS_WIN + 10485760;
constexpr size_t WS_WBG = WS_WBA + 1048576;
constexpr size_t WS_WOUT = WS_WBG + 1048576;
constexpr size_t WS_H = WS_WOUT + 2097152;
constexpr size_t WS_OA = WS_H;
constexpr size_t WS_OG = WS_H + 17825792;
constexpr size_t WS_QA = WS_H + 35651584;
constexpr size_t WS_KA = WS_QA + 17825792;
constexpr size_t WS_VA = WS_KA + 4456448;
constexpr size_t WS_QG = WS_VA + 4456448;
constexpr size_t WS_TMP = WS_QA;
constexpr size_t WS_KG = WS_QG + 8912896;
constexpr size_t WS_VG = WS_KG + 8912896;
constexpr size_t WS_ZG = WS_VG + 17825792;
constexpr size_t WS_MRG = WS_KG;
constexpr size_t WS_ZA = WS_ZG + 17825792;
constexpr size_t WS_MA = WS_ZA + 17825792;
constexpr size_t WS_MG = WS_MA + 35651584;
constexpr size_t WS_LR = WS_MG + 35651584;
constexpr size_t WS_DS = WS_LR + 4456448;
constexpr size_t WS_DEC = WS_DS + 33554432;
constexpr size_t WS_END = WS_DEC + 262144;

constexpr size_t O_Y = 0;
constexpr size_t O_PWK = 17825792;
constexpr size_t O_PWV = O_PWK + 32768;
constexpr size_t O_PGS = O_PWV + 32768;
constexpr size_t O_SWK = O_PGS + 65536;
constexpr size_t O_SWV = O_SWK + 2097152;
constexpr size_t O_SGS = O_SWV + 2097152;

struct Params {
    const float* in[20];
    float* out; unsigned char* ws;
    float inv[32];
    int ph_lo, ph_hi;
};

__device__ __forceinline__ unsigned pk2(float lo, float hi) { f32x2v v = {lo, hi}; bf16x2v b = __builtin_convertvector(v, bf16x2v); return __builtin_bit_cast(unsigned, b); }
__device__ __forceinline__ float bflo(unsigned w) { return __uint_as_float(w << 16); }
__device__ __forceinline__ float bfhi(unsigned w) { return __uint_as_float(w & 0xffff0000u); }
__device__ __forceinline__ float bf2f(bf16_t h) { return __uint_as_float((unsigned)h << 16); }
__device__ __forceinline__ float fast_rcp(float x) { return __builtin_amdgcn_rcpf(x); }
__device__ __forceinline__ float sigmoidf_(float x) { return fast_rcp(1.f + __expf(-x)); }
__device__ __forceinline__ float siluf_(float x) { return x * fast_rcp(1.f + __expf(-x)); }
__device__ __forceinline__ float wave_sum(float v) {
#pragma unroll
    for (int o = 1; o < 64; o <<= 1) v += __shfl_xor(v, o);
    return v;
}
__device__ __forceinline__ f32x4 mfma16(bf16x8 a, bf16x8 b, f32x4 c) { return __builtin_amdgcn_mfma_f32_16x16x32_bf16(a, b, c, 0, 0, 0); }
__device__ __forceinline__ int mod_row(int r) { return r < MP ? (r >> 13) : 2 + ((r - MP) >> 3); }

struct EpiProj {
    static constexpr bool PERM = true, AFTER_DRAIN = false;
    unsigned char* ws;
    __device__ __forceinline__ void operator()(const f32x4 (&acc)[2][2][4][2], const Unit& u, int wr, int wc, int fr, int fq) const {
        const int row0 = u.pm * 256 + wr * 64 + fr;
#pragma unroll
        for (int bj = 0; bj < 2; ++bj) {
            const int cb = u.pn * 2 + bj;
            size_t off; int ld, cbase, act;
            if (cb < 4) { off = WS_QA; ld = 512; cbase = cb * 128; act = 0; }
            else if (cb == 4) { off = WS_KA; ld = 128; cbase = 0; act = 0; }
            else if (cb == 5) { off = WS_VA; ld = 128; cbase = 0; act = 0; }
            else if (cb < 10) { off = WS_ZA; ld = 512; cbase = (cb - 6) * 128; act = 1; }
            else if (cb < 12) { off = WS_QG; ld = 256; cbase = (cb - 10) * 128; act = 3; }
            else if (cb < 14) { off = WS_KG; ld = 256; cbase = (cb - 12) * 128; act = 0; }
            else if (cb < 18) { off = WS_VG; ld = 512; cbase = (cb - 14) * 128; act = 0; }
            else if (cb < 22) { off = WS_ZG; ld = 512; cbase = (cb - 18) * 128; act = 1; }
            else if (cb < 30) { off = WS_MA; ld = 1024; cbase = (cb - 22) * 128; act = 2; }
            else if (cb < 38) { off = WS_MG; ld = 1024; cbase = (cb - 30) * 128; act = 2; }
            else if (cb == 38) { off = WS_LR; ld = 128; cbase = 0; act = 0; }
            else continue;
            bf16_t* base = (bf16_t*)(ws + off) + cbase + wc * 32 + 8 * fq;
#pragma unroll
            for (int ai = 0; ai < 2; ++ai)
#pragma unroll
                for (int m = 0; m < 4; ++m) {
                    f32x4 v0 = acc[ai][bj][m][0], v1 = acc[ai][bj][m][1];
                    if (act == 1) { for (int j = 0; j < 4; ++j) { v0[j] = siluf_(v0[j]); v1[j] = siluf_(v1[j]); } }
                    else if (act == 2) { for (int j = 0; j < 4; ++j) { v0[j] = sigmoidf_(v0[j]); v1[j] = sigmoidf_(v1[j]); } }
                    else if (act == 3) { v0 = v0 * 0.125f; v1 = v1 * 0.125f; }
                    u32x4 w; w.x = pk2(v0[0], v0[1]); w.y = pk2(v0[2], v0[3]); w.z = pk2(v1[0], v1[1]); w.w = pk2(v1[2], v1[3]);
                    *(u32x4*)(base + (size_t)(row0 + ai * 128 + m * 16) * ld) = w;
                }
        }
    }
};
template <int MODE> struct EpiBranch {
    static constexpr bool PERM = true, AFTER_DRAIN = false;
    const bf16_t* gate; const bf16_t* prev; bf16_t* dst;
    __device__ __forceinline__ void operator()(const f32x4 (&acc)[2][2][4][2], const Unit& u, int wr, int wc, int fr, int fq) const {
        const int row0 = u.pm * 256 + wr * 64 + fr, col0 = u.pn * 256 + wc * 32 + 8 * fq;
#pragma unroll
        for (int ai = 0; ai < 2; ++ai)
#pragma unroll
            for (int m = 0; m < 4; ++m)
#pragma unroll
                for (int bj = 0; bj < 2; ++bj) {
                    const size_t o = (size_t)(row0 + ai * 128 + m * 16) * 1024 + col0 + bj * 128;
                    const u32x4 g = *(const u32x4*)(gate + o);
                    f32x4 v0 = acc[ai][bj][m][0], v1 = acc[ai][bj][m][1];
                    v0[0] *= bflo(g.x); v0[1] *= bfhi(g.x); v0[2] *= bflo(g.y); v0[3] *= bfhi(g.y);
                    v1[0] *= bflo(g.z); v1[1] *= bfhi(g.z); v1[2] *= bflo(g.w); v1[3] *= bfhi(g.w);
                    if (MODE == 1) { const u32x4 t = *(const u32x4*)(prev + o);
                        v0[0] += bflo(t.x); v0[1] += bfhi(t.x); v0[2] += bflo(t.y); v0[3] += bfhi(t.y);
                        v1[0] += bflo(t.z); v1[1] += bfhi(t.z); v1[2] += bflo(t.w); v1[3] += bfhi(t.w); }
                    u32x4 w; w.x = pk2(v0[0], v0[1]); w.y = pk2(v0[2], v0[3]); w.z = pk2(v1[0], v1[1]); w.w = pk2(v1[2], v1[3]);
                    *(u32x4*)(dst + o) = w;
                }
    }
};
struct EpiOut {
    static constexpr bool PERM = false, AFTER_DRAIN = false;
    const float* xp; const float* xs; const float* mod; float* out;
    __device__ __forceinline__ void operator()(const f32x4 (&acc)[2][2][4][2], const Unit& u, int wr, int wc, int fr, int fq) const {
        const int col0 = u.pn * 256 + wc * 32 + 4 * fq;
#pragma unroll
        for (int ai = 0; ai < 2; ++ai)
#pragma unroll
            for (int m = 0; m < 4; ++m) {
                const int row = u.pm * 256 + ai * 128 + wr * 64 + m * 16 + fr;
                const float* xrow = row < MP ? xp + (size_t)row * 1024 : xs + (size_t)(row - MP) * 1024;
                const float* grow = mod + (size_t)mod_row(row) * 3072 + 2048;
                float* orow = out + (size_t)row * 1024;
#pragma unroll
                for (int bj = 0; bj < 2; ++bj)
#pragma unroll
                    for (int n = 0; n < 2; ++n) { const int c = col0 + bj * 128 + n * 16;
                        const f32x4 x4 = *(const f32x4*)(xrow + c), g4 = *(const f32x4*)(grow + c);
                        *(f32x4*)(orow + c) = x4 + g4 * acc[ai][bj][m][n]; }
            }
    }
};

__device__ __forceinline__ void p0_ada(const Params& p, unsigned char* lds, int unit) {
    float* sc = (float*)lds;
    const int tid = threadIdx.x, col = tid & 31, rg = tid >> 5;
    const int c0 = unit * 32;
    const float* w = p.in[8];
    float acc[9];
#pragma unroll
    for (int i = 0; i < 9; ++i) acc[i] = 0.f;
    for (int kc = 0; kc < 8; ++kc) {
        __syncthreads();
        for (int e = tid; e < 130 * 128; e += 512) { const int r = e >> 7, k = e & 127;
            const float* cp = r < 2 ? p.in[5] + r * 1024 : p.in[6] + (r - 2) * 1024;
            const float v = cp[kc * 128 + k]; sc[r * 132 + k] = v / (1.f + __expf(-v)); }
        __syncthreads();
        for (int k4 = 0; k4 < 32; ++k4) {
            const float* wp = w + (size_t)(kc * 128 + k4 * 4) * 3072 + c0 + col;
            const float w0 = wp[0], w1 = wp[3072], w2 = wp[6144], w3 = wp[9216];
#pragma unroll
            for (int i = 0; i < 9; ++i) { const int r = min(rg + 16 * i, 129); const f32x4 s = *(const f32x4*)(sc + r * 132 + k4 * 4);
                acc[i] += s.x * w0 + s.y * w1 + s.z * w2 + s.w * w3; }
        }
    }
    float* mod = (float*)(p.ws + WS_MOD);
    const float bias = p.in[9][c0 + col];
#pragma unroll
    for (int i = 0; i < 9; ++i) { const int r = rg + 16 * i; if (r < 130) mod[(size_t)r * 3072 + c0 + col] = acc[i] + bias; }
    __syncthreads();
}
__device__ __forceinline__ void p0_transpose(const float* src, int N, int n0, int nvalid, bf16_t* dst, int K, int n0p, int k0, unsigned char* lds) {
    float* t = (float*)lds;
    const int tid = threadIdx.x;
#pragma unroll
    for (int i = 0; i < 2; ++i) { const int idx = tid + 512 * i, r = idx >> 4, c4 = (idx & 15) * 4;
        f32x4 v = {0.f, 0.f, 0.f, 0.f};
        if (c4 < nvalid) v = *(const f32x4*)(src + (size_t)(k0 + r) * N + n0 + c4);
        t[r * 65 + c4] = v.x; t[r * 65 + c4 + 1] = v.y; t[r * 65 + c4 + 2] = v.z; t[r * 65 + c4 + 3] = v.w; }
    __syncthreads();
    { const int c = tid >> 3, r8 = (tid & 7) * 8; const float* s = t + r8 * 65 + c;
      u32x4 o; o.x = pk2(s[0], s[65]); o.y = pk2(s[130], s[195]); o.z = pk2(s[260], s[325]); o.w = pk2(s[390], s[455]);
      *(u32x4*)(dst + (size_t)(n0p + c) * K + k0 + r8) = o; }
    __syncthreads();
}
__device__ __forceinline__ void p0_rope(const Params& p, int unit) {
    float* rope = (float*)(p.ws + WS_ROPE);
#pragma unroll
    for (int q = 0; q < 4; ++q) { const int e = unit * 2048 + q * 512 + threadIdx.x;
        if (e < 8200 * 32) { const int pp = e >> 5, i = e & 31; const int pos = pp < 8192 ? pp : pp + 8192;
            const float ang = (float)pos * p.inv[i];
            const double a = (double)ang; const double n = rint(a * 0.15915494309189535);
            const float r = (float)fma(-n, 6.283185307179586, a);
            rope[(size_t)pp * 64 + i] = __cosf(r); rope[(size_t)pp * 64 + 32 + i] = __sinf(r); } }
}
__device__ __forceinline__ void phase0(const Params& p, unsigned char* lds) {
    constexpr int N_ADA = 96, N_TIN = 1280, N_TB = 128, N_TO = 256, N_ROPE = 129;
    constexpr int TOT = N_ADA + N_TIN + 2 * N_TB + N_TO + N_ROPE;
    for (int it = blockIdx.x; it < TOT; it += gridDim.x) {
        int r = it;
        if (r < N_ADA) { p0_ada(p, lds, r); continue; } r -= N_ADA;
        if (r < N_TIN) { const int kt = r / 80, nt = r % 80; int n0, nv;
            if (nt < 36) { n0 = nt * 64; nv = 64; } else if (nt < 76) { n0 = nt * 64 + 16; nv = 64; } else if (nt == 76) { n0 = 2304; nv = 16; } else { n0 = 0; nv = 0; }
            p0_transpose(p.in[10], NIN, n0, nv, (bf16_t*)(p.ws + WS_WIN), 1024, nt * 64, kt * 64, lds); continue; } r -= N_TIN;
        if (r < N_TB) { p0_transpose(p.in[17], 1024, (r % 16) * 64, 64, (bf16_t*)(p.ws + WS_WBA), 512, (r % 16) * 64, (r / 16) * 64, lds); continue; } r -= N_TB;
        if (r < N_TB) { p0_transpose(p.in[18], 1024, (r % 16) * 64, 64, (bf16_t*)(p.ws + WS_WBG), 512, (r % 16) * 64, (r / 16) * 64, lds); continue; } r -= N_TB;
        if (r < N_TO) { p0_transpose(p.in[19], 1024, (r % 16) * 64, 64, (bf16_t*)(p.ws + WS_WOUT), 1024, (r % 16) * 64, (r / 16) * 64, lds); continue; } r -= N_TO;
        p0_rope(p, r);
    }
}

__device__ __forceinline__ void phase1(const Params& p) {
    const int lane = threadIdx.x & 63, wave = threadIdx.x >> 6;
    const float* mod = (const float*)(p.ws + WS_MOD);
    bf16_t* H = (bf16_t*)(p.ws + WS_H);
    for (int r = blockIdx.x * 8 + wave; r < MT; r += gridDim.x * 8) {
        const float* xrow = r < MP ? p.in[0] + (size_t)r * 1024 : p.in[1] + (size_t)(r - MP) * 1024;
        const float* mr = mod + (size_t)mod_row(r) * 3072;
        f32x4 v[4]; float ss = 0.f;
#pragma unroll
        for (int j = 0; j < 4; ++j) { v[j] = *(const f32x4*)(xrow + 4 * lane + 256 * j); ss += (v[j].x * v[j].x + v[j].y * v[j].y) + (v[j].z * v[j].z + v[j].w * v[j].w); }
        const float rstd = rsqrtf(wave_sum(ss) * (1.f / 1024.f) + EPS);
#pragma unroll
        for (int j = 0; j < 4; ++j) { const int c = 4 * lane + 256 * j;
            const f32x4 g = *(const f32x4*)(p.in[7] + c), sh = *(const f32x4*)(mr + c), sc = *(const f32x4*)(mr + 1024 + c);
            const f32x4 h = v[j] * rstd * g * (sc + 1.f) + sh;
            u32x2 w; w.x = pk2(h.x, h.y); w.y = pk2(h.z, h.w);
            *(u32x2*)(H + (size_t)r * 1024 + c) = w; }
    }
}

constexpr int KS_STRIDE = 72, VT_STRIDE = 264, ATT_VT_OFF = 256 * 72 * 2;
constexpr float QSCALE = 0.125f * LOG2E;

__device__ __forceinline__ void attn_group(const bf16_t* Ks, const bf16_t* Vt, int kt0, int lo, int hi, bf16x8 qf0, bf16x8 qf1, float sinkv, f32x4 (&o)[4], int lane) {
    const int fr = lane & 15, fq = lane >> 4;
    f32x4 s[9];
#pragma unroll
    for (int t = 0; t < 9; ++t) {
        const bf16_t* kp = Ks + ((kt0 + t) * 16 + fr) * KS_STRIDE + fq * 8;
        const bf16x8 k0 = *(const bf16x8*)kp, k1 = *(const bf16x8*)(kp + 32);
        f32x4 a = {0.f, 0.f, 0.f, 0.f};
        a = mfma16(k0, qf0, a); a = mfma16(k1, qf1, a);
        s[t] = a;
    }
    float m = sinkv;
#pragma unroll
    for (int t = 0; t < 9; ++t)
#pragma unroll
        for (int r = 0; r < 4; ++r) { const int j = (kt0 + t) * 16 + fq * 4 + r; const float v = (j >= lo && j <= hi) ? s[t][r] : -1e30f; s[t][r] = v; m = fmaxf(m, v); }
    m = fmaxf(m, __shfl_xor(m, 16)); m = fmaxf(m, __shfl_xor(m, 32));
    float l = 0.f;
#pragma unroll
    for (int t = 0; t < 9; ++t)
#pragma unroll
        for (int r = 0; r < 4; ++r) { const float pv = exp2f(s[t][r] - m); l += pv; s[t][r] = pv; }
    l += __shfl_xor(l, 16); l += __shfl_xor(l, 32);
    l += exp2f(sinkv - m);
#pragma unroll
    for (int dt = 0; dt < 4; ++dt) o[dt] = (f32x4){0.f, 0.f, 0.f, 0.f};
#pragma unroll
    for (int ks = 0; ks < 5; ++ks) {
        u32x4 pw; pw.x = pk2(s[2 * ks][0], s[2 * ks][1]); pw.y = pk2(s[2 * ks][2], s[2 * ks][3]);
        if (ks < 4) { pw.z = pk2(s[2 * ks + 1][0], s[2 * ks + 1][1]); pw.w = pk2(s[2 * ks + 1][2], s[2 * ks + 1][3]); } else { pw.z = 0u; pw.w = 0u; }
        const bf16x8 pb = __builtin_bit_cast(bf16x8, pw);
#pragma unroll
        for (int dt = 0; dt < 4; ++dt) {
            const bf16_t* vp = Vt + (dt * 16 + fr) * VT_STRIDE + (kt0 + 2 * ks) * 16 + fq * 4;
            const u32x2 a0 = *(const u32x2*)vp; u32x2 a1 = {0u, 0u};
            if (ks < 4) a1 = *(const u32x2*)(vp + 16);
            u32x4 aw; aw.x = a0.x; aw.y = a0.y; aw.z = a1.x; aw.w = a1.y;
            o[dt] = mfma16(__builtin_bit_cast(bf16x8, aw), pb, o[dt]);
        }
    }
    const float inv = 1.f / l;
#pragma unroll
    for (int dt = 0; dt < 4; ++dt) o[dt] = o[dt] * inv;
}
__device__ __forceinline__ void norm_rope16(float (&a)[8], float (&b)[8], const float* g, const float* rp, int f, int sx1, int sx2) {
    float ss = 0.f;
#pragma unroll
    for (int j = 0; j < 8; ++j) ss += a[j] * a[j] + b[j] * b[j];
    ss += __shfl_xor(ss, sx1); ss += __shfl_xor(ss, sx2);
    const float rstd = rsqrtf(ss * (1.f / 64.f) + EPS);
#pragma unroll
    for (int j = 0; j < 8; ++j) {
        const float y1 = a[j] * rstd * g[f * 8 + j], y2 = b[j] * rstd * g[32 + f * 8 + j];
        const float c = rp[f * 8 + j], s = rp[32 + f * 8 + j];
        a[j] = y1 * c - y2 * s; b[j] = y2 * c + y1 * s;
    }
}
__device__ __forceinline__ void unpack8(const u32x4 w, float (&a)[8]) {
    a[0] = bflo(w.x); a[1] = bfhi(w.x); a[2] = bflo(w.y); a[3] = bfhi(w.y); a[4] = bflo(w.z); a[5] = bfhi(w.z); a[6] = bflo(w.w); a[7] = bfhi(w.w);
}
__device__ __forceinline__ u32x4 pack8(const float (&a)[8]) { u32x4 w; w.x = pk2(a[0], a[1]); w.y = pk2(a[2], a[3]); w.z = pk2(a[4], a[5]); w.w = pk2(a[6], a[7]); return w; }
__device__ __forceinline__ u32x4 pack8s(const float (&a)[8], float sc) { u32x4 w; w.x = pk2(a[0] * sc, a[1] * sc); w.y = pk2(a[2] * sc, a[3] * sc); w.z = pk2(a[4] * sc, a[5] * sc); w.w = pk2(a[6] * sc, a[7] * sc); return w; }

__device__ __forceinline__ void attn_rows(const Params& p, const bf16_t* Ks, const bf16_t* Vt, size_t tok, int head, int prow, int kt0, int lo, int hi, bool store, int lane) {
    const int fq = lane >> 4;
    const bf16_t* qp = (const bf16_t*)(p.ws + WS_QA) + tok * 512 + head * 64 + fq * 8;
    float a[8], b[8];
    unpack8(*(const u32x4*)qp, a); unpack8(*(const u32x4*)(qp + 32), b);
    norm_rope16(a, b, p.in[11], (const float*)(p.ws + WS_ROPE) + (size_t)prow * 64, fq, 16, 32);
    const bf16x8 qf0 = __builtin_bit_cast(bf16x8, pack8s(a, QSCALE)), qf1 = __builtin_bit_cast(bf16x8, pack8s(b, QSCALE));
    f32x4 o[4];
    attn_group(Ks, Vt, kt0, lo, hi, qf0, qf1, p.in[13][head] * LOG2E, o, lane);
    if (store) {
        const bf16_t* zp = (const bf16_t*)(p.ws + WS_ZA) + tok * 512 + head * 64 + fq * 4;
        bf16_t* op = (bf16_t*)(p.ws + WS_OA) + tok * 512 + head * 64 + fq * 4;
#pragma unroll
        for (int dt = 0; dt < 4; ++dt) { const u32x2 z = *(const u32x2*)(zp + dt * 16);
            u32x2 w; w.x = pk2(o[dt][0] * bflo(z.x), o[dt][1] * bfhi(z.x)); w.y = pk2(o[dt][2] * bflo(z.y), o[dt][3] * bfhi(z.y));
            *(u32x2*)(op + dt * 16) = w; }
    }
}

__device__ __forceinline__ void attn_prompt_unit(const Params& p, unsigned char* lds, int u) {
    bf16_t* Ks = (bf16_t*)lds; bf16_t* Vt = (bf16_t*)(lds + ATT_VT_OFF);
    const int tid = threadIdx.x, lane = tid & 63, w = tid >> 6;
    const int b = u >> 7, qb = (u & 127) >> 1, kvh = u & 1;
    const bf16_t* KA = (const bf16_t*)(p.ws + WS_KA); const bf16_t* VA = (const bf16_t*)(p.ws + WS_VA);
    const float* rope = (const float*)(p.ws + WS_ROPE);
#pragma unroll
    for (int it = 0; it < 2; ++it) {
        const int j = it * 128 + w * 16 + (lane >> 2), f = lane & 3;
        const int t = (qb - 1) * 128 + j; const int tc = t < 0 ? 0 : t;
        const bf16_t* kp = KA + ((size_t)b * SEQ + tc) * 128 + kvh * 64 + f * 8;
        float a[8], c[8];
        unpack8(*(const u32x4*)kp, a); unpack8(*(const u32x4*)(kp + 32), c);
        norm_rope16(a, c, p.in[12], rope + (size_t)tc * 64, f, 1, 2);
        if (t < 0) {
#pragma unroll
            for (int q = 0; q < 8; ++q) { a[q] = 0.f; c[q] = 0.f; } }
        *(u32x4*)(Ks + j * KS_STRIDE + f * 8) = pack8(a); *(u32x4*)(Ks + j * KS_STRIDE + 32 + f * 8) = pack8(c);
        if (t >= SEQ - 128) { float* op = p.out + O_PWK + (((size_t)b * 128 + (t - (SEQ - 128))) * 2 + kvh) * 64 + f * 8;
            *(f32x4*)op = (f32x4){a[0], a[1], a[2], a[3]}; *(f32x4*)(op + 4) = (f32x4){a[4], a[5], a[6], a[7]};
            *(f32x4*)(op + 32) = (f32x4){c[0], c[1], c[2], c[3]}; *(f32x4*)(op + 36) = (f32x4){c[4], c[5], c[6], c[7]}; }
    }
#pragma unroll
    for (int it = 0; it < 4; ++it) {
        const int idx = tid + 512 * it, j = idx >> 3, ch = idx & 7;
        const int t = (qb - 1) * 128 + j; const int tc = t < 0 ? 0 : t;
        u32x4 v = *(const u32x4*)(VA + ((size_t)b * SEQ + tc) * 128 + kvh * 64 + ch * 8);
        if (t < 0) v = (u32x4){0u, 0u, 0u, 0u};
        bf16_t* vp = Vt + (ch * 8) * VT_STRIDE + j;
        vp[0] = (bf16_t)(v.x & 0xffff); vp[VT_STRIDE] = (bf16_t)(v.x >> 16); vp[2 * VT_STRIDE] = (bf16_t)(v.y & 0xffff); vp[3 * VT_STRIDE] = (bf16_t)(v.y >> 16);
        vp[4 * VT_STRIDE] = (bf16_t)(v.z & 0xffff); vp[5 * VT_STRIDE] = (bf16_t)(v.z >> 16); vp[6 * VT_STRIDE] = (bf16_t)(v.w & 0xffff); vp[7 * VT_STRIDE] = (bf16_t)(v.w >> 16);
        if (t >= SEQ - 128) { float* op = p.out + O_PWV + (((size_t)b * 128 + (t - (SEQ - 128))) * 2 + kvh) * 64 + ch * 8;
            *(f32x4*)op = (f32x4){bflo(v.x), bfhi(v.x), bflo(v.y), bfhi(v.y)}; *(f32x4*)(op + 4) = (f32x4){bflo(v.z), bfhi(v.z), bflo(v.w), bfhi(v.w)}; }
    }
    __syncthreads();
    const int head = kvh * 4 + (w >> 1), half = w & 1;
    for (int g = 0; g < 4; ++g) {
        const int i0 = half * 64 + g * 16, i = i0 + (lane & 15), t = qb * 128 + i;
        attn_rows(p, Ks, Vt, (size_t)b * SEQ + t, head, t, i0 >> 4, qb == 0 ? 128 : i, i + 128, true, lane);
    }
    __syncthreads();
}

__device__ __forceinline__ void attn_sample_unit(const Params& p, unsigned char* lds, int u) {
    bf16_t* Ks = (bf16_t*)lds; bf16_t* Vt = (bf16_t*)(lds + ATT_VT_OFF);
    const int tid = threadIdx.x, lane = tid & 63, w = tid >> 6;
    const int sb = u >> 1, kvh = u & 1;
    const bf16_t* KA = (const bf16_t*)(p.ws + WS_KA); const bf16_t* VA = (const bf16_t*)(p.ws + WS_VA);
    const float* rope = (const float*)(p.ws + WS_ROPE);
#pragma unroll
    for (int it = 0; it < 2; ++it) {
        const int j = it * 128 + w * 16 + (lane >> 2), f = lane & 3;
        if (j < 144) {
            const int l = (j >= 128 && j < 136) ? j - 128 : 0;
            const bf16_t* kp = KA + ((size_t)MP + sb * 8 + l) * 128 + kvh * 64 + f * 8;
            float a[8], c[8];
            unpack8(*(const u32x4*)kp, a); unpack8(*(const u32x4*)(kp + 32), c);
            norm_rope16(a, c, p.in[12], rope + (size_t)(8192 + l) * 64, f, 1, 2);
            if (j < 128) { const float* cp = p.in[2] + (((size_t)sb * 128 + j) * 2 + kvh) * 64 + f * 8;
                const f32x4 c0 = *(const f32x4*)cp, c1 = *(const f32x4*)(cp + 4), c2 = *(const f32x4*)(cp + 32), c3 = *(const f32x4*)(cp + 36);
                a[0] = c0.x; a[1] = c0.y; a[2] = c0.z; a[3] = c0.w; a[4] = c1.x; a[5] = c1.y; a[6] = c1.z; a[7] = c1.w;
                c[0] = c2.x; c[1] = c2.y; c[2] = c2.z; c[3] = c2.w; c[4] = c3.x; c[5] = c3.y; c[6] = c3.z; c[7] = c3.w; }
            else if (j >= 136) {
#pragma unroll
                for (int q = 0; q < 8; ++q) { a[q] = 0.f; c[q] = 0.f; } }
            *(u32x4*)(Ks + j * KS_STRIDE + f * 8) = pack8(a); *(u32x4*)(Ks + j * KS_STRIDE + 32 + f * 8) = pack8(c);
            if (j >= 8 && j < 136) { float* op = p.out + O_SWK + (((size_t)sb * 128 + (j - 8)) * 2 + kvh) * 64 + f * 8;
                *(f32x4*)op = (f32x4){a[0], a[1], a[2], a[3]}; *(f32x4*)(op + 4) = (f32x4){a[4], a[5], a[6], a[7]};
                *(f32x4*)(op + 32) = (f32x4){c[0], c[1], c[2], c[3]}; *(f32x4*)(op + 36) = (f32x4){c[4], c[5], c[6], c[7]}; }
        }
    }
#pragma unroll
    for (int it = 0; it < 3; ++it) {
        const int idx = tid + 512 * it, j = idx >> 3, ch = idx & 7;
        if (j < 144) {
            float v[8];
            if (j < 128) { const float* cp = p.in[3] + (((size_t)sb * 128 + j) * 2 + kvh) * 64 + ch * 8;
                const f32x4 c0 = *(const f32x4*)cp, c1 = *(const f32x4*)(cp + 4);
                v[0] = c0.x; v[1] = c0.y; v[2] = c0.z; v[3] = c0.w; v[4] = c1.x; v[5] = c1.y; v[6] = c1.z; v[7] = c1.w; }
            else if (j < 136) unpack8(*(const u32x4*)(VA + ((size_t)MP + sb * 8 + (j - 128)) * 128 + kvh * 64 + ch * 8), v);
            else {
#pragma unroll
                for (int q = 0; q < 8; ++q) v[q] = 0.f; }
            const u32x4 pv = pack8(v);
            bf16_t* vp = Vt + (ch * 8) * VT_STRIDE + j;
            vp[0] = (bf16_t)(pv.x & 0xffff); vp[VT_STRIDE] = (bf16_t)(pv.x >> 16); vp[2 * VT_STRIDE] = (bf16_t)(pv.y & 0xffff); vp[3 * VT_STRIDE] = (bf16_t)(pv.y >> 16);
            vp[4 * VT_STRIDE] = (bf16_t)(pv.z & 0xffff); vp[5 * VT_STRIDE] = (bf16_t)(pv.z >> 16); vp[6 * VT_STRIDE] = (bf16_t)(pv.w & 0xffff); vp[7 * VT_STRIDE] = (bf16_t)(pv.w >> 16);
            if (j >= 8 && j < 136) { float* op = p.out + O_SWV + (((size_t)sb * 128 + (j - 8)) * 2 + kvh) * 64 + ch * 8;
                *(f32x4*)op = (f32x4){v[0], v[1], v[2], v[3]}; *(f32x4*)(op + 4) = (f32x4){v[4], v[5], v[6], v[7]}; }
        }
    }
    __syncthreads();
    if (w < 2) {
        const int q = lane & 15, l = q & 7, head = kvh * 4 + w * 2 + (q >> 3);
        attn_rows(p, Ks, Vt, (size_t)MP + sb * 8 + l, head, 8192 + l, 0, l, l + 128, true, lane);
    }
    __syncthreads();
}

constexpr int G_BC = 0, G_TOT = 16640, G_QT = 18688, G_KT = 27904, G_VT = 37120, G_ST = 55552, G_AM = 73984, G_RED = 83200;
constexpr int GS = 72;

__device__ __forceinline__ void gla_compute_b(const Params& p, unsigned char* lds, size_t tok0, int L, int h) {
    float* Bc = (float*)(lds + G_BC); float* TOT = (float*)(lds + G_TOT);
    const int tid = threadIdx.x, k = tid & 63, tg = tid >> 6;
    const float* wg = p.in[14] + h * 64 + k;
    float wr[16];
#pragma unroll
    for (int r = 0; r < 16; ++r) wr[r] = wg[r * 256];
    const float bias = p.in[15][h * 64 + k];
    const bf16_t* LR = (const bf16_t*)(p.ws + WS_LR);
    float cs[8]; float run = 0.f;
#pragma unroll
    for (int i = 0; i < 8; ++i) {
        const int tt = tg * 8 + i; float la = 0.f;
        if (tt < L) {
            const u32x4 l0 = *(const u32x4*)(LR + (tok0 + tt) * 128), l1 = *(const u32x4*)(LR + (tok0 + tt) * 128 + 8);
            float g = bias;
            g += bflo(l0.x) * wr[0] + bfhi(l0.x) * wr[1] + bflo(l0.y) * wr[2] + bfhi(l0.y) * wr[3] + bflo(l0.z) * wr[4] + bfhi(l0.z) * wr[5] + bflo(l0.w) * wr[6] + bfhi(l0.w) * wr[7];
            g += bflo(l1.x) * wr[8] + bfhi(l1.x) * wr[9] + bflo(l1.y) * wr[10] + bfhi(l1.y) * wr[11] + bflo(l1.z) * wr[12] + bfhi(l1.z) * wr[13] + bflo(l1.w) * wr[14] + bfhi(l1.w) * wr[15];
            la = (fminf(g, 0.f) - __logf(1.f + __expf(-fabsf(g)))) * (1.f / 16.f);
        }
        run += la; cs[i] = run;
    }
    TOT[tg * 64 + k] = run;
    __syncthreads();
    float pre = 0.f;
#pragma unroll
    for (int j = 0; j < 8; ++j) if (j < tg) pre += TOT[j * 64 + k];
#pragma unroll
    for (int i = 0; i < 8; ++i) Bc[(tg * 8 + i) * 65 + k] = pre + cs[i];
    __syncthreads();
}
__device__ __forceinline__ void gla_stage_vt(const Params& p, unsigned char* lds, size_t tok0, int L, int h) {
    const int tid = threadIdx.x, dv = tid & 127, t4 = tid >> 7;
    const bf16_t* VG = (const bf16_t*)(p.ws + WS_VG) + h * 128 + dv;
    unsigned w[8];
#pragma unroll
    for (int i = 0; i < 8; ++i) { const int t0 = t4 * 16 + 2 * i;
        const unsigned lo = t0 < L ? (unsigned)VG[(tok0 + t0) * 512] : 0u, hi = t0 + 1 < L ? (unsigned)VG[(tok0 + t0 + 1) * 512] : 0u;
        w[i] = lo | (hi << 16); }
    bf16_t* VT = (bf16_t*)(lds + G_VT) + dv * GS + t4 * 16;
    *(u32x4*)VT = (u32x4){w[0], w[1], w[2], w[3]}; *(u32x4*)(VT + 8) = (u32x4){w[4], w[5], w[6], w[7]};
}
__device__ __forceinline__ void gla_unit_info(int u, size_t& tok0, int& L, int& h) {
    if (u < 1024) { const int b = u >> 9, c = (u >> 2) & 127; h = u & 3; tok0 = (size_t)b * SEQ + c * 64; L = 64; }
    else { const int v = u - 1024; h = v & 3; tok0 = (size_t)MP + (v >> 2) * 8; L = 8; }
}
__device__ __forceinline__ void gla_delta_unit(const Params& p, unsigned char* lds, int u) {
    size_t tok0; int L, h; gla_unit_info(u, tok0, L, h);
    gla_compute_b(p, lds, tok0, L, h);
    const float* Bc = (const float*)(lds + G_BC);
    const int tid = threadIdx.x, lane = tid & 63, w = tid >> 6, fr = lane & 15, fq = lane >> 4;
    { const int k = tid & 63, tg = tid >> 6; const float bl = Bc[63 * 65 + k];
      const bf16_t* KG = (const bf16_t*)(p.ws + WS_KG) + h * 64 + k;
      float v[8];
#pragma unroll
      for (int i = 0; i < 8; ++i) { const int tt = tg * 8 + i; const float kv = tt < L ? bf2f(KG[(tok0 + tt) * 256]) : 0.f; v[i] = kv * __expf(bl - Bc[tt * 65 + k]); }
      *(u32x4*)((bf16_t*)(lds + G_KT) + k * GS + tg * 8) = pack8(v); }
    gla_stage_vt(p, lds, tok0, L, h);
    __syncthreads();
    const bf16_t* VT = (const bf16_t*)(lds + G_VT) + (w * 16 + fr) * GS + fq * 8;
    const bf16x8 a0 = *(const bf16x8*)VT, a1 = *(const bf16x8*)(VT + 32);
#pragma unroll
    for (int kt = 0; kt < 4; ++kt) {
        const bf16_t* KT = (const bf16_t*)(lds + G_KT) + (kt * 16 + fr) * GS + fq * 8;
        f32x4 acc = {0.f, 0.f, 0.f, 0.f};
        acc = mfma16(a0, *(const bf16x8*)KT, acc); acc = mfma16(a1, *(const bf16x8*)(KT + 32), acc);
        const int kk = kt * 16 + fr, dv = w * 16 + fq * 4;
        if (u < 1024) *(f32x4*)((float*)(p.ws + WS_DS) + (size_t)u * 8192 + kk * 128 + dv) = acc;
        else { const int v = u - 1024; const size_t so = ((size_t)v * 64 + kk) * 128 + dv;
            const float d = __expf(Bc[63 * 65 + kk]); const f32x4 s0 = *(const f32x4*)(p.in[4] + so);
            *(f32x4*)(p.out + O_SGS + so) = s0 * d + acc; }
    }
    if (u < 1024 && tid < 64) ((float*)(p.ws + WS_DEC))[(size_t)u * 64 + tid] = __expf(Bc[63 * 65 + tid]);
    __syncthreads();
}
__device__ __forceinline__ void gla_scan(const Params& p) {
    if (threadIdx.x >= 256) return;
    const int e = blockIdx.x * 256 + threadIdx.x;
    if (e >= 65536) return;
    const int b = e >> 15, h = (e >> 13) & 3, k = (e >> 7) & 63, dv = e & 127;
    float* DS = (float*)(p.ws + WS_DS); const float* DEC = (const float*)(p.ws + WS_DEC);
    float S = 0.f;
#pragma unroll 8
    for (int c = 0; c < 128; ++c) { const size_t u = (size_t)b * 512 + c * 4 + h;
        const float d = DEC[u * 64 + k]; float* sp = DS + u * 8192 + k * 128 + dv; const float ds = *sp; *sp = S; S = d * S + ds; }
    p.out[O_PGS + e] = S;
}
__device__ __forceinline__ void gla_out_unit(const Params& p, unsigned char* lds, int u) {
    size_t tok0; int L, h; gla_unit_info(u, tok0, L, h);
    gla_compute_b(p, lds, tok0, L, h);
    const float* Bc = (const float*)(lds + G_BC);
    const int tid = threadIdx.x, lane = tid & 63, w = tid >> 6, fr = lane & 15, fq = lane >> 4;
    { const int k = tid & 63, tg = tid >> 6; const float bm = Bc[31 * 65 + k];
      const bf16_t* QG = (const bf16_t*)(p.ws + WS_QG) + h * 64 + k; const bf16_t* KG = (const bf16_t*)(p.ws + WS_KG) + h * 64 + k;
      bf16_t* QT = (bf16_t*)(lds + G_QT) + k; bf16_t* KT = (bf16_t*)(lds + G_KT) + k;
#pragma unroll
      for (int i = 0; i < 8; ++i) { const int tt = tg * 8 + i; const float bb = Bc[tt * 65 + k];
          const float qv = tt < L ? bf2f(QG[(tok0 + tt) * 256]) : 0.f, kv = tt < L ? bf2f(KG[(tok0 + tt) * 256]) : 0.f;
          QT[tt * GS] = (bf16_t)(pk2(qv * __expf(bb - bm), 0.f) & 0xffff); KT[tt * GS] = (bf16_t)(pk2(kv * __expf(bm - bb), 0.f) & 0xffff); } }
    gla_stage_vt(p, lds, tok0, L, h);
    { const int dv = tid & 127, kg = tid >> 7;
      const float* Sp = (u < 1024 ? (const float*)(p.ws + WS_DS) + (size_t)u * 8192 : p.in[4] + (size_t)(u - 1024) * 8192) + dv;
      float v[16];
#pragma unroll
      for (int i = 0; i < 16; ++i) { const int kk = kg * 16 + i; v[i] = Sp[kk * 128] * __expf(Bc[31 * 65 + kk]); }
      bf16_t* ST = (bf16_t*)(lds + G_ST) + dv * GS + kg * 16;
      u32x4 w0, w1; w0.x = pk2(v[0], v[1]); w0.y = pk2(v[2], v[3]); w0.z = pk2(v[4], v[5]); w0.w = pk2(v[6], v[7]);
      w1.x = pk2(v[8], v[9]); w1.y = pk2(v[10], v[11]); w1.z = pk2(v[12], v[13]); w1.w = pk2(v[14], v[15]);
      *(u32x4*)ST = w0; *(u32x4*)(ST + 8) = w1; }
    __syncthreads();
    const int tt = w & 3, hh = w >> 2;
    const bf16_t* QTr = (const bf16_t*)(lds + G_QT) + (tt * 16 + fr) * GS + fq * 8;
    const bf16x8 bq0 = *(const bf16x8*)QTr, bq1 = *(const bf16x8*)(QTr + 32);
#pragma unroll
    for (int q = 0; q < 2; ++q) { const int st = hh * 2 + q;
        const bf16_t* KTr = (const bf16_t*)(lds + G_KT) + (st * 16 + fr) * GS + fq * 8;
        f32x4 acc = {0.f, 0.f, 0.f, 0.f};
        acc = mfma16(*(const bf16x8*)KTr, bq0, acc); acc = mfma16(*(const bf16x8*)(KTr + 32), bq1, acc);
        const int ti = tt * 16 + fr, s0 = st * 16 + fq * 4;
        u32x2 wv; wv.x = pk2(s0 <= ti ? acc[0] : 0.f, s0 + 1 <= ti ? acc[1] : 0.f); wv.y = pk2(s0 + 2 <= ti ? acc[2] : 0.f, s0 + 3 <= ti ? acc[3] : 0.f);
        *(u32x2*)((bf16_t*)(lds + G_AM) + ti * GS + s0) = wv; }
    __syncthreads();
    const bf16_t* AMr = (const bf16_t*)(lds + G_AM) + (tt * 16 + fr) * GS + fq * 8;
    const bf16x8 ba0 = *(const bf16x8*)AMr, ba1 = *(const bf16x8*)(AMr + 32);
    f32x4 o[4]; float ss = 0.f;
#pragma unroll
    for (int d4 = 0; d4 < 4; ++d4) { const int row = (hh * 4 + d4) * 16 + fr;
        const bf16_t* VT = (const bf16_t*)(lds + G_VT) + row * GS + fq * 8; const bf16_t* ST = (const bf16_t*)(lds + G_ST) + row * GS + fq * 8;
        f32x4 acc = {0.f, 0.f, 0.f, 0.f};
        acc = mfma16(*(const bf16x8*)VT, ba0, acc); acc = mfma16(*(const bf16x8*)(VT + 32), ba1, acc);
        acc = mfma16(*(const bf16x8*)ST, bq0, acc); acc = mfma16(*(const bf16x8*)(ST + 32), bq1, acc);
        o[d4] = acc; ss += (acc[0] * acc[0] + acc[1] * acc[1]) + (acc[2] * acc[2] + acc[3] * acc[3]); }
    ss += __shfl_xor(ss, 16); ss += __shfl_xor(ss, 32);
    float* RED = (float*)(lds + G_RED);
    if (fq == 0) RED[hh * 64 + tt * 16 + fr] = ss;
    __syncthreads();
    const float rstd = rsqrtf((RED[tt * 16 + fr] + RED[64 + tt * 16 + fr]) * (1.f / 128.f) + EPS);
    const int ti = tt * 16 + fr;
    if (ti < L) {
        const size_t tok = tok0 + ti;
#pragma unroll
        for (int d4 = 0; d4 < 4; ++d4) { const int dv = (hh * 4 + d4) * 16 + fq * 4;
            const f32x4 g = *(const f32x4*)(p.in[16] + dv);
            const u32x2 z = *(const u32x2*)((const bf16_t*)(p.ws + WS_ZG) + tok * 512 + h * 128 + dv);
            u32x2 wv; wv.x = pk2(o[d4][0] * rstd * g.x * bflo(z.x), o[d4][1] * rstd * g.y * bfhi(z.x));
            wv.y = pk2(o[d4][2] * rstd * g.z * bflo(z.y), o[d4][3] * rstd * g.w * bfhi(z.y));
            *(u32x2*)((bf16_t*)(p.ws + WS_OG) + tok * 512 + h * 128 + dv) = wv; }
    }
    __syncthreads();
}

__global__ void __launch_bounds__(512) mega_fwd(Params p) {
    extern __shared__ __attribute__((aligned(16))) unsigned char lds[];
    cg::grid_group grid = cg::this_grid();
    const int lo = p.ph_lo, hi = p.ph_hi;
#define IN(k) (lo <= (k) && (k) < hi)
#define SEAM(k) do { if (IN(k) && IN((k) + 1)) grid.sync(); } while (0)
    PG8_LAS unsigned char* glds = (PG8_LAS unsigned char*)lds;
    if (IN(0)) phase0(p, lds);
    SEAM(0);
    if (IN(1)) phase1(p);
    SEAM(1);
    if (IN(2)) { pg8::Gemm g{(const bf16_t*)(p.ws + WS_H), (const bf16_t*)(p.ws + WS_WIN), MT, NINP, 1024}; pg8::StaticOrder S; S.init(MT, NINP, gridDim.x, blockIdx.x);
        EpiProj E{p.ws}; pg8::gemm_phase<EpiProj, pg8::StaticOrder, true, true>(glds, g, S, E); }
    SEAM(2);
    if (IN(3)) {
        for (int u = blockIdx.x; u < 2048; u += gridDim.x) {
            if (u < 256) attn_prompt_unit(p, lds, u);
            else if (u < 512) attn_sample_unit(p, lds, u - 256);
            else gla_delta_unit(p, lds, u - 512);
        }
    }
    SEAM(3);
    if (IN(4)) gla_scan(p);
    SEAM(4);
    if (IN(5)) { for (int u = blockIdx.x; u < 1536; u += gridDim.x) gla_out_unit(p, lds, u); }
    SEAM(5);
    if (IN(6)) {
        pg8::StaticOrder S; S.init(MT, 1024, gridDim.x, blockIdx.x);
        { pg8::Gemm g{(const bf16_t*)(p.ws + WS_OA), (const bf16_t*)(p.ws + WS_WBA), MT, 1024, 512};
          EpiBranch<0> E{(const bf16_t*)(p.ws + WS_MA), nullptr, (bf16_t*)(p.ws + WS_TMP)};
          pg8::gemm_phase<EpiBranch<0>, pg8::StaticOrder, true, true>(glds, g, S, E); }
        { pg8::Gemm g{(const bf16_t*)(p.ws + WS_OG), (const bf16_t*)(p.ws + WS_WBG), MT, 1024, 512};
          EpiBranch<1> E{(const bf16_t*)(p.ws + WS_MG), (const bf16_t*)(p.ws + WS_TMP), (bf16_t*)(p.ws + WS_MRG)};
          pg8::gemm_phase<EpiBranch<1>, pg8::StaticOrder, true, true>(glds, g, S, E); }
    }
    SEAM(6);
    if (IN(7)) { pg8::Gemm g{(const bf16_t*)(p.ws + WS_MRG), (const bf16_t*)(p.ws + WS_WOUT), MT, 1024, 1024}; pg8::StaticOrder S; S.init(MT, 1024, gridDim.x, blockIdx.x);
        EpiOut E{p.in[0], p.in[1], (const float*)(p.ws + WS_MOD), p.out + O_Y};
        pg8::gemm_phase<EpiOut, pg8::StaticOrder, true, true>(glds, g, S, E); }
#undef IN
#undef SEAM
}

constexpr int LDS_BYTES = 131072;
#ifndef N_LAUNCH_MODE
#define N_LAUNCH_MODE 1
#endif

extern "C" void kernel_launch(void* const* d_in, const int* in_sizes, int n_in, void* d_out, int out_size, void* d_ws, size_t ws_size, hipStream_t stream) {
    static int grid = 0;
    if (grid == 0) {
        if (n_in != 20 || ws_size < WS_END) { fprintf(stderr, "kernel_launch: unexpected n_in %d / ws_size %zu (need %zu)\n", n_in, ws_size, (size_t)WS_END); grid = -1; return; }
        int dev = 0, cus = 0, per_cu = 0;
        hipGetDevice(&dev);
        hipDeviceGetAttribute(&cus, hipDeviceAttributeMultiprocessorCount, dev);
        if (hipFuncSetAttribute((const void*)mega_fwd, hipFuncAttributeMaxDynamicSharedMemorySize, LDS_BYTES) != hipSuccess) { fprintf(stderr, "kernel_launch: hipFuncSetAttribute failed\n"); grid = -1; return; }
        if (hipOccupancyMaxActiveBlocksPerMultiprocessor(&per_cu, (const void*)mega_fwd, 512, LDS_BYTES) != hipSuccess || per_cu < 1) { fprintf(stderr, "kernel_launch: occupancy query gives %d\n", per_cu); per_cu = 1; }
        (void)hipGetLastError();
        grid = cus * 1;
        if (grid > cus * per_cu) grid = cus * per_cu;
    }
    if (grid < 0) return;
    Params p{};
    for (int i = 0; i < 20; ++i) p.in[i] = (const float*)d_in[i];
    p.out = (float*)d_out; p.ws = (unsigned char*)d_ws;
    for (int i = 0; i < 32; ++i) { const float e = (float)i / 32.0f; const float pw = powf(10000.0f, e); p.inv[i] = 1.0f / pw; }
#if N_LAUNCH_MODE == 1
    p.ph_lo = 0; p.ph_hi = 8;
    void* args[] = {&p};
    hipError_t e = hipLaunchCooperativeKernel((const void*)mega_fwd, dim3(grid), dim3(512), args, LDS_BYTES, stream);
    if (e != hipSuccess) fprintf(stderr, "cooperative launch failed: %s (grid %d)\n", hipGetErrorString(e), grid);
#else
    for (int ph = 0; ph < 8; ++ph) { p.ph_lo = ph; p.ph_hi = ph + 1;
        hipLaunchKernelGGL(mega_fwd, dim3(grid), dim3(512), LDS_BYTES, stream, p); }
#endif
}
```

```cpp
#define PROBE_MASK 0
#include <hip/hip_runtime.h>
#include <hip/hip_cooperative_groups.h>
#include <cstdio>
#include <cstdint>
#include <cmath>
namespace cg = cooperative_groups;
__device__ __forceinline__ int opaque_tid() { int t = threadIdx.x; asm volatile("" : "+v"(t)); return t; }
namespace pg8 {
#define PG8_LAS __attribute__((address_space(3)))
typedef unsigned short bf16_t;
typedef short bf16x8 __attribute__((ext_vector_type(8)));
typedef float f32x4 __attribute__((ext_vector_type(4)));
typedef unsigned u32x4 __attribute__((ext_vector_type(4)));
constexpr int BM = 256, BK = 64, HALF = 128, HTB = HALF * BK * 2  , STAGE_BYTES = 8 * HTB, NXCD = 8, WGM = 8;

__host__ __device__ __forceinline__ int lds_byte(int r, int c) { const int st = (r >> 4) * 2 + (c >> 5), rr = r & 15, cc = c & 31, ob = rr * 64 + cc * 2; return st * 1024 + (ob ^ (((ob >> 9) & 1) << 5)); }
__host__ __device__ __forceinline__ void stage_rc(int b, int& R, int& C) { const int st = b / 1024, sb = b % 1024, swz = sb ^ (((sb >> 9) & 1) << 5); R = (st >> 1) * 16 + swz / 64; C = (st & 1) * 32 + (swz % 64) / 2; }
__host__ __device__ __forceinline__ int perm32(int rho) { const int n = rho >> 4, i = rho & 15; return 8 * (i >> 2) + 4 * n + (i & 3); }

struct Unit { int pm, pn; };
struct Gemm { const bf16_t* A; const bf16_t* Bt; int M, N, K; };

struct StaticOrder {
    int nM, nN, nwg, G, c;
    __host__ __device__ void init(int M, int N, int G_, int c_) { nM = M / BM; nN = N / BM; nwg = nM * nN; G = G_; c = c_; }
    __host__ __device__ bool next(int i, Unit& u) const {
        const long L = (long)i * G + c; if (L >= nwg) return false;
        int wgid = (int)L; { const int q = nwg / NXCD, r = nwg % NXCD, xcd = wgid % NXCD, off = wgid / NXCD; wgid = (xcd < r ? xcd * (q + 1) : r * (q + 1) + (xcd - r) * q) + off; }
        const int nig = WGM * nN, gid = wgid / nig, fm = gid * WGM, gsz = (nM - fm) < WGM ? (nM - fm) : WGM;
        u.pm = fm + ((wgid % nig) % gsz); u.pn = (wgid % nig) / gsz; return true;
    }
    __device__ __forceinline__ void a_ready(const Unit&) const {}
    __device__ __forceinline__ void done(const Unit&) const {}
};
__device__ __forceinline__ unsigned cvt_pk_bf16(float lo, float hi) { unsigned r; asm volatile("v_cvt_pk_bf16_f32 %0, %1, %2" : "=v"(r) : "v"(lo), "v"(hi)); return r; }
typedef float f32x2 __attribute__((ext_vector_type(2)));
template <class Epi, class Sched, bool ALIGN_EPI = false, bool SP2 = false>
__device__ __forceinline__ void gemm_phase(PG8_LAS unsigned char* lds, const Gemm g, const Sched& S, const Epi& E) {
    const int tid = opaque_tid(), wid = __builtin_amdgcn_readfirstlane(tid >> 6), lane = tid & 63, wr = wid >> 2, wc = wid & 3, fr = lane & 15, fq = lane >> 4;
    const int K = g.K, nt = K / BK;
    unsigned voffA[2], voffB[2];
#pragma unroll
    for (int i = 0; i < 2; ++i) { int R, C; stage_rc(tid * 16 + i * 8192, R, C); const int Rb = Epi::PERM ? ((R & ~31) + perm32(R & 31)) : R;
        voffA[i] = (unsigned)(R * K + C) * 2u; voffB[i] = (unsigned)(Rb * K + C) * 2u; }
    const size_t kstep = (size_t)(BK * 2);
    const size_t hstep = (size_t)HALF * K * 2;
    const size_t tstep = 2 * hstep;
    const unsigned ldsw = (unsigned)wid * 1024u;
    const int aoff = lds_byte(wr * 64 + fr, fq * 8), boff = lds_byte(wc * 32 + fr, fq * 8);
#define PG8_SA(b, h) (((b) * 2 + (h)) * HTB)
#define PG8_SB(b, h) ((4 + (b) * 2 + (h)) * HTB)
#define PG8_STAGE(bufoff, gbase, voff) do { _Pragma("unroll") for (int _i = 0; _i < 2; ++_i) \
        __builtin_amdgcn_global_load_lds((const unsigned*)((const char*)(gbase) + (voff)[_i]), (PG8_LAS unsigned*)(lds + (bufoff) + ldsw + _i * 8192), 16, 0, 0); } while (0)
#define PG8_LDA(dst, b, h) do { _Pragma("unroll") for (int m = 0; m < 4; ++m) _Pragma("unroll") for (int k = 0; k < 2; ++k) dst[m][k] = *(const PG8_LAS bf16x8*)(lds + PG8_SA(b, h) + aoff + m * 2048 + k * 1024); } while (0)
#define PG8_LDB(dst, b, h) do { _Pragma("unroll") for (int n = 0; n < 2; ++n) _Pragma("unroll") for (int k = 0; k < 2; ++k) dst[n][k] = *(const PG8_LAS bf16x8*)(lds + PG8_SB(b, h) + boff + n * 2048 + k * 1024); } while (0)
#define PG8_MMA(ai, bj, At, Bt) do { __builtin_amdgcn_s_setprio(1); _Pragma("unroll") for (int m = 0; m < 4; ++m) _Pragma("unroll") for (int n = 0; n < 2; ++n) _Pragma("unroll") for (int k = 0; k < 2; ++k) \
        acc[ai][bj][m][n] = __builtin_amdgcn_mfma_f32_16x16x32_bf16(Bt[n][k], At[m][k], acc[ai][bj][m][n], 0, 0, 0); __builtin_amdgcn_s_setprio(0); } while (0)
#define PG8_WAIT_V(n) asm volatile("s_waitcnt vmcnt(" #n ")" ::: "memory")
#define PG8_WAIT_L(n) asm volatile("s_waitcnt lgkmcnt(" #n ")" ::: "memory")
#define PG8_BAR __builtin_amdgcn_s_barrier()
#define PG8_SCHED __builtin_amdgcn_sched_barrier(0)
    Unit cur, nxt; int ui = 0;
    if (!S.next(0, cur)) return;
    f32x4 acc[2][2][4][2];
#pragma unroll
    for (int a = 0; a < 2; ++a)
#pragma unroll
        for (int b = 0; b < 2; ++b)
#pragma unroll
            for (int m = 0; m < 4; ++m)
#pragma unroll
                for (int n = 0; n < 2; ++n) acc[a][b][m][n] = (f32x4){0.f, 0.f, 0.f, 0.f};
    bf16x8 At[4][2], B0[2][2], B1[2][2];
    const char* cA = (const char*)g.A + (size_t)cur.pm * tstep; const char* cB = (const char*)g.Bt + (size_t)cur.pn * tstep;
    S.a_ready(cur);
    if constexpr (SP2) {
        PG8_STAGE(PG8_SB(0, 0), cB, voffB); PG8_STAGE(PG8_SB(0, 1), cB + hstep, voffB); PG8_STAGE(PG8_SA(0, 0), cA, voffA); PG8_STAGE(PG8_SA(0, 1), cA + hstep, voffA);
        if (wr == 1) PG8_BAR;
        PG8_WAIT_V(2); PG8_BAR;
        PG8_STAGE(PG8_SB(1, 0), cB + kstep, voffB); PG8_STAGE(PG8_SA(1, 0), cA + kstep, voffA); PG8_STAGE(PG8_SB(1, 1), cB + hstep + kstep, voffB);
        PG8_WAIT_V(6); PG8_BAR;
    } else {
        PG8_STAGE(PG8_SB(0, 0), cB, voffB); PG8_STAGE(PG8_SA(0, 0), cA, voffA); PG8_STAGE(PG8_SB(0, 1), cB + hstep, voffB); PG8_STAGE(PG8_SA(0, 1), cA + hstep, voffA);
        if (wr == 1) PG8_BAR;
        PG8_WAIT_V(4); PG8_BAR;
        PG8_STAGE(PG8_SB(1, 0), cB + kstep, voffB); PG8_STAGE(PG8_SA(1, 0), cA + kstep, voffA); PG8_STAGE(PG8_SB(1, 1), cB + hstep + kstep, voffB);
        PG8_WAIT_V(6); PG8_BAR;
    }
    for (;;) {
        const bool has_next = S.next(ui + 1, nxt);
        const char* nA = has_next ? (const char*)g.A + (size_t)nxt.pm * tstep : cA; const char* nB = has_next ? (const char*)g.Bt + (size_t)nxt.pn * tstep : cB;
        for (int t = 0; t < nt; t += 2) {
            const bool last = (t == nt - 2);
            const char* a1 = cA + (size_t)(t + 1) * kstep;
            const char* a2 = last ? nA : cA + (size_t)(t + 2) * kstep; const char* b2 = last ? nB : cB + (size_t)(t + 2) * kstep;
            const char* a3 = a2 + kstep; const char* b3 = b2 + kstep;
            if (last && has_next) S.a_ready(nxt);
            if constexpr (SP2) {
            PG8_LDB(B0, 0, 0); PG8_LDB(B1, 0, 1); PG8_SCHED; PG8_LDA(At, 0, 0); PG8_STAGE(PG8_SA(1, 1), a1 + hstep, voffA);
            PG8_WAIT_V(8); PG8_WAIT_L(0); PG8_BAR; PG8_MMA(0, 0, At, B0); PG8_MMA(0, 1, At, B1); PG8_BAR; PG8_SCHED;
            PG8_LDA(At, 0, 1); PG8_STAGE(PG8_SB(0, 0), b2, voffB); PG8_STAGE(PG8_SB(0, 1), b2 + hstep, voffB); PG8_STAGE(PG8_SA(0, 0), a2, voffA);
            PG8_WAIT_V(8); PG8_WAIT_L(0); PG8_BAR; PG8_MMA(1, 0, At, B0); PG8_MMA(1, 1, At, B1); PG8_BAR; PG8_SCHED;
            PG8_LDB(B0, 1, 0); PG8_LDB(B1, 1, 1); PG8_SCHED; PG8_LDA(At, 1, 0); PG8_STAGE(PG8_SA(0, 1), a2 + hstep, voffA);
            PG8_WAIT_V(8); PG8_WAIT_L(0); PG8_BAR; PG8_MMA(0, 0, At, B0); PG8_MMA(0, 1, At, B1); PG8_BAR; PG8_SCHED;
            PG8_LDA(At, 1, 1); PG8_STAGE(PG8_SB(1, 0), b3, voffB); PG8_STAGE(PG8_SB(1, 1), b3 + hstep, voffB); PG8_STAGE(PG8_SA(1, 0), a3, voffA);
            PG8_WAIT_V(8); PG8_WAIT_L(0); PG8_BAR; PG8_MMA(1, 0, At, B0); PG8_MMA(1, 1, At, B1); PG8_BAR; PG8_SCHED;
            } else {
            PG8_LDB(B0, 0, 0); PG8_SCHED; PG8_LDA(At, 0, 0); PG8_STAGE(PG8_SA(1, 1), a1 + hstep, voffA);
            PG8_WAIT_L(8); PG8_BAR; PG8_WAIT_L(0); PG8_MMA(0, 0, At, B0); PG8_BAR; PG8_SCHED;
            PG8_LDB(B1, 0, 1); PG8_STAGE(PG8_SB(0, 0), b2, voffB);
            PG8_BAR; PG8_WAIT_L(0); PG8_MMA(0, 1, At, B1); PG8_BAR;
            PG8_LDA(At, 0, 1); PG8_STAGE(PG8_SA(0, 0), a2, voffA);
            PG8_BAR; PG8_WAIT_L(0); PG8_MMA(1, 0, At, B0); PG8_BAR; PG8_SCHED;
            PG8_STAGE(PG8_SB(0, 1), b2 + hstep, voffB);
            PG8_WAIT_V(6); PG8_BAR; PG8_MMA(1, 1, At, B1); PG8_BAR;
            PG8_LDB(B0, 1, 0); PG8_SCHED; PG8_LDA(At, 1, 0); PG8_STAGE(PG8_SA(0, 1), a2 + hstep, voffA);
            PG8_WAIT_L(8); PG8_BAR; PG8_WAIT_L(0); PG8_MMA(0, 0, At, B0); PG8_BAR; PG8_SCHED;
            PG8_LDB(B1, 1, 1); PG8_STAGE(PG8_SB(1, 0), b3, voffB);
            PG8_BAR; PG8_WAIT_L(0); PG8_MMA(0, 1, At, B1); PG8_BAR;
            PG8_LDA(At, 1, 1); PG8_STAGE(PG8_SA(1, 0), a3, voffA);
            PG8_BAR; PG8_WAIT_L(0); PG8_MMA(1, 0, At, B0); PG8_BAR; PG8_SCHED;
            PG8_STAGE(PG8_SB(1, 1), b3 + hstep, voffB);
            PG8_WAIT_V(6); PG8_BAR; PG8_MMA(1, 1, At, B1); PG8_BAR;
            }
        }
        if constexpr (ALIGN_EPI) { if (wr == 0) PG8_BAR; }
        if constexpr (!Epi::AFTER_DRAIN) { E(acc, cur, wr, wc, fr, fq); S.done(cur); }
        if (!has_next) break;
#pragma unroll
        for (int a = 0; a < 2; ++a)
#pragma unroll
            for (int b = 0; b < 2; ++b)
#pragma unroll
                for (int m = 0; m < 4; ++m)
#pragma unroll
                    for (int n = 0; n < 2; ++n) acc[a][b][m][n] = (f32x4){0.f, 0.f, 0.f, 0.f};
        cur = nxt; cA = nA; cB = nB; ++ui;
        if constexpr (ALIGN_EPI) { if (wr == 1) PG8_BAR; }
    }
    PG8_WAIT_V(0);
    if constexpr (!ALIGN_EPI) { if (wr == 0) PG8_BAR; }
    PG8_BAR;
    if constexpr (Epi::AFTER_DRAIN) { E.fused(acc, cur, wr, wc, fr, fq, lds, wid, lane); S.done(cur); }
#undef PG8_SA
#undef PG8_SB
#undef PG8_STAGE
#undef PG8_LDA
#undef PG8_LDB
#undef PG8_MMA
#undef PG8_WAIT_V
#undef PG8_WAIT_L
#undef PG8_BAR
#undef PG8_SCHED
}
}

using pg8::bf16_t; using pg8::bf16x8; using pg8::f32x4; using pg8::u32x4; using pg8::Unit;
typedef unsigned u32x2 __attribute__((ext_vector_type(2)));
typedef float f32x2v __attribute__((ext_vector_type(2)));
typedef __bf16 bf16x2v __attribute__((ext_vector_type(2)));

constexpr int DM = 1024, SEQ = 8192, MP = 16384, MS = 1024, MT = MP + MS;
constexpr int NIN = 4880, NINP = 5120;
constexpr float EPS = 1e-6f;
constexpr float LOG2E = 1.4426950408889634f;

constexpr size_t WS_MOD = 0;
constexpr size_t WS_ROPE = WS_MOD + 1597440;
constexpr size_t WS_WIN = WS_ROPE + 2099200;
constexpr size_t WS_WBA = WS_WIN + 10485760;
constexpr size_t WS_WBG = WS_WBA + 1048576;
constexpr size_t WS_WOUT = WS_WBG + 1048576;
constexpr size_t WS_H = WS_WOUT + 2097152;
constexpr size_t WS_OA = WS_H;
constexpr size_t WS_OG = WS_H + 17825792;
constexpr size_t WS_QA = WS_H + 35651584;
constexpr size_t WS_KA = WS_QA + 17825792;
constexpr size_t WS_VA = WS_KA + 4456448;
constexpr size_t WS_QG = WS_VA + 4456448;
constexpr size_t WS_TMP = WS_QA;
constexpr size_t WS_KG = WS_QG + 8912896;
constexpr size_t WS_VG = WS_KG + 8912896;
constexpr size_t WS_ZG = WS_VG + 17825792;
constexpr size_t WS_MRG = WS_KG;
constexpr size_t WS_ZA = WS_ZG + 17825792;
constexpr size_t WS_MA = WS_ZA + 17825792;
constexpr size_t WS_MG = WS_MA + 35651584;
constexpr size_t WS_LR = WS_MG + 35651584;
constexpr size_t WS_DS = WS_LR + 4456448;
constexpr size_t WS_DEC = WS_DS + 33554432;
constexpr size_t WS_END = WS_DEC + 262144;

constexpr size_t O_Y = 0;
constexpr size_t O_PWK = 17825792;
constexpr size_t O_PWV = O_PWK + 32768;
constexpr size_t O_PGS = O_PWV + 32768;
constexpr size_t O_SWK = O_PGS + 65536;
constexpr size_t O_SWV = O_SWK + 2097152;
constexpr size_t O_SGS = O_SWV + 2097152;

struct Params {
    const float* in[20];
    float* out; unsigned char* ws;
    float inv[32];
    int ph_lo, ph_hi;
};

__device__ __forceinline__ unsigned pk2(float lo, float hi) { f32x2v v = {lo, hi}; bf16x2v b = __builtin_convertvector(v, bf16x2v); return __builtin_bit_cast(unsigned, b); }
__device__ __forceinline__ float bflo(unsigned w) { return __uint_as_float(w << 16); }
__device__ __forceinline__ float bfhi(unsigned w) { return __uint_as_float(w & 0xffff0000u); }
__device__ __forceinline__ float bf2f(bf16_t h) { return __uint_as_float((unsigned)h << 16); }
__device__ __forceinline__ float fast_rcp(float x) { return __builtin_amdgcn_rcpf(x); }
__device__ __forceinline__ float sigmoidf_(float x) { return fast_rcp(1.f + __expf(-x)); }
__device__ __forceinline__ float siluf_(float x) { return x * fast_rcp(1.f + __expf(-x)); }
__device__ __forceinline__ float wave_sum(float v) {
#pragma unroll
    for (int o = 1; o < 64; o <<= 1) v += __shfl_xor(v, o);
    return v;
}
__device__ __forceinline__ f32x4 mfma16(bf16x8 a, bf16x8 b, f32x4 c) { return __builtin_amdgcn_mfma_f32_16x16x32_bf16(a, b, c, 0, 0, 0); }
__device__ __forceinline__ void unpack8(const u32x4 w, float (&a)[8]) {
    a[0] = bflo(w.x); a[1] = bfhi(w.x); a[2] = bflo(w.y); a[3] = bfhi(w.y); a[4] = bflo(w.z); a[5] = bfhi(w.z); a[6] = bflo(w.w); a[7] = bfhi(w.w);
}
__device__ __forceinline__ u32x4 pack8(const float (&a)[8]) { u32x4 w; w.x = pk2(a[0], a[1]); w.y = pk2(a[2], a[3]); w.z = pk2(a[4], a[5]); w.w = pk2(a[6], a[7]); return w; }
__device__ __forceinline__ u32x4 pack8s(const float (&a)[8], float sc) { u32x4 w; w.x = pk2(a[0] * sc, a[1] * sc); w.y = pk2(a[2] * sc, a[3] * sc); w.z = pk2(a[4] * sc, a[5] * sc); w.w = pk2(a[6] * sc, a[7] * sc); return w; }
__device__ __forceinline__ int mod_row(int r) { return r < MP ? (r >> 13) : 2 + ((r - MP) >> 3); }

struct EpiProj {
    static constexpr bool PERM = true, AFTER_DRAIN = false;
    unsigned char* ws;
    __device__ __forceinline__ void operator()(const f32x4 (&acc)[2][2][4][2], const Unit& u, int wr, int wc, int fr, int fq) const {
        const int row0 = u.pm * 256 + wr * 64 + fr;
#pragma unroll
        for (int bj = 0; bj < 2; ++bj) {
            const int cb = u.pn * 2 + bj;
            size_t off; int ld, cbase, act;
            if (cb < 4) { off = WS_QA; ld = 512; cbase = cb * 128; act = 0; }
            else if (cb == 4) { off = WS_KA; ld = 128; cbase = 0; act = 0; }
            else if (cb == 5) { off = WS_VA; ld = 128; cbase = 0; act = 0; }
            else if (cb < 10) { off = WS_ZA; ld = 512; cbase = (cb - 6) * 128; act = 1; }
            else if (cb < 12) { off = WS_QG; ld = 256; cbase = (cb - 10) * 128; act = 3; }
            else if (cb < 14) { off = WS_KG; ld = 256; cbase = (cb - 12) * 128; act = 0; }
            else if (cb < 18) { off = WS_VG; ld = 512; cbase = (cb - 14) * 128; act = 0; }
            else if (cb < 22) { off = WS_ZG; ld = 512; cbase = (cb - 18) * 128; act = 1; }
            else if (cb < 30) { off = WS_MA; ld = 1024; cbase = (cb - 22) * 128; act = 2; }
            else if (cb < 38) { off = WS_MG; ld = 1024; cbase = (cb - 30) * 128; act = 2; }
            else if (cb == 38) { off = WS_LR; ld = 128; cbase = 0; act = 0; }
            else continue;
            bf16_t* base = (bf16_t*)(ws + off) + cbase + wc * 32 + 8 * fq;
#pragma unroll
            for (int ai = 0; ai < 2; ++ai)
#pragma unroll
                for (int m = 0; m < 4; ++m) {
                    f32x4 v0 = acc[ai][bj][m][0], v1 = acc[ai][bj][m][1];
                    if (act == 1) { for (int j = 0; j < 4; ++j) { v0[j] = siluf_(v0[j]); v1[j] = siluf_(v1[j]); } }
                    else if (act == 2) { for (int j = 0; j < 4; ++j) { v0[j] = sigmoidf_(v0[j]); v1[j] = sigmoidf_(v1[j]); } }
                    else if (act == 3) { v0 = v0 * 0.125f; v1 = v1 * 0.125f; }
                    u32x4 w; w.x = pk2(v0[0], v0[1]); w.y = pk2(v0[2], v0[3]); w.z = pk2(v1[0], v1[1]); w.w = pk2(v1[2], v1[3]);
                    *(u32x4*)(base + (size_t)(row0 + ai * 128 + m * 16) * ld) = w;
                }
        }
    }
};
template <int MODE> struct EpiBranch {
    static constexpr bool PERM = true, AFTER_DRAIN = false;
    const bf16_t* gate; const bf16_t* prev; bf16_t* dst;
    __device__ __forceinline__ void operator()(const f32x4 (&acc)[2][2][4][2], const Unit& u, int wr, int wc, int fr, int fq) const {
        const int row0 = u.pm * 256 + wr * 64 + fr, col0 = u.pn * 256 + wc * 32 + 8 * fq;
#pragma unroll
        for (int ai = 0; ai < 2; ++ai)
#pragma unroll
            for (int m = 0; m < 4; ++m)
#pragma unroll
                for (int bj = 0; bj < 2; ++bj) {
                    const size_t o = (size_t)(row0 + ai * 128 + m * 16) * 1024 + col0 + bj * 128;
                    const u32x4 g = *(const u32x4*)(gate + o);
                    f32x4 v0 = acc[ai][bj][m][0], v1 = acc[ai][bj][m][1];
                    v0[0] *= bflo(g.x); v0[1] *= bfhi(g.x); v0[2] *= bflo(g.y); v0[3] *= bfhi(g.y);
                    v1[0] *= bflo(g.z); v1[1] *= bfhi(g.z); v1[2] *= bflo(g.w); v1[3] *= bfhi(g.w);
                    if (MODE == 1) { const u32x4 t = *(const u32x4*)(prev + o);
                        v0[0] += bflo(t.x); v0[1] += bfhi(t.x); v0[2] += bflo(t.y); v0[3] += bfhi(t.y);
                        v1[0] += bflo(t.z); v1[1] += bfhi(t.z); v1[2] += bflo(t.w); v1[3] += bfhi(t.w); }
                    u32x4 w; w.x = pk2(v0[0], v0[1]); w.y = pk2(v0[2], v0[3]); w.z = pk2(v1[0], v1[1]); w.w = pk2(v1[2], v1[3]);
                    *(u32x4*)(dst + o) = w;
                }
    }
};
struct EpiOut {
    static constexpr bool PERM = false, AFTER_DRAIN = false;
    const float* xp; const float* xs; const float* mod; float* out;
    __device__ __forceinline__ void operator()(const f32x4 (&acc)[2][2][4][2], const Unit& u, int wr, int wc, int fr, int fq) const {
        const int col0 = u.pn * 256 + wc * 32 + 4 * fq;
#pragma unroll
        for (int ai = 0; ai < 2; ++ai)
#pragma unroll
            for (int m = 0; m < 4; ++m) {
                const int row = u.pm * 256 + ai * 128 + wr * 64 + m * 16 + fr;
                const float* xrow = row < MP ? xp + (size_t)row * 1024 : xs + (size_t)(row - MP) * 1024;
                const float* grow = mod + (size_t)mod_row(row) * 3072 + 2048;
                float* orow = out + (size_t)row * 1024;
#pragma unroll
                for (int bj = 0; bj < 2; ++bj)
#pragma unroll
                    for (int n = 0; n < 2; ++n) { const int c = col0 + bj * 128 + n * 16;
                        const f32x4 x4 = *(const f32x4*)(xrow + c), g4 = *(const f32x4*)(grow + c);
                        *(f32x4*)(orow + c) = x4 + g4 * acc[ai][bj][m][n]; }
            }
    }
};

__device__ __forceinline__ void p0_ada(const Params& p, unsigned char* lds, int unit) {
    const int tid = opaque_tid(), lane = tid & 63, w = tid >> 6, fr = lane & 15, fq = lane >> 4;
    const int c0 = unit * 16;
    const float* wa = p.in[8];
    f32x4 acc[9];
#pragma unroll
    for (int i = 0; i < 9; ++i) acc[i] = (f32x4){0.f, 0.f, 0.f, 0.f};
#pragma unroll 1
    for (int ks = 0; ks < 4; ++ks) {
        const int k0 = w * 128 + ks * 32 + fq * 8;
        float bv[8];
#pragma unroll
        for (int j = 0; j < 8; ++j) bv[j] = wa[(size_t)(k0 + j) * 3072 + c0 + fr];
        const bf16x8 bfrag = __builtin_bit_cast(bf16x8, pack8(bv));
#pragma unroll
        for (int rt = 0; rt < 9; ++rt) {
            const int row = min(rt * 16 + fr, 129);
            const float* cp = (row < 2 ? p.in[5] + row * 1024 : p.in[6] + (row - 2) * 1024) + k0;
            const f32x4 x0 = *(const f32x4*)cp, x1 = *(const f32x4*)(cp + 4);
            float av[8] = {x0.x, x0.y, x0.z, x0.w, x1.x, x1.y, x1.z, x1.w};
#pragma unroll
            for (int j = 0; j < 8; ++j) av[j] = av[j] * fast_rcp(1.f + __expf(-av[j]));
            acc[rt] = mfma16(__builtin_bit_cast(bf16x8, pack8(av)), bfrag, acc[rt]);
            if (rt % 3 == 2) asm volatile("" ::: "memory");
        }
    }
    f32x4* red = (f32x4*)lds;
#pragma unroll
    for (int rt = 0; rt < 9; ++rt) red[(w * 9 + rt) * 64 + lane] = acc[rt];
    __syncthreads();
    float* mod = (float*)(p.ws + WS_MOD);
    for (int idx = tid; idx < 576; idx += 512) { const int rt = idx >> 6, ln = idx & 63;
        f32x4 sum = red[rt * 64 + ln];
#pragma unroll
        for (int ww = 1; ww < 8; ++ww) sum = sum + red[(ww * 9 + rt) * 64 + ln];
        const int col = c0 + (ln & 15); const float bias = p.in[9][col];
#pragma unroll
        for (int r = 0; r < 4; ++r) { const int row = rt * 16 + (ln >> 4) * 4 + r; if (row < 130) mod[(size_t)row * 3072 + col] = sum[r] + bias; } }
    __syncthreads();
}
__device__ __forceinline__ void p0_transpose_item(const float* W, int N, int n0, int nvalid, bf16_t* WT, int K, int n0p, int k0, float* scr, int lane) {
    const int c = lane & 31; const bool ok = c < nvalid;
#pragma unroll 8
    for (int i = 0; i < 32; ++i) { const int kk = 2 * i + (lane >> 5); scr[kk * 33 + c] = ok ? W[(size_t)(k0 + kk) * N + n0 + c] : 0.f; }
    asm volatile("s_waitcnt lgkmcnt(0)" ::: "memory");
    const int c8 = lane & 7;
#pragma unroll
    for (int j = 0; j < 4; ++j) { const int n = (lane >> 3) + 8 * j; const float* s = scr + (8 * c8) * 33 + n;
        u32x4 o; o.x = pk2(s[0], s[33]); o.y = pk2(s[66], s[99]); o.z = pk2(s[132], s[165]); o.w = pk2(s[198], s[231]);
        *(u32x4*)(WT + (size_t)(n0p + n) * K + k0 + 8 * c8) = o; }
    asm volatile("s_waitcnt lgkmcnt(0)" ::: "memory");
}
__device__ __forceinline__ void phase0(const Params& p, unsigned char* lds) {
    { int u0 = gridDim.x >= 192 ? (int)blockIdx.x - ((int)gridDim.x - 192) : (int)blockIdx.x;
      for (int u = u0; u < 192; u += gridDim.x) if (u >= 0) p0_ada(p, lds, u); }
    const int tid_ = opaque_tid(); const int lane = tid_ & 63, wave = tid_ >> 6;
    float* scr = (float*)(lds + wave * 8448);
    constexpr int I_IN = 16 * 160, I_B = 8 * 32, I_O = 16 * 32, TOT = I_IN + 2 * I_B + I_O;
    for (int it = blockIdx.x * 8 + wave; it < TOT; it += gridDim.x * 8) {
        int r = it;
        if (r < I_IN) { const int kb = r / 160, nb = r % 160; int n0, nv;
            if (nb < 72) { n0 = nb * 32; nv = 32; } else if (nb < 152) { n0 = nb * 32 + 16; nv = 32; } else if (nb == 152) { n0 = 2304; nv = 16; } else { n0 = 0; nv = 0; }
            p0_transpose_item(p.in[10], NIN, n0, nv, (bf16_t*)(p.ws + WS_WIN), 1024, nb * 32, kb * 64, scr, lane); continue; } r -= I_IN;
        if (r < I_B) { p0_transpose_item(p.in[17], 1024, (r % 32) * 32, 32, (bf16_t*)(p.ws + WS_WBA), 512, (r % 32) * 32, (r / 32) * 64, scr, lane); continue; } r -= I_B;
        if (r < I_B) { p0_transpose_item(p.in[18], 1024, (r % 32) * 32, 32, (bf16_t*)(p.ws + WS_WBG), 512, (r % 32) * 32, (r / 32) * 64, scr, lane); continue; } r -= I_B;
        p0_transpose_item(p.in[19], 1024, (r % 32) * 32, 32, (bf16_t*)(p.ws + WS_WOUT), 1024, (r % 32) * 32, (r / 32) * 64, scr, lane);
    }
    float* rope = (float*)(p.ws + WS_ROPE);
    for (int e = blockIdx.x * 512 + tid_; e < 8200 * 32; e += gridDim.x * 512) {
        const int pp = e >> 5, i = e & 31; const int pos = pp < 8192 ? pp : pp + 8192;
        const float ang = (float)pos * p.inv[i];
        const double a = (double)ang; const double n = rint(a * 0.15915494309189535);
        const float r = (float)fma(-n, 6.283185307179586, a);
        rope[(size_t)pp * 64 + i] = __cosf(r); rope[(size_t)pp * 64 + 32 + i] = __sinf(r); }
    __syncthreads();
}

__device__ __forceinline__ void phase1(const Params& p) {
    const int tid_ = opaque_tid(); const int lane = tid_ & 63, wave = tid_ >> 6;
    const float* mod = (const float*)(p.ws + WS_MOD);
    bf16_t* H = (bf16_t*)(p.ws + WS_H);
    for (int r = blockIdx.x * 8 + wave; r < MT; r += gridDim.x * 8) {
        const float* xrow = r < MP ? p.in[0] + (size_t)r * 1024 : p.in[1] + (size_t)(r - MP) * 1024;
        const float* mr = mod + (size_t)mod_row(r) * 3072;
        f32x4 v[4]; float ss = 0.f;
#pragma unroll
        for (int j = 0; j < 4; ++j) { v[j] = *(const f32x4*)(xrow + 4 * lane + 256 * j); ss += (v[j].x * v[j].x + v[j].y * v[j].y) + (v[j].z * v[j].z + v[j].w * v[j].w); }
        const float rstd = rsqrtf(wave_sum(ss) * (1.f / 1024.f) + EPS);
#pragma unroll
        for (int j = 0; j < 4; ++j) { const int c = 4 * lane + 256 * j;
            const f32x4 g = *(const f32x4*)(p.in[7] + c), sh = *(const f32x4*)(mr + c), sc = *(const f32x4*)(mr + 1024 + c);
            const f32x4 h = v[j] * rstd * g * (sc + 1.f) + sh;
            u32x2 w; w.x = pk2(h.x, h.y); w.y = pk2(h.z, h.w);
            *(u32x2*)(H + (size_t)r * 1024 + c) = w; }
    }
}

constexpr int KS_STRIDE = 72, VT_STRIDE = 264, ATT_VT_OFF = 256 * 72 * 2;
constexpr float QSCALE = 0.125f * LOG2E;

__device__ __forceinline__ void attn_group(const bf16_t* Ks, const bf16_t* Vt, int kt0, int lo, int hi, bf16x8 qf0, bf16x8 qf1, float sinkv, f32x4 (&o)[4], int lane) {
    const int fr = lane & 15, fq = lane >> 4;
    f32x4 s[9];
#pragma unroll
    for (int t = 0; t < 9; ++t) {
        const bf16_t* kp = Ks + ((kt0 + t) * 16 + fr) * KS_STRIDE + fq * 8;
        const bf16x8 k0 = *(const bf16x8*)kp, k1 = *(const bf16x8*)(kp + 32);
        f32x4 a = {0.f, 0.f, 0.f, 0.f};
        a = mfma16(k0, qf0, a); a = mfma16(k1, qf1, a);
        s[t] = a;
    }
    float m = sinkv;
#pragma unroll
    for (int t = 0; t < 9; ++t)
#pragma unroll
        for (int r = 0; r < 4; ++r) { const int j = (kt0 + t) * 16 + fq * 4 + r; const float v = (j >= lo && j <= hi) ? s[t][r] : -1e30f; s[t][r] = v; m = fmaxf(m, v); }
    m = fmaxf(m, __shfl_xor(m, 16)); m = fmaxf(m, __shfl_xor(m, 32));
    float l = 0.f;
#pragma unroll
    for (int t = 0; t < 9; ++t)
#pragma unroll
        for (int r = 0; r < 4; ++r) { const float pv = exp2f(s[t][r] - m); l += pv; s[t][r] = pv; }
    l += __shfl_xor(l, 16); l += __shfl_xor(l, 32);
    l += exp2f(sinkv - m);
#pragma unroll
    for (int dt = 0; dt < 4; ++dt) o[dt] = (f32x4){0.f, 0.f, 0.f, 0.f};
#pragma unroll
    for (int ks = 0; ks < 5; ++ks) {
        u32x4 pw; pw.x = pk2(s[2 * ks][0], s[2 * ks][1]); pw.y = pk2(s[2 * ks][2], s[2 * ks][3]);
        if (ks < 4) { pw.z = pk2(s[2 * ks + 1][0], s[2 * ks + 1][1]); pw.w = pk2(s[2 * ks + 1][2], s[2 * ks + 1][3]); } else { pw.z = 0u; pw.w = 0u; }
        const bf16x8 pb = __builtin_bit_cast(bf16x8, pw);
#pragma unroll
        for (int dt = 0; dt < 4; ++dt) {
            const bf16_t* vp = Vt + (dt * 16 + fr) * VT_STRIDE + (kt0 + 2 * ks) * 16 + fq * 4;
            const u32x2 a0 = *(const u32x2*)vp; u32x2 a1 = {0u, 0u};
            if (ks < 4) a1 = *(const u32x2*)(vp + 16);
            u32x4 aw; aw.x = a0.x; aw.y = a0.y; aw.z = a1.x; aw.w = a1.y;
            o[dt] = mfma16(__builtin_bit_cast(bf16x8, aw), pb, o[dt]);
        }
    }
    const float inv = 1.f / l;
#pragma unroll
    for (int dt = 0; dt < 4; ++dt) o[dt] = o[dt] * inv;
}
__device__ __forceinline__ void norm_rope16(float (&a)[8], float (&b)[8], const float* g, const float* rp, int f, int sx1, int sx2) {
    float ss = 0.f;
#pragma unroll
    for (int j = 0; j < 8; ++j) ss += a[j] * a[j] + b[j] * b[j];
    ss += __shfl_xor(ss, sx1); ss += __shfl_xor(ss, sx2);
    const float rstd = rsqrtf(ss * (1.f / 64.f) + EPS);
#pragma unroll
    for (int j = 0; j < 8; ++j) {
        const float y1 = a[j] * rstd * g[f * 8 + j], y2 = b[j] * rstd * g[32 + f * 8 + j];
        const float c = rp[f * 8 + j], s = rp[32 + f * 8 + j];
        a[j] = y1 * c - y2 * s; b[j] = y2 * c + y1 * s;
    }
}

__device__ __forceinline__ void attn_rows(const Params& p, const bf16_t* Ks, const bf16_t* Vt, size_t tok, int head, int prow, int kt0, int lo, int hi, bool store, int lane) {
    const int fq = lane >> 4;
    const bf16_t* qp = (const bf16_t*)(p.ws + WS_QA) + tok * 512 + head * 64 + fq * 8;
    float a[8], b[8];
    unpack8(*(const u32x4*)qp, a); unpack8(*(const u32x4*)(qp + 32), b);
    norm_rope16(a, b, p.in[11], (const float*)(p.ws + WS_ROPE) + (size_t)prow * 64, fq, 16, 32);
    const bf16x8 qf0 = __builtin_bit_cast(bf16x8, pack8s(a, QSCALE)), qf1 = __builtin_bit_cast(bf16x8, pack8s(b, QSCALE));
    f32x4 o[4];
    attn_group(Ks, Vt, kt0, lo, hi, qf0, qf1, p.in[13][head] * LOG2E, o, lane);
    if (store) {
        const bf16_t* zp = (const bf16_t*)(p.ws + WS_ZA) + tok * 512 + head * 64 + fq * 4;
        bf16_t* op = (bf16_t*)(p.ws + WS_OA) + tok * 512 + head * 64 + fq * 4;
#pragma unroll
        for (int dt = 0; dt < 4; ++dt) { const u32x2 z = *(const u32x2*)(zp + dt * 16);
            u32x2 w; w.x = pk2(o[dt][0] * bflo(z.x), o[dt][1] * bfhi(z.x)); w.y = pk2(o[dt][2] * bflo(z.y), o[dt][3] * bfhi(z.y));
            *(u32x2*)(op + dt * 16) = w; }
    }
}

__device__ __forceinline__ void attn_prompt_unit(const Params& p, unsigned char* lds, int u) {
    bf16_t* Ks = (bf16_t*)lds; bf16_t* Vt = (bf16_t*)(lds + ATT_VT_OFF);
    const int tid = opaque_tid(), lane = tid & 63, w = tid >> 6;
    const int b = u >> 7, qb = (u & 127) >> 1, kvh = u & 1;
    const bf16_t* KA = (const bf16_t*)(p.ws + WS_KA); const bf16_t* VA = (const bf16_t*)(p.ws + WS_VA);
    const float* rope = (const float*)(p.ws + WS_ROPE);
#pragma unroll
    for (int it = 0; it < 2; ++it) {
        const int j = it * 128 + w * 16 + (lane >> 2), f = lane & 3;
        const int t = (qb - 1) * 128 + j; const int tc = t < 0 ? 0 : t;
        const bf16_t* kp = KA + ((size_t)b * SEQ + tc) * 128 + kvh * 64 + f * 8;
        float a[8], c[8];
        unpack8(*(const u32x4*)kp, a); unpack8(*(const u32x4*)(kp + 32), c);
        norm_rope16(a, c, p.in[12], rope + (size_t)tc * 64, f, 1, 2);
        if (t < 0) {
#pragma unroll
            for (int q = 0; q < 8; ++q) { a[q] = 0.f; c[q] = 0.f; } }
        *(u32x4*)(Ks + j * KS_STRIDE + f * 8) = pack8(a); *(u32x4*)(Ks + j * KS_STRIDE + 32 + f * 8) = pack8(c);
        if (t >= SEQ - 128) { float* op = p.out + O_PWK + (((size_t)b * 128 + (t - (SEQ - 128))) * 2 + kvh) * 64 + f * 8;
            *(f32x4*)op = (f32x4){a[0], a[1], a[2], a[3]}; *(f32x4*)(op + 4) = (f32x4){a[4], a[5], a[6], a[7]};
            *(f32x4*)(op + 32) = (f32x4){c[0], c[1], c[2], c[3]}; *(f32x4*)(op + 36) = (f32x4){c[4], c[5], c[6], c[7]}; }
    }
#pragma unroll
    for (int it = 0; it < 4; ++it) {
        const int idx = tid + 512 * it, j = idx >> 3, ch = idx & 7;
        const int t = (qb - 1) * 128 + j; const int tc = t < 0 ? 0 : t;
        u32x4 v = *(const u32x4*)(VA + ((size_t)b * SEQ + tc) * 128 + kvh * 64 + ch * 8);
        if (t < 0) v = (u32x4){0u, 0u, 0u, 0u};
        bf16_t* vp = Vt + (ch * 8) * VT_STRIDE + j;
        vp[0] = (bf16_t)(v.x & 0xffff); vp[VT_STRIDE] = (bf16_t)(v.x >> 16); vp[2 * VT_STRIDE] = (bf16_t)(v.y & 0xffff); vp[3 * VT_STRIDE] = (bf16_t)(v.y >> 16);
        vp[4 * VT_STRIDE] = (bf16_t)(v.z & 0xffff); vp[5 * VT_STRIDE] = (bf16_t)(v.z >> 16); vp[6 * VT_STRIDE] = (bf16_t)(v.w & 0xffff); vp[7 * VT_STRIDE] = (bf16_t)(v.w >> 16);
        if (t >= SEQ - 128) { float* op = p.out + O_PWV + (((size_t)b * 128 + (t - (SEQ - 128))) * 2 + kvh) * 64 + ch * 8;
            *(f32x4*)op = (f32x4){bflo(v.x), bfhi(v.x), bflo(v.y), bfhi(v.y)}; *(f32x4*)(op + 4) = (f32x4){bflo(v.z), bfhi(v.z), bflo(v.w), bfhi(v.w)}; }
    }
    __syncthreads();
    const int head = kvh * 4 + (w >> 1), half = w & 1;
    for (int g = 0; g < 4; ++g) {
        const int i0 = half * 64 + g * 16, i = i0 + (lane & 15), t = qb * 128 + i;
        attn_rows(p, Ks, Vt, (size_t)b * SEQ + t, head, t, i0 >> 4, qb == 0 ? 128 : i, i + 128, true, lane);
    }
    __syncthreads();
}

__device__ __forceinline__ void attn_sample_unit(const Params& p, unsigned char* lds, int u) {
    bf16_t* Ks = (bf16_t*)lds; bf16_t* Vt = (bf16_t*)(lds + ATT_VT_OFF);
    const int tid = opaque_tid(), lane = tid & 63, w = tid >> 6;
    const int sb = u >> 1, kvh = u & 1;
    const bf16_t* KA = (const bf16_t*)(p.ws + WS_KA); const bf16_t* VA = (const bf16_t*)(p.ws + WS_VA);
    const float* rope = (const float*)(p.ws + WS_ROPE);
#pragma unroll
    for (int it = 0; it < 2; ++it) {
        const int j = it * 128 + w * 16 + (lane >> 2), f = lane & 3;
        if (j < 144) {
            const int l = (j >= 128 && j < 136) ? j - 128 : 0;
            const bf16_t* kp = KA + ((size_t)MP + sb * 8 + l) * 128 + kvh * 64 + f * 8;
            float a[8], c[8];
            unpack8(*(const u32x4*)kp, a); unpack8(*(const u32x4*)(kp + 32), c);
            norm_rope16(a, c, p.in[12], rope + (size_t)(8192 + l) * 64, f, 1, 2);
            if (j < 128) { const float* cp = p.in[2] + (((size_t)sb * 128 + j) * 2 + kvh) * 64 + f * 8;
                const f32x4 c0 = *(const f32x4*)cp, c1 = *(const f32x4*)(cp + 4), c2 = *(const f32x4*)(cp + 32), c3 = *(const f32x4*)(cp + 36);
                a[0] = c0.x; a[1] = c0.y; a[2] = c0.z; a[3] = c0.w; a[4] = c1.x; a[5] = c1.y; a[6] = c1.z; a[7] = c1.w;
                c[0] = c2.x; c[1] = c2.y; c[2] = c2.z; c[3] = c2.w; c[4] = c3.x; c[5] = c3.y; c[6] = c3.z; c[7] = c3.w; }
            else if (j >= 136) {
#pragma unroll
                for (int q = 0; q < 8; ++q) { a[q] = 0.f; c[q] = 0.f; } }
            *(u32x4*)(Ks + j * KS_STRIDE + f * 8) = pack8(a); *(u32x4*)(Ks + j * KS_STRIDE + 32 + f * 8) = pack8(c);
            if (j >= 8 && j < 136) { float* op = p.out + O_SWK + (((size_t)sb * 128 + (j - 8)) * 2 + kvh) * 64 + f * 8;
                *(f32x4*)op = (f32x4){a[0], a[1], a[2], a[3]}; *(f32x4*)(op + 4) = (f32x4){a[4], a[5], a[6], a[7]};
                *(f32x4*)(op + 32) = (f32x4){c[0], c[1], c[2], c[3]}; *(f32x4*)(op + 36) = (f32x4){c[4], c[5], c[6], c[7]}; }
        }
    }
#pragma unroll
    for (int it = 0; it < 3; ++it) {
        const int idx = tid + 512 * it, j = idx >> 3, ch = idx & 7;
        if (j < 144) {
            float v[8];
            if (j < 128) { const float* cp = p.in[3] + (((size_t)sb * 128 + j) * 2 + kvh) * 64 + ch * 8;
                const f32x4 c0 = *(const f32x4*)cp, c1 = *(const f32x4*)(cp + 4);
                v[0] = c0.x; v[1] = c0.y; v[2] = c0.z; v[3] = c0.w; v[4] = c1.x; v[5] = c1.y; v[6] = c1.z; v[7] = c1.w; }
            else if (j < 136) unpack8(*(const u32x4*)(VA + ((size_t)MP + sb * 8 + (j - 128)) * 128 + kvh * 64 + ch * 8), v);
            else {
#pragma unroll
                for (int q = 0; q < 8; ++q) v[q] = 0.f; }
            const u32x4 pv = pack8(v);
            bf16_t* vp = Vt + (ch * 8) * VT_STRIDE + j;
            vp[0] = (bf16_t)(pv.x & 0xffff); vp[VT_STRIDE] = (bf16_t)(pv.x >> 16); vp[2 * VT_STRIDE] = (bf16_t)(pv.y & 0xffff); vp[3 * VT_STRIDE] = (bf16_t)(pv.y >> 16);
            vp[4 * VT_STRIDE] = (bf16_t)(pv.z & 0xffff); vp[5 * VT_STRIDE] = (bf16_t)(pv.z >> 16); vp[6 * VT_STRIDE] = (bf16_t)(pv.w & 0xffff); vp[7 * VT_STRIDE] = (bf16_t)(pv.w >> 16);
            if (j >= 8 && j < 136) { float* op = p.out + O_SWV + (((size_t)sb * 128 + (j - 8)) * 2 + kvh) * 64 + ch * 8;
                *(f32x4*)op = (f32x4){v[0], v[1], v[2], v[3]}; *(f32x4*)(op + 4) = (f32x4){v[4], v[5], v[6], v[7]}; }
        }
    }
    __syncthreads();
    if (w < 2) {
        const int q = lane & 15, l = q & 7, head = kvh * 4 + w * 2 + (q >> 3);
        attn_rows(p, Ks, Vt, (size_t)MP + sb * 8 + l, head, 8192 + l, 0, l, l + 128, true, lane);
    }
    __syncthreads();
}

constexpr int G_BC = 0, G_TOT = 16640, G_QT = 18688, G_KT = 27904, G_VT = 37120, G_ST = 55552, G_AM = 73984, G_RED = 83200;
constexpr int GS = 72;

__device__ __forceinline__ void gla_compute_b(const Params& p, unsigned char* lds, size_t tok0, int L, int h) {
    float* Bc = (float*)(lds + G_BC); float* TOT = (float*)(lds + G_TOT);
    const int tid = opaque_tid(), k = tid & 63, tg = tid >> 6;
    const float* wg = p.in[14] + h * 64 + k;
    float wr[16];
#pragma unroll
    for (int r = 0; r < 16; ++r) wr[r] = wg[r * 256];
    const float bias = p.in[15][h * 64 + k];
    const bf16_t* LR = (const bf16_t*)(p.ws + WS_LR);
    float cs[8]; float run = 0.f;
#pragma unroll
    for (int i = 0; i < 8; ++i) {
        const int tt = tg * 8 + i; float la = 0.f;
        if (tt < L) {
            const u32x4 l0 = *(const u32x4*)(LR + (tok0 + tt) * 128), l1 = *(const u32x4*)(LR + (tok0 + tt) * 128 + 8);
            float g = bias;
            g += bflo(l0.x) * wr[0] + bfhi(l0.x) * wr[1] + bflo(l0.y) * wr[2] + bfhi(l0.y) * wr[3] + bflo(l0.z) * wr[4] + bfhi(l0.z) * wr[5] + bflo(l0.w) * wr[6] + bfhi(l0.w) * wr[7];
            g += bflo(l1.x) * wr[8] + bfhi(l1.x) * wr[9] + bflo(l1.y) * wr[10] + bfhi(l1.y) * wr[11] + bflo(l1.z) * wr[12] + bfhi(l1.z) * wr[13] + bflo(l1.w) * wr[14] + bfhi(l1.w) * wr[15];
            la = (fminf(g, 0.f) - __logf(1.f + __expf(-fabsf(g)))) * (1.f / 16.f);
        }
        run += la; cs[i] = run;
    }
    TOT[tg * 64 + k] = run;
    __syncthreads();
    float pre = 0.f;
#pragma unroll
    for (int j = 0; j < 8; ++j) if (j < tg) pre += TOT[j * 64 + k];
#pragma unroll
    for (int i = 0; i < 8; ++i) Bc[(tg * 8 + i) * 65 + k] = pre + cs[i];
    __syncthreads();
}
__device__ __forceinline__ void gla_stage_vt(const Params& p, unsigned char* lds, size_t tok0, int L, int h) {
    const int tid = opaque_tid(), dv = tid & 127, t4 = tid >> 7;
    const bf16_t* VG = (const bf16_t*)(p.ws + WS_VG) + h * 128 + dv;
    unsigned w[8];
#pragma unroll
    for (int i = 0; i < 8; ++i) { const int t0 = t4 * 16 + 2 * i;
        const unsigned lo = t0 < L ? (unsigned)VG[(tok0 + t0) * 512] : 0u, hi = t0 + 1 < L ? (unsigned)VG[(tok0 + t0 + 1) * 512] : 0u;
        w[i] = lo | (hi << 16); }
    bf16_t* VT = (bf16_t*)(lds + G_VT) + dv * GS + t4 * 16;
    *(u32x4*)VT = (u32x4){w[0], w[1], w[2], w[3]}; *(u32x4*)(VT + 8) = (u32x4){w[4], w[5], w[6], w[7]};
}
__device__ __forceinline__ void gla_unit_info(int u, size_t& tok0, int& L, int& h) {
    if (u < 1024) { const int b = u >> 9, c = (u >> 2) & 127; h = u & 3; tok0 = (size_t)b * SEQ + c * 64; L = 64; }
    else { const int v = u - 1024; h = v & 3; tok0 = (size_t)MP + (v >> 2) * 8; L = 8; }
}
__device__ __forceinline__ void gla_delta_unit(const Params& p, unsigned char* lds, int u) {
    size_t tok0; int L, h; gla_unit_info(u, tok0, L, h);
    gla_compute_b(p, lds, tok0, L, h);
    const float* Bc = (const float*)(lds + G_BC);
    const int tid = opaque_tid(), lane = tid & 63, w = tid >> 6, fr = lane & 15, fq = lane >> 4;
    { const int k = tid & 63, tg = tid >> 6; const float bl = Bc[63 * 65 + k];
      const bf16_t* KG = (const bf16_t*)(p.ws + WS_KG) + h * 64 + k;
      float v[8];
#pragma unroll
      for (int i = 0; i < 8; ++i) { const int tt = tg * 8 + i; const float kv = tt < L ? bf2f(KG[(tok0 + tt) * 256]) : 0.f; v[i] = kv * __expf(bl - Bc[tt * 65 + k]); }
      *(u32x4*)((bf16_t*)(lds + G_KT) + k * GS + tg * 8) = pack8(v); }
    gla_stage_vt(p, lds, tok0, L, h);
    __syncthreads();
    const bf16_t* VT = (const bf16_t*)(lds + G_VT) + (w * 16 + fr) * GS + fq * 8;
    const bf16x8 a0 = *(const bf16x8*)VT, a1 = *(const bf16x8*)(VT + 32);
#pragma unroll
    for (int kt = 0; kt < 4; ++kt) {
        const bf16_t* KT = (const bf16_t*)(lds + G_KT) + (kt * 16 + fr) * GS + fq * 8;
        f32x4 acc = {0.f, 0.f, 0.f, 0.f};
        acc = mfma16(a0, *(const bf16x8*)KT, acc); acc = mfma16(a1, *(const bf16x8*)(KT + 32), acc);
        const int kk = kt * 16 + fr, dv = w * 16 + fq * 4;
        if (u < 1024) *(f32x4*)((float*)(p.ws + WS_DS) + (size_t)u * 8192 + kk * 128 + dv) = acc;
        else { const int v = u - 1024; const size_t so = ((size_t)v * 64 + kk) * 128 + dv;
            const float d = __expf(Bc[63 * 65 + kk]); const f32x4 s0 = *(const f32x4*)(p.in[4] + so);
            *(f32x4*)(p.out + O_SGS + so) = s0 * d + acc; }
    }
    if (u < 1024 && tid < 64) ((float*)(p.ws + WS_DEC))[(size_t)u * 64 + tid] = __expf(Bc[63 * 65 + tid]);
    __syncthreads();
}
__device__ __forceinline__ void gla_scan_dummy(const Params& p) {
    if (threadIdx.x >= 256) return;
    const int e = blockIdx.x * 256 + threadIdx.x;
    if (e >= 65536) return;
    const int b = e >> 15, h = (e >> 13) & 3, k = (e >> 7) & 63, dv = e & 127;
    float* DS = (float*)(p.ws + WS_DS); const float* DEC = (const float*)(p.ws + WS_DEC);
    float S = 0.f;
#pragma unroll 8
    for (int c = 0; c < 128; ++c) { const size_t u = (size_t)b * 512 + c * 4 + h;
        const float d = DEC[u * 64 + k]; float* sp = DS + u * 8192 + k * 128 + dv; const float ds = *sp; *sp = ds; S = d * S + ds; }
    if (S == 123.456f) p.out[O_PGS + e] = S;
}
__device__ __forceinline__ void gla_scan(const Params& p) {
    if (threadIdx.x >= 256) return;
    const int e = blockIdx.x * 256 + threadIdx.x;
    if (e >= 65536) return;
    const int b = e >> 15, h = (e >> 13) & 3, k = (e >> 7) & 63, dv = e & 127;
    float* DS = (float*)(p.ws + WS_DS); const float* DEC = (const float*)(p.ws + WS_DEC);
    float S = 0.f;
#pragma unroll 8
    for (int c = 0; c < 128; ++c) { const size_t u = (size_t)b * 512 + c * 4 + h;
        const float d = DEC[u * 64 + k]; float* sp = DS + u * 8192 + k * 128 + dv; const float ds = *sp; *sp = S; S = d * S + ds; }
    p.out[O_PGS + e] = S;
}
__device__ __forceinline__ void gla_out_unit(const Params& p, unsigned char* lds, int u) {
    size_t tok0; int L, h; gla_unit_info(u, tok0, L, h);
    gla_compute_b(p, lds, tok0, L, h);
    const float* Bc = (const float*)(lds + G_BC);
    const int tid = opaque_tid(), lane = tid & 63, w = tid >> 6, fr = lane & 15, fq = lane >> 4;
    { const int k = tid & 63, tg = tid >> 6; const float bm = Bc[31 * 65 + k];
      const bf16_t* QG = (const bf16_t*)(p.ws + WS_QG) + h * 64 + k; const bf16_t* KG = (const bf16_t*)(p.ws + WS_KG) + h * 64 + k;
      bf16_t* QT = (bf16_t*)(lds + G_QT) + k; bf16_t* KT = (bf16_t*)(lds + G_KT) + k;
#pragma unroll
      for (int i = 0; i < 8; ++i) { const int tt = tg * 8 + i; const float bb = Bc[tt * 65 + k];
          const float qv = tt < L ? bf2f(QG[(tok0 + tt) * 256]) : 0.f, kv = tt < L ? bf2f(KG[(tok0 + tt) * 256]) : 0.f;
          QT[tt * GS] = (bf16_t)(pk2(qv * __expf(bb - bm), 0.f) & 0xffff); KT[tt * GS] = (bf16_t)(pk2(kv * __expf(bm - bb), 0.f) & 0xffff); } }
    gla_stage_vt(p, lds, tok0, L, h);
    { const int dv = tid & 127, kg = tid >> 7;
      const float* Sp = (u < 1024 ? (const float*)(p.ws + WS_DS) + (size_t)u * 8192 : p.in[4] + (size_t)(u - 1024) * 8192) + dv;
      float v[16];
#pragma unroll
      for (int i = 0; i < 16; ++i) { const int kk = kg * 16 + i; v[i] = Sp[kk * 128] * __expf(Bc[31 * 65 + kk]); }
      bf16_t* ST = (bf16_t*)(lds + G_ST) + dv * GS + kg * 16;
      u32x4 w0, w1; w0.x = pk2(v[0], v[1]); w0.y = pk2(v[2], v[3]); w0.z = pk2(v[4], v[5]); w0.w = pk2(v[6], v[7]);
      w1.x = pk2(v[8], v[9]); w1.y = pk2(v[10], v[11]); w1.z = pk2(v[12], v[13]); w1.w = pk2(v[14], v[15]);
      *(u32x4*)ST = w0; *(u32x4*)(ST + 8) = w1; }
    __syncthreads();
    const int tt = w & 3, hh = w >> 2;
    const bf16_t* QTr = (const bf16_t*)(lds + G_QT) + (tt * 16 + fr) * GS + fq * 8;
    const bf16x8 bq0 = *(const bf16x8*)QTr, bq1 = *(const bf16x8*)(QTr + 32);
#pragma unroll
    for (int q = 0; q < 2; ++q) { const int st = hh * 2 + q;
        const bf16_t* KTr = (const bf16_t*)(lds + G_KT) + (st * 16 + fr) * GS + fq * 8;
        f32x4 acc = {0.f, 0.f, 0.f, 0.f};
        acc = mfma16(*(const bf16x8*)KTr, bq0, acc); acc = mfma16(*(const bf16x8*)(KTr + 32), bq1, acc);
        const int ti = tt * 16 + fr, s0 = st * 16 + fq * 4;
        u32x2 wv; wv.x = pk2(s0 <= ti ? acc[0] : 0.f, s0 + 1 <= ti ? acc[1] : 0.f); wv.y = pk2(s0 + 2 <= ti ? acc[2] : 0.f, s0 + 3 <= ti ? acc[3] : 0.f);
        *(u32x2*)((bf16_t*)(lds + G_AM) + ti * GS + s0) = wv; }
    __syncthreads();
    const bf16_t* AMr = (const bf16_t*)(lds + G_AM) + (tt * 16 + fr) * GS + fq * 8;
    const bf16x8 ba0 = *(const bf16x8*)AMr, ba1 = *(const bf16x8*)(AMr + 32);
    f32x4 o[4]; float ss = 0.f;
#pragma unroll
    for (int d4 = 0; d4 < 4; ++d4) { const int row = (hh * 4 + d4) * 16 + fr;
        const bf16_t* VT = (const bf16_t*)(lds + G_VT) + row * GS + fq * 8; const bf16_t* ST = (const bf16_t*)(lds + G_ST) + row * GS + fq * 8;
        f32x4 acc = {0.f, 0.f, 0.f, 0.f};
        acc = mfma16(*(const bf16x8*)VT, ba0, acc); acc = mfma16(*(const bf16x8*)(VT + 32), ba1, acc);
        acc = mfma16(*(const bf16x8*)ST, bq0, acc); acc = mfma16(*(const bf16x8*)(ST + 32), bq1, acc);
        o[d4] = acc; ss += (acc[0] * acc[0] + acc[1] * acc[1]) + (acc[2] * acc[2] + acc[3] * acc[3]); }
    ss += __shfl_xor(ss, 16); ss += __shfl_xor(ss, 32);
    float* RED = (float*)(lds + G_RED);
    if (fq == 0) RED[hh * 64 + tt * 16 + fr] = ss;
    __syncthreads();
    const float rstd = rsqrtf((RED[tt * 16 + fr] + RED[64 + tt * 16 + fr]) * (1.f / 128.f) + EPS);
    const int ti = tt * 16 + fr;
    if (ti < L) {
        const size_t tok = tok0 + ti;
#pragma unroll
        for (int d4 = 0; d4 < 4; ++d4) { const int dv = (hh * 4 + d4) * 16 + fq * 4;
            const f32x4 g = *(const f32x4*)(p.in[16] + dv);
            const u32x2 z = *(const u32x2*)((const bf16_t*)(p.ws + WS_ZG) + tok * 512 + h * 128 + dv);
            u32x2 wv; wv.x = pk2(o[d4][0] * rstd * g.x * bflo(z.x), o[d4][1] * rstd * g.y * bfhi(z.x));
            wv.y = pk2(o[d4][2] * rstd * g.z * bflo(z.y), o[d4][3] * rstd * g.w * bfhi(z.y));
            *(u32x2*)((bf16_t*)(p.ws + WS_OG) + tok * 512 + h * 128 + dv) = wv; }
    }
    __syncthreads();
}

__global__ void __launch_bounds__(512) mega_fwd(Params p) {
    extern __shared__ __attribute__((aligned(16))) unsigned char lds[];
    cg::grid_group grid = cg::this_grid();
    const int lo = p.ph_lo, hi = p.ph_hi;
#define IN(k) (lo <= (k) && (k) < hi)
#define SEAM(k) do { if (IN(k) && IN((k) + 1)) grid.sync(); } while (0)
    PG8_LAS unsigned char* glds = (PG8_LAS unsigned char*)lds;
#ifndef PROBE_MASK
#define PROBE_MASK 0
#endif
#define REP(bit) ((((PROBE_MASK) >> (bit)) & 1) + 1)
    if (IN(0)) for (int rep = 0; rep < REP(0); ++rep) phase0(p, lds);
    SEAM(0);
    if (IN(1)) for (int rep = 0; rep < REP(1); ++rep) phase1(p);
    SEAM(1);
    if (IN(2)) for (int rep = 0; rep < REP(2); ++rep) { pg8::Gemm g{(const bf16_t*)(p.ws + WS_H), (const bf16_t*)(p.ws + WS_WIN), MT, NINP, 1024}; pg8::StaticOrder S; S.init(MT, NINP, gridDim.x, blockIdx.x);
        EpiProj E{p.ws}; pg8::gemm_phase<EpiProj, pg8::StaticOrder, true, true>(glds, g, S, E); }
    SEAM(2);
    if (IN(3)) {
        for (int u = blockIdx.x; u < 2048; u += gridDim.x) {
            if (u < 256) { for (int rep = 0; rep < REP(3); ++rep) attn_prompt_unit(p, lds, u); }
            else if (u < 512) { for (int rep = 0; rep < REP(4); ++rep) attn_sample_unit(p, lds, u - 256); }
            else { for (int rep = 0; rep < REP(5); ++rep) gla_delta_unit(p, lds, u - 512); }
        }
    }
    SEAM(3);
    if (IN(4)) { gla_scan(p); if (REP(9) > 1) gla_scan_dummy(p); }
    SEAM(4);
    if (IN(5)) for (int rep = 0; rep < REP(6); ++rep) { for (int u = blockIdx.x; u < 1536; u += gridDim.x) gla_out_unit(p, lds, u); }
    SEAM(5);
    if (IN(6)) for (int rep = 0; rep < REP(7); ++rep) {
        pg8::StaticOrder S; S.init(MT, 1024, gridDim.x, blockIdx.x);
        { pg8::Gemm g{(const bf16_t*)(p.ws + WS_OA), (const bf16_t*)(p.ws + WS_WBA), MT, 1024, 512};
          EpiBranch<0> E{(const bf16_t*)(p.ws + WS_MA), nullptr, (bf16_t*)(p.ws + WS_TMP)};
          pg8::gemm_phase<EpiBranch<0>, pg8::StaticOrder, true, true>(glds, g, S, E); }
        { pg8::Gemm g{(const bf16_t*)(p.ws + WS_OG), (const bf16_t*)(p.ws + WS_WBG), MT, 1024, 512};
          EpiBranch<1> E{(const bf16_t*)(p.ws + WS_MG), (const bf16_t*)(p.ws + WS_TMP), (bf16_t*)(p.ws + WS_MRG)};
          pg8::gemm_phase<EpiBranch<1>, pg8::StaticOrder, true, true>(glds, g, S, E); }
    }
    SEAM(6);
    if (IN(7)) for (int rep = 0; rep < REP(8); ++rep) { pg8::Gemm g{(const bf16_t*)(p.ws + WS_MRG), (const bf16_t*)(p.ws + WS_WOUT), MT, 1024, 1024}; pg8::StaticOrder S; S.init(MT, 1024, gridDim.x, blockIdx.x);
        EpiOut E{p.in[0], p.in[1], (const float*)(p.ws + WS_MOD), p.out + O_Y};
        pg8::gemm_phase<EpiOut, pg8::StaticOrder, true, true>(glds, g, S, E); }
#undef IN
#undef SEAM
}

constexpr int LDS_BYTES = 131072;
#ifndef N_LAUNCH_MODE
#define N_LAUNCH_MODE 1
#endif

extern "C" void kernel_launch(void* const* d_in, const int* in_sizes, int n_in, void* d_out, int out_size, void* d_ws, size_t ws_size, hipStream_t stream) {
    static int grid = 0;
    if (grid == 0) {
        if (n_in != 20 || ws_size < WS_END) { fprintf(stderr, "kernel_launch: unexpected n_in %d / ws_size %zu (need %zu)\n", n_in, ws_size, (size_t)WS_END); grid = -1; return; }
        int dev = 0, cus = 0, per_cu = 0;
        hipGetDevice(&dev);
        hipDeviceGetAttribute(&cus, hipDeviceAttributeMultiprocessorCount, dev);
        if (hipFuncSetAttribute((const void*)mega_fwd, hipFuncAttributeMaxDynamicSharedMemorySize, LDS_BYTES) != hipSuccess) { fprintf(stderr, "kernel_launch: hipFuncSetAttribute failed\n"); grid = -1; return; }
        if (hipOccupancyMaxActiveBlocksPerMultiprocessor(&per_cu, (const void*)mega_fwd, 512, LDS_BYTES) != hipSuccess || per_cu < 1) { fprintf(stderr, "kernel_launch: occupancy query gives %d\n", per_cu); per_cu = 1; }
        (void)hipGetLastError();
        grid = cus * 1;
        if (grid > cus * per_cu) grid = cus * per_cu;
    }
    if (grid < 0) return;
    Params p{};
    for (int i = 0; i < 20; ++i) p.in[i] = (const float*)d_in[i];
    p.out = (float*)d_out; p.ws = (unsigned char*)d_ws;
    for (int i = 0; i < 32; ++i) { const float e = (float)i / 32.0f; const float pw = powf(10000.0f, e); p.inv[i] = 1.0f / pw; }
#if N_LAUNCH_MODE == 1
    p.ph_lo = 0; p.ph_hi = 8;
    void* args[] = {&p};
    hipError_t e = hipLaunchCooperativeKernel((const void*)mega_fwd, dim3(grid), dim3(512), args, LDS_BYTES, stream);
    if (e != hipSuccess) fprintf(stderr, "cooperative launch failed: %s (grid %d)\n", hipGetErrorString(e), grid);
#else
    for (int ph = 0; ph < 8; ++ph) { p.ph_lo = ph; p.ph_hi = ph + 1;
        hipLaunchKernelGGL(mega_fwd, dim3(grid), dim3(512), LDS_BYTES, stream, p); }
#endif
}
```

```cpp
#define PROBE_MASK 0
#include <hip/hip_runtime.h>
#include <hip/hip_cooperative_groups.h>
#include <cstdio>
#include <cstdint>
#include <cmath>
namespace cg = cooperative_groups;
__device__ __forceinline__ int opaque_tid() { int t = threadIdx.x; asm volatile("" : "+v"(t)); return t; }
namespace pg8 {
#define PG8_LAS __attribute__((address_space(3)))
typedef unsigned short bf16_t;
typedef short bf16x8 __attribute__((ext_vector_type(8)));
typedef float f32x4 __attribute__((ext_vector_type(4)));
typedef unsigned u32x4 __attribute__((ext_vector_type(4)));
constexpr int BM = 256, BK = 64, HALF = 128, HTB = HALF * BK * 2  , STAGE_BYTES = 8 * HTB, NXCD = 8, WGM = 8;

__host__ __device__ __forceinline__ int lds_byte(int r, int c) { const int st = (r >> 4) * 2 + (c >> 5), rr = r & 15, cc = c & 31, ob = rr * 64 + cc * 2; return st * 1024 + (ob ^ (((ob >> 9) & 1) << 5)); }
__host__ __device__ __forceinline__ void stage_rc(int b, int& R, int& C) { const int st = b / 1024, sb = b % 1024, swz = sb ^ (((sb >> 9) & 1) << 5); R = (st >> 1) * 16 + swz / 64; C = (st & 1) * 32 + (swz % 64) / 2; }
__host__ __device__ __forceinline__ int perm32(int rho) { const int n = rho >> 4, i = rho & 15; return 8 * (i >> 2) + 4 * n + (i & 3); }

struct Unit { int pm, pn; };
struct Gemm { const bf16_t* A; const bf16_t* Bt; int M, N, K; };

struct StaticOrder {
    int nM, nN, nwg, G, c;
    __host__ __device__ void init(int M, int N, int G_, int c_) { nM = M / BM; nN = N / BM; nwg = nM * nN; G = G_; c = c_; }
    __host__ __device__ bool next(int i, Unit& u) const {
        const long L = (long)i * G + c; if (L >= nwg) return false;
        int wgid = (int)L; { const int q = nwg / NXCD, r = nwg % NXCD, xcd = wgid % NXCD, off = wgid / NXCD; wgid = (xcd < r ? xcd * (q + 1) : r * (q + 1) + (xcd - r) * q) + off; }
        const int nig = WGM * nN, gid = wgid / nig, fm = gid * WGM, gsz = (nM - fm) < WGM ? (nM - fm) : WGM;
        u.pm = fm + ((wgid % nig) % gsz); u.pn = (wgid % nig) / gsz; return true;
    }
    __device__ __forceinline__ void a_ready(const Unit&) const {}
    __device__ __forceinline__ void done(const Unit&) const {}
};
__device__ __forceinline__ unsigned cvt_pk_bf16(float lo, float hi) { unsigned r; asm volatile("v_cvt_pk_bf16_f32 %0, %1, %2" : "=v"(r) : "v"(lo), "v"(hi)); return r; }
typedef float f32x2 __attribute__((ext_vector_type(2)));
template <class Epi, class Sched, bool ALIGN_EPI = false, bool SP2 = false>
__device__ __forceinline__ void gemm_phase(PG8_LAS unsigned char* lds, const Gemm g, const Sched& S, const Epi& E) {
    const int tid = opaque_tid(), wid = __builtin_amdgcn_readfirstlane(tid >> 6), lane = tid & 63, wr = wid >> 2, wc = wid & 3, fr = lane & 15, fq = lane >> 4;
    const int K = g.K, nt = K / BK;
    unsigned voffA[2], voffB[2];
#pragma unroll
    for (int i = 0; i < 2; ++i) { int R, C; stage_rc(tid * 16 + i * 8192, R, C); const int Rb = Epi::PERM ? ((R & ~31) + perm32(R & 31)) : R;
        voffA[i] = (unsigned)(R * K + C) * 2u; voffB[i] = (unsigned)(Rb * K + C) * 2u; }
    const size_t kstep = (size_t)(BK * 2);
    const size_t hstep = (size_t)HALF * K * 2;
    const size_t tstep = 2 * hstep;
    const unsigned ldsw = (unsigned)wid * 1024u;
    const int aoff = lds_byte(wr * 64 + fr, fq * 8), boff = lds_byte(wc * 32 + fr, fq * 8);
#define PG8_SA(b, h) (((b) * 2 + (h)) * HTB)
#define PG8_SB(b, h) ((4 + (b) * 2 + (h)) * HTB)
#define PG8_STAGE(bufoff, gbase, voff) do { _Pragma("unroll") for (int _i = 0; _i < 2; ++_i) \
        __builtin_amdgcn_global_load_lds((const unsigned*)((const char*)(gbase) + (voff)[_i]), (PG8_LAS unsigned*)(lds + (bufoff) + ldsw + _i * 8192), 16, 0, 0); } while (0)
#define PG8_LDA(dst, b, h) do { _Pragma("unroll") for (int m = 0; m < 4; ++m) _Pragma("unroll") for (int k = 0; k < 2; ++k) dst[m][k] = *(const PG8_LAS bf16x8*)(lds + PG8_SA(b, h) + aoff + m * 2048 + k * 1024); } while (0)
#define PG8_LDB(dst, b, h) do { _Pragma("unroll") for (int n = 0; n < 2; ++n) _Pragma("unroll") for (int k = 0; k < 2; ++k) dst[n][k] = *(const PG8_LAS bf16x8*)(lds + PG8_SB(b, h) + boff + n * 2048 + k * 1024); } while (0)
#define PG8_MMA(ai, bj, At, Bt) do { __builtin_amdgcn_s_setprio(1); _Pragma("unroll") for (int m = 0; m < 4; ++m) _Pragma("unroll") for (int n = 0; n < 2; ++n) _Pragma("unroll") for (int k = 0; k < 2; ++k) \
        acc[ai][bj][m][n] = __builtin_amdgcn_mfma_f32_16x16x32_bf16(Bt[n][k], At[m][k], acc[ai][bj][m][n], 0, 0, 0); __builtin_amdgcn_s_setprio(0); } while (0)
#define PG8_WAIT_V(n) asm volatile("s_waitcnt vmcnt(" #n ")" ::: "memory")
#define PG8_WAIT_L(n) asm volatile("s_waitcnt lgkmcnt(" #n ")" ::: "memory")
#define PG8_BAR __builtin_amdgcn_s_barrier()
#define PG8_SCHED __builtin_amdgcn_sched_barrier(0)
    Unit cur, nxt; int ui = 0;
    if (!S.next(0, cur)) return;
    f32x4 acc[2][2][4][2];
#pragma unroll
    for (int a = 0; a < 2; ++a)
#pragma unroll
        for (int b = 0; b < 2; ++b)
#pragma unroll
            for (int m = 0; m < 4; ++m)
#pragma unroll
                for (int n = 0; n < 2; ++n) acc[a][b][m][n] = (f32x4){0.f, 0.f, 0.f, 0.f};
    bf16x8 At[4][2], B0[2][2], B1[2][2];
    const char* cA = (const char*)g.A + (size_t)cur.pm * tstep; const char* cB = (const char*)g.Bt + (size_t)cur.pn * tstep;
    S.a_ready(cur);
    if constexpr (SP2) {
        PG8_STAGE(PG8_SB(0, 0), cB, voffB); PG8_STAGE(PG8_SB(0, 1), cB + hstep, voffB); PG8_STAGE(PG8_SA(0, 0), cA, voffA); PG8_STAGE(PG8_SA(0, 1), cA + hstep, voffA);
        if (wr == 1) PG8_BAR;
        PG8_WAIT_V(2); PG8_BAR;
        PG8_STAGE(PG8_SB(1, 0), cB + kstep, voffB); PG8_STAGE(PG8_SA(1, 0), cA + kstep, voffA); PG8_STAGE(PG8_SB(1, 1), cB + hstep + kstep, voffB);
        PG8_WAIT_V(6); PG8_BAR;
    } else {
        PG8_STAGE(PG8_SB(0, 0), cB, voffB); PG8_STAGE(PG8_SA(0, 0), cA, voffA); PG8_STAGE(PG8_SB(0, 1), cB + hstep, voffB); PG8_STAGE(PG8_SA(0, 1), cA + hstep, voffA);
        if (wr == 1) PG8_BAR;
        PG8_WAIT_V(4); PG8_BAR;
        PG8_STAGE(PG8_SB(1, 0), cB + kstep, voffB); PG8_STAGE(PG8_SA(1, 0), cA + kstep, voffA); PG8_STAGE(PG8_SB(1, 1), cB + hstep + kstep, voffB);
        PG8_WAIT_V(6); PG8_BAR;
    }
    for (;;) {
        const bool has_next = S.next(ui + 1, nxt);
        const char* nA = has_next ? (const char*)g.A + (size_t)nxt.pm * tstep : cA; const char* nB = has_next ? (const char*)g.Bt + (size_t)nxt.pn * tstep : cB;
        for (int t = 0; t < nt; t += 2) {
            const bool last = (t == nt - 2);
            const char* a1 = cA + (size_t)(t + 1) * kstep;
            const char* a2 = last ? nA : cA + (size_t)(t + 2) * kstep; const char* b2 = last ? nB : cB + (size_t)(t + 2) * kstep;
            const char* a3 = a2 + kstep; const char* b3 = b2 + kstep;
            if (last && has_next) S.a_ready(nxt);
            if constexpr (SP2) {
            PG8_LDB(B0, 0, 0); PG8_LDB(B1, 0, 1); PG8_SCHED; PG8_LDA(At, 0, 0); PG8_STAGE(PG8_SA(1, 1), a1 + hstep, voffA);
            PG8_WAIT_V(8); PG8_WAIT_L(0); PG8_BAR; PG8_MMA(0, 0, At, B0); PG8_MMA(0, 1, At, B1); PG8_BAR; PG8_SCHED;
            PG8_LDA(At, 0, 1); PG8_STAGE(PG8_SB(0, 0), b2, voffB); PG8_STAGE(PG8_SB(0, 1), b2 + hstep, voffB); PG8_STAGE(PG8_SA(0, 0), a2, voffA);
            PG8_WAIT_V(8); PG8_WAIT_L(0); PG8_BAR; PG8_MMA(1, 0, At, B0); PG8_MMA(1, 1, At, B1); PG8_BAR; PG8_SCHED;
            PG8_LDB(B0, 1, 0); PG8_LDB(B1, 1, 1); PG8_SCHED; PG8_LDA(At, 1, 0); PG8_STAGE(PG8_SA(0, 1), a2 + hstep, voffA);
            PG8_WAIT_V(8); PG8_WAIT_L(0); PG8_BAR; PG8_MMA(0, 0, At, B0); PG8_MMA(0, 1, At, B1); PG8_BAR; PG8_SCHED;
            PG8_LDA(At, 1, 1); PG8_STAGE(PG8_SB(1, 0), b3, voffB); PG8_STAGE(PG8_SB(1, 1), b3 + hstep, voffB); PG8_STAGE(PG8_SA(1, 0), a3, voffA);
            PG8_WAIT_V(8); PG8_WAIT_L(0); PG8_BAR; PG8_MMA(1, 0, At, B0); PG8_MMA(1, 1, At, B1); PG8_BAR; PG8_SCHED;
            } else {
            PG8_LDB(B0, 0, 0); PG8_SCHED; PG8_LDA(At, 0, 0); PG8_STAGE(PG8_SA(1, 1), a1 + hstep, voffA);
            PG8_WAIT_L(8); PG8_BAR; PG8_WAIT_L(0); PG8_MMA(0, 0, At, B0); PG8_BAR; PG8_SCHED;
            PG8_LDB(B1, 0, 1); PG8_STAGE(PG8_SB(0, 0), b2, voffB);
            PG8_BAR; PG8_WAIT_L(0); PG8_MMA(0, 1, At, B1); PG8_BAR;
            PG8_LDA(At, 0, 1); PG8_STAGE(PG8_SA(0, 0), a2, voffA);
            PG8_BAR; PG8_WAIT_L(0); PG8_MMA(1, 0, At, B0); PG8_BAR; PG8_SCHED;
            PG8_STAGE(PG8_SB(0, 1), b2 + hstep, voffB);
            PG8_WAIT_V(6); PG8_BAR; PG8_MMA(1, 1, At, B1); PG8_BAR;
            PG8_LDB(B0, 1, 0); PG8_SCHED; PG8_LDA(At, 1, 0); PG8_STAGE(PG8_SA(0, 1), a2 + hstep, voffA);
            PG8_WAIT_L(8); PG8_BAR; PG8_WAIT_L(0); PG8_MMA(0, 0, At, B0); PG8_BAR; PG8_SCHED;
            PG8_LDB(B1, 1, 1); PG8_STAGE(PG8_SB(1, 0), b3, voffB);
            PG8_BAR; PG8_WAIT_L(0); PG8_MMA(0, 1, At, B1); PG8_BAR;
            PG8_LDA(At, 1, 1); PG8_STAGE(PG8_SA(1, 0), a3, voffA);
            PG8_BAR; PG8_WAIT_L(0); PG8_MMA(1, 0, At, B0); PG8_BAR; PG8_SCHED;
            PG8_STAGE(PG8_SB(1, 1), b3 + hstep, voffB);
            PG8_WAIT_V(6); PG8_BAR; PG8_MMA(1, 1, At, B1); PG8_BAR;
            }
        }
        if constexpr (ALIGN_EPI) { if (wr == 0) PG8_BAR; }
        if constexpr (!Epi::AFTER_DRAIN) { E(acc, cur, wr, wc, fr, fq); S.done(cur); }
        if (!has_next) break;
#pragma unroll
        for (int a = 0; a < 2; ++a)
#pragma unroll
            for (int b = 0; b < 2; ++b)
#pragma unroll
                for (int m = 0; m < 4; ++m)
#pragma unroll
                    for (int n = 0; n < 2; ++n) acc[a][b][m][n] = (f32x4){0.f, 0.f, 0.f, 0.f};
        cur = nxt; cA = nA; cB = nB; ++ui;
        if constexpr (ALIGN_EPI) { if (wr == 1) PG8_BAR; }
    }
    PG8_WAIT_V(0);
    if constexpr (!ALIGN_EPI) { if (wr == 0) PG8_BAR; }
    PG8_BAR;
    if constexpr (Epi::AFTER_DRAIN) { E.fused(acc, cur, wr, wc, fr, fq, lds, wid, lane); S.done(cur); }
#undef PG8_SA
#undef PG8_SB
#undef PG8_STAGE
#undef PG8_LDA
#undef PG8_LDB
#undef PG8_MMA
#undef PG8_WAIT_V
#undef PG8_WAIT_L
#undef PG8_BAR
#undef PG8_SCHED
}
}

using pg8::bf16_t; using pg8::bf16x8; using pg8::f32x4; using pg8::u32x4; using pg8::Unit;
typedef unsigned u32x2 __attribute__((ext_vector_type(2)));
typedef float f32x2v __attribute__((ext_vector_type(2)));
typedef __bf16 bf16x2v __attribute__((ext_vector_type(2)));

constexpr int DM = 1024, SEQ = 8192, MP = 16384, MS = 1024, MT = MP + MS;
constexpr int NIN = 4880, NINP = 5120;
constexpr float EPS = 1e-6f;
constexpr float LOG2E = 1.4426950408889634f;

constexpr size_t WS_MOD = 0;
constexpr size_t WS_ROPE = WS_MOD + 1597440;
constexpr size_t WS_WIN = WS_ROPE + 2099200;
constexpr size_t WS_WBA = WS_WIN + 10485760;
constexpr size_t WS_WBG = WS_WBA + 1048576;
constexpr size_t WS_WOUT = WS_WBG + 1048576;
constexpr size_t WS_H = WS_WOUT + 2097152;
constexpr size_t WS_OA = WS_H;
constexpr size_t WS_OG = WS_H + 17825792;
constexpr size_t WS_QA = WS_H + 35651584;
constexpr size_t WS_KA = WS_QA + 17825792;
constexpr size_t WS_VA = WS_KA + 4456448;
constexpr size_t WS_QG = WS_VA + 4456448;
constexpr size_t WS_TMP = WS_QA;
constexpr size_t WS_KG = WS_QG + 8912896;
constexpr size_t WS_VG = WS_KG + 8912896;
constexpr size_t WS_ZG = WS_VG + 17825792;
constexpr size_t WS_MRG = WS_KG;
constexpr size_t WS_ZA = WS_ZG + 17825792;
constexpr size_t WS_MA = WS_ZA + 17825792;
constexpr size_t WS_MG = WS_MA + 35651584;
constexpr size_t WS_LR = WS_MG + 35651584;
constexpr size_t WS_DS = WS_LR + 4456448;
constexpr size_t WS_DEC = WS_DS + 33554432;
constexpr size_t WS_END = WS_DEC + 262144;

constexpr size_t O_Y = 0;
constexpr size_t O_PWK = 17825792;
constexpr size_t O_PWV = O_PWK + 32768;
constexpr size_t O_PGS = O_PWV + 32768;
constexpr size_t O_SWK = O_PGS + 65536;
constexpr size_t O_SWV = O_SWK + 2097152;
constexpr size_t O_SGS = O_SWV + 2097152;

struct Params {
    const float* in[20];
    float* out; unsigned char* ws;
    float inv[32];
    int ph_lo, ph_hi;
};

__device__ __forceinline__ unsigned pk2(float lo, float hi) { f32x2v v = {lo, hi}; bf16x2v b = __builtin_convertvector(v, bf16x2v); return __builtin_bit_cast(unsigned, b); }
__device__ __forceinline__ float bflo(unsigned w) { return __uint_as_float(w << 16); }
__device__ __forceinline__ float bfhi(unsigned w) { return __uint_as_float(w & 0xffff0000u); }
__device__ __forceinline__ float bf2f(bf16_t h) { return __uint_as_float((unsigned)h << 16); }
__device__ __forceinline__ float fast_rcp(float x) { return __builtin_amdgcn_rcpf(x); }
__device__ __forceinline__ float sigmoidf_(float x) { return fast_rcp(1.f + __expf(-x)); }
__device__ __forceinline__ float siluf_(float x) { return x * fast_rcp(1.f + __expf(-x)); }
__device__ __forceinline__ float wave_sum(float v) {
#pragma unroll
    for (int o = 1; o < 64; o <<= 1) v += __shfl_xor(v, o);
    return v;
}
__device__ __forceinline__ f32x4 mfma16(bf16x8 a, bf16x8 b, f32x4 c) { return __builtin_amdgcn_mfma_f32_16x16x32_bf16(a, b, c, 0, 0, 0); }
__device__ __forceinline__ void unpack8(const u32x4 w, float (&a)[8]) {
    a[0] = bflo(w.x); a[1] = bfhi(w.x); a[2] = bflo(w.y); a[3] = bfhi(w.y); a[4] = bflo(w.z); a[5] = bfhi(w.z); a[6] = bflo(w.w); a[7] = bfhi(w.w);
}
__device__ __forceinline__ u32x4 pack8(const float (&a)[8]) { u32x4 w; w.x = pk2(a[0], a[1]); w.y = pk2(a[2], a[3]); w.z = pk2(a[4], a[5]); w.w = pk2(a[6], a[7]); return w; }
__device__ __forceinline__ u32x4 pack8s(const float (&a)[8], float sc) { u32x4 w; w.x = pk2(a[0] * sc, a[1] * sc); w.y = pk2(a[2] * sc, a[3] * sc); w.z = pk2(a[4] * sc, a[5] * sc); w.w = pk2(a[6] * sc, a[7] * sc); return w; }
__device__ __forceinline__ int mod_row(int r) { return r < MP ? (r >> 13) : 2 + ((r - MP) >> 3); }

struct EpiProj {
    static constexpr bool PERM = true, AFTER_DRAIN = false;
    unsigned char* ws;
    __device__ __forceinline__ void operator()(const f32x4 (&acc)[2][2][4][2], const Unit& u, int wr, int wc, int fr, int fq) const {
        const int row0 = u.pm * 256 + wr * 64 + fr;
#pragma unroll
        for (int bj = 0; bj < 2; ++bj) {
            const int cb = u.pn * 2 + bj;
            size_t off; int ld, cbase, act;
            if (cb < 4) { off = WS_QA; ld = 512; cbase = cb * 128; act = 0; }
            else if (cb == 4) { off = WS_KA; ld = 128; cbase = 0; act = 0; }
            else if (cb == 5) { off = WS_VA; ld = 128; cbase = 0; act = 0; }
            else if (cb < 10) { off = WS_ZA; ld = 512; cbase = (cb - 6) * 128; act = 1; }
            else if (cb < 12) { off = WS_QG; ld = 256; cbase = (cb - 10) * 128; act = 3; }
            else if (cb < 14) { off = WS_KG; ld = 256; cbase = (cb - 12) * 128; act = 0; }
            else if (cb < 18) { off = WS_VG; ld = 512; cbase = (cb - 14) * 128; act = 0; }
            else if (cb < 22) { off = WS_ZG; ld = 512; cbase = (cb - 18) * 128; act = 1; }
            else if (cb < 30) { off = WS_MA; ld = 1024; cbase = (cb - 22) * 128; act = 2; }
            else if (cb < 38) { off = WS_MG; ld = 1024; cbase = (cb - 30) * 128; act = 2; }
            else if (cb == 38) { off = WS_LR; ld = 128; cbase = 0; act = 0; }
            else continue;
            bf16_t* base = (bf16_t*)(ws + off) + cbase + wc * 32 + 8 * fq;
#pragma unroll
            for (int ai = 0; ai < 2; ++ai)
#pragma unroll
                for (int m = 0; m < 4; ++m) {
                    f32x4 v0 = acc[ai][bj][m][0], v1 = acc[ai][bj][m][1];
                    if (act == 1) { for (int j = 0; j < 4; ++j) { v0[j] = siluf_(v0[j]); v1[j] = siluf_(v1[j]); } }
                    else if (act == 2) { for (int j = 0; j < 4; ++j) { v0[j] = sigmoidf_(v0[j]); v1[j] = sigmoidf_(v1[j]); } }
                    else if (act == 3) { v0 = v0 * 0.125f; v1 = v1 * 0.125f; }
                    u32x4 w; w.x = pk2(v0[0], v0[1]); w.y = pk2(v0[2], v0[3]); w.z = pk2(v1[0], v1[1]); w.w = pk2(v1[2], v1[3]);
                    *(u32x4*)(base + (size_t)(row0 + ai * 128 + m * 16) * ld) = w;
                }
        }
    }
};
template <int MODE> struct EpiBranch {
    static constexpr bool PERM = true, AFTER_DRAIN = false;
    const bf16_t* gate; const bf16_t* prev; bf16_t* dst;
    __device__ __forceinline__ void operator()(const f32x4 (&acc)[2][2][4][2], const Unit& u, int wr, int wc, int fr, int fq) const {
        const int row0 = u.pm * 256 + wr * 64 + fr, col0 = u.pn * 256 + wc * 32 + 8 * fq;
#pragma unroll
        for (int ai = 0; ai < 2; ++ai)
#pragma unroll
            for (int m = 0; m < 4; ++m)
#pragma unroll
                for (int bj = 0; bj < 2; ++bj) {
                    const size_t o = (size_t)(row0 + ai * 128 + m * 16) * 1024 + col0 + bj * 128;
                    const u32x4 g = *(const u32x4*)(gate + o);
                    f32x4 v0 = acc[ai][bj][m][0], v1 = acc[ai][bj][m][1];
                    v0[0] *= bflo(g.x); v0[1] *= bfhi(g.x); v0[2] *= bflo(g.y); v0[3] *= bfhi(g.y);
                    v1[0] *= bflo(g.z); v1[1] *= bfhi(g.z); v1[2] *= bflo(g.w); v1[3] *= bfhi(g.w);
                    if (MODE == 1) { const u32x4 t = *(const u32x4*)(prev + o);
                        v0[0] += bflo(t.x); v0[1] += bfhi(t.x); v0[2] += bflo(t.y); v0[3] += bfhi(t.y);
                        v1[0] += bflo(t.z); v1[1] += bfhi(t.z); v1[2] += bflo(t.w); v1[3] += bfhi(t.w); }
                    u32x4 w; w.x = pk2(v0[0], v0[1]); w.y = pk2(v0[2], v0[3]); w.z = pk2(v1[0], v1[1]); w.w = pk2(v1[2], v1[3]);
                    *(u32x4*)(dst + o) = w;
                }
    }
};
struct EpiOut {
    static constexpr bool PERM = false, AFTER_DRAIN = false;
    const float* xp; const float* xs; const float* mod; float* out;
    __device__ __forceinline__ void operator()(const f32x4 (&acc)[2][2][4][2], const Unit& u, int wr, int wc, int fr, int fq) const {
        const int col0 = u.pn * 256 + wc * 32 + 4 * fq;
#pragma unroll
        for (int ai = 0; ai < 2; ++ai)
#pragma unroll
            for (int m = 0; m < 4; ++m) {
                const int row = u.pm * 256 + ai * 128 + wr * 64 + m * 16 + fr;
                const float* xrow = row < MP ? xp + (size_t)row * 1024 : xs + (size_t)(row - MP) * 1024;
                const float* grow = mod + (size_t)mod_row(row) * 3072 + 2048;
                float* orow = out + (size_t)row * 1024;
#pragma unroll
                for (int bj = 0; bj < 2; ++bj)
#pragma unroll
                    for (int n = 0; n < 2; ++n) { const int c = col0 + bj * 128 + n * 16;
                        const f32x4 x4 = *(const f32x4*)(xrow + c), g4 = *(const f32x4*)(grow + c);
                        *(f32x4*)(orow + c) = x4 + g4 * acc[ai][bj][m][n]; }
            }
    }
};

__device__ __forceinline__ void p0_ada(const Params& p, unsigned char* lds, int unit) {
    const int tid = opaque_tid(), lane = tid & 63, w = tid >> 6, fr = lane & 15, fq = lane >> 4;
    const int c0 = unit * 16;
    const float* wa = p.in[8];
    f32x4 acc[9];
#pragma unroll
    for (int i = 0; i < 9; ++i) acc[i] = (f32x4){0.f, 0.f, 0.f, 0.f};
#pragma unroll 1
    for (int ks = 0; ks < 4; ++ks) {
        const int k0 = w * 128 + ks * 32 + fq * 8;
        float bv[8];
#pragma unroll
        for (int j = 0; j < 8; ++j) bv[j] = wa[(size_t)(k0 + j) * 3072 + c0 + fr];
        const bf16x8 bfrag = __builtin_bit_cast(bf16x8, pack8(bv));
#pragma unroll
        for (int rt = 0; rt < 9; ++rt) {
            const int row = min(rt * 16 + fr, 129);
            const float* cp = (row < 2 ? p.in[5] + row * 1024 : p.in[6] + (row - 2) * 1024) + k0;
            const f32x4 x0 = *(const f32x4*)cp, x1 = *(const f32x4*)(cp + 4);
            float av[8] = {x0.x, x0.y, x0.z, x0.w, x1.x, x1.y, x1.z, x1.w};
#pragma unroll
            for (int j = 0; j < 8; ++j) av[j] = av[j] * fast_rcp(1.f + __expf(-av[j]));
            acc[rt] = mfma16(__builtin_bit_cast(bf16x8, pack8(av)), bfrag, acc[rt]);
            if (rt % 3 == 2) asm volatile("" ::: "memory");
        }
    }
    f32x4* red = (f32x4*)lds;
#pragma unroll
    for (int rt = 0; rt < 9; ++rt) red[(w * 9 + rt) * 64 + lane] = acc[rt];
    __syncthreads();
    float* mod = (float*)(p.ws + WS_MOD);
    for (int idx = tid; idx < 576; idx += 512) { const int rt = idx >> 6, ln = idx & 63;
        f32x4 sum = red[rt * 64 + ln];
#pragma unroll
        for (int ww = 1; ww < 8; ++ww) sum = sum + red[(ww * 9 + rt) * 64 + ln];
        const int col = c0 + (ln & 15); const float bias = p.in[9][col];
#pragma unroll
        for (int r = 0; r < 4; ++r) { const int row = rt * 16 + (ln >> 4) * 4 + r; if (row < 130) mod[(size_t)row * 3072 + col] = sum[r] + bias; } }
    __syncthreads();
}
__device__ __forceinline__ void p0_transpose_item(const float* W, int N, int n0, int nvalid, bf16_t* WT, int K, int n0p, int k0, float* scr, int lane) {
    const int c = lane & 31; const bool ok = c < nvalid;
#pragma unroll 8
    for (int i = 0; i < 32; ++i) { const int kk = 2 * i + (lane >> 5); scr[kk * 33 + c] = ok ? W[(size_t)(k0 + kk) * N + n0 + c] : 0.f; }
    asm volatile("s_waitcnt lgkmcnt(0)" ::: "memory");
    const int c8 = lane & 7;
#pragma unroll
    for (int j = 0; j < 4; ++j) { const int n = (lane >> 3) + 8 * j; const float* s = scr + (8 * c8) * 33 + n;
        u32x4 o; o.x = pk2(s[0], s[33]); o.y = pk2(s[66], s[99]); o.z = pk2(s[132], s[165]); o.w = pk2(s[198], s[231]);
        *(u32x4*)(WT + (size_t)(n0p + n) * K + k0 + 8 * c8) = o; }
    asm volatile("s_waitcnt lgkmcnt(0)" ::: "memory");
}
__device__ __forceinline__ void phase0(const Params& p, unsigned char* lds) {
    { int u0 = gridDim.x >= 192 ? (int)blockIdx.x - ((int)gridDim.x - 192) : (int)blockIdx.x;
      for (int u = u0; u < 192; u += gridDim.x) if (u >= 0) p0_ada(p, lds, u); }
}
__device__ __forceinline__ void phase0b(const Params& p, unsigned char* lds) {
    const int tid_ = opaque_tid(); const int lane = tid_ & 63, wave = tid_ >> 6;
    float* scr = (float*)(lds + wave * 8448);
    constexpr int I_IN = 16 * 160, I_B = 8 * 32, I_O = 16 * 32, TOT = I_IN + 2 * I_B + I_O;
    for (int it = blockIdx.x * 8 + wave; it < TOT; it += gridDim.x * 8) {
        int r = it;
        if (r < I_IN) { const int kb = r / 160, nb = r % 160; int n0, nv;
            if (nb < 72) { n0 = nb * 32; nv = 32; } else if (nb < 152) { n0 = nb * 32 + 16; nv = 32; } else if (nb == 152) { n0 = 2304; nv = 16; } else { n0 = 0; nv = 0; }
            p0_transpose_item(p.in[10], NIN, n0, nv, (bf16_t*)(p.ws + WS_WIN), 1024, nb * 32, kb * 64, scr, lane); continue; } r -= I_IN;
        if (r < I_B) { p0_transpose_item(p.in[17], 1024, (r % 32) * 32, 32, (bf16_t*)(p.ws + WS_WBA), 512, (r % 32) * 32, (r / 32) * 64, scr, lane); continue; } r -= I_B;
        if (r < I_B) { p0_transpose_item(p.in[18], 1024, (r % 32) * 32, 32, (bf16_t*)(p.ws + WS_WBG), 512, (r % 32) * 32, (r / 32) * 64, scr, lane); continue; } r -= I_B;
        p0_transpose_item(p.in[19], 1024, (r % 32) * 32, 32, (bf16_t*)(p.ws + WS_WOUT), 1024, (r % 32) * 32, (r / 32) * 64, scr, lane);
    }
    float* rope = (float*)(p.ws + WS_ROPE);
    for (int e = blockIdx.x * 512 + tid_; e < 8200 * 32; e += gridDim.x * 512) {
        const int pp = e >> 5, i = e & 31; const int pos = pp < 8192 ? pp : pp + 8192;
        const float ang = (float)pos * p.inv[i];
        const double a = (double)ang; const double n = rint(a * 0.15915494309189535);
        const float r = (float)fma(-n, 6.283185307179586, a);
        rope[(size_t)pp * 64 + i] = __cosf(r); rope[(size_t)pp * 64 + 32 + i] = __sinf(r); }
    __syncthreads();
}

__device__ __forceinline__ void phase1(const Params& p) {
    const int tid_ = opaque_tid(); const int lane = tid_ & 63, wave = tid_ >> 6;
    const float* mod = (const float*)(p.ws + WS_MOD);
    bf16_t* H = (bf16_t*)(p.ws + WS_H);
    for (int r = blockIdx.x * 8 + wave; r < MT; r += gridDim.x * 8) {
        const float* xrow = r < MP ? p.in[0] + (size_t)r * 1024 : p.in[1] + (size_t)(r - MP) * 1024;
        const float* mr = mod + (size_t)mod_row(r) * 3072;
        f32x4 v[4]; float ss = 0.f;
#pragma unroll
        for (int j = 0; j < 4; ++j) { v[j] = *(const f32x4*)(xrow + 4 * lane + 256 * j); ss += (v[j].x * v[j].x + v[j].y * v[j].y) + (v[j].z * v[j].z + v[j].w * v[j].w); }
        const float rstd = rsqrtf(wave_sum(ss) * (1.f / 1024.f) + EPS);
#pragma unroll
        for (int j = 0; j < 4; ++j) { const int c = 4 * lane + 256 * j;
            const f32x4 g = *(const f32x4*)(p.in[7] + c), sh = *(const f32x4*)(mr + c), sc = *(const f32x4*)(mr + 1024 + c);
            const f32x4 h = v[j] * rstd * g * (sc + 1.f) + sh;
            u32x2 w; w.x = pk2(h.x, h.y); w.y = pk2(h.z, h.w);
            *(u32x2*)(H + (size_t)r * 1024 + c) = w; }
    }
}

constexpr int KS_STRIDE = 72, VT_STRIDE = 264, ATT_VT_OFF = 256 * 72 * 2;
constexpr float QSCALE = 0.125f * LOG2E;

__device__ __forceinline__ void attn_group(const bf16_t* Ks, const bf16_t* Vt, int kt0, int lo, int hi, bf16x8 qf0, bf16x8 qf1, float sinkv, f32x4 (&o)[4], int lane) {
    const int fr = lane & 15, fq = lane >> 4;
    f32x4 s[9];
#pragma unroll
    for (int t = 0; t < 9; ++t) {
        const bf16_t* kp = Ks + ((kt0 + t) * 16 + fr) * KS_STRIDE + fq * 8;
        const bf16x8 k0 = *(const bf16x8*)kp, k1 = *(const bf16x8*)(kp + 32);
        f32x4 a = {0.f, 0.f, 0.f, 0.f};
        a = mfma16(k0, qf0, a); a = mfma16(k1, qf1, a);
        s[t] = a;
    }
    float m = sinkv;
#pragma unroll
    for (int t = 0; t < 9; ++t)
#pragma unroll
        for (int r = 0; r < 4; ++r) { const int j = (kt0 + t) * 16 + fq * 4 + r; const float v = (j >= lo && j <= hi) ? s[t][r] : -1e30f; s[t][r] = v; m = fmaxf(m, v); }
    m = fmaxf(m, __shfl_xor(m, 16)); m = fmaxf(m, __shfl_xor(m, 32));
    float l = 0.f;
#pragma unroll
    for (int t = 0; t < 9; ++t)
#pragma unroll
        for (int r = 0; r < 4; ++r) { const float pv = exp2f(s[t][r] - m); l += pv; s[t][r] = pv; }
    l += __shfl_xor(l, 16); l += __shfl_xor(l, 32);
    l += exp2f(sinkv - m);
#pragma unroll
    for (int dt = 0; dt < 4; ++dt) o[dt] = (f32x4){0.f, 0.f, 0.f, 0.f};
#pragma unroll
    for (int ks = 0; ks < 5; ++ks) {
        u32x4 pw; pw.x = pk2(s[2 * ks][0], s[2 * ks][1]); pw.y = pk2(s[2 * ks][2], s[2 * ks][3]);
        if (ks < 4) { pw.z = pk2(s[2 * ks + 1][0], s[2 * ks + 1][1]); pw.w = pk2(s[2 * ks + 1][2], s[2 * ks + 1][3]); } else { pw.z = 0u; pw.w = 0u; }
        const bf16x8 pb = __builtin_bit_cast(bf16x8, pw);
#pragma unroll
        for (int dt = 0; dt < 4; ++dt) {
            const bf16_t* vp = Vt + (dt * 16 + fr) * VT_STRIDE + (kt0 + 2 * ks) * 16 + fq * 4;
            const u32x2 a0 = *(const u32x2*)vp; u32x2 a1 = {0u, 0u};
            if (ks < 4) a1 = *(const u32x2*)(vp + 16);
            u32x4 aw; aw.x = a0.x; aw.y = a0.y; aw.z = a1.x; aw.w = a1.y;
            o[dt] = mfma16(__builtin_bit_cast(bf16x8, aw), pb, o[dt]);
        }
    }
    const float inv = 1.f / l;
#pragma unroll
    for (int dt = 0; dt < 4; ++dt) o[dt] = o[dt] * inv;
}
__device__ __forceinline__ void norm_rope16(float (&a)[8], float (&b)[8], const float* g, const float* rp, int f, int sx1, int sx2) {
    float ss = 0.f;
#pragma unroll
    for (int j = 0; j < 8; ++j) ss += a[j] * a[j] + b[j] * b[j];
    ss += __shfl_xor(ss, sx1); ss += __shfl_xor(ss, sx2);
    const float rstd = rsqrtf(ss * (1.f / 64.f) + EPS);
#pragma unroll
    for (int j = 0; j < 8; ++j) {
        const float y1 = a[j] * rstd * g[f * 8 + j], y2 = b[j] * rstd * g[32 + f * 8 + j];
        const float c = rp[f * 8 + j], s = rp[32 + f * 8 + j];
        a[j] = y1 * c - y2 * s; b[j] = y2 * c + y1 * s;
    }
}

__device__ __forceinline__ void attn_rows(const Params& p, const bf16_t* Ks, const bf16_t* Vt, size_t tok, int head, int prow, int kt0, int lo, int hi, bool store, int lane) {
    const int fq = lane >> 4;
    const bf16_t* qp = (const bf16_t*)(p.ws + WS_QA) + tok * 512 + head * 64 + fq * 8;
    float a[8], b[8];
    unpack8(*(const u32x4*)qp, a); unpack8(*(const u32x4*)(qp + 32), b);
    norm_rope16(a, b, p.in[11], (const float*)(p.ws + WS_ROPE) + (size_t)prow * 64, fq, 16, 32);
    const bf16x8 qf0 = __builtin_bit_cast(bf16x8, pack8s(a, QSCALE)), qf1 = __builtin_bit_cast(bf16x8, pack8s(b, QSCALE));
    f32x4 o[4];
    attn_group(Ks, Vt, kt0, lo, hi, qf0, qf1, p.in[13][head] * LOG2E, o, lane);
    if (store) {
        const bf16_t* zp = (const bf16_t*)(p.ws + WS_ZA) + tok * 512 + head * 64 + fq * 4;
        bf16_t* op = (bf16_t*)(p.ws + WS_OA) + tok * 512 + head * 64 + fq * 4;
#pragma unroll
        for (int dt = 0; dt < 4; ++dt) { const u32x2 z = *(const u32x2*)(zp + dt * 16);
            u32x2 w; w.x = pk2(o[dt][0] * bflo(z.x), o[dt][1] * bfhi(z.x)); w.y = pk2(o[dt][2] * bflo(z.y), o[dt][3] * bfhi(z.y));
            *(u32x2*)(op + dt * 16) = w; }
    }
}

__device__ __forceinline__ void attn_prompt_unit(const Params& p, unsigned char* lds, int u) {
    bf16_t* Ks = (bf16_t*)lds; bf16_t* Vt = (bf16_t*)(lds + ATT_VT_OFF);
    const int tid = opaque_tid(), lane = tid & 63, w = tid >> 6;
    const int b = u >> 7, qb = (u & 127) >> 1, kvh = u & 1;
    const bf16_t* KA = (const bf16_t*)(p.ws + WS_KA); const bf16_t* VA = (const bf16_t*)(p.ws + WS_VA);
    const float* rope = (const float*)(p.ws + WS_ROPE);
#pragma unroll
    for (int it = 0; it < 2; ++it) {
        const int j = it * 128 + w * 16 + (lane >> 2), f = lane & 3;
        const int t = (qb - 1) * 128 + j; const int tc = t < 0 ? 0 : t;
        const bf16_t* kp = KA + ((size_t)b * SEQ + tc) * 128 + kvh * 64 + f * 8;
        float a[8], c[8];
        unpack8(*(const u32x4*)kp, a); unpack8(*(const u32x4*)(kp + 32), c);
        norm_rope16(a, c, p.in[12], rope + (size_t)tc * 64, f, 1, 2);
        if (t < 0) {
#pragma unroll
            for (int q = 0; q < 8; ++q) { a[q] = 0.f; c[q] = 0.f; } }
        *(u32x4*)(Ks + j * KS_STRIDE + f * 8) = pack8(a); *(u32x4*)(Ks + j * KS_STRIDE + 32 + f * 8) = pack8(c);
        if (t >= SEQ - 128) { float* op = p.out + O_PWK + (((size_t)b * 128 + (t - (SEQ - 128))) * 2 + kvh) * 64 + f * 8;
            *(f32x4*)op = (f32x4){a[0], a[1], a[2], a[3]}; *(f32x4*)(op + 4) = (f32x4){a[4], a[5], a[6], a[7]};
            *(f32x4*)(op + 32) = (f32x4){c[0], c[1], c[2], c[3]}; *(f32x4*)(op + 36) = (f32x4){c[4], c[5], c[6], c[7]}; }
    }
#pragma unroll
    for (int it = 0; it < 4; ++it) {
        const int idx = tid + 512 * it, j = idx >> 3, ch = idx & 7;
        const int t = (qb - 1) * 128 + j; const int tc = t < 0 ? 0 : t;
        u32x4 v = *(const u32x4*)(VA + ((size_t)b * SEQ + tc) * 128 + kvh * 64 + ch * 8);
        if (t < 0) v = (u32x4){0u, 0u, 0u, 0u};
        bf16_t* vp = Vt + (ch * 8) * VT_STRIDE + j;
        vp[0] = (bf16_t)(v.x & 0xffff); vp[VT_STRIDE] = (bf16_t)(v.x >> 16); vp[2 * VT_STRIDE] = (bf16_t)(v.y & 0xffff); vp[3 * VT_STRIDE] = (bf16_t)(v.y >> 16);
        vp[4 * VT_STRIDE] = (bf16_t)(v.z & 0xffff); vp[5 * VT_STRIDE] = (bf16_t)(v.z >> 16); vp[6 * VT_STRIDE] = (bf16_t)(v.w & 0xffff); vp[7 * VT_STRIDE] = (bf16_t)(v.w >> 16);
        if (t >= SEQ - 128) { float* op = p.out + O_PWV + (((size_t)b * 128 + (t - (SEQ - 128))) * 2 + kvh) * 64 + ch * 8;
            *(f32x4*)op = (f32x4){bflo(v.x), bfhi(v.x), bflo(v.y), bfhi(v.y)}; *(f32x4*)(op + 4) = (f32x4){bflo(v.z), bfhi(v.z), bflo(v.w), bfhi(v.w)}; }
    }
    __syncthreads();
    const int head = kvh * 4 + (w >> 1), half = w & 1;
    for (int g = 0; g < 4; ++g) {
        const int i0 = half * 64 + g * 16, i = i0 + (lane & 15), t = qb * 128 + i;
        attn_rows(p, Ks, Vt, (size_t)b * SEQ + t, head, t, i0 >> 4, qb == 0 ? 128 : i, i + 128, true, lane);
    }
    __syncthreads();
}

__device__ __forceinline__ void attn_sample_unit(const Params& p, unsigned char* lds, int u) {
    bf16_t* Ks = (bf16_t*)lds; bf16_t* Vt = (bf16_t*)(lds + ATT_VT_OFF);
    const int tid = opaque_tid(), lane = tid & 63, w = tid >> 6;
    const int sb = u >> 1, kvh = u & 1;
    const bf16_t* KA = (const bf16_t*)(p.ws + WS_KA); const bf16_t* VA = (const bf16_t*)(p.ws + WS_VA);
    const float* rope = (const float*)(p.ws + WS_ROPE);
#pragma unroll
    for (int it = 0; it < 2; ++it) {
        const int j = it * 128 + w * 16 + (lane >> 2), f = lane & 3;
        if (j < 144) {
            const int l = (j >= 128 && j < 136) ? j - 128 : 0;
            const bf16_t* kp = KA + ((size_t)MP + sb * 8 + l) * 128 + kvh * 64 + f * 8;
            float a[8], c[8];
            unpack8(*(const u32x4*)kp, a); unpack8(*(const u32x4*)(kp + 32), c);
            norm_rope16(a, c, p.in[12], rope + (size_t)(8192 + l) * 64, f, 1, 2);
            if (j < 128) { const float* cp = p.in[2] + (((size_t)sb * 128 + j) * 2 + kvh) * 64 + f * 8;
                const f32x4 c0 = *(const f32x4*)cp, c1 = *(const f32x4*)(cp + 4), c2 = *(const f32x4*)(cp + 32), c3 = *(const f32x4*)(cp + 36);
                a[0] = c0.x; a[1] = c0.y; a[2] = c0.z; a[3] = c0.w; a[4] = c1.x; a[5] = c1.y; a[6] = c1.z; a[7] = c1.w;
                c[0] = c2.x; c[1] = c2.y; c[2] = c2.z; c[3] = c2.w; c[4] = c3.x; c[5] = c3.y; c[6] = c3.z; c[7] = c3.w; }
            else if (j >= 136) {
#pragma unroll
                for (int q = 0; q < 8; ++q) { a[q] = 0.f; c[q] = 0.f; } }
            *(u32x4*)(Ks + j * KS_STRIDE + f * 8) = pack8(a); *(u32x4*)(Ks + j * KS_STRIDE + 32 + f * 8) = pack8(c);
            if (j >= 8 && j < 136) { float* op = p.out + O_SWK + (((size_t)sb * 128 + (j - 8)) * 2 + kvh) * 64 + f * 8;
                *(f32x4*)op = (f32x4){a[0], a[1], a[2], a[3]}; *(f32x4*)(op + 4) = (f32x4){a[4], a[5], a[6], a[7]};
                *(f32x4*)(op + 32) = (f32x4){c[0], c[1], c[2], c[3]}; *(f32x4*)(op + 36) = (f32x4){c[4], c[5], c[6], c[7]}; }
        }
    }
#pragma unroll
    for (int it = 0; it < 3; ++it) {
        const int idx = tid + 512 * it, j = idx >> 3, ch = idx & 7;
        if (j < 144) {
            float v[8];
            if (j < 128) { const float* cp = p.in[3] + (((size_t)sb * 128 + j) * 2 + kvh) * 64 + ch * 8;
                const f32x4 c0 = *(const f32x4*)cp, c1 = *(const f32x4*)(cp + 4);
                v[0] = c0.x; v[1] = c0.y; v[2] = c0.z; v[3] = c0.w; v[4] = c1.x; v[5] = c1.y; v[6] = c1.z; v[7] = c1.w; }
            else if (j < 136) unpack8(*(const u32x4*)(VA + ((size_t)MP + sb * 8 + (j - 128)) * 128 + kvh * 64 + ch * 8), v);
            else {
#pragma unroll
                for (int q = 0; q < 8; ++q) v[q] = 0.f; }
            const u32x4 pv = pack8(v);
            bf16_t* vp = Vt + (ch * 8) * VT_STRIDE + j;
            vp[0] = (bf16_t)(pv.x & 0xffff); vp[VT_STRIDE] = (bf16_t)(pv.x >> 16); vp[2 * VT_STRIDE] = (bf16_t)(pv.y & 0xffff); vp[3 * VT_STRIDE] = (bf16_t)(pv.y >> 16);
            vp[4 * VT_STRIDE] = (bf16_t)(pv.z & 0xffff); vp[5 * VT_STRIDE] = (bf16_t)(pv.z >> 16); vp[6 * VT_STRIDE] = (bf16_t)(pv.w & 0xffff); vp[7 * VT_STRIDE] = (bf16_t)(pv.w >> 16);
            if (j >= 8 && j < 136) { float* op = p.out + O_SWV + (((size_t)sb * 128 + (j - 8)) * 2 + kvh) * 64 + ch * 8;
                *(f32x4*)op = (f32x4){v[0], v[1], v[2], v[3]}; *(f32x4*)(op + 4) = (f32x4){v[4], v[5], v[6], v[7]}; }
        }
    }
    __syncthreads();
    if (w < 2) {
        const int q = lane & 15, l = q & 7, head = kvh * 4 + w * 2 + (q >> 3);
        attn_rows(p, Ks, Vt, (size_t)MP + sb * 8 + l, head, 8192 + l, 0, l, l + 128, true, lane);
    }
    __syncthreads();
}

constexpr int G_BC = 0, G_TOT = 16640, G_QT = 18688, G_KT = 27904, G_VT = 37120, G_ST = 55552, G_AM = 73984, G_RED = 83200;
constexpr int GS = 72;

__device__ __forceinline__ void gla_compute_b(const Params& p, unsigned char* lds, size_t tok0, int L, int h) {
    float* Bc = (float*)(lds + G_BC); float* TOT = (float*)(lds + G_TOT);
    const int tid = opaque_tid(), k = tid & 63, tg = tid >> 6;
    const float* wg = p.in[14] + h * 64 + k;
    float wr[16];
#pragma unroll
    for (int r = 0; r < 16; ++r) wr[r] = wg[r * 256];
    const float bias = p.in[15][h * 64 + k];
    const bf16_t* LR = (const bf16_t*)(p.ws + WS_LR);
    float cs[8]; float run = 0.f;
#pragma unroll
    for (int i = 0; i < 8; ++i) {
        const int tt = tg * 8 + i; float la = 0.f;
        if (tt < L) {
            const u32x4 l0 = *(const u32x4*)(LR + (tok0 + tt) * 128), l1 = *(const u32x4*)(LR + (tok0 + tt) * 128 + 8);
            float g = bias;
            g += bflo(l0.x) * wr[0] + bfhi(l0.x) * wr[1] + bflo(l0.y) * wr[2] + bfhi(l0.y) * wr[3] + bflo(l0.z) * wr[4] + bfhi(l0.z) * wr[5] + bflo(l0.w) * wr[6] + bfhi(l0.w) * wr[7];
            g += bflo(l1.x) * wr[8] + bfhi(l1.x) * wr[9] + bflo(l1.y) * wr[10] + bfhi(l1.y) * wr[11] + bflo(l1.z) * wr[12] + bfhi(l1.z) * wr[13] + bflo(l1.w) * wr[14] + bfhi(l1.w) * wr[15];
            la = (fminf(g, 0.f) - __logf(1.f + __expf(-fabsf(g)))) * (1.f / 16.f);
        }
        run += la; cs[i] = run;
    }
    TOT[tg * 64 + k] = run;
    __syncthreads();
    float pre = 0.f;
#pragma unroll
    for (int j = 0; j < 8; ++j) if (j < tg) pre += TOT[j * 64 + k];
#pragma unroll
    for (int i = 0; i < 8; ++i) Bc[(tg * 8 + i) * 65 + k] = pre + cs[i];
    __syncthreads();
}
__device__ __forceinline__ void gla_stage_vt(const Params& p, unsigned char* lds, size_t tok0, int L, int h) {
    const int tid = opaque_tid(), dv = tid & 127, t4 = tid >> 7;
    const bf16_t* VG = (const bf16_t*)(p.ws + WS_VG) + h * 128 + dv;
    unsigned w[8];
#pragma unroll
    for (int i = 0; i < 8; ++i) { const int t0 = t4 * 16 + 2 * i;
        const unsigned lo = t0 < L ? (unsigned)VG[(tok0 + t0) * 512] : 0u, hi = t0 + 1 < L ? (unsigned)VG[(tok0 + t0 + 1) * 512] : 0u;
        w[i] = lo | (hi << 16); }
    bf16_t* VT = (bf16_t*)(lds + G_VT) + dv * GS + t4 * 16;
    *(u32x4*)VT = (u32x4){w[0], w[1], w[2], w[3]}; *(u32x4*)(VT + 8) = (u32x4){w[4], w[5], w[6], w[7]};
}
__device__ __forceinline__ void gla_unit_info(int u, size_t& tok0, int& L, int& h) {
    if (u < 1024) { const int b = u >> 9, c = (u >> 2) & 127; h = u & 3; tok0 = (size_t)b * SEQ + c * 64; L = 64; }
    else { const int v = u - 1024; h = v & 3; tok0 = (size_t)MP + (v >> 2) * 8; L = 8; }
}
__device__ __forceinline__ void gla_delta_unit(const Params& p, unsigned char* lds, int u) {
    size_t tok0; int L, h; gla_unit_info(u, tok0, L, h);
    gla_compute_b(p, lds, tok0, L, h);
    const float* Bc = (const float*)(lds + G_BC);
    const int tid = opaque_tid(), lane = tid & 63, w = tid >> 6, fr = lane & 15, fq = lane >> 4;
    { const int k = tid & 63, tg = tid >> 6; const float bl = Bc[63 * 65 + k];
      const bf16_t* KG = (const bf16_t*)(p.ws + WS_KG) + h * 64 + k;
      float v[8];
#pragma unroll
      for (int i = 0; i < 8; ++i) { const int tt = tg * 8 + i; const float kv = tt < L ? bf2f(KG[(tok0 + tt) * 256]) : 0.f; v[i] = kv * __expf(bl - Bc[tt * 65 + k]); }
      *(u32x4*)((bf16_t*)(lds + G_KT) + k * GS + tg * 8) = pack8(v); }
    gla_stage_vt(p, lds, tok0, L, h);
    __syncthreads();
    const bf16_t* VT = (const bf16_t*)(lds + G_VT) + (w * 16 + fr) * GS + fq * 8;
    const bf16x8 a0 = *(const bf16x8*)VT, a1 = *(const bf16x8*)(VT + 32);
#pragma unroll
    for (int kt = 0; kt < 4; ++kt) {
        const bf16_t* KT = (const bf16_t*)(lds + G_KT) + (kt * 16 + fr) * GS + fq * 8;
        f32x4 acc = {0.f, 0.f, 0.f, 0.f};
        acc = mfma16(a0, *(const bf16x8*)KT, acc); acc = mfma16(a1, *(const bf16x8*)(KT + 32), acc);
        const int kk = kt * 16 + fr, dv = w * 16 + fq * 4;
        if (u < 1024) *(f32x4*)((float*)(p.ws + WS_DS) + (size_t)u * 8192 + kk * 128 + dv) = acc;
        else { const int v = u - 1024; const size_t so = ((size_t)v * 64 + kk) * 128 + dv;
            const float d = __expf(Bc[63 * 65 + kk]); const f32x4 s0 = *(const f32x4*)(p.in[4] + so);
            *(f32x4*)(p.out + O_SGS + so) = s0 * d + acc; }
    }
    if (u < 1024 && tid < 64) ((float*)(p.ws + WS_DEC))[(size_t)u * 64 + tid] = __expf(Bc[63 * 65 + tid]);
    __syncthreads();
}
__device__ __forceinline__ void gla_scan_dummy(const Params& p) {
    if (threadIdx.x >= 256) return;
    const int e = blockIdx.x * 256 + threadIdx.x;
    if (e >= 65536) return;
    const int b = e >> 15, h = (e >> 13) & 3, k = (e >> 7) & 63, dv = e & 127;
    float* DS = (float*)(p.ws + WS_DS); const float* DEC = (const float*)(p.ws + WS_DEC);
    float S = 0.f;
#pragma unroll 8
    for (int c = 0; c < 128; ++c) { const size_t u = (size_t)b * 512 + c * 4 + h;
        const float d = DEC[u * 64 + k]; float* sp = DS + u * 8192 + k * 128 + dv; const float ds = *sp; *sp = ds; S = d * S + ds; }
    if (S == 123.456f) p.out[O_PGS + e] = S;
}
__device__ __forceinline__ void gla_scan(const Params& p) {
    if (threadIdx.x >= 256) return;
    const int e = blockIdx.x * 256 + threadIdx.x;
    if (e >= 65536) return;
    const int b = e >> 15, h = (e >> 13) & 3, k = (e >> 7) & 63, dv = e & 127;
    float* DS = (float*)(p.ws + WS_DS); const float* DEC = (const float*)(p.ws + WS_DEC);
    float S = 0.f;
#pragma unroll 8
    for (int c = 0; c < 128; ++c) { const size_t u = (size_t)b * 512 + c * 4 + h;
        const float d = DEC[u * 64 + k]; float* sp = DS + u * 8192 + k * 128 + dv; const float ds = *sp; *sp = S; S = d * S + ds; }
    p.out[O_PGS + e] = S;
}
__device__ __forceinline__ void gla_out_unit(const Params& p, unsigned char* lds, int u) {
    size_t tok0; int L, h; gla_unit_info(u, tok0, L, h);
    gla_compute_b(p, lds, tok0, L, h);
    const float* Bc = (const float*)(lds + G_BC);
    const int tid = opaque_tid(), lane = tid & 63, w = tid >> 6, fr = lane & 15, fq = lane >> 4;
    { const int k = tid & 63, tg = tid >> 6; const float bm = Bc[31 * 65 + k];
      const bf16_t* QG = (const bf16_t*)(p.ws + WS_QG) + h * 64 + k; const bf16_t* KG = (const bf16_t*)(p.ws + WS_KG) + h * 64 + k;
      bf16_t* QT = (bf16_t*)(lds + G_QT) + k; bf16_t* KT = (bf16_t*)(lds + G_KT) + k;
#pragma unroll
      for (int i = 0; i < 8; ++i) { const int tt = tg * 8 + i; const float bb = Bc[tt * 65 + k];
          const float qv = tt < L ? bf2f(QG[(tok0 + tt) * 256]) : 0.f, kv = tt < L ? bf2f(KG[(tok0 + tt) * 256]) : 0.f;
          QT[tt * GS] = (bf16_t)(pk2(qv * __expf(bb - bm), 0.f) & 0xffff); KT[tt * GS] = (bf16_t)(pk2(kv * __expf(bm - bb), 0.f) & 0xffff); } }
    gla_stage_vt(p, lds, tok0, L, h);
    { const int dv = tid & 127, kg = tid >> 7;
      const float* Sp = (u < 1024 ? (const float*)(p.ws + WS_DS) + (size_t)u * 8192 : p.in[4] + (size_t)(u - 1024) * 8192) + dv;
      float v[16];
#pragma unroll
      for (int i = 0; i < 16; ++i) { const int kk = kg * 16 + i; v[i] = Sp[kk * 128] * __expf(Bc[31 * 65 + kk]); }
      bf16_t* ST = (bf16_t*)(lds + G_ST) + dv * GS + kg * 16;
      u32x4 w0, w1; w0.x = pk2(v[0], v[1]); w0.y = pk2(v[2], v[3]); w0.z = pk2(v[4], v[5]); w0.w = pk2(v[6], v[7]);
      w1.x = pk2(v[8], v[9]); w1.y = pk2(v[10], v[11]); w1.z = pk2(v[12], v[13]); w1.w = pk2(v[14], v[15]);
      *(u32x4*)ST = w0; *(u32x4*)(ST + 8) = w1; }
    __syncthreads();
    const int tt = w & 3, hh = w >> 2;
    const bf16_t* QTr = (const bf16_t*)(lds + G_QT) + (tt * 16 + fr) * GS + fq * 8;
    const bf16x8 bq0 = *(const bf16x8*)QTr, bq1 = *(const bf16x8*)(QTr + 32);
#pragma unroll
    for (int q = 0; q < 2; ++q) { const int st = hh * 2 + q;
        const bf16_t* KTr = (const bf16_t*)(lds + G_KT) + (st * 16 + fr) * GS + fq * 8;
        f32x4 acc = {0.f, 0.f, 0.f, 0.f};
        acc = mfma16(*(const bf16x8*)KTr, bq0, acc); acc = mfma16(*(const bf16x8*)(KTr + 32), bq1, acc);
        const int ti = tt * 16 + fr, s0 = st * 16 + fq * 4;
        u32x2 wv; wv.x = pk2(s0 <= ti ? acc[0] : 0.f, s0 + 1 <= ti ? acc[1] : 0.f); wv.y = pk2(s0 + 2 <= ti ? acc[2] : 0.f, s0 + 3 <= ti ? acc[3] : 0.f);
        *(u32x2*)((bf16_t*)(lds + G_AM) + ti * GS + s0) = wv; }
    __syncthreads();
    const bf16_t* AMr = (const bf16_t*)(lds + G_AM) + (tt * 16 + fr) * GS + fq * 8;
    const bf16x8 ba0 = *(const bf16x8*)AMr, ba1 = *(const bf16x8*)(AMr + 32);
    f32x4 o[4]; float ss = 0.f;
#pragma unroll
    for (int d4 = 0; d4 < 4; ++d4) { const int row = (hh * 4 + d4) * 16 + fr;
        const bf16_t* VT = (const bf16_t*)(lds + G_VT) + row * GS + fq * 8; const bf16_t* ST = (const bf16_t*)(lds + G_ST) + row * GS + fq * 8;
        f32x4 acc = {0.f, 0.f, 0.f, 0.f};
        acc = mfma16(*(const bf16x8*)VT, ba0, acc); acc = mfma16(*(const bf16x8*)(VT + 32), ba1, acc);
        acc = mfma16(*(const bf16x8*)ST, bq0, acc); acc = mfma16(*(const bf16x8*)(ST + 32), bq1, acc);
        o[d4] = acc; ss += (acc[0] * acc[0] + acc[1] * acc[1]) + (acc[2] * acc[2] + acc[3] * acc[3]); }
    ss += __shfl_xor(ss, 16); ss += __shfl_xor(ss, 32);
    float* RED = (float*)(lds + G_RED);
    if (fq == 0) RED[hh * 64 + tt * 16 + fr] = ss;
    __syncthreads();
    const float rstd = rsqrtf((RED[tt * 16 + fr] + RED[64 + tt * 16 + fr]) * (1.f / 128.f) + EPS);
    const int ti = tt * 16 + fr;
    if (ti < L) {
        const size_t tok = tok0 + ti;
#pragma unroll
        for (int d4 = 0; d4 < 4; ++d4) { const int dv = (hh * 4 + d4) * 16 + fq * 4;
            const f32x4 g = *(const f32x4*)(p.in[16] + dv);
            const u32x2 z = *(const u32x2*)((const bf16_t*)(p.ws + WS_ZG) + tok * 512 + h * 128 + dv);
            u32x2 wv; wv.x = pk2(o[d4][0] * rstd * g.x * bflo(z.x), o[d4][1] * rstd * g.y * bfhi(z.x));
            wv.y = pk2(o[d4][2] * rstd * g.z * bflo(z.y), o[d4][3] * rstd * g.w * bfhi(z.y));
            *(u32x2*)((bf16_t*)(p.ws + WS_OG) + tok * 512 + h * 128 + dv) = wv; }
    }
    __syncthreads();
}

template <int KK> __device__ __forceinline__ void small_tile_acc(const bf16_t* A, int lda, const bf16_t* Bt, int ldb, int row0, int col0, f32x4 (&acc)[2], int lane, int w) {
    const int fr = lane & 15, fq = lane >> 4, rt = w & 3, ch = w >> 2;
    const bf16_t* ap = A + (size_t)(row0 + rt * 16 + fr) * lda + fq * 8;
    const bf16_t* bp0 = Bt + (size_t)(col0 + ch * 32 + fr) * ldb + fq * 8;
    const bf16_t* bp1 = bp0 + (size_t)16 * ldb;
#pragma unroll 8
    for (int k = 0; k < KK; k += 32) {
        const bf16x8 a = *(const bf16x8*)(ap + k), b0 = *(const bf16x8*)(bp0 + k), b1 = *(const bf16x8*)(bp1 + k);
        acc[0] = mfma16(b0, a, acc[0]); acc[1] = mfma16(b1, a, acc[1]);
    }
}
__device__ __forceinline__ void small_merge_tiles(const Params& p) {
    const int tid = opaque_tid(), lane = tid & 63, w = tid >> 6, fr = lane & 15, fq = lane >> 4;
    for (int t = blockIdx.x; t < 256; t += gridDim.x) {
        const int row0 = MP + (t >> 4) * 64, col0 = (t & 15) * 64;
        f32x4 aa[2] = {{0.f, 0.f, 0.f, 0.f}, {0.f, 0.f, 0.f, 0.f}}, ag[2] = {{0.f, 0.f, 0.f, 0.f}, {0.f, 0.f, 0.f, 0.f}};
        small_tile_acc<512>((const bf16_t*)(p.ws + WS_OA), 512, (const bf16_t*)(p.ws + WS_WBA), 512, row0, col0, aa, lane, w);
        small_tile_acc<512>((const bf16_t*)(p.ws + WS_OG), 512, (const bf16_t*)(p.ws + WS_WBG), 512, row0, col0, ag, lane, w);
        const size_t o = (size_t)(row0 + (w & 3) * 16 + fr) * 1024 + col0 + (w >> 2) * 32 + fq * 4;
#pragma unroll
        for (int nt = 0; nt < 2; ++nt) {
            const u32x2 ma = *(const u32x2*)((const bf16_t*)(p.ws + WS_MA) + o + nt * 16), mg = *(const u32x2*)((const bf16_t*)(p.ws + WS_MG) + o + nt * 16);
            u32x2 wv; wv.x = pk2(bflo(ma.x) * aa[nt][0] + bflo(mg.x) * ag[nt][0], bfhi(ma.x) * aa[nt][1] + bfhi(mg.x) * ag[nt][1]);
            wv.y = pk2(bflo(ma.y) * aa[nt][2] + bflo(mg.y) * ag[nt][2], bfhi(ma.y) * aa[nt][3] + bfhi(mg.y) * ag[nt][3]);
            *(u32x2*)((bf16_t*)(p.ws + WS_MRG) + o + nt * 16) = wv; }
    }
}
__device__ __forceinline__ void small_out_tiles(const Params& p) {
    const int tid = opaque_tid(), lane = tid & 63, w = tid >> 6, fr = lane & 15, fq = lane >> 4;
    for (int t = blockIdx.x; t < 256; t += gridDim.x) {
        const int row0 = MP + (t >> 4) * 64, col0 = (t & 15) * 64;
        f32x4 acc[2] = {{0.f, 0.f, 0.f, 0.f}, {0.f, 0.f, 0.f, 0.f}};
        small_tile_acc<1024>((const bf16_t*)(p.ws + WS_MRG), 1024, (const bf16_t*)(p.ws + WS_WOUT), 1024, row0, col0, acc, lane, w);
        const int row = row0 + (w & 3) * 16 + fr, c = col0 + (w >> 2) * 32 + fq * 4;
        const float* xrow = p.in[1] + (size_t)(row - MP) * 1024; const float* grow = (const float*)(p.ws + WS_MOD) + (size_t)mod_row(row) * 3072 + 2048;
#pragma unroll
        for (int nt = 0; nt < 2; ++nt) { const f32x4 x4 = *(const f32x4*)(xrow + c + nt * 16), g4 = *(const f32x4*)(grow + c + nt * 16);
            *(f32x4*)(p.out + O_Y + (size_t)row * 1024 + c + nt * 16) = x4 + g4 * acc[nt]; }
    }
}

__global__ void __launch_bounds__(512) mega_fwd(Params p) {
    extern __shared__ __attribute__((aligned(16))) unsigned char lds[];
    cg::grid_group grid = cg::this_grid();
    const int lo = p.ph_lo, hi = p.ph_hi;
#define IN(k) (lo <= (k) && (k) < hi)
#define SEAM(k) do { if (IN(k) && IN((k) + 1)) grid.sync(); } while (0)
    PG8_LAS unsigned char* glds = (PG8_LAS unsigned char*)lds;
#ifndef PROBE_MASK
#define PROBE_MASK 0
#endif
#define REP(bit) ((((PROBE_MASK) >> (bit)) & 1) + 1)
    if (IN(0)) for (int rep = 0; rep < REP(0); ++rep) phase0(p, lds);
    SEAM(0);
    if (IN(1)) for (int rep = 0; rep < REP(1); ++rep) { phase0b(p, lds); phase1(p); }
    SEAM(1);
    if (IN(2)) for (int rep = 0; rep < REP(2); ++rep) { pg8::Gemm g{(const bf16_t*)(p.ws + WS_H), (const bf16_t*)(p.ws + WS_WIN), MT, NINP, 1024}; pg8::StaticOrder S; S.init(MT, NINP, gridDim.x, blockIdx.x);
        EpiProj E{p.ws}; pg8::gemm_phase<EpiProj, pg8::StaticOrder, true, true>(glds, g, S, E); }
    SEAM(2);
    if (IN(3)) {
        for (int u = blockIdx.x; u < 2048; u += gridDim.x) {
            if (u < 256) { for (int rep = 0; rep < REP(3); ++rep) attn_prompt_unit(p, lds, u); }
            else if (u < 512) { for (int rep = 0; rep < REP(4); ++rep) attn_sample_unit(p, lds, u - 256); }
            else { for (int rep = 0; rep < REP(5); ++rep) gla_delta_unit(p, lds, u - 512); }
        }
    }
    SEAM(3);
    if (IN(4)) { gla_scan(p); if (REP(9) > 1) gla_scan_dummy(p); }
    SEAM(4);
    if (IN(5)) for (int rep = 0; rep < REP(6); ++rep) { for (int u = blockIdx.x; u < 1536; u += gridDim.x) gla_out_unit(p, lds, u); }
    SEAM(5);
    if (IN(6)) for (int rep = 0; rep < REP(7); ++rep) {
        pg8::StaticOrder S; S.init(MP, 1024, gridDim.x, blockIdx.x);
        { pg8::Gemm g{(const bf16_t*)(p.ws + WS_OA), (const bf16_t*)(p.ws + WS_WBA), MP, 1024, 512};
          EpiBranch<0> E{(const bf16_t*)(p.ws + WS_MA), nullptr, (bf16_t*)(p.ws + WS_TMP)};
          pg8::gemm_phase<EpiBranch<0>, pg8::StaticOrder, true, true>(glds, g, S, E); }
        { pg8::Gemm g{(const bf16_t*)(p.ws + WS_OG), (const bf16_t*)(p.ws + WS_WBG), MP, 1024, 512};
          EpiBranch<1> E{(const bf16_t*)(p.ws + WS_MG), (const bf16_t*)(p.ws + WS_TMP), (bf16_t*)(p.ws + WS_MRG)};
          pg8::gemm_phase<EpiBranch<1>, pg8::StaticOrder, true, true>(glds, g, S, E); }
        small_merge_tiles(p);
    }
    SEAM(6);
    if (IN(7)) for (int rep = 0; rep < REP(8); ++rep) { pg8::Gemm g{(const bf16_t*)(p.ws + WS_MRG), (const bf16_t*)(p.ws + WS_WOUT), MP, 1024, 1024}; pg8::StaticOrder S; S.init(MP, 1024, gridDim.x, blockIdx.x);
        EpiOut E{p.in[0], p.in[1], (const float*)(p.ws + WS_MOD), p.out + O_Y};
        pg8::gemm_phase<EpiOut, pg8::StaticOrder, true, true>(glds, g, S, E);
        small_out_tiles(p); }
#undef IN
#undef SEAM
}

constexpr int LDS_BYTES = 131072;
#ifndef N_LAUNCH_MODE
#define N_LAUNCH_MODE 1
#endif

extern "C" void kernel_launch(void* const* d_in, const int* in_sizes, int n_in, void* d_out, int out_size, void* d_ws, size_t ws_size, hipStream_t stream) {
    static int grid = 0;
    if (grid == 0) {
        if (n_in != 20 || ws_size < WS_END) { fprintf(stderr, "kernel_launch: unexpected n_in %d / ws_size %zu (need %zu)\n", n_in, ws_size, (size_t)WS_END); grid = -1; return; }
        int dev = 0, cus = 0, per_cu = 0;
        hipGetDevice(&dev);
        hipDeviceGetAttribute(&cus, hipDeviceAttributeMultiprocessorCount, dev);
        if (hipFuncSetAttribute((const void*)mega_fwd, hipFuncAttributeMaxDynamicSharedMemorySize, LDS_BYTES) != hipSuccess) { fprintf(stderr, "kernel_launch: hipFuncSetAttribute failed\n"); grid = -1; return; }
        if (hipOccupancyMaxActiveBlocksPerMultiprocessor(&per_cu, (const void*)mega_fwd, 512, LDS_BYTES) != hipSuccess || per_cu < 1) { fprintf(stderr, "kernel_launch: occupancy query gives %d\n", per_cu); per_cu = 1; }
        (void)hipGetLastError();
        grid = cus * 1;
        if (grid > cus * per_cu) grid = cus * per_cu;
    }
    if (grid < 0) return;
    Params p{};
    for (int i = 0; i < 20; ++i) p.in[i] = (const float*)d_in[i];
    p.out = (float*)d_out; p.ws = (unsigned char*)d_ws;
    for (int i = 0; i < 32; ++i) { const float e = (float)i / 32.0f; const float pw = powf(10000.0f, e); p.inv[i] = 1.0f / pw; }
#if N_LAUNCH_MODE == 1
    p.ph_lo = 0; p.ph_hi = 8;
    void* args[] = {&p};
    hipError_t e = hipLaunchCooperativeKernel((const void*)mega_fwd, dim3(grid), dim3(512), args, LDS_BYTES, stream);
    if (e != hipSuccess) fprintf(stderr, "cooperative launch failed: %s (grid %d)\n", hipGetErrorString(e), grid);
#else
    for (int ph = 0; ph < 8; ++ph) { p.ph_lo = ph; p.ph_hi = ph + 1;
        hipLaunchKernelGGL(mega_fwd, dim3(grid), dim3(512), LDS_BYTES, stream, p); }
#endif
}
```

```cpp
#define PROBE_MASK 0
#include <hip/hip_runtime.h>
#include <hip/hip_cooperative_groups.h>
#include <cstdio>
#include <cstdint>
#include <cmath>
namespace cg = cooperative_groups;
__device__ __forceinline__ int opaque_tid() { int t = threadIdx.x; asm volatile("" : "+v"(t)); return t; }
namespace pg8 {
#define PG8_LAS __attribute__((address_space(3)))
typedef unsigned short bf16_t;
typedef short bf16x8 __attribute__((ext_vector_type(8)));
typedef float f32x4 __attribute__((ext_vector_type(4)));
typedef unsigned u32x4 __attribute__((ext_vector_type(4)));
constexpr int BM = 256, BK = 64, HALF = 128, HTB = HALF * BK * 2  , STAGE_BYTES = 8 * HTB, NXCD = 8, WGM = 8;

__host__ __device__ __forceinline__ int lds_byte(int r, int c) { const int st = (r >> 4) * 2 + (c >> 5), rr = r & 15, cc = c & 31, ob = rr * 64 + cc * 2; return st * 1024 + (ob ^ (((ob >> 9) & 1) << 5)); }
__host__ __device__ __forceinline__ void stage_rc(int b, int& R, int& C) { const int st = b / 1024, sb = b % 1024, swz = sb ^ (((sb >> 9) & 1) << 5); R = (st >> 1) * 16 + swz / 64; C = (st & 1) * 32 + (swz % 64) / 2; }
__host__ __device__ __forceinline__ int perm32(int rho) { const int n = rho >> 4, i = rho & 15; return 8 * (i >> 2) + 4 * n + (i & 3); }

struct Unit { int pm, pn; };
struct Gemm { const bf16_t* A; const bf16_t* Bt; int M, N, K; };

struct StaticOrder {
    int nM, nN, nwg, G, c;
    __host__ __device__ void init(int M, int N, int G_, int c_) { nM = M / BM; nN = N / BM; nwg = nM * nN; G = G_; c = c_; }
    __host__ __device__ bool next(int i, Unit& u) const {
        const long L = (long)i * G + c; if (L >= nwg) return false;
        int wgid = (int)L; { const int q = nwg / NXCD, r = nwg % NXCD, xcd = wgid % NXCD, off = wgid / NXCD; wgid = (xcd < r ? xcd * (q + 1) : r * (q + 1) + (xcd - r) * q) + off; }
        const int nig = WGM * nN, gid = wgid / nig, fm = gid * WGM, gsz = (nM - fm) < WGM ? (nM - fm) : WGM;
        u.pm = fm + ((wgid % nig) % gsz); u.pn = (wgid % nig) / gsz; return true;
    }
    __device__ __forceinline__ void a_ready(const Unit&) const {}
    __device__ __forceinline__ void done(const Unit&) const {}
};
__device__ __forceinline__ unsigned cvt_pk_bf16(float lo, float hi) { unsigned r; asm volatile("v_cvt_pk_bf16_f32 %0, %1, %2" : "=v"(r) : "v"(lo), "v"(hi)); return r; }
typedef float f32x2 __attribute__((ext_vector_type(2)));
template <class Epi, class Sched, bool ALIGN_EPI = false, bool SP2 = false>
__device__ __forceinline__ void gemm_phase(PG8_LAS unsigned char* lds, const Gemm g, const Sched& S, const Epi& E) {
    const int tid = opaque_tid(), wid = __builtin_amdgcn_readfirstlane(tid >> 6), lane = tid & 63, wr = wid >> 2, wc = wid & 3, fr = lane & 15, fq = lane >> 4;
    const int K = g.K, nt = K / BK;
    unsigned voffA[2], voffB[2];
#pragma unroll
    for (int i = 0; i < 2; ++i) { int R, C; stage_rc(tid * 16 + i * 8192, R, C); const int Rb = Epi::PERM ? ((R & ~31) + perm32(R & 31)) : R;
        voffA[i] = (unsigned)(R * K + C) * 2u; voffB[i] = (unsigned)(Rb * K + C) * 2u; }
    const size_t kstep = (size_t)(BK * 2);
    const size_t hstep = (size_t)HALF * K * 2;
    const size_t tstep = 2 * hstep;
    const unsigned ldsw = (unsigned)wid * 1024u;
    const int aoff = lds_byte(wr * 64 + fr, fq * 8), boff = lds_byte(wc * 32 + fr, fq * 8);
#define PG8_SA(b, h) (((b) * 2 + (h)) * HTB)
#define PG8_SB(b, h) ((4 + (b) * 2 + (h)) * HTB)
#define PG8_STAGE(bufoff, gbase, voff) do { _Pragma("unroll") for (int _i = 0; _i < 2; ++_i) \
        __builtin_amdgcn_global_load_lds((const unsigned*)((const char*)(gbase) + (voff)[_i]), (PG8_LAS unsigned*)(lds + (bufoff) + ldsw + _i * 8192), 16, 0, 0); } while (0)
#define PG8_LDA(dst, b, h) do { _Pragma("unroll") for (int m = 0; m < 4; ++m) _Pragma("unroll") for (int k = 0; k < 2; ++k) dst[m][k] = *(const PG8_LAS bf16x8*)(lds + PG8_SA(b, h) + aoff + m * 2048 + k * 1024); } while (0)
#define PG8_LDB(dst, b, h) do { _Pragma("unroll") for (int n = 0; n < 2; ++n) _Pragma("unroll") for (int k = 0; k < 2; ++k) dst[n][k] = *(const PG8_LAS bf16x8*)(lds + PG8_SB(b, h) + boff + n * 2048 + k * 1024); } while (0)
#define PG8_MMA(ai, bj, At, Bt) do { __builtin_amdgcn_s_setprio(1); _Pragma("unroll") for (int m = 0; m < 4; ++m) _Pragma("unroll") for (int n = 0; n < 2; ++n) _Pragma("unroll") for (int k = 0; k < 2; ++k) \
        acc[ai][bj][m][n] = __builtin_amdgcn_mfma_f32_16x16x32_bf16(Bt[n][k], At[m][k], acc[ai][bj][m][n], 0, 0, 0); __builtin_amdgcn_s_setprio(0); } while (0)
#define PG8_WAIT_V(n) asm volatile("s_waitcnt vmcnt(" #n ")" ::: "memory")
#define PG8_WAIT_L(n) asm volatile("s_waitcnt lgkmcnt(" #n ")" ::: "memory")
#define PG8_BAR __builtin_amdgcn_s_barrier()
#define PG8_SCHED __builtin_amdgcn_sched_barrier(0)
    Unit cur, nxt; int ui = 0;
    if (!S.next(0, cur)) return;
    f32x4 acc[2][2][4][2];
#pragma unroll
    for (int a = 0; a < 2; ++a)
#pragma unroll
        for (int b = 0; b < 2; ++b)
#pragma unroll
            for (int m = 0; m < 4; ++m)
#pragma unroll
                for (int n = 0; n < 2; ++n) acc[a][b][m][n] = (f32x4){0.f, 0.f, 0.f, 0.f};
    bf16x8 At[4][2], B0[2][2], B1[2][2];
    const char* cA = (const char*)g.A + (size_t)cur.pm * tstep; const char* cB = (const char*)g.Bt + (size_t)cur.pn * tstep;
    S.a_ready(cur);
    if constexpr (SP2) {
        PG8_STAGE(PG8_SB(0, 0), cB, voffB); PG8_STAGE(PG8_SB(0, 1), cB + hstep, voffB); PG8_STAGE(PG8_SA(0, 0), cA, voffA); PG8_STAGE(PG8_SA(0, 1), cA + hstep, voffA);
        if (wr == 1) PG8_BAR;
        PG8_WAIT_V(2); PG8_BAR;
        PG8_STAGE(PG8_SB(1, 0), cB + kstep, voffB); PG8_STAGE(PG8_SA(1, 0), cA + kstep, voffA); PG8_STAGE(PG8_SB(1, 1), cB + hstep + kstep, voffB);
        PG8_WAIT_V(6); PG8_BAR;
    } else {
        PG8_STAGE(PG8_SB(0, 0), cB, voffB); PG8_STAGE(PG8_SA(0, 0), cA, voffA); PG8_STAGE(PG8_SB(0, 1), cB + hstep, voffB); PG8_STAGE(PG8_SA(0, 1), cA + hstep, voffA);
        if (wr == 1) PG8_BAR;
        PG8_WAIT_V(4); PG8_BAR;
        PG8_STAGE(PG8_SB(1, 0), cB + kstep, voffB); PG8_STAGE(PG8_SA(1, 0), cA + kstep, voffA); PG8_STAGE(PG8_SB(1, 1), cB + hstep + kstep, voffB);
        PG8_WAIT_V(6); PG8_BAR;
    }
    for (;;) {
        const bool has_next = S.next(ui + 1, nxt);
        const char* nA = has_next ? (const char*)g.A + (size_t)nxt.pm * tstep : cA; const char* nB = has_next ? (const char*)g.Bt + (size_t)nxt.pn * tstep : cB;
        for (int t = 0; t < nt; t += 2) {
            const bool last = (t == nt - 2);
            const char* a1 = cA + (size_t)(t + 1) * kstep;
            const char* a2 = last ? nA : cA + (size_t)(t + 2) * kstep; const char* b2 = last ? nB : cB + (size_t)(t + 2) * kstep;
            const char* a3 = a2 + kstep; const char* b3 = b2 + kstep;
            if (last && has_next) S.a_ready(nxt);
            if constexpr (SP2) {
            PG8_LDB(B0, 0, 0); PG8_LDB(B1, 0, 1); PG8_SCHED; PG8_LDA(At, 0, 0); PG8_STAGE(PG8_SA(1, 1), a1 + hstep, voffA);
            PG8_WAIT_V(8); PG8_WAIT_L(0); PG8_BAR; PG8_MMA(0, 0, At, B0); PG8_MMA(0, 1, At, B1); PG8_BAR; PG8_SCHED;
            PG8_LDA(At, 0, 1); PG8_STAGE(PG8_SB(0, 0), b2, voffB); PG8_STAGE(PG8_SB(0, 1), b2 + hstep, voffB); PG8_STAGE(PG8_SA(0, 0), a2, voffA);
            PG8_WAIT_V(8); PG8_WAIT_L(0); PG8_BAR; PG8_MMA(1, 0, At, B0); PG8_MMA(1, 1, At, B1); PG8_BAR; PG8_SCHED;
            PG8_LDB(B0, 1, 0); PG8_LDB(B1, 1, 1); PG8_SCHED; PG8_LDA(At, 1, 0); PG8_STAGE(PG8_SA(0, 1), a2 + hstep, voffA);
            PG8_WAIT_V(8); PG8_WAIT_L(0); PG8_BAR; PG8_MMA(0, 0, At, B0); PG8_MMA(0, 1, At, B1); PG8_BAR; PG8_SCHED;
            PG8_LDA(At, 1, 1); PG8_STAGE(PG8_SB(1, 0), b3, voffB); PG8_STAGE(PG8_SB(1, 1), b3 + hstep, voffB); PG8_STAGE(PG8_SA(1, 0), a3, voffA);
            PG8_WAIT_V(8); PG8_WAIT_L(0); PG8_BAR; PG8_MMA(1, 0, At, B0); PG8_MMA(1, 1, At, B1); PG8_BAR; PG8_SCHED;
            } else {
            PG8_LDB(B0, 0, 0); PG8_SCHED; PG8_LDA(At, 0, 0); PG8_STAGE(PG8_SA(1, 1), a1 + hstep, voffA);
            PG8_WAIT_L(8); PG8_BAR; PG8_WAIT_L(0); PG8_MMA(0, 0, At, B0); PG8_BAR; PG8_SCHED;
            PG8_LDB(B1, 0, 1); PG8_STAGE(PG8_SB(0, 0), b2, voffB);
            PG8_BAR; PG8_WAIT_L(0); PG8_MMA(0, 1, At, B1); PG8_BAR;
            PG8_LDA(At, 0, 1); PG8_STAGE(PG8_SA(0, 0), a2, voffA);
            PG8_BAR; PG8_WAIT_L(0); PG8_MMA(1, 0, At, B0); PG8_BAR; PG8_SCHED;
            PG8_STAGE(PG8_SB(0, 1), b2 + hstep, voffB);
            PG8_WAIT_V(6); PG8_BAR; PG8_MMA(1, 1, At, B1); PG8_BAR;
            PG8_LDB(B0, 1, 0); PG8_SCHED; PG8_LDA(At, 1, 0); PG8_STAGE(PG8_SA(0, 1), a2 + hstep, voffA);
            PG8_WAIT_L(8); PG8_BAR; PG8_WAIT_L(0); PG8_MMA(0, 0, At, B0); PG8_BAR; PG8_SCHED;
            PG8_LDB(B1, 1, 1); PG8_STAGE(PG8_SB(1, 0), b3, voffB);
            PG8_BAR; PG8_WAIT_L(0); PG8_MMA(0, 1, At, B1); PG8_BAR;
            PG8_LDA(At, 1, 1); PG8_STAGE(PG8_SA(1, 0), a3, voffA);
            PG8_BAR; PG8_WAIT_L(0); PG8_MMA(1, 0, At, B0); PG8_BAR; PG8_SCHED;
            PG8_STAGE(PG8_SB(1, 1), b3 + hstep, voffB);
            PG8_WAIT_V(6); PG8_BAR; PG8_MMA(1, 1, At, B1); PG8_BAR;
            }
        }
        if constexpr (ALIGN_EPI) { if (wr == 0) PG8_BAR; }
        if constexpr (!Epi::AFTER_DRAIN) { E(acc, cur, wr, wc, fr, fq); S.done(cur); }
        if (!has_next) break;
#pragma unroll
        for (int a = 0; a < 2; ++a)
#pragma unroll
            for (int b = 0; b < 2; ++b)
#pragma unroll
                for (int m = 0; m < 4; ++m)
#pragma unroll
                    for (int n = 0; n < 2; ++n) acc[a][b][m][n] = (f32x4){0.f, 0.f, 0.f, 0.f};
        cur = nxt; cA = nA; cB = nB; ++ui;
        if constexpr (ALIGN_EPI) { if (wr == 1) PG8_BAR; }
    }
    PG8_WAIT_V(0);
    if constexpr (!ALIGN_EPI) { if (wr == 0) PG8_BAR; }
    PG8_BAR;
    if constexpr (Epi::AFTER_DRAIN) { E.fused(acc, cur, wr, wc, fr, fq, lds, wid, lane); S.done(cur); }
#undef PG8_SA
#undef PG8_SB
#undef PG8_STAGE
#undef PG8_LDA
#undef PG8_LDB
#undef PG8_MMA
#undef PG8_WAIT_V
#undef PG8_WAIT_L
#undef PG8_BAR
#undef PG8_SCHED
}
}

using pg8::bf16_t; using pg8::bf16x8; using pg8::f32x4; using pg8::u32x4; using pg8::Unit;
typedef unsigned u32x2 __attribute__((ext_vector_type(2)));
typedef float f32x2v __attribute__((ext_vector_type(2)));
typedef __bf16 bf16x2v __attribute__((ext_vector_type(2)));

constexpr int DM = 1024, SEQ = 8192, MP = 16384, MS = 1024, MT = MP + MS;
constexpr int NIN = 4880, NINP = 5120;
constexpr float EPS = 1e-6f;
constexpr float LOG2E = 1.4426950408889634f;

constexpr size_t WS_MOD = 0;
constexpr size_t WS_ROPE = WS_MOD + 1597440;
constexpr size_t WS_WIN = WS_ROPE + 2099200;
constexpr size_t WS_WBA = WS_WIN + 10485760;
constexpr size_t WS_WBG = WS_WBA + 1048576;
constexpr size_t WS_WOUT = WS_WBG + 1048576;
constexpr size_t WS_H = WS_WOUT + 2097152;
constexpr size_t WS_OA = WS_H;
constexpr size_t WS_OG = WS_H + 17825792;
constexpr size_t WS_QA = WS_H + 35651584;
constexpr size_t WS_KA = WS_QA + 17825792;
constexpr size_t WS_VA = WS_KA + 4456448;
constexpr size_t WS_QG = WS_VA + 4456448;
constexpr size_t WS_TMP = WS_QA;
constexpr size_t WS_KG = WS_QG + 8912896;
constexpr size_t WS_VG = WS_KG + 8912896;
constexpr size_t WS_ZG = WS_VG + 17825792;
constexpr size_t WS_MRG = WS_KG;
constexpr size_t WS_ZA = WS_ZG + 17825792;
constexpr size_t WS_MA = WS_ZA + 17825792;
constexpr size_t WS_MG = WS_MA + 35651584;
constexpr size_t WS_LR = WS_MG + 35651584;
constexpr size_t WS_DS = WS_LR + 4456448;
constexpr size_t WS_DEC = WS_DS + 33554432;
constexpr size_t WS_END = WS_DEC + 262144;

constexpr size_t O_Y = 0;
constexpr size_t O_PWK = 17825792;
constexpr size_t O_PWV = O_PWK + 32768;
constexpr size_t O_PGS = O_PWV + 32768;
constexpr size_t O_SWK = O_PGS + 65536;
constexpr size_t O_SWV = O_SWK + 2097152;
constexpr size_t O_SGS = O_SWV + 2097152;

struct Params {
    const float* in[20];
    float* out; unsigned char* ws;
    float inv[32];
    int ph_lo, ph_hi;
};

__device__ __forceinline__ unsigned pk2(float lo, float hi) { f32x2v v = {lo, hi}; bf16x2v b = __builtin_convertvector(v, bf16x2v); return __builtin_bit_cast(unsigned, b); }
__device__ __forceinline__ float bflo(unsigned w) { return __uint_as_float(w << 16); }
__device__ __forceinline__ float bfhi(unsigned w) { return __uint_as_float(w & 0xffff0000u); }
__device__ __forceinline__ float bf2f(bf16_t h) { return __uint_as_float((unsigned)h << 16); }
__device__ __forceinline__ float fast_rcp(float x) { return __builtin_amdgcn_rcpf(x); }
__device__ __forceinline__ float sigmoidf_(float x) { return fast_rcp(1.f + __expf(-x)); }
__device__ __forceinline__ float siluf_(float x) { return x * fast_rcp(1.f + __expf(-x)); }
__device__ __forceinline__ float wave_sum(float v) {
#pragma unroll
    for (int o = 1; o < 64; o <<= 1) v += __shfl_xor(v, o);
    return v;
}
__device__ __forceinline__ f32x4 mfma16(bf16x8 a, bf16x8 b, f32x4 c) { return __builtin_amdgcn_mfma_f32_16x16x32_bf16(a, b, c, 0, 0, 0); }
__device__ __forceinline__ void unpack8(const u32x4 w, float (&a)[8]) {
    a[0] = bflo(w.x); a[1] = bfhi(w.x); a[2] = bflo(w.y); a[3] = bfhi(w.y); a[4] = bflo(w.z); a[5] = bfhi(w.z); a[6] = bflo(w.w); a[7] = bfhi(w.w);
}
__device__ __forceinline__ u32x4 pack8(const float (&a)[8]) { u32x4 w; w.x = pk2(a[0], a[1]); w.y = pk2(a[2], a[3]); w.z = pk2(a[4], a[5]); w.w = pk2(a[6], a[7]); return w; }
__device__ __forceinline__ u32x4 pack8s(const float (&a)[8], float sc) { u32x4 w; w.x = pk2(a[0] * sc, a[1] * sc); w.y = pk2(a[2] * sc, a[3] * sc); w.z = pk2(a[4] * sc, a[5] * sc); w.w = pk2(a[6] * sc, a[7] * sc); return w; }
__device__ __forceinline__ int mod_row(int r) { return r < MP ? (r >> 13) : 2 + ((r - MP) >> 3); }

struct EpiProj {
    static constexpr bool PERM = true, AFTER_DRAIN = false;
    unsigned char* ws;
    __device__ __forceinline__ void operator()(const f32x4 (&acc)[2][2][4][2], const Unit& u, int wr, int wc, int fr, int fq) const {
        const int row0 = u.pm * 256 + wr * 64 + fr;
#pragma unroll
        for (int bj = 0; bj < 2; ++bj) {
            const int cb = u.pn * 2 + bj;
            size_t off; int ld, cbase, act;
            if (cb < 4) { off = WS_QA; ld = 512; cbase = cb * 128; act = 0; }
            else if (cb == 4) { off = WS_KA; ld = 128; cbase = 0; act = 0; }
            else if (cb == 5) { off = WS_VA; ld = 128; cbase = 0; act = 0; }
            else if (cb < 10) { off = WS_ZA; ld = 512; cbase = (cb - 6) * 128; act = 1; }
            else if (cb < 12) { off = WS_QG; ld = 256; cbase = (cb - 10) * 128; act = 3; }
            else if (cb < 14) { off = WS_KG; ld = 256; cbase = (cb - 12) * 128; act = 0; }
            else if (cb < 18) { off = WS_VG; ld = 512; cbase = (cb - 14) * 128; act = 0; }
            else if (cb < 22) { off = WS_ZG; ld = 512; cbase = (cb - 18) * 128; act = 1; }
            else if (cb < 30) { off = WS_MA; ld = 1024; cbase = (cb - 22) * 128; act = 2; }
            else if (cb < 38) { off = WS_MG; ld = 1024; cbase = (cb - 30) * 128; act = 2; }
            else if (cb == 38) { off = WS_LR; ld = 128; cbase = 0; act = 0; }
            else continue;
            bf16_t* base = (bf16_t*)(ws + off) + cbase + wc * 32 + 8 * fq;
#pragma unroll
            for (int ai = 0; ai < 2; ++ai)
#pragma unroll
                for (int m = 0; m < 4; ++m) {
                    f32x4 v0 = acc[ai][bj][m][0], v1 = acc[ai][bj][m][1];
                    if (act == 1) { for (int j = 0; j < 4; ++j) { v0[j] = siluf_(v0[j]); v1[j] = siluf_(v1[j]); } }
                    else if (act == 2) { for (int j = 0; j < 4; ++j) { v0[j] = sigmoidf_(v0[j]); v1[j] = sigmoidf_(v1[j]); } }
                    else if (act == 3) { v0 = v0 * 0.125f; v1 = v1 * 0.125f; }
                    u32x4 w; w.x = pk2(v0[0], v0[1]); w.y = pk2(v0[2], v0[3]); w.z = pk2(v1[0], v1[1]); w.w = pk2(v1[2], v1[3]);
                    *(u32x4*)(base + (size_t)(row0 + ai * 128 + m * 16) * ld) = w;
                }
        }
    }
};
template <int MODE> struct EpiBranch {
    static constexpr bool PERM = true, AFTER_DRAIN = false;
    const bf16_t* gate; const bf16_t* prev; bf16_t* dst;
    __device__ __forceinline__ void operator()(const f32x4 (&acc)[2][2][4][2], const Unit& u, int wr, int wc, int fr, int fq) const {
        const int row0 = u.pm * 256 + wr * 64 + fr, col0 = u.pn * 256 + wc * 32 + 8 * fq;
#pragma unroll
        for (int ai = 0; ai < 2; ++ai)
#pragma unroll
            for (int m = 0; m < 4; ++m)
#pragma unroll
                for (int bj = 0; bj < 2; ++bj) {
                    const size_t o = (size_t)(row0 + ai * 128 + m * 16) * 1024 + col0 + bj * 128;
                    const u32x4 g = *(const u32x4*)(gate + o);
                    f32x4 v0 = acc[ai][bj][m][0], v1 = acc[ai][bj][m][1];
                    v0[0] *= bflo(g.x); v0[1] *= bfhi(g.x); v0[2] *= bflo(g.y); v0[3] *= bfhi(g.y);
                    v1[0] *= bflo(g.z); v1[1] *= bfhi(g.z); v1[2] *= bflo(g.w); v1[3] *= bfhi(g.w);
                    if (MODE == 1) { const u32x4 t = *(const u32x4*)(prev + o);
                        v0[0] += bflo(t.x); v0[1] += bfhi(t.x); v0[2] += bflo(t.y); v0[3] += bfhi(t.y);
                        v1[0] += bflo(t.z); v1[1] += bfhi(t.z); v1[2] += bflo(t.w); v1[3] += bfhi(t.w); }
                    u32x4 w; w.x = pk2(v0[0], v0[1]); w.y = pk2(v0[2], v0[3]); w.z = pk2(v1[0], v1[1]); w.w = pk2(v1[2], v1[3]);
                    *(u32x4*)(dst + o) = w;
                }
    }
};
struct EpiOut {
    static constexpr bool PERM = false, AFTER_DRAIN = false;
    const float* xp; const float* xs; const float* mod; float* out;
    __device__ __forceinline__ void operator()(const f32x4 (&acc)[2][2][4][2], const Unit& u, int wr, int wc, int fr, int fq) const {
        const int col0 = u.pn * 256 + wc * 32 + 4 * fq;
#pragma unroll
        for (int ai = 0; ai < 2; ++ai)
#pragma unroll
            for (int m = 0; m < 4; ++m) {
                const int row = u.pm * 256 + ai * 128 + wr * 64 + m * 16 + fr;
                const float* xrow = row < MP ? xp + (size_t)row * 1024 : xs + (size_t)(row - MP) * 1024;
                const float* grow = mod + (size_t)mod_row(row) * 3072 + 2048;
                float* orow = out + (size_t)row * 1024;
#pragma unroll
                for (int bj = 0; bj < 2; ++bj)
#pragma unroll
                    for (int n = 0; n < 2; ++n) { const int c = col0 + bj * 128 + n * 16;
                        const f32x4 x4 = *(const f32x4*)(xrow + c), g4 = *(const f32x4*)(grow + c);
                        *(f32x4*)(orow + c) = x4 + g4 * acc[ai][bj][m][n]; }
            }
    }
};

__device__ __forceinline__ void p0_ada(const Params& p, unsigned char* lds, int unit) {
    const int tid = opaque_tid(), lane = tid & 63, w = tid >> 6, fr = lane & 15, fq = lane >> 4;
    const int c0 = unit * 16;
    const float* wa = p.in[8];
    f32x4 acc[9];
#pragma unroll
    for (int i = 0; i < 9; ++i) acc[i] = (f32x4){0.f, 0.f, 0.f, 0.f};
#pragma unroll 1
    for (int ks = 0; ks < 4; ++ks) {
        const int k0 = w * 128 + ks * 32 + fq * 8;
        float bv[8];
#pragma unroll
        for (int j = 0; j < 8; ++j) bv[j] = wa[(size_t)(k0 + j) * 3072 + c0 + fr];
        const bf16x8 bfrag = __builtin_bit_cast(bf16x8, pack8(bv));
#pragma unroll
        for (int rt = 0; rt < 9; ++rt) {
            const int row = min(rt * 16 + fr, 129);
            const float* cp = (row < 2 ? p.in[5] + row * 1024 : p.in[6] + (row - 2) * 1024) + k0;
            const f32x4 x0 = *(const f32x4*)cp, x1 = *(const f32x4*)(cp + 4);
            float av[8] = {x0.x, x0.y, x0.z, x0.w, x1.x, x1.y, x1.z, x1.w};
#pragma unroll
            for (int j = 0; j < 8; ++j) av[j] = av[j] * fast_rcp(1.f + __expf(-av[j]));
            acc[rt] = mfma16(__builtin_bit_cast(bf16x8, pack8(av)), bfrag, acc[rt]);
            if (rt % 3 == 2) asm volatile("" ::: "memory");
        }
    }
    f32x4* red = (f32x4*)lds;
#pragma unroll
    for (int rt = 0; rt < 9; ++rt) red[(w * 9 + rt) * 64 + lane] = acc[rt];
    __syncthreads();
    float* mod = (float*)(p.ws + WS_MOD);
    for (int idx = tid; idx < 576; idx += 512) { const int rt = idx >> 6, ln = idx & 63;
        f32x4 sum = red[rt * 64 + ln];
#pragma unroll
        for (int ww = 1; ww < 8; ++ww) sum = sum + red[(ww * 9 + rt) * 64 + ln];
        const int col = c0 + (ln & 15); const float bias = p.in[9][col];
#pragma unroll
        for (int r = 0; r < 4; ++r) { const int row = rt * 16 + (ln >> 4) * 4 + r; if (row < 130) mod[(size_t)row * 3072 + col] = sum[r] + bias; } }
    __syncthreads();
}
__device__ __forceinline__ void p0_transpose_item(const float* W, int N, int n0, int nvalid, bf16_t* WT, int K, int n0p, int k0, float* scr, int lane) {
    const int c = lane & 31; const bool ok = c < nvalid;
#pragma unroll 8
    for (int i = 0; i < 32; ++i) { const int kk = 2 * i + (lane >> 5); scr[kk * 33 + c] = ok ? W[(size_t)(k0 + kk) * N + n0 + c] : 0.f; }
    asm volatile("s_waitcnt lgkmcnt(0)" ::: "memory");
    const int c8 = lane & 7;
#pragma unroll
    for (int j = 0; j < 4; ++j) { const int n = (lane >> 3) + 8 * j; const float* s = scr + (8 * c8) * 33 + n;
        u32x4 o; o.x = pk2(s[0], s[33]); o.y = pk2(s[66], s[99]); o.z = pk2(s[132], s[165]); o.w = pk2(s[198], s[231]);
        *(u32x4*)(WT + (size_t)(n0p + n) * K + k0 + 8 * c8) = o; }
    asm volatile("s_waitcnt lgkmcnt(0)" ::: "memory");
}
__device__ __forceinline__ void phase0(const Params& p, unsigned char* lds) {
    { int u0 = gridDim.x >= 192 ? (int)blockIdx.x - ((int)gridDim.x - 192) : (int)blockIdx.x;
      for (int u = u0; u < 192; u += gridDim.x) if (u >= 0) p0_ada(p, lds, u); }
}
__device__ __forceinline__ void phase0b(const Params& p, unsigned char* lds) {
    const int tid_ = opaque_tid(); const int lane = tid_ & 63, wave = tid_ >> 6;
    float* scr = (float*)(lds + wave * 8448);
    constexpr int I_IN = 16 * 160, I_B = 8 * 32, I_O = 16 * 32, TOT = I_IN + 2 * I_B + I_O;
    for (int it = blockIdx.x * 8 + wave; it < TOT; it += gridDim.x * 8) {
        int r = it;
        if (r < I_IN) { const int kb = r / 160, nb = r % 160; int n0, nv;
            if (nb < 72) { n0 = nb * 32; nv = 32; } else if (nb < 152) { n0 = nb * 32 + 16; nv = 32; } else if (nb == 152) { n0 = 2304; nv = 16; } else { n0 = 0; nv = 0; }
            p0_transpose_item(p.in[10], NIN, n0, nv, (bf16_t*)(p.ws + WS_WIN), 1024, nb * 32, kb * 64, scr, lane); continue; } r -= I_IN;
        if (r < I_B) { p0_transpose_item(p.in[17], 1024, (r % 32) * 32, 32, (bf16_t*)(p.ws + WS_WBA), 512, (r % 32) * 32, (r / 32) * 64, scr, lane); continue; } r -= I_B;
        if (r < I_B) { p0_transpose_item(p.in[18], 1024, (r % 32) * 32, 32, (bf16_t*)(p.ws + WS_WBG), 512, (r % 32) * 32, (r / 32) * 64, scr, lane); continue; } r -= I_B;
        p0_transpose_item(p.in[19], 1024, (r % 32) * 32, 32, (bf16_t*)(p.ws + WS_WOUT), 1024, (r % 32) * 32, (r / 32) * 64, scr, lane);
    }
    float* rope = (float*)(p.ws + WS_ROPE);
    for (int e = blockIdx.x * 512 + tid_; e < 8200 * 32; e += gridDim.x * 512) {
        const int pp = e >> 5, i = e & 31; const int pos = pp < 8192 ? pp : pp + 8192;
        const float ang = (float)pos * p.inv[i];
        const double a = (double)ang; const double n = rint(a * 0.15915494309189535);
        const float r = (float)fma(-n, 6.283185307179586, a);
        rope[(size_t)pp * 64 + i] = __cosf(r); rope[(size_t)pp * 64 + 32 + i] = __sinf(r); }
    __syncthreads();
}

__device__ __forceinline__ void phase1(const Params& p) {
    const int tid_ = opaque_tid(); const int lane = tid_ & 63, wave = tid_ >> 6;
    const float* mod = (const float*)(p.ws + WS_MOD);
    bf16_t* H = (bf16_t*)(p.ws + WS_H);
    for (int r = blockIdx.x * 8 + wave; r < MT; r += gridDim.x * 8) {
        const float* xrow = r < MP ? p.in[0] + (size_t)r * 1024 : p.in[1] + (size_t)(r - MP) * 1024;
        const float* mr = mod + (size_t)mod_row(r) * 3072;
        f32x4 v[4]; float ss = 0.f;
#pragma unroll
        for (int j = 0; j < 4; ++j) { v[j] = *(const f32x4*)(xrow + 4 * lane + 256 * j); ss += (v[j].x * v[j].x + v[j].y * v[j].y) + (v[j].z * v[j].z + v[j].w * v[j].w); }
        const float rstd = rsqrtf(wave_sum(ss) * (1.f / 1024.f) + EPS);
#pragma unroll
        for (int j = 0; j < 4; ++j) { const int c = 4 * lane + 256 * j;
            const f32x4 g = *(const f32x4*)(p.in[7] + c), sh = *(const f32x4*)(mr + c), sc = *(const f32x4*)(mr + 1024 + c);
            const f32x4 h = v[j] * rstd * g * (sc + 1.f) + sh;
            u32x2 w; w.x = pk2(h.x, h.y); w.y = pk2(h.z, h.w);
            *(u32x2*)(H + (size_t)r * 1024 + c) = w; }
    }
}

constexpr int KS_STRIDE = 72, VT_STRIDE = 264, ATT_VT_OFF = 256 * 72 * 2;
constexpr float QSCALE = 0.125f * LOG2E;

__device__ __forceinline__ void attn_group(const bf16_t* Ks, const bf16_t* Vt, int kt0, int lo, int hi, bf16x8 qf0, bf16x8 qf1, float sinkv, f32x4 (&o)[4], int lane) {
    const int fr = lane & 15, fq = lane >> 4;
    f32x4 s[9];
#pragma unroll
    for (int t = 0; t < 9; ++t) {
        const bf16_t* kp = Ks + ((kt0 + t) * 16 + fr) * KS_STRIDE + fq * 8;
        const bf16x8 k0 = *(const bf16x8*)kp, k1 = *(const bf16x8*)(kp + 32);
        f32x4 a = {0.f, 0.f, 0.f, 0.f};
        a = mfma16(k0, qf0, a); a = mfma16(k1, qf1, a);
        s[t] = a;
    }
    float m = sinkv;
#pragma unroll
    for (int t = 0; t < 9; ++t)
#pragma unroll
        for (int r = 0; r < 4; ++r) { const int j = (kt0 + t) * 16 + fq * 4 + r; const float v = (j >= lo && j <= hi) ? s[t][r] : -1e30f; s[t][r] = v; m = fmaxf(m, v); }
    m = fmaxf(m, __shfl_xor(m, 16)); m = fmaxf(m, __shfl_xor(m, 32));
    float l = 0.f;
#pragma unroll
    for (int t = 0; t < 9; ++t)
#pragma unroll
        for (int r = 0; r < 4; ++r) { const float pv = exp2f(s[t][r] - m); l += pv; s[t][r] = pv; }
    l += __shfl_xor(l, 16); l += __shfl_xor(l, 32);
    l += exp2f(sinkv - m);
#pragma unroll
    for (int dt = 0; dt < 4; ++dt) o[dt] = (f32x4){0.f, 0.f, 0.f, 0.f};
#pragma unroll
    for (int ks = 0; ks < 5; ++ks) {
        u32x4 pw; pw.x = pk2(s[2 * ks][0], s[2 * ks][1]); pw.y = pk2(s[2 * ks][2], s[2 * ks][3]);
        if (ks < 4) { pw.z = pk2(s[2 * ks + 1][0], s[2 * ks + 1][1]); pw.w = pk2(s[2 * ks + 1][2], s[2 * ks + 1][3]); } else { pw.z = 0u; pw.w = 0u; }
        const bf16x8 pb = __builtin_bit_cast(bf16x8, pw);
#pragma unroll
        for (int dt = 0; dt < 4; ++dt) {
            const bf16_t* vp = Vt + (dt * 16 + fr) * VT_STRIDE + (kt0 + 2 * ks) * 16 + fq * 4;
            const u32x2 a0 = *(const u32x2*)vp; u32x2 a1 = {0u, 0u};
            if (ks < 4) a1 = *(const u32x2*)(vp + 16);
            u32x4 aw; aw.x = a0.x; aw.y = a0.y; aw.z = a1.x; aw.w = a1.y;
            o[dt] = mfma16(__builtin_bit_cast(bf16x8, aw), pb, o[dt]);
        }
    }
    const float inv = 1.f / l;
#pragma unroll
    for (int dt = 0; dt < 4; ++dt) o[dt] = o[dt] * inv;
}
__device__ __forceinline__ void norm_rope16(float (&a)[8], float (&b)[8], const float* g, const float* rp, int f, int sx1, int sx2) {
    float ss = 0.f;
#pragma unroll
    for (int j = 0; j < 8; ++j) ss += a[j] * a[j] + b[j] * b[j];
    ss += __shfl_xor(ss, sx1); ss += __shfl_xor(ss, sx2);
    const float rstd = rsqrtf(ss * (1.f / 64.f) + EPS);
#pragma unroll
    for (int j = 0; j < 8; ++j) {
        const float y1 = a[j] * rstd * g[f * 8 + j], y2 = b[j] * rstd * g[32 + f * 8 + j];
        const float c = rp[f * 8 + j], s = rp[32 + f * 8 + j];
        a[j] = y1 * c - y2 * s; b[j] = y2 * c + y1 * s;
    }
}

__device__ __forceinline__ void attn_rows(const Params& p, const bf16_t* Ks, const bf16_t* Vt, size_t tok, int head, int prow, int kt0, int lo, int hi, bool store, int lane) {
    const int fq = lane >> 4;
    const bf16_t* qp = (const bf16_t*)(p.ws + WS_QA) + tok * 512 + head * 64 + fq * 8;
    float a[8], b[8];
    unpack8(*(const u32x4*)qp, a); unpack8(*(const u32x4*)(qp + 32), b);
    norm_rope16(a, b, p.in[11], (const float*)(p.ws + WS_ROPE) + (size_t)prow * 64, fq, 16, 32);
    const bf16x8 qf0 = __builtin_bit_cast(bf16x8, pack8s(a, QSCALE)), qf1 = __builtin_bit_cast(bf16x8, pack8s(b, QSCALE));
    f32x4 o[4];
    attn_group(Ks, Vt, kt0, lo, hi, qf0, qf1, p.in[13][head] * LOG2E, o, lane);
    if (store) {
        const bf16_t* zp = (const bf16_t*)(p.ws + WS_ZA) + tok * 512 + head * 64 + fq * 4;
        bf16_t* op = (bf16_t*)(p.ws + WS_OA) + tok * 512 + head * 64 + fq * 4;
#pragma unroll
        for (int dt = 0; dt < 4; ++dt) { const u32x2 z = *(const u32x2*)(zp + dt * 16);
            u32x2 w; w.x = pk2(o[dt][0] * bflo(z.x), o[dt][1] * bfhi(z.x)); w.y = pk2(o[dt][2] * bflo(z.y), o[dt][3] * bfhi(z.y));
            *(u32x2*)(op + dt * 16) = w; }
    }
}

__device__ __forceinline__ void attn_prompt_unit(const Params& p, unsigned char* lds, int u) {
    bf16_t* Ks = (bf16_t*)lds; bf16_t* Vt = (bf16_t*)(lds + ATT_VT_OFF);
    const int tid = opaque_tid(), lane = tid & 63, w = tid >> 6;
    const int b = u >> 7, qb = (u & 127) >> 1, kvh = u & 1;
    const bf16_t* KA = (const bf16_t*)(p.ws + WS_KA); const bf16_t* VA = (const bf16_t*)(p.ws + WS_VA);
    const float* rope = (const float*)(p.ws + WS_ROPE);
#pragma unroll
    for (int it = 0; it < 2; ++it) {
        const int j = it * 128 + w * 16 + (lane >> 2), f = lane & 3;
        const int t = (qb - 1) * 128 + j; const int tc = t < 0 ? 0 : t;
        const bf16_t* kp = KA + ((size_t)b * SEQ + tc) * 128 + kvh * 64 + f * 8;
        float a[8], c[8];
        unpack8(*(const u32x4*)kp, a); unpack8(*(const u32x4*)(kp + 32), c);
        norm_rope16(a, c, p.in[12], rope + (size_t)tc * 64, f, 1, 2);
        if (t < 0) {
#pragma unroll
            for (int q = 0; q < 8; ++q) { a[q] = 0.f; c[q] = 0.f; } }
        *(u32x4*)(Ks + j * KS_STRIDE + f * 8) = pack8(a); *(u32x4*)(Ks + j * KS_STRIDE + 32 + f * 8) = pack8(c);
        if (t >= SEQ - 128) { float* op = p.out + O_PWK + (((size_t)b * 128 + (t - (SEQ - 128))) * 2 + kvh) * 64 + f * 8;
            *(f32x4*)op = (f32x4){a[0], a[1], a[2], a[3]}; *(f32x4*)(op + 4) = (f32x4){a[4], a[5], a[6], a[7]};
            *(f32x4*)(op + 32) = (f32x4){c[0], c[1], c[2], c[3]}; *(f32x4*)(op + 36) = (f32x4){c[4], c[5], c[6], c[7]}; }
    }
#pragma unroll
    for (int it = 0; it < 4; ++it) {
        const int idx = tid + 512 * it, j = idx >> 3, ch = idx & 7;
        const int t = (qb - 1) * 128 + j; const int tc = t < 0 ? 0 : t;
        u32x4 v = *(const u32x4*)(VA + ((size_t)b * SEQ + tc) * 128 + kvh * 64 + ch * 8);
        if (t < 0) v = (u32x4){0u, 0u, 0u, 0u};
        bf16_t* vp = Vt + (ch * 8) * VT_STRIDE + j;
        vp[0] = (bf16_t)(v.x & 0xffff); vp[VT_STRIDE] = (bf16_t)(v.x >> 16); vp[2 * VT_STRIDE] = (bf16_t)(v.y & 0xffff); vp[3 * VT_STRIDE] = (bf16_t)(v.y >> 16);
        vp[4 * VT_STRIDE] = (bf16_t)(v.z & 0xffff); vp[5 * VT_STRIDE] = (bf16_t)(v.z >> 16); vp[6 * VT_STRIDE] = (bf16_t)(v.w & 0xffff); vp[7 * VT_STRIDE] = (bf16_t)(v.w >> 16);
        if (t >= SEQ - 128) { float* op = p.out + O_PWV + (((size_t)b * 128 + (t - (SEQ - 128))) * 2 + kvh) * 64 + ch * 8;
            *(f32x4*)op = (f32x4){bflo(v.x), bfhi(v.x), bflo(v.y), bfhi(v.y)}; *(f32x4*)(op + 4) = (f32x4){bflo(v.z), bfhi(v.z), bflo(v.w), bfhi(v.w)}; }
    }
    __syncthreads();
    const int head = kvh * 4 + (w >> 1), half = w & 1;
    for (int g = 0; g < 4; ++g) {
        const int i0 = half * 64 + g * 16, i = i0 + (lane & 15), t = qb * 128 + i;
        attn_rows(p, Ks, Vt, (size_t)b * SEQ + t, head, t, i0 >> 4, qb == 0 ? 128 : i, i + 128, true, lane);
    }
    __syncthreads();
}

__device__ __forceinline__ void attn_sample_unit(const Params& p, unsigned char* lds, int u) {
    bf16_t* Ks = (bf16_t*)lds; bf16_t* Vt = (bf16_t*)(lds + ATT_VT_OFF);
    const int tid = opaque_tid(), lane = tid & 63, w = tid >> 6;
    const int sb = u >> 1, kvh = u & 1;
    const bf16_t* KA = (const bf16_t*)(p.ws + WS_KA); const bf16_t* VA = (const bf16_t*)(p.ws + WS_VA);
    const float* rope = (const float*)(p.ws + WS_ROPE);
#pragma unroll
    for (int it = 0; it < 2; ++it) {
        const int j = it * 128 + w * 16 + (lane >> 2), f = lane & 3;
        if (j < 144) {
            const int l = (j >= 128 && j < 136) ? j - 128 : 0;
            const bf16_t* kp = KA + ((size_t)MP + sb * 8 + l) * 128 + kvh * 64 + f * 8;
            float a[8], c[8];
            unpack8(*(const u32x4*)kp, a); unpack8(*(const u32x4*)(kp + 32), c);
            norm_rope16(a, c, p.in[12], rope + (size_t)(8192 + l) * 64, f, 1, 2);
            if (j < 128) { const float* cp = p.in[2] + (((size_t)sb * 128 + j) * 2 + kvh) * 64 + f * 8;
                const f32x4 c0 = *(const f32x4*)cp, c1 = *(const f32x4*)(cp + 4), c2 = *(const f32x4*)(cp + 32), c3 = *(const f32x4*)(cp + 36);
                a[0] = c0.x; a[1] = c0.y; a[2] = c0.z; a[3] = c0.w; a[4] = c1.x; a[5] = c1.y; a[6] = c1.z; a[7] = c1.w;
                c[0] = c2.x; c[1] = c2.y; c[2] = c2.z; c[3] = c2.w; c[4] = c3.x; c[5] = c3.y; c[6] = c3.z; c[7] = c3.w; }
            else if (j >= 136) {
#pragma unroll
                for (int q = 0; q < 8; ++q) { a[q] = 0.f; c[q] = 0.f; } }
            *(u32x4*)(Ks + j * KS_STRIDE + f * 8) = pack8(a); *(u32x4*)(Ks + j * KS_STRIDE + 32 + f * 8) = pack8(c);
            if (j >= 8 && j < 136) { float* op = p.out + O_SWK + (((size_t)sb * 128 + (j - 8)) * 2 + kvh) * 64 + f * 8;
                *(f32x4*)op = (f32x4){a[0], a[1], a[2], a[3]}; *(f32x4*)(op + 4) = (f32x4){a[4], a[5], a[6], a[7]};
                *(f32x4*)(op + 32) = (f32x4){c[0], c[1], c[2], c[3]}; *(f32x4*)(op + 36) = (f32x4){c[4], c[5], c[6], c[7]}; }
        }
    }
#pragma unroll
    for (int it = 0; it < 3; ++it) {
        const int idx = tid + 512 * it, j = idx >> 3, ch = idx & 7;
        if (j < 144) {
            float v[8];
            if (j < 128) { const float* cp = p.in[3] + (((size_t)sb * 128 + j) * 2 + kvh) * 64 + ch * 8;
                const f32x4 c0 = *(const f32x4*)cp, c1 = *(const f32x4*)(cp + 4);
                v[0] = c0.x; v[1] = c0.y; v[2] = c0.z; v[3] = c0.w; v[4] = c1.x; v[5] = c1.y; v[6] = c1.z; v[7] = c1.w; }
            else if (j < 136) unpack8(*(const u32x4*)(VA + ((size_t)MP + sb * 8 + (j - 128)) * 128 + kvh * 64 + ch * 8), v);
            else {
#pragma unroll
                for (int q = 0; q < 8; ++q) v[q] = 0.f; }
            const u32x4 pv = pack8(v);
            bf16_t* vp = Vt + (ch * 8) * VT_STRIDE + j;
            vp[0] = (bf16_t)(pv.x & 0xffff); vp[VT_STRIDE] = (bf16_t)(pv.x >> 16); vp[2 * VT_STRIDE] = (bf16_t)(pv.y & 0xffff); vp[3 * VT_STRIDE] = (bf16_t)(pv.y >> 16);
            vp[4 * VT_STRIDE] = (bf16_t)(pv.z & 0xffff); vp[5 * VT_STRIDE] = (bf16_t)(pv.z >> 16); vp[6 * VT_STRIDE] = (bf16_t)(pv.w & 0xffff); vp[7 * VT_STRIDE] = (bf16_t)(pv.w >> 16);
            if (j >= 8 && j < 136) { float* op = p.out + O_SWV + (((size_t)sb * 128 + (j - 8)) * 2 + kvh) * 64 + ch * 8;
                *(f32x4*)op = (f32x4){v[0], v[1], v[2], v[3]}; *(f32x4*)(op + 4) = (f32x4){v[4], v[5], v[6], v[7]}; }
        }
    }
    __syncthreads();
    if (w < 2) {
        const int q = lane & 15, l = q & 7, head = kvh * 4 + w * 2 + (q >> 3);
        attn_rows(p, Ks, Vt, (size_t)MP + sb * 8 + l, head, 8192 + l, 0, l, l + 128, true, lane);
    }
    __syncthreads();
}

constexpr int G_BC = 0, G_TOT = 16640, G_QT = 18688, G_KT = 27904, G_VT = 37120, G_ST = 55552, G_AM = 73984, G_RED = 83200, G_KT2 = 83712, G_VS = 92928, G_LRS = 110336;
constexpr int GS = 72, VSS = 136;

__device__ __forceinline__ void gla_unit_info(int u, size_t& tok0, int& L, int& h) {
    if (u < 1024) { const int b = u >> 9, c = (u >> 2) & 127; h = u & 3; tok0 = (size_t)b * SEQ + c * 64; L = 64; }
    else { const int v = u - 1024; h = v & 3; tok0 = (size_t)MP + (v >> 2) * 8; L = 8; }
}
struct GlaRaw { u32x4 lr, q, k, v0, v1; float s[16]; u32x2 z[4]; };
template <int MODE> __device__ __forceinline__ void gla_load(const Params& p, int u, GlaRaw& R, int tid) {
    size_t tok0; int L, h; gla_unit_info(u, tok0, L, h);
    const int tok = tid >> 3, c = tid & 7; const bool ok = tok < L; const u32x4 z4 = {0u, 0u, 0u, 0u};
    R.lr = z4;
    if (tid < 128 && (tid >> 1) < L) R.lr = *(const u32x4*)((const bf16_t*)(p.ws + WS_LR) + (tok0 + (tid >> 1)) * 128 + (tid & 1) * 8);
    R.k = z4; R.v0 = z4; R.v1 = z4; R.q = z4;
    if (ok) { R.k = *(const u32x4*)((const bf16_t*)(p.ws + WS_KG) + (tok0 + tok) * 256 + h * 64 + c * 8);
        const bf16_t* vp = (const bf16_t*)(p.ws + WS_VG) + (tok0 + tok) * 512 + h * 128 + c * 16;
        R.v0 = *(const u32x4*)vp; R.v1 = *(const u32x4*)(vp + 8);
        if (MODE & 2) R.q = *(const u32x4*)((const bf16_t*)(p.ws + WS_QG) + (tok0 + tok) * 256 + h * 64 + c * 8); }
    if (MODE & 2) {
        const float* Sp = (u < 1024 ? (const float*)(p.ws + WS_DS) + (size_t)u * 8192 : p.in[4] + (size_t)(u - 1024) * 8192) + (tid & 127) + (tid >> 7) * 16 * 128;
#pragma unroll
        for (int i = 0; i < 16; ++i) R.s[i] = Sp[i * 128];
        const int lane = tid & 63, w = tid >> 6, ti = (w & 3) * 16 + (lane & 15);
        const bf16_t* zp = (const bf16_t*)(p.ws + WS_ZG) + (tok0 + min(ti, L - 1)) * 512 + h * 128 + (w >> 2) * 64 + (lane >> 4) * 4;
#pragma unroll
        for (int d4 = 0; d4 < 4; ++d4) R.z[d4] = *(const u32x2*)(zp + d4 * 16);
    }
}
template <int MODE> __device__ __forceinline__ void gla_process(const Params& p, unsigned char* lds, int u, GlaRaw& R, int unext) {
    size_t tok0; int L, h; gla_unit_info(u, tok0, L, h);
    const int tid = opaque_tid(), lane = tid & 63, w = tid >> 6, fr = lane & 15, fq = lane >> 4;
    float* Bc = (float*)(lds + G_BC); float* TOT = (float*)(lds + G_TOT);
    bf16_t* QS = (bf16_t*)(lds + G_QT); bf16_t* KS = (bf16_t*)(lds + G_KT); bf16_t* VS = (bf16_t*)(lds + G_VS); bf16_t* LRS = (bf16_t*)(lds + G_LRS);
    { const int tok = tid >> 3, c = tid & 7;
      if (tid < 128) *(u32x4*)(LRS + (tid >> 1) * 16 + (tid & 1) * 8) = R.lr;
      *(u32x4*)(KS + tok * GS + c * 8) = R.k;
      if (MODE & 2) *(u32x4*)(QS + tok * GS + c * 8) = R.q;
      *(u32x4*)(VS + tok * VSS + c * 16) = R.v0; *(u32x4*)(VS + tok * VSS + c * 16 + 8) = R.v1; }
    float sreg[16]; u32x2 zreg[4];
    if (MODE & 2) {
#pragma unroll
        for (int i = 0; i < 16; ++i) sreg[i] = R.s[i];
#pragma unroll
        for (int i = 0; i < 4; ++i) zreg[i] = R.z[i]; }
    __syncthreads();
    const int k = tid & 63, tg = tid >> 6;
    { const float* wg = p.in[14] + h * 64 + k;
      float wr[16];
#pragma unroll
      for (int r = 0; r < 16; ++r) wr[r] = wg[r * 256];
      const float bias = p.in[15][h * 64 + k];
      float cs[8]; float run = 0.f;
#pragma unroll
      for (int i = 0; i < 8; ++i) {
          const int tt = tg * 8 + i; float la = 0.f;
          if (tt < L) {
              const u32x4 l0 = *(const u32x4*)(LRS + tt * 16), l1 = *(const u32x4*)(LRS + tt * 16 + 8);
              float g = bias;
              g += bflo(l0.x) * wr[0] + bfhi(l0.x) * wr[1] + bflo(l0.y) * wr[2] + bfhi(l0.y) * wr[3] + bflo(l0.z) * wr[4] + bfhi(l0.z) * wr[5] + bflo(l0.w) * wr[6] + bfhi(l0.w) * wr[7];
              g += bflo(l1.x) * wr[8] + bfhi(l1.x) * wr[9] + bflo(l1.y) * wr[10] + bfhi(l1.y) * wr[11] + bflo(l1.z) * wr[12] + bfhi(l1.z) * wr[13] + bflo(l1.w) * wr[14] + bfhi(l1.w) * wr[15];
              la = (fminf(g, 0.f) - __logf(1.f + __expf(-fabsf(g)))) * (1.f / 16.f);
          }
          run += la; cs[i] = run;
      }
      TOT[tg * 64 + k] = run;
      __syncthreads();
      float pre = 0.f;
#pragma unroll
      for (int j = 0; j < 8; ++j) if (j < tg) pre += TOT[j * 64 + k];
#pragma unroll
      for (int i = 0; i < 8; ++i) Bc[(tg * 8 + i) * 65 + k] = pre + cs[i];
      __syncthreads(); }
    { const float bl = Bc[63 * 65 + k], bm = Bc[31 * 65 + k];
      float kd[8];
#pragma unroll
      for (int i = 0; i < 8; ++i) { const int tt = tg * 8 + i; const float bb = Bc[tt * 65 + k]; const float kv = bf2f(KS[tt * GS + k]);
          if (MODE & 1) kd[i] = kv * __expf(bl - bb);
          if (MODE & 2) { const float qv = bf2f(QS[tt * GS + k]);
              QS[tt * GS + k] = (bf16_t)(pk2(qv * __expf(bb - bm), 0.f) & 0xffff); KS[tt * GS + k] = (bf16_t)(pk2(kv * __expf(bm - bb), 0.f) & 0xffff); } }
      if (MODE & 1) *(u32x4*)((bf16_t*)(lds + G_KT2) + k * GS + tg * 8) = pack8(kd); }
    { const int dv = tid & 127, t4 = tid >> 7; unsigned wv[8];
#pragma unroll
      for (int i = 0; i < 8; ++i) wv[i] = (unsigned)VS[(t4 * 16 + 2 * i) * VSS + dv] | ((unsigned)VS[(t4 * 16 + 2 * i + 1) * VSS + dv] << 16);
      bf16_t* VT = (bf16_t*)(lds + G_VT) + dv * GS + t4 * 16;
      *(u32x4*)VT = (u32x4){wv[0], wv[1], wv[2], wv[3]}; *(u32x4*)(VT + 8) = (u32x4){wv[4], wv[5], wv[6], wv[7]};
      if (MODE & 2) { float v[16];
#pragma unroll
          for (int i = 0; i < 16; ++i) v[i] = sreg[i] * __expf(Bc[31 * 65 + t4 * 16 + i]);
          bf16_t* ST = (bf16_t*)(lds + G_ST) + dv * GS + t4 * 16;
          u32x4 w0, w1; w0.x = pk2(v[0], v[1]); w0.y = pk2(v[2], v[3]); w0.z = pk2(v[4], v[5]); w0.w = pk2(v[6], v[7]);
          w1.x = pk2(v[8], v[9]); w1.y = pk2(v[10], v[11]); w1.z = pk2(v[12], v[13]); w1.w = pk2(v[14], v[15]);
          *(u32x4*)ST = w0; *(u32x4*)(ST + 8) = w1; } }
    if (unext >= 0) gla_load<MODE>(p, unext, R, tid);
    __syncthreads();
    if (MODE & 1) {
        const bf16_t* VT = (const bf16_t*)(lds + G_VT) + (w * 16 + fr) * GS + fq * 8;
        const bf16x8 a0 = *(const bf16x8*)VT, a1 = *(const bf16x8*)(VT + 32);
#pragma unroll
        for (int kt = 0; kt < 4; ++kt) {
            const bf16_t* KT = (const bf16_t*)(lds + G_KT2) + (kt * 16 + fr) * GS + fq * 8;
            f32x4 acc = {0.f, 0.f, 0.f, 0.f};
            acc = mfma16(a0, *(const bf16x8*)KT, acc); acc = mfma16(a1, *(const bf16x8*)(KT + 32), acc);
            const int kk = kt * 16 + fr, dv = w * 16 + fq * 4;
            if (u < 1024) *(f32x4*)((float*)(p.ws + WS_DS) + (size_t)u * 8192 + kk * 128 + dv) = acc;
            else { const size_t so = ((size_t)(u - 1024) * 64 + kk) * 128 + dv;
                const float d = __expf(Bc[63 * 65 + kk]); const f32x4 s0 = *(const f32x4*)(p.in[4] + so);
                *(f32x4*)(p.out + O_SGS + so) = s0 * d + acc; }
        }
        if (u < 1024 && tid < 64) ((float*)(p.ws + WS_DEC))[(size_t)u * 64 + tid] = __expf(Bc[63 * 65 + tid]);
    }
    if (MODE & 2) {
        const int tt = w & 3, hh = w >> 2;
        const bf16_t* QTr = QS + (tt * 16 + fr) * GS + fq * 8;
        const bf16x8 bq0 = *(const bf16x8*)QTr, bq1 = *(const bf16x8*)(QTr + 32);
#pragma unroll
        for (int q = 0; q < 2; ++q) { const int st = hh * 2 + q;
            const bf16_t* KTr = KS + (st * 16 + fr) * GS + fq * 8;
            f32x4 acc = {0.f, 0.f, 0.f, 0.f};
            acc = mfma16(*(const bf16x8*)KTr, bq0, acc); acc = mfma16(*(const bf16x8*)(KTr + 32), bq1, acc);
            const int ti = tt * 16 + fr, s0 = st * 16 + fq * 4;
            u32x2 wv; wv.x = pk2(s0 <= ti ? acc[0] : 0.f, s0 + 1 <= ti ? acc[1] : 0.f); wv.y = pk2(s0 + 2 <= ti ? acc[2] : 0.f, s0 + 3 <= ti ? acc[3] : 0.f);
            *(u32x2*)((bf16_t*)(lds + G_AM) + ti * GS + s0) = wv; }
        __syncthreads();
        const bf16_t* AMr = (const bf16_t*)(lds + G_AM) + (tt * 16 + fr) * GS + fq * 8;
        const bf16x8 ba0 = *(const bf16x8*)AMr, ba1 = *(const bf16x8*)(AMr + 32);
        f32x4 o[4]; float ss = 0.f;
#pragma unroll
        for (int d4 = 0; d4 < 4; ++d4) { const int row = (hh * 4 + d4) * 16 + fr;
            const bf16_t* VT = (const bf16_t*)(lds + G_VT) + row * GS + fq * 8; const bf16_t* ST = (const bf16_t*)(lds + G_ST) + row * GS + fq * 8;
            f32x4 acc = {0.f, 0.f, 0.f, 0.f};
            acc = mfma16(*(const bf16x8*)VT, ba0, acc); acc = mfma16(*(const bf16x8*)(VT + 32), ba1, acc);
            acc = mfma16(*(const bf16x8*)ST, bq0, acc); acc = mfma16(*(const bf16x8*)(ST + 32), bq1, acc);
            o[d4] = acc; ss += (acc[0] * acc[0] + acc[1] * acc[1]) + (acc[2] * acc[2] + acc[3] * acc[3]); }
        ss += __shfl_xor(ss, 16); ss += __shfl_xor(ss, 32);
        float* RED = (float*)(lds + G_RED);
        if (fq == 0) RED[hh * 64 + tt * 16 + fr] = ss;
        __syncthreads();
        const float rstd = rsqrtf((RED[tt * 16 + fr] + RED[64 + tt * 16 + fr]) * (1.f / 128.f) + EPS);
        const int ti = tt * 16 + fr;
        if (ti < L) {
            const size_t tok = tok0 + ti;
#pragma unroll
            for (int d4 = 0; d4 < 4; ++d4) { const int dv = (hh * 4 + d4) * 16 + fq * 4;
                const f32x4 g = *(const f32x4*)(p.in[16] + dv);
                const u32x2 z = zreg[d4];
                u32x2 wv; wv.x = pk2(o[d4][0] * rstd * g.x * bflo(z.x), o[d4][1] * rstd * g.y * bfhi(z.x));
                wv.y = pk2(o[d4][2] * rstd * g.z * bflo(z.y), o[d4][3] * rstd * g.w * bfhi(z.y));
                *(u32x2*)((bf16_t*)(p.ws + WS_OG) + tok * 512 + h * 128 + dv) = wv; }
        }
    }
    __syncthreads();
}
template <int MODE> __device__ __forceinline__ void gla_units(const Params& p, unsigned char* lds, int ubase, int uend) {
    const int tid = opaque_tid();
    int u = ubase + blockIdx.x;
    if (u >= uend) return;
    GlaRaw R; gla_load<MODE>(p, u, R, tid);
    for (; u < uend; u += gridDim.x) { const int un = u + gridDim.x; gla_process<MODE>(p, lds, u, R, un < uend ? un : -1); }
}
__device__ __forceinline__ void gla_scan_dummy(const Params& p) {
    if (threadIdx.x >= 256) return;
    const int e = blockIdx.x * 256 + threadIdx.x;
    if (e >= 65536) return;
    const int b = e >> 15, h = (e >> 13) & 3, k = (e >> 7) & 63, dv = e & 127;
    float* DS = (float*)(p.ws + WS_DS); const float* DEC = (const float*)(p.ws + WS_DEC);
    float S = 0.f;
#pragma unroll 8
    for (int c = 0; c < 128; ++c) { const size_t u = (size_t)b * 512 + c * 4 + h;
        const float d = DEC[u * 64 + k]; float* sp = DS + u * 8192 + k * 128 + dv; const float ds = *sp; *sp = ds; S = d * S + ds; }
    if (S == 123.456f) p.out[O_PGS + e] = S;
}
__device__ __forceinline__ void gla_scan(const Params& p) {
    if (threadIdx.x >= 256) return;
    const int e = blockIdx.x * 256 + threadIdx.x;
    if (e >= 65536) return;
    const int b = e >> 15, h = (e >> 13) & 3, k = (e >> 7) & 63, dv = e & 127;
    float* DS = (float*)(p.ws + WS_DS); const float* DEC = (const float*)(p.ws + WS_DEC);
    float S = 0.f;
#pragma unroll 8
    for (int c = 0; c < 128; ++c) { const size_t u = (size_t)b * 512 + c * 4 + h;
        const float d = DEC[u * 64 + k]; float* sp = DS + u * 8192 + k * 128 + dv; const float ds = *sp; *sp = S; S = d * S + ds; }
    p.out[O_PGS + e] = S;
}

template <int KK> __device__ __forceinline__ void small_tile_acc(const bf16_t* A, int lda, const bf16_t* Bt, int ldb, int row0, int col0, f32x4 (&acc)[2], int lane, int w) {
    const int fr = lane & 15, fq = lane >> 4, rt = w & 3, ch = w >> 2;
    const bf16_t* ap = A + (size_t)(row0 + rt * 16 + fr) * lda + fq * 8;
    const bf16_t* bp0 = Bt + (size_t)(col0 + ch * 32 + fr) * ldb + fq * 8;
    const bf16_t* bp1 = bp0 + (size_t)16 * ldb;
#pragma unroll 8
    for (int k = 0; k < KK; k += 32) {
        const bf16x8 a = *(const bf16x8*)(ap + k), b0 = *(const bf16x8*)(bp0 + k), b1 = *(const bf16x8*)(bp1 + k);
        acc[0] = mfma16(b0, a, acc[0]); acc[1] = mfma16(b1, a, acc[1]);
    }
}
__device__ __forceinline__ void small_merge_tiles(const Params& p) {
    const int tid = opaque_tid(), lane = tid & 63, w = tid >> 6, fr = lane & 15, fq = lane >> 4;
    for (int t = blockIdx.x; t < 256; t += gridDim.x) {
        const int row0 = MP + (t >> 4) * 64, col0 = (t & 15) * 64;
        f32x4 aa[2] = {{0.f, 0.f, 0.f, 0.f}, {0.f, 0.f, 0.f, 0.f}}, ag[2] = {{0.f, 0.f, 0.f, 0.f}, {0.f, 0.f, 0.f, 0.f}};
        small_tile_acc<512>((const bf16_t*)(p.ws + WS_OA), 512, (const bf16_t*)(p.ws + WS_WBA), 512, row0, col0, aa, lane, w);
        small_tile_acc<512>((const bf16_t*)(p.ws + WS_OG), 512, (const bf16_t*)(p.ws + WS_WBG), 512, row0, col0, ag, lane, w);
        const size_t o = (size_t)(row0 + (w & 3) * 16 + fr) * 1024 + col0 + (w >> 2) * 32 + fq * 4;
#pragma unroll
        for (int nt = 0; nt < 2; ++nt) {
            const u32x2 ma = *(const u32x2*)((const bf16_t*)(p.ws + WS_MA) + o + nt * 16), mg = *(const u32x2*)((const bf16_t*)(p.ws + WS_MG) + o + nt * 16);
            u32x2 wv; wv.x = pk2(bflo(ma.x) * aa[nt][0] + bflo(mg.x) * ag[nt][0], bfhi(ma.x) * aa[nt][1] + bfhi(mg.x) * ag[nt][1]);
            wv.y = pk2(bflo(ma.y) * aa[nt][2] + bflo(mg.y) * ag[nt][2], bfhi(ma.y) * aa[nt][3] + bfhi(mg.y) * ag[nt][3]);
            *(u32x2*)((bf16_t*)(p.ws + WS_MRG) + o + nt * 16) = wv; }
    }
}
__device__ __forceinline__ void small_out_tiles(const Params& p) {
    const int tid = opaque_tid(), lane = tid & 63, w = tid >> 6, fr = lane & 15, fq = lane >> 4;
    for (int t = blockIdx.x; t < 256; t += gridDim.x) {
        const int row0 = MP + (t >> 4) * 64, col0 = (t & 15) * 64;
        f32x4 acc[2] = {{0.f, 0.f, 0.f, 0.f}, {0.f, 0.f, 0.f, 0.f}};
        small_tile_acc<1024>((const bf16_t*)(p.ws + WS_MRG), 1024, (const bf16_t*)(p.ws + WS_WOUT), 1024, row0, col0, acc, lane, w);
        const int row = row0 + (w & 3) * 16 + fr, c = col0 + (w >> 2) * 32 + fq * 4;
        const float* xrow = p.in[1] + (size_t)(row - MP) * 1024; const float* grow = (const float*)(p.ws + WS_MOD) + (size_t)mod_row(row) * 3072 + 2048;
#pragma unroll
        for (int nt = 0; nt < 2; ++nt) { const f32x4 x4 = *(const f32x4*)(xrow + c + nt * 16), g4 = *(const f32x4*)(grow + c + nt * 16);
            *(f32x4*)(p.out + O_Y + (size_t)row * 1024 + c + nt * 16) = x4 + g4 * acc[nt]; }
    }
}

__global__ void __launch_bounds__(512) mega_fwd(Params p) {
    extern __shared__ __attribute__((aligned(16))) unsigned char lds[];
    cg::grid_group grid = cg::this_grid();
    const int lo = p.ph_lo, hi = p.ph_hi;
#define IN(k) (lo <= (k) && (k) < hi)
#define SEAM(k) do { if (IN(k) && IN((k) + 1)) grid.sync(); } while (0)
    PG8_LAS unsigned char* glds = (PG8_LAS unsigned char*)lds;
#ifndef PROBE_MASK
#define PROBE_MASK 0
#endif
#define REP(bit) ((((PROBE_MASK) >> (bit)) & 1) + 1)
    if (IN(0)) for (int rep = 0; rep < REP(0); ++rep) phase0(p, lds);
    SEAM(0);
    if (IN(1)) for (int rep = 0; rep < REP(1); ++rep) { phase0b(p, lds); phase1(p); }
    SEAM(1);
    if (IN(2)) for (int rep = 0; rep < REP(2); ++rep) { pg8::Gemm g{(const bf16_t*)(p.ws + WS_H), (const bf16_t*)(p.ws + WS_WIN), MT, NINP, 1024}; pg8::StaticOrder S; S.init(MT, NINP, gridDim.x, blockIdx.x);
        EpiProj E{p.ws}; pg8::gemm_phase<EpiProj, pg8::StaticOrder, true, true>(glds, g, S, E); }
    SEAM(2);
    if (IN(3)) {
        for (int u = blockIdx.x; u < 512; u += gridDim.x) {
            if (u < 256) { for (int rep = 0; rep < REP(3); ++rep) attn_prompt_unit(p, lds, u); }
            else { for (int rep = 0; rep < REP(4); ++rep) attn_sample_unit(p, lds, u - 256); }
        }
        gla_units<1>(p, lds, 0, 1024);
        gla_units<3>(p, lds, 1024, 1536);
    }
    SEAM(3);
    if (IN(4)) { gla_scan(p); if (REP(9) > 1) gla_scan_dummy(p); }
    SEAM(4);
    if (IN(5)) for (int rep = 0; rep < REP(6); ++rep) gla_units<2>(p, lds, 0, 1024);
    SEAM(5);
    if (IN(6)) for (int rep = 0; rep < REP(7); ++rep) {
        pg8::StaticOrder S; S.init(MP, 1024, gridDim.x, blockIdx.x);
        { pg8::Gemm g{(const bf16_t*)(p.ws + WS_OA), (const bf16_t*)(p.ws + WS_WBA), MP, 1024, 512};
          EpiBranch<0> E{(const bf16_t*)(p.ws + WS_MA), nullptr, (bf16_t*)(p.ws + WS_TMP)};
          pg8::gemm_phase<EpiBranch<0>, pg8::StaticOrder, true, true>(glds, g, S, E); }
        { pg8::Gemm g{(const bf16_t*)(p.ws + WS_OG), (const bf16_t*)(p.ws + WS_WBG), MP, 1024, 512};
          EpiBranch<1> E{(const bf16_t*)(p.ws + WS_MG), (const bf16_t*)(p.ws + WS_TMP), (bf16_t*)(p.ws + WS_MRG)};
          pg8::gemm_phase<EpiBranch<1>, pg8::StaticOrder, true, true>(glds, g, S, E); }
        small_merge_tiles(p);
    }
    SEAM(6);
    if (IN(7)) for (int rep = 0; rep < REP(8); ++rep) { pg8::Gemm g{(const bf16_t*)(p.ws + WS_MRG), (const bf16_t*)(p.ws + WS_WOUT), MP, 1024, 1024}; pg8::StaticOrder S; S.init(MP, 1024, gridDim.x, blockIdx.x);
        EpiOut E{p.in[0], p.in[1], (const float*)(p.ws + WS_MOD), p.out + O_Y};
        pg8::gemm_phase<EpiOut, pg8::StaticOrder, true, true>(glds, g, S, E);
        small_out_tiles(p); }
#undef IN
#undef SEAM
}

constexpr int LDS_BYTES = 131072;
#ifndef N_LAUNCH_MODE
#define N_LAUNCH_MODE 1
#endif

extern "C" void kernel_launch(void* const* d_in, const int* in_sizes, int n_in, void* d_out, int out_size, void* d_ws, size_t ws_size, hipStream_t stream) {
    static int grid = 0;
    if (grid == 0) {
        if (n_in != 20 || ws_size < WS_END) { fprintf(stderr, "kernel_launch: unexpected n_in %d / ws_size %zu (need %zu)\n", n_in, ws_size, (size_t)WS_END); grid = -1; return; }
        int dev = 0, cus = 0, per_cu = 0;
        hipGetDevice(&dev);
        hipDeviceGetAttribute(&cus, hipDeviceAttributeMultiprocessorCount, dev);
        if (hipFuncSetAttribute((const void*)mega_fwd, hipFuncAttributeMaxDynamicSharedMemorySize, LDS_BYTES) != hipSuccess) { fprintf(stderr, "kernel_launch: hipFuncSetAttribute failed\n"); grid = -1; return; }
        if (hipOccupancyMaxActiveBlocksPerMultiprocessor(&per_cu, (const void*)mega_fwd, 512, LDS_BYTES) != hipSuccess || per_cu < 1) { fprintf(stderr, "kernel_launch: occupancy query gives %d\n", per_cu); per_cu = 1; }
        (void)hipGetLastError();
        grid = cus * 1;
        if (grid > cus * per_cu) grid = cus * per_cu;
    }
    if (grid < 0) return;
    Params p{};
    for (int i = 0; i < 20; ++i) p.in[i] = (const float*)d_in[i];
    p.out = (float*)d_out; p.ws = (unsigned char*)d_ws;
    for (int i = 0; i < 32; ++i) { const float e = (float)i / 32.0f; const float pw = powf(10000.0f, e); p.inv[i] = 1.0f / pw; }
#if N_LAUNCH_MODE == 1
    p.ph_lo = 0; p.ph_hi = 8;
    void* args[] = {&p};
    hipError_t e = hipLaunchCooperativeKernel((const void*)mega_fwd, dim3(grid), dim3(512), args, LDS_BYTES, stream);
    if (e != hipSuccess) fprintf(stderr, "cooperative launch failed: %s (grid %d)\n", hipGetErrorString(e), grid);
#else
    for (int ph = 0; ph < 8; ++ph) { p.ph_lo = ph; p.ph_hi = ph + 1;
        hipLaunchKernelGGL(mega_fwd, dim3(grid), dim3(512), LDS_BYTES, stream, p); }
#endif
}
```

```cpp
#define PROBE_MASK 0
#include <hip/hip_runtime.h>
#include <hip/hip_cooperative_groups.h>
#include <cstdio>
#include <cstdint>
#include <cmath>
namespace cg = cooperative_groups;
__device__ __forceinline__ int opaque_tid() { int t = threadIdx.x; asm volatile("" : "+v"(t)); return t; }
namespace pg8 {
#define PG8_LAS __attribute__((address_space(3)))
typedef unsigned short bf16_t;
typedef short bf16x8 __attribute__((ext_vector_type(8)));
typedef float f32x4 __attribute__((ext_vector_type(4)));
typedef unsigned u32x4 __attribute__((ext_vector_type(4)));
constexpr int BM = 256, BK = 64, HALF = 128, HTB = HALF * BK * 2  , STAGE_BYTES = 8 * HTB, NXCD = 8, WGM = 8;

__host__ __device__ __forceinline__ int lds_byte(int r, int c) { const int st = (r >> 4) * 2 + (c >> 5), rr = r & 15, cc = c & 31, ob = rr * 64 + cc * 2; return st * 1024 + (ob ^ (((ob >> 9) & 1) << 5)); }
__host__ __device__ __forceinline__ void stage_rc(int b, int& R, int& C) { const int st = b / 1024, sb = b % 1024, swz = sb ^ (((sb >> 9) & 1) << 5); R = (st >> 1) * 16 + swz / 64; C = (st & 1) * 32 + (swz % 64) / 2; }
__host__ __device__ __forceinline__ int perm32(int rho) { const int n = rho >> 4, i = rho & 15; return 8 * (i >> 2) + 4 * n + (i & 3); }

struct Unit { int pm, pn; };
struct Gemm { const bf16_t* A; const bf16_t* Bt; int M, N, K; };

struct StaticOrder {
    int nM, nN, nwg, G, c;
    __host__ __device__ void init(int M, int N, int G_, int c_) { nM = M / BM; nN = N / BM; nwg = nM * nN; G = G_; c = c_; }
    __host__ __device__ bool next(int i, Unit& u) const {
        const long L = (long)i * G + c; if (L >= nwg) return false;
        int wgid = (int)L; { const int q = nwg / NXCD, r = nwg % NXCD, xcd = wgid % NXCD, off = wgid / NXCD; wgid = (xcd < r ? xcd * (q + 1) : r * (q + 1) + (xcd - r) * q) + off; }
        const int nig = WGM * nN, gid = wgid / nig, fm = gid * WGM, gsz = (nM - fm) < WGM ? (nM - fm) : WGM;
        u.pm = fm + ((wgid % nig) % gsz); u.pn = (wgid % nig) / gsz; return true;
    }
    __device__ __forceinline__ void a_ready(const Unit&) const {}
    __device__ __forceinline__ void done(const Unit&) const {}
};
__device__ __forceinline__ unsigned cvt_pk_bf16(float lo, float hi) { unsigned r; asm volatile("v_cvt_pk_bf16_f32 %0, %1, %2" : "=v"(r) : "v"(lo), "v"(hi)); return r; }
typedef float f32x2 __attribute__((ext_vector_type(2)));
template <class Epi, class Sched, bool ALIGN_EPI = false, bool SP2 = false>
__device__ __forceinline__ void gemm_phase(PG8_LAS unsigned char* lds, const Gemm g, const Sched& S, const Epi& E) {
    const int tid = opaque_tid(), wid = __builtin_amdgcn_readfirstlane(tid >> 6), lane = tid & 63, wr = wid >> 2, wc = wid & 3, fr = lane & 15, fq = lane >> 4;
    const int K = g.K, nt = K / BK;
    unsigned voffA[2], voffB[2];
#pragma unroll
    for (int i = 0; i < 2; ++i) { int R, C; stage_rc(tid * 16 + i * 8192, R, C); const int Rb = Epi::PERM ? ((R & ~31) + perm32(R & 31)) : R;
        voffA[i] = (unsigned)(R * K + C) * 2u; voffB[i] = (unsigned)(Rb * K + C) * 2u; }
    const size_t kstep = (size_t)(BK * 2);
    const size_t hstep = (size_t)HALF * K * 2;
    const size_t tstep = 2 * hstep;
    const unsigned ldsw = (unsigned)wid * 1024u;
    const int aoff = lds_byte(wr * 64 + fr, fq * 8), boff = lds_byte(wc * 32 + fr, fq * 8);
#define PG8_SA(b, h) (((b) * 2 + (h)) * HTB)
#define PG8_SB(b, h) ((4 + (b) * 2 + (h)) * HTB)
#define PG8_STAGE(bufoff, gbase, voff) do { _Pragma("unroll") for (int _i = 0; _i < 2; ++_i) \
        __builtin_amdgcn_global_load_lds((const unsigned*)((const char*)(gbase) + (voff)[_i]), (PG8_LAS unsigned*)(lds + (bufoff) + ldsw + _i * 8192), 16, 0, 0); } while (0)
#define PG8_LDA(dst, b, h) do { _Pragma("unroll") for (int m = 0; m < 4; ++m) _Pragma("unroll") for (int k = 0; k < 2; ++k) dst[m][k] = *(const PG8_LAS bf16x8*)(lds + PG8_SA(b, h) + aoff + m * 2048 + k * 1024); } while (0)
#define PG8_LDB(dst, b, h) do { _Pragma("unroll") for (int n = 0; n < 2; ++n) _Pragma("unroll") for (int k = 0; k < 2; ++k) dst[n][k] = *(const PG8_LAS bf16x8*)(lds + PG8_SB(b, h) + boff + n * 2048 + k * 1024); } while (0)
#define PG8_MMA(ai, bj, At, Bt) do { __builtin_amdgcn_s_setprio(1); _Pragma("unroll") for (int m = 0; m < 4; ++m) _Pragma("unroll") for (int n = 0; n < 2; ++n) _Pragma("unroll") for (int k = 0; k < 2; ++k) \
        acc[ai][bj][m][n] = __builtin_amdgcn_mfma_f32_16x16x32_bf16(Bt[n][k], At[m][k], acc[ai][bj][m][n], 0, 0, 0); __builtin_amdgcn_s_setprio(0); } while (0)
#define PG8_WAIT_V(n) asm volatile("s_waitcnt vmcnt(" #n ")" ::: "memory")
#define PG8_WAIT_L(n) asm volatile("s_waitcnt lgkmcnt(" #n ")" ::: "memory")
#define PG8_BAR __builtin_amdgcn_s_barrier()
#define PG8_SCHED __builtin_amdgcn_sched_barrier(0)
    Unit cur, nxt; int ui = 0;
    if (!S.next(0, cur)) return;
    f32x4 acc[2][2][4][2];
#pragma unroll
    for (int a = 0; a < 2; ++a)
#pragma unroll
        for (int b = 0; b < 2; ++b)
#pragma unroll
            for (int m = 0; m < 4; ++m)
#pragma unroll
                for (int n = 0; n < 2; ++n) acc[a][b][m][n] = (f32x4){0.f, 0.f, 0.f, 0.f};
    bf16x8 At[4][2], B0[2][2], B1[2][2];
    const char* cA = (const char*)g.A + (size_t)cur.pm * tstep; const char* cB = (const char*)g.Bt + (size_t)cur.pn * tstep;
    S.a_ready(cur);
    if constexpr (SP2) {
        PG8_STAGE(PG8_SB(0, 0), cB, voffB); PG8_STAGE(PG8_SB(0, 1), cB + hstep, voffB); PG8_STAGE(PG8_SA(0, 0), cA, voffA); PG8_STAGE(PG8_SA(0, 1), cA + hstep, voffA);
        if (wr == 1) PG8_BAR;
        PG8_WAIT_V(2); PG8_BAR;
        PG8_STAGE(PG8_SB(1, 0), cB + kstep, voffB); PG8_STAGE(PG8_SA(1, 0), cA + kstep, voffA); PG8_STAGE(PG8_SB(1, 1), cB + hstep + kstep, voffB);
        PG8_WAIT_V(6); PG8_BAR;
    } else {
        PG8_STAGE(PG8_SB(0, 0), cB, voffB); PG8_STAGE(PG8_SA(0, 0), cA, voffA); PG8_STAGE(PG8_SB(0, 1), cB + hstep, voffB); PG8_STAGE(PG8_SA(0, 1), cA + hstep, voffA);
        if (wr == 1) PG8_BAR;
        PG8_WAIT_V(4); PG8_BAR;
        PG8_STAGE(PG8_SB(1, 0), cB + kstep, voffB); PG8_STAGE(PG8_SA(1, 0), cA + kstep, voffA); PG8_STAGE(PG8_SB(1, 1), cB + hstep + kstep, voffB);
        PG8_WAIT_V(6); PG8_BAR;
    }
    for (;;) {
        const bool has_next = S.next(ui + 1, nxt);
        const char* nA = has_next ? (const char*)g.A + (size_t)nxt.pm * tstep : cA; const char* nB = has_next ? (const char*)g.Bt + (size_t)nxt.pn * tstep : cB;
        for (int t = 0; t < nt; t += 2) {
            const bool last = (t == nt - 2);
            const char* a1 = cA + (size_t)(t + 1) * kstep;
            const char* a2 = last ? nA : cA + (size_t)(t + 2) * kstep; const char* b2 = last ? nB : cB + (size_t)(t + 2) * kstep;
            const char* a3 = a2 + kstep; const char* b3 = b2 + kstep;
            if (last && has_next) S.a_ready(nxt);
            if constexpr (SP2) {
            PG8_LDB(B0, 0, 0); PG8_LDB(B1, 0, 1); PG8_SCHED; PG8_LDA(At, 0, 0); PG8_STAGE(PG8_SA(1, 1), a1 + hstep, voffA);
            PG8_WAIT_V(8); PG8_WAIT_L(0); PG8_BAR; PG8_MMA(0, 0, At, B0); PG8_MMA(0, 1, At, B1); PG8_BAR; PG8_SCHED;
            PG8_LDA(At, 0, 1); PG8_STAGE(PG8_SB(0, 0), b2, voffB); PG8_STAGE(PG8_SB(0, 1), b2 + hstep, voffB); PG8_STAGE(PG8_SA(0, 0), a2, voffA);
            PG8_WAIT_V(8); PG8_WAIT_L(0); PG8_BAR; PG8_MMA(1, 0, At, B0); PG8_MMA(1, 1, At, B1); PG8_BAR; PG8_SCHED;
            PG8_LDB(B0, 1, 0); PG8_LDB(B1, 1, 1); PG8_SCHED; PG8_LDA(At, 1, 0); PG8_STAGE(PG8_SA(0, 1), a2 + hstep, voffA);
            PG8_WAIT_V(8); PG8_WAIT_L(0); PG8_BAR; PG8_MMA(0, 0, At, B0); PG8_MMA(0, 1, At, B1); PG8_BAR; PG8_SCHED;
            PG8_LDA(At, 1, 1); PG8_STAGE(PG8_SB(1, 0), b3, voffB); PG8_STAGE(PG8_SB(1, 1), b3 + hstep, voffB); PG8_STAGE(PG8_SA(1, 0), a3, voffA);
            PG8_WAIT_V(8); PG8_WAIT_L(0); PG8_BAR; PG8_MMA(1, 0, At, B0); PG8_MMA(1, 1, At, B1); PG8_BAR; PG8_SCHED;
            } else {
            PG8_LDB(B0, 0, 0); PG8_SCHED; PG8_LDA(At, 0, 0); PG8_STAGE(PG8_SA(1, 1), a1 + hstep, voffA);
            PG8_WAIT_L(8); PG8_BAR; PG8_WAIT_L(0); PG8_MMA(0, 0, At, B0); PG8_BAR; PG8_SCHED;
            PG8_LDB(B1, 0, 1); PG8_STAGE(PG8_SB(0, 0), b2, voffB);
            PG8_BAR; PG8_WAIT_L(0); PG8_MMA(0, 1, At, B1); PG8_BAR;
            PG8_LDA(At, 0, 1); PG8_STAGE(PG8_SA(0, 0), a2, voffA);
            PG8_BAR; PG8_WAIT_L(0); PG8_MMA(1, 0, At, B0); PG8_BAR; PG8_SCHED;
            PG8_STAGE(PG8_SB(0, 1), b2 + hstep, voffB);
            PG8_WAIT_V(6); PG8_BAR; PG8_MMA(1, 1, At, B1); PG8_BAR;
            PG8_LDB(B0, 1, 0); PG8_SCHED; PG8_LDA(At, 1, 0); PG8_STAGE(PG8_SA(0, 1), a2 + hstep, voffA);
            PG8_WAIT_L(8); PG8_BAR; PG8_WAIT_L(0); PG8_MMA(0, 0, At, B0); PG8_BAR; PG8_SCHED;
            PG8_LDB(B1, 1, 1); PG8_STAGE(PG8_SB(1, 0), b3, voffB);
            PG8_BAR; PG8_WAIT_L(0); PG8_MMA(0, 1, At, B1); PG8_BAR;
            PG8_LDA(At, 1, 1); PG8_STAGE(PG8_SA(1, 0), a3, voffA);
            PG8_BAR; PG8_WAIT_L(0); PG8_MMA(1, 0, At, B0); PG8_BAR; PG8_SCHED;
            PG8_STAGE(PG8_SB(1, 1), b3 + hstep, voffB);
            PG8_WAIT_V(6); PG8_BAR; PG8_MMA(1, 1, At, B1); PG8_BAR;
            }
        }
        if constexpr (ALIGN_EPI) { if (wr == 0) PG8_BAR; }
        if constexpr (!Epi::AFTER_DRAIN) { E(acc, cur, wr, wc, fr, fq); S.done(cur); }
        if (!has_next) break;
#pragma unroll
        for (int a = 0; a < 2; ++a)
#pragma unroll
            for (int b = 0; b < 2; ++b)
#pragma unroll
                for (int m = 0; m < 4; ++m)
#pragma unroll
                    for (int n = 0; n < 2; ++n) acc[a][b][m][n] = (f32x4){0.f, 0.f, 0.f, 0.f};
        cur = nxt; cA = nA; cB = nB; ++ui;
        if constexpr (ALIGN_EPI) { if (wr == 1) PG8_BAR; }
    }
    PG8_WAIT_V(0);
    if constexpr (!ALIGN_EPI) { if (wr == 0) PG8_BAR; }
    PG8_BAR;
    if constexpr (Epi::AFTER_DRAIN) { E.fused(acc, cur, wr, wc, fr, fq, lds, wid, lane); S.done(cur); }
#undef PG8_SA
#undef PG8_SB
#undef PG8_STAGE
#undef PG8_LDA
#undef PG8_LDB
#undef PG8_MMA
#undef PG8_WAIT_V
#undef PG8_WAIT_L
#undef PG8_BAR
#undef PG8_SCHED
}
}
#define XB_TMO      128
#define XB_XCNT(j)  (256  + 64 * (j))
#define XB_XSUB(j)  (1280 + 64 * (j))
#define XB_XGEN(j)  (2304 + 64 * (j))
#define XB_TOP      3328
#define XB_TOPGEN   3392
#define XCD_BAR_WORDS 3456
#define XB_SPIN_CAP (1u << 18)
#define LAS __attribute__((address_space(3)))

__device__ __forceinline__ unsigned xb_ld(unsigned* p)              { return __hip_atomic_load(p, __ATOMIC_RELAXED, __HIP_MEMORY_SCOPE_AGENT); }
__device__ __forceinline__ unsigned xb_add(unsigned* p, unsigned v) { return __hip_atomic_fetch_add(p, v, __ATOMIC_RELAXED, __HIP_MEMORY_SCOPE_AGENT); }
__device__ __forceinline__ unsigned xb_xcc_id() { return (unsigned)__builtin_amdgcn_s_getreg((3 << 11) | 20) & 0xFu; }
#define XB_SPIN(cond, bar) do { unsigned _sp = 0; while (cond) { __builtin_amdgcn_s_sleep(1); \
    if ((++_sp & 255u) == 0u) { if (xb_ld(&(bar)[XB_TMO])) break; if (_sp > XB_SPIN_CAP) { atomicAdd(&(bar)[XB_TMO], 1u); break; } } } } while (0)

struct XcdBarrier {
    unsigned* bar; unsigned x;
    volatile LAS unsigned* st;
};

__device__ __forceinline__ XcdBarrier xcd_barrier_post(unsigned* bar, volatile LAS unsigned* st) {
    XcdBarrier b; b.bar = bar; b.x = xb_xcc_id(); b.st = st;
    if (threadIdx.x == 0) (void)xb_add(&bar[XB_XCNT(b.x)], 1u);
    return b;
}
__device__ __forceinline__ void xcd_barrier_complete(unsigned* bar, unsigned x, unsigned& nloc, unsigned& nx) {
    const unsigned G = gridDim.x * gridDim.y * gridDim.z;
    unsigned sum, cnt, mine, sp = 0u;
    for (;;) {
        sum = 0u; cnt = 0u; mine = 0u;
#pragma unroll
        for (unsigned j = 0; j < 16; ++j) { const unsigned c = xb_ld(&bar[XB_XCNT(j)]); sum += c; cnt += (c > 0u) ? 1u : 0u; mine = (j == x) ? c : mine; }
        if (sum == G) break;
        __builtin_amdgcn_s_sleep(1);
        if ((++sp & 255u) == 0u) { if (xb_ld(&bar[XB_TMO])) break; if (sp > XB_SPIN_CAP) { atomicAdd(&bar[XB_TMO], 1u); break; } }
    }
    nloc = mine > 0u ? mine : 1u; nx = cnt > 0u ? cnt : 1u;
}

__device__ __forceinline__ void xcd_barrier(const XcdBarrier& b) {
    asm volatile("s_waitcnt vmcnt(0)" ::: "memory");
    __syncthreads();
    if (threadIdx.x == 0) {
        unsigned* bar = b.bar;
        __builtin_amdgcn_s_waitcnt(0);
        unsigned nloc = b.st[0], nx = b.st[1];
        if (nloc == 0u) { xcd_barrier_complete(bar, b.x, nloc, nx); b.st[0] = nloc; b.st[1] = nx; }
        const unsigned old = xb_add(&bar[XB_XSUB(b.x)], 1u);
        const unsigned gen = old / nloc;
        if (old + 1u == (gen + 1u) * nloc) {
            __builtin_amdgcn_fence(__ATOMIC_RELEASE, "agent");
            asm volatile("s_waitcnt vmcnt(0)" ::: "memory");
            const unsigned og = xb_add(&bar[XB_TOP], 1u);
            const unsigned tg = og / nx;
            if (og + 1u == (tg + 1u) * nx) xb_add(&bar[XB_TOPGEN], 1u);
            else XB_SPIN(xb_ld(&bar[XB_TOPGEN]) == tg, bar);
            __builtin_amdgcn_fence(__ATOMIC_ACQUIRE, "agent");
            xb_add(&bar[XB_XGEN(b.x)], 1u);
            asm volatile("s_waitcnt vmcnt(0)" ::: "memory");
        } else {
            XB_SPIN(xb_ld(&bar[XB_XGEN(b.x)]) == gen, bar);
            __builtin_amdgcn_fence(__ATOMIC_ACQUIRE, "agent");
            asm volatile("s_waitcnt vmcnt(0)" ::: "memory");
        }
    }
    __syncthreads();
}

using pg8::bf16_t; using pg8::bf16x8; using pg8::f32x4; using pg8::u32x4; using pg8::Unit;
typedef unsigned u32x2 __attribute__((ext_vector_type(2)));
typedef float f32x2v __attribute__((ext_vector_type(2)));
typedef __bf16 bf16x2v __attribute__((ext_vector_type(2)));

constexpr int DM = 1024, SEQ = 8192, MP = 16384, MS = 1024, MT = MP + MS;
constexpr int NIN = 4880, NINP = 5120;
constexpr float EPS = 1e-6f;
constexpr float LOG2E = 1.4426950408889634f;

constexpr size_t WS_MOD = 0;
constexpr size_t WS_ROPE = WS_MOD + 1597440;
constexpr size_t WS_WIN = WS_ROPE + 2099200;
constexpr size_t WS_WBA = WS_WIN + 10485760;
constexpr size_t WS_WBG = WS_WBA + 1048576;
constexpr size_t WS_WOUT = WS_WBG + 1048576;
constexpr size_t WS_H = WS_WOUT + 2097152;
constexpr size_t WS_OA = WS_H;
constexpr size_t WS_OG = WS_H + 17825792;
constexpr size_t WS_QA = WS_H + 35651584;
constexpr size_t WS_KA = WS_QA + 17825792;
constexpr size_t WS_VA = WS_KA + 4456448;
constexpr size_t WS_QG = WS_VA + 4456448;
constexpr size_t WS_TMP = WS_QA;
constexpr size_t WS_KG = WS_QG + 8912896;
constexpr size_t WS_VG = WS_KG + 8912896;
constexpr size_t WS_ZG = WS_VG + 17825792;
constexpr size_t WS_MRG = WS_KG;
constexpr size_t WS_ZA = WS_ZG + 17825792;
constexpr size_t WS_MA = WS_ZA + 17825792;
constexpr size_t WS_MG = WS_MA + 35651584;
constexpr size_t WS_LR = WS_MG + 35651584;
constexpr size_t WS_DS = WS_LR + 4456448;
constexpr size_t WS_DEC = WS_DS + 33554432;
constexpr size_t WS_BAR = WS_DEC + 262144;
constexpr size_t WS_END = WS_BAR + 16384;

constexpr size_t O_Y = 0;
constexpr size_t O_PWK = 17825792;
constexpr size_t O_PWV = O_PWK + 32768;
constexpr size_t O_PGS = O_PWV + 32768;
constexpr size_t O_SWK = O_PGS + 65536;
constexpr size_t O_SWV = O_SWK + 2097152;
constexpr size_t O_SGS = O_SWV + 2097152;

struct Params {
    const float* in[20];
    float* out; unsigned char* ws;
    float inv[32];
    int ph_lo, ph_hi;
};

__device__ __forceinline__ unsigned pk2(float lo, float hi) { f32x2v v = {lo, hi}; bf16x2v b = __builtin_convertvector(v, bf16x2v); return __builtin_bit_cast(unsigned, b); }
__device__ __forceinline__ float bflo(unsigned w) { return __uint_as_float(w << 16); }
__device__ __forceinline__ float bfhi(unsigned w) { return __uint_as_float(w & 0xffff0000u); }
__device__ __forceinline__ float bf2f(bf16_t h) { return __uint_as_float((unsigned)h << 16); }
__device__ __forceinline__ float fast_rcp(float x) { return __builtin_amdgcn_rcpf(x); }
__device__ __forceinline__ float sigmoidf_(float x) { return fast_rcp(1.f + __expf(-x)); }
__device__ __forceinline__ float siluf_(float x) { return x * fast_rcp(1.f + __expf(-x)); }
__device__ __forceinline__ float wave_sum(float v) {
#pragma unroll
    for (int o = 1; o < 64; o <<= 1) v += __shfl_xor(v, o);
    return v;
}
__device__ __forceinline__ f32x4 mfma16(bf16x8 a, bf16x8 b, f32x4 c) { return __builtin_amdgcn_mfma_f32_16x16x32_bf16(a, b, c, 0, 0, 0); }
__device__ __forceinline__ void unpack8(const u32x4 w, float (&a)[8]) {
    a[0] = bflo(w.x); a[1] = bfhi(w.x); a[2] = bflo(w.y); a[3] = bfhi(w.y); a[4] = bflo(w.z); a[5] = bfhi(w.z); a[6] = bflo(w.w); a[7] = bfhi(w.w);
}
__device__ __forceinline__ u32x4 pack8(const float (&a)[8]) { u32x4 w; w.x = pk2(a[0], a[1]); w.y = pk2(a[2], a[3]); w.z = pk2(a[4], a[5]); w.w = pk2(a[6], a[7]); return w; }
__device__ __forceinline__ u32x4 pack8s(const float (&a)[8], float sc) { u32x4 w; w.x = pk2(a[0] * sc, a[1] * sc); w.y = pk2(a[2] * sc, a[3] * sc); w.z = pk2(a[4] * sc, a[5] * sc); w.w = pk2(a[6] * sc, a[7] * sc); return w; }
__device__ __forceinline__ int mod_row(int r) { return r < MP ? (r >> 13) : 2 + ((r - MP) >> 3); }

struct EpiProj {
    static constexpr bool PERM = true, AFTER_DRAIN = false;
    unsigned char* ws;
    __device__ __forceinline__ void operator()(const f32x4 (&acc)[2][2][4][2], const Unit& u, int wr, int wc, int fr, int fq) const {
        const int row0 = u.pm * 256 + wr * 64 + fr;
#pragma unroll
        for (int bj = 0; bj < 2; ++bj) {
            const int cb = u.pn * 2 + bj;
            size_t off; int ld, cbase, act;
            if (cb < 4) { off = WS_QA; ld = 512; cbase = cb * 128; act = 0; }
            else if (cb == 4) { off = WS_KA; ld = 128; cbase = 0; act = 0; }
            else if (cb == 5) { off = WS_VA; ld = 128; cbase = 0; act = 0; }
            else if (cb < 10) { off = WS_ZA; ld = 512; cbase = (cb - 6) * 128; act = 1; }
            else if (cb < 12) { off = WS_QG; ld = 256; cbase = (cb - 10) * 128; act = 3; }
            else if (cb < 14) { off = WS_KG; ld = 256; cbase = (cb - 12) * 128; act = 0; }
            else if (cb < 18) { off = WS_VG; ld = 512; cbase = (cb - 14) * 128; act = 0; }
            else if (cb < 22) { off = WS_ZG; ld = 512; cbase = (cb - 18) * 128; act = 1; }
            else if (cb < 30) { off = WS_MA; ld = 1024; cbase = (cb - 22) * 128; act = 2; }
            else if (cb < 38) { off = WS_MG; ld = 1024; cbase = (cb - 30) * 128; act = 2; }
            else if (cb == 38) { off = WS_LR; ld = 128; cbase = 0; act = 0; }
            else continue;
            bf16_t* base = (bf16_t*)(ws + off) + cbase + wc * 32 + 8 * fq;
#pragma unroll
            for (int ai = 0; ai < 2; ++ai)
#pragma unroll
                for (int m = 0; m < 4; ++m) {
                    f32x4 v0 = acc[ai][bj][m][0], v1 = acc[ai][bj][m][1];
                    if (act == 1) { for (int j = 0; j < 4; ++j) { v0[j] = siluf_(v0[j]); v1[j] = siluf_(v1[j]); } }
                    else if (act == 2) { for (int j = 0; j < 4; ++j) { v0[j] = sigmoidf_(v0[j]); v1[j] = sigmoidf_(v1[j]); } }
                    else if (act == 3) { v0 = v0 * 0.125f; v1 = v1 * 0.125f; }
                    u32x4 w; w.x = pk2(v0[0], v0[1]); w.y = pk2(v0[2], v0[3]); w.z = pk2(v1[0], v1[1]); w.w = pk2(v1[2], v1[3]);
                    *(u32x4*)(base + (size_t)(row0 + ai * 128 + m * 16) * ld) = w;
                }
        }
    }
};
template <int MODE> struct EpiBranch {
    static constexpr bool PERM = true, AFTER_DRAIN = false;
    const bf16_t* gate; const bf16_t* prev; bf16_t* dst;
    __device__ __forceinline__ void operator()(const f32x4 (&acc)[2][2][4][2], const Unit& u, int wr, int wc, int fr, int fq) const {
        const int row0 = u.pm * 256 + wr * 64 + fr, col0 = u.pn * 256 + wc * 32 + 8 * fq;
#pragma unroll
        for (int ai = 0; ai < 2; ++ai)
#pragma unroll
            for (int m = 0; m < 4; ++m)
#pragma unroll
                for (int bj = 0; bj < 2; ++bj) {
                    const size_t o = (size_t)(row0 + ai * 128 + m * 16) * 1024 + col0 + bj * 128;
                    const u32x4 g = *(const u32x4*)(gate + o);
                    f32x4 v0 = acc[ai][bj][m][0], v1 = acc[ai][bj][m][1];
                    v0[0] *= bflo(g.x); v0[1] *= bfhi(g.x); v0[2] *= bflo(g.y); v0[3] *= bfhi(g.y);
                    v1[0] *= bflo(g.z); v1[1] *= bfhi(g.z); v1[2] *= bflo(g.w); v1[3] *= bfhi(g.w);
                    if (MODE == 1) { const u32x4 t = *(const u32x4*)(prev + o);
                        v0[0] += bflo(t.x); v0[1] += bfhi(t.x); v0[2] += bflo(t.y); v0[3] += bfhi(t.y);
                        v1[0] += bflo(t.z); v1[1] += bfhi(t.z); v1[2] += bflo(t.w); v1[3] += bfhi(t.w); }
                    u32x4 w; w.x = pk2(v0[0], v0[1]); w.y = pk2(v0[2], v0[3]); w.z = pk2(v1[0], v1[1]); w.w = pk2(v1[2], v1[3]);
                    *(u32x4*)(dst + o) = w;
                }
    }
};
struct EpiOut {
    static constexpr bool PERM = false, AFTER_DRAIN = false;
    const float* xp; const float* xs; const float* mod; float* out;
    __device__ __forceinline__ void operator()(const f32x4 (&acc)[2][2][4][2], const Unit& u, int wr, int wc, int fr, int fq) const {
        const int col0 = u.pn * 256 + wc * 32 + 4 * fq;
#pragma unroll
        for (int ai = 0; ai < 2; ++ai)
#pragma unroll
            for (int m = 0; m < 4; ++m) {
                const int row = u.pm * 256 + ai * 128 + wr * 64 + m * 16 + fr;
                const float* xrow = row < MP ? xp + (size_t)row * 1024 : xs + (size_t)(row - MP) * 1024;
                const float* grow = mod + (size_t)mod_row(row) * 3072 + 2048;
                float* orow = out + (size_t)row * 1024;
#pragma unroll
                for (int bj = 0; bj < 2; ++bj)
#pragma unroll
                    for (int n = 0; n < 2; ++n) { const int c = col0 + bj * 128 + n * 16;
                        const f32x4 x4 = *(const f32x4*)(xrow + c), g4 = *(const f32x4*)(grow + c);
                        *(f32x4*)(orow + c) = x4 + g4 * acc[ai][bj][m][n]; }
            }
    }
};

__device__ __forceinline__ void p0_ada(const Params& p, unsigned char* lds, int unit) {
    const int tid = opaque_tid(), lane = tid & 63, w = tid >> 6, fr = lane & 15, fq = lane >> 4;
    const int c0 = unit * 16;
    const float* wa = p.in[8];
    f32x4 acc[9];
#pragma unroll
    for (int i = 0; i < 9; ++i) acc[i] = (f32x4){0.f, 0.f, 0.f, 0.f};
#pragma unroll 1
    for (int ks = 0; ks < 4; ++ks) {
        const int k0 = w * 128 + ks * 32 + fq * 8;
        float bv[8];
#pragma unroll
        for (int j = 0; j < 8; ++j) bv[j] = wa[(size_t)(k0 + j) * 3072 + c0 + fr];
        const bf16x8 bfrag = __builtin_bit_cast(bf16x8, pack8(bv));
#pragma unroll
        for (int rt = 0; rt < 9; ++rt) {
            const int row = min(rt * 16 + fr, 129);
            const float* cp = (row < 2 ? p.in[5] + row * 1024 : p.in[6] + (row - 2) * 1024) + k0;
            const f32x4 x0 = *(const f32x4*)cp, x1 = *(const f32x4*)(cp + 4);
            float av[8] = {x0.x, x0.y, x0.z, x0.w, x1.x, x1.y, x1.z, x1.w};
#pragma unroll
            for (int j = 0; j < 8; ++j) av[j] = av[j] * fast_rcp(1.f + __expf(-av[j]));
            acc[rt] = mfma16(__builtin_bit_cast(bf16x8, pack8(av)), bfrag, acc[rt]);
            if (rt % 3 == 2) asm volatile("" ::: "memory");
        }
    }
    f32x4* red = (f32x4*)lds;
#pragma unroll
    for (int rt = 0; rt < 9; ++rt) red[(w * 9 + rt) * 64 + lane] = acc[rt];
    __syncthreads();
    float* mod = (float*)(p.ws + WS_MOD);
    for (int idx = tid; idx < 576; idx += 512) { const int rt = idx >> 6, ln = idx & 63;
        f32x4 sum = red[rt * 64 + ln];
#pragma unroll
        for (int ww = 1; ww < 8; ++ww) sum = sum + red[(ww * 9 + rt) * 64 + ln];
        const int col = c0 + (ln & 15); const float bias = p.in[9][col];
#pragma unroll
        for (int r = 0; r < 4; ++r) { const int row = rt * 16 + (ln >> 4) * 4 + r; if (row < 130) mod[(size_t)row * 3072 + col] = sum[r] + bias; } }
    __syncthreads();
}
__device__ __forceinline__ void p0_transpose_item(const float* W, int N, int n0, int nvalid, bf16_t* WT, int K, int n0p, int k0, float* scr, int lane) {
    const int c = lane & 31; const bool ok = c < nvalid;
#pragma unroll 8
    for (int i = 0; i < 32; ++i) { const int kk = 2 * i + (lane >> 5); scr[kk * 33 + c] = ok ? W[(size_t)(k0 + kk) * N + n0 + c] : 0.f; }
    asm volatile("s_waitcnt lgkmcnt(0)" ::: "memory");
    const int c8 = lane & 7;
#pragma unroll
    for (int j = 0; j < 4; ++j) { const int n = (lane >> 3) + 8 * j; const float* s = scr + (8 * c8) * 33 + n;
        u32x4 o; o.x = pk2(s[0], s[33]); o.y = pk2(s[66], s[99]); o.z = pk2(s[132], s[165]); o.w = pk2(s[198], s[231]);
        *(u32x4*)(WT + (size_t)(n0p + n) * K + k0 + 8 * c8) = o; }
    asm volatile("s_waitcnt lgkmcnt(0)" ::: "memory");
}
__device__ __forceinline__ void phase0(const Params& p, unsigned char* lds) {
    { int u0 = gridDim.x >= 192 ? (int)blockIdx.x - ((int)gridDim.x - 192) : (int)blockIdx.x;
      for (int u = u0; u < 192; u += gridDim.x) if (u >= 0) p0_ada(p, lds, u); }
}
__device__ __forceinline__ void phase0b(const Params& p, unsigned char* lds) {
    const int tid_ = opaque_tid(); const int lane = tid_ & 63, wave = tid_ >> 6;
    float* scr = (float*)(lds + wave * 8448);
    constexpr int I_IN = 16 * 160, I_B = 8 * 32, I_O = 16 * 32, TOT = I_IN + 2 * I_B + I_O;
    for (int it = blockIdx.x * 8 + wave; it < TOT; it += gridDim.x * 8) {
        int r = it;
        if (r < I_IN) { const int kb = r / 160, nb = r % 160; int n0, nv;
            if (nb < 72) { n0 = nb * 32; nv = 32; } else if (nb < 152) { n0 = nb * 32 + 16; nv = 32; } else if (nb == 152) { n0 = 2304; nv = 16; } else { n0 = 0; nv = 0; }
            p0_transpose_item(p.in[10], NIN, n0, nv, (bf16_t*)(p.ws + WS_WIN), 1024, nb * 32, kb * 64, scr, lane); continue; } r -= I_IN;
        if (r < I_B) { p0_transpose_item(p.in[17], 1024, (r % 32) * 32, 32, (bf16_t*)(p.ws + WS_WBA), 512, (r % 32) * 32, (r / 32) * 64, scr, lane); continue; } r -= I_B;
        if (r < I_B) { p0_transpose_item(p.in[18], 1024, (r % 32) * 32, 32, (bf16_t*)(p.ws + WS_WBG), 512, (r % 32) * 32, (r / 32) * 64, scr, lane); continue; } r -= I_B;
        p0_transpose_item(p.in[19], 1024, (r % 32) * 32, 32, (bf16_t*)(p.ws + WS_WOUT), 1024, (r % 32) * 32, (r / 32) * 64, scr, lane);
    }
    float* rope = (float*)(p.ws + WS_ROPE);
    for (int e = blockIdx.x * 512 + tid_; e < 8200 * 32; e += gridDim.x * 512) {
        const int pp = e >> 5, i = e & 31; const int pos = pp < 8192 ? pp : pp + 8192;
        const float ang = (float)pos * p.inv[i];
        const double a = (double)ang; const double n = rint(a * 0.15915494309189535);
        const float r = (float)fma(-n, 6.283185307179586, a);
        rope[(size_t)pp * 64 + i] = __cosf(r); rope[(size_t)pp * 64 + 32 + i] = __sinf(r); }
    __syncthreads();
}

__device__ __forceinline__ void phase1(const Params& p) {
    const int tid_ = opaque_tid(); const int lane = tid_ & 63, wave = tid_ >> 6;
    const float* mod = (const float*)(p.ws + WS_MOD);
    bf16_t* H = (bf16_t*)(p.ws + WS_H);
    for (int r = blockIdx.x * 8 + wave; r < MT; r += gridDim.x * 8) {
        const float* xrow = r < MP ? p.in[0] + (size_t)r * 1024 : p.in[1] + (size_t)(r - MP) * 1024;
        const float* mr = mod + (size_t)mod_row(r) * 3072;
        f32x4 v[4]; float ss = 0.f;
#pragma unroll
        for (int j = 0; j < 4; ++j) { v[j] = *(const f32x4*)(xrow + 4 * lane + 256 * j); ss += (v[j].x * v[j].x + v[j].y * v[j].y) + (v[j].z * v[j].z + v[j].w * v[j].w); }
        const float rstd = rsqrtf(wave_sum(ss) * (1.f / 1024.f) + EPS);
#pragma unroll
        for (int j = 0; j < 4; ++j) { const int c = 4 * lane + 256 * j;
            const f32x4 g = *(const f32x4*)(p.in[7] + c), sh = *(const f32x4*)(mr + c), sc = *(const f32x4*)(mr + 1024 + c);
            const f32x4 h = v[j] * rstd * g * (sc + 1.f) + sh;
            u32x2 w; w.x = pk2(h.x, h.y); w.y = pk2(h.z, h.w);
            *(u32x2*)(H + (size_t)r * 1024 + c) = w; }
    }
}

constexpr int KS_STRIDE = 72, VT_STRIDE = 264, ATT_VT_OFF = 256 * 72 * 2;
constexpr float QSCALE = 0.125f * LOG2E;

__device__ __forceinline__ void attn_group(const bf16_t* Ks, const bf16_t* Vt, int kt0, int lo, int hi, bf16x8 qf0, bf16x8 qf1, float sinkv, f32x4 (&o)[4], int lane) {
    const int fr = lane & 15, fq = lane >> 4;
    f32x4 s[9];
#pragma unroll
    for (int t = 0; t < 9; ++t) {
        const bf16_t* kp = Ks + ((kt0 + t) * 16 + fr) * KS_STRIDE + fq * 8;
        const bf16x8 k0 = *(const bf16x8*)kp, k1 = *(const bf16x8*)(kp + 32);
        f32x4 a = {0.f, 0.f, 0.f, 0.f};
        a = mfma16(k0, qf0, a); a = mfma16(k1, qf1, a);
        s[t] = a;
    }
    float m = sinkv;
#pragma unroll
    for (int t = 0; t < 9; ++t)
#pragma unroll
        for (int r = 0; r < 4; ++r) { const int j = (kt0 + t) * 16 + fq * 4 + r; const float v = (j >= lo && j <= hi) ? s[t][r] : -1e30f; s[t][r] = v; m = fmaxf(m, v); }
    m = fmaxf(m, __shfl_xor(m, 16)); m = fmaxf(m, __shfl_xor(m, 32));
    float l = 0.f;
#pragma unroll
    for (int t = 0; t < 9; ++t)
#pragma unroll
        for (int r = 0; r < 4; ++r) { const float pv = exp2f(s[t][r] - m); l += pv; s[t][r] = pv; }
    l += __shfl_xor(l, 16); l += __shfl_xor(l, 32);
    l += exp2f(sinkv - m);
#pragma unroll
    for (int dt = 0; dt < 4; ++dt) o[dt] = (f32x4){0.f, 0.f, 0.f, 0.f};
#pragma unroll
    for (int ks = 0; ks < 5; ++ks) {
        u32x4 pw; pw.x = pk2(s[2 * ks][0], s[2 * ks][1]); pw.y = pk2(s[2 * ks][2], s[2 * ks][3]);
        if (ks < 4) { pw.z = pk2(s[2 * ks + 1][0], s[2 * ks + 1][1]); pw.w = pk2(s[2 * ks + 1][2], s[2 * ks + 1][3]); } else { pw.z = 0u; pw.w = 0u; }
        const bf16x8 pb = __builtin_bit_cast(bf16x8, pw);
#pragma unroll
        for (int dt = 0; dt < 4; ++dt) {
            const bf16_t* vp = Vt + (dt * 16 + fr) * VT_STRIDE + (kt0 + 2 * ks) * 16 + fq * 4;
            const u32x2 a0 = *(const u32x2*)vp; u32x2 a1 = {0u, 0u};
            if (ks < 4) a1 = *(const u32x2*)(vp + 16);
            u32x4 aw; aw.x = a0.x; aw.y = a0.y; aw.z = a1.x; aw.w = a1.y;
            o[dt] = mfma16(__builtin_bit_cast(bf16x8, aw), pb, o[dt]);
        }
    }
    const float inv = 1.f / l;
#pragma unroll
    for (int dt = 0; dt < 4; ++dt) o[dt] = o[dt] * inv;
}
__device__ __forceinline__ void norm_rope16(float (&a)[8], float (&b)[8], const float* g, const float* rp, int f, int sx1, int sx2) {
    float ss = 0.f;
#pragma unroll
    for (int j = 0; j < 8; ++j) ss += a[j] * a[j] + b[j] * b[j];
    ss += __shfl_xor(ss, sx1); ss += __shfl_xor(ss, sx2);
    const float rstd = rsqrtf(ss * (1.f / 64.f) + EPS);
#pragma unroll
    for (int j = 0; j < 8; ++j) {
        const float y1 = a[j] * rstd * g[f * 8 + j], y2 = b[j] * rstd * g[32 + f * 8 + j];
        const float c = rp[f * 8 + j], s = rp[32 + f * 8 + j];
        a[j] = y1 * c - y2 * s; b[j] = y2 * c + y1 * s;
    }
}

__device__ __forceinline__ void attn_rows(const Params& p, const bf16_t* Ks, const bf16_t* Vt, size_t tok, int head, int prow, int kt0, int lo, int hi, bool store, int lane) {
    const int fq = lane >> 4;
    const bf16_t* qp = (const bf16_t*)(p.ws + WS_QA) + tok * 512 + head * 64 + fq * 8;
    float a[8], b[8];
    unpack8(*(const u32x4*)qp, a); unpack8(*(const u32x4*)(qp + 32), b);
    norm_rope16(a, b, p.in[11], (const float*)(p.ws + WS_ROPE) + (size_t)prow * 64, fq, 16, 32);
    const bf16x8 qf0 = __builtin_bit_cast(bf16x8, pack8s(a, QSCALE)), qf1 = __builtin_bit_cast(bf16x8, pack8s(b, QSCALE));
    f32x4 o[4];
    attn_group(Ks, Vt, kt0, lo, hi, qf0, qf1, p.in[13][head] * LOG2E, o, lane);
    if (store) {
        const bf16_t* zp = (const bf16_t*)(p.ws + WS_ZA) + tok * 512 + head * 64 + fq * 4;
        bf16_t* op = (bf16_t*)(p.ws + WS_OA) + tok * 512 + head * 64 + fq * 4;
#pragma unroll
        for (int dt = 0; dt < 4; ++dt) { const u32x2 z = *(const u32x2*)(zp + dt * 16);
            u32x2 w; w.x = pk2(o[dt][0] * bflo(z.x), o[dt][1] * bfhi(z.x)); w.y = pk2(o[dt][2] * bflo(z.y), o[dt][3] * bfhi(z.y));
            *(u32x2*)(op + dt * 16) = w; }
    }
}

__device__ __forceinline__ void attn_prompt_unit(const Params& p, unsigned char* lds, int u) {
    bf16_t* Ks = (bf16_t*)lds; bf16_t* Vt = (bf16_t*)(lds + ATT_VT_OFF);
    const int tid = opaque_tid(), lane = tid & 63, w = tid >> 6;
    const int b = u >> 7, qb = (u & 127) >> 1, kvh = u & 1;
    const bf16_t* KA = (const bf16_t*)(p.ws + WS_KA); const bf16_t* VA = (const bf16_t*)(p.ws + WS_VA);
    const float* rope = (const float*)(p.ws + WS_ROPE);
#pragma unroll
    for (int it = 0; it < 2; ++it) {
        const int j = it * 128 + w * 16 + (lane >> 2), f = lane & 3;
        const int t = (qb - 1) * 128 + j; const int tc = t < 0 ? 0 : t;
        const bf16_t* kp = KA + ((size_t)b * SEQ + tc) * 128 + kvh * 64 + f * 8;
        float a[8], c[8];
        unpack8(*(const u32x4*)kp, a); unpack8(*(const u32x4*)(kp + 32), c);
        norm_rope16(a, c, p.in[12], rope + (size_t)tc * 64, f, 1, 2);
        if (t < 0) {
#pragma unroll
            for (int q = 0; q < 8; ++q) { a[q] = 0.f; c[q] = 0.f; } }
        *(u32x4*)(Ks + j * KS_STRIDE + f * 8) = pack8(a); *(u32x4*)(Ks + j * KS_STRIDE + 32 + f * 8) = pack8(c);
        if (t >= SEQ - 128) { float* op = p.out + O_PWK + (((size_t)b * 128 + (t - (SEQ - 128))) * 2 + kvh) * 64 + f * 8;
            *(f32x4*)op = (f32x4){a[0], a[1], a[2], a[3]}; *(f32x4*)(op + 4) = (f32x4){a[4], a[5], a[6], a[7]};
            *(f32x4*)(op + 32) = (f32x4){c[0], c[1], c[2], c[3]}; *(f32x4*)(op + 36) = (f32x4){c[4], c[5], c[6], c[7]}; }
    }
#pragma unroll
    for (int it = 0; it < 4; ++it) {
        const int idx = tid + 512 * it, j = idx >> 3, ch = idx & 7;
        const int t = (qb - 1) * 128 + j; const int tc = t < 0 ? 0 : t;
        u32x4 v = *(const u32x4*)(VA + ((size_t)b * SEQ + tc) * 128 + kvh * 64 + ch * 8);
        if (t < 0) v = (u32x4){0u, 0u, 0u, 0u};
        bf16_t* vp = Vt + (ch * 8) * VT_STRIDE + j;
        vp[0] = (bf16_t)(v.x & 0xffff); vp[VT_STRIDE] = (bf16_t)(v.x >> 16); vp[2 * VT_STRIDE] = (bf16_t)(v.y & 0xffff); vp[3 * VT_STRIDE] = (bf16_t)(v.y >> 16);
        vp[4 * VT_STRIDE] = (bf16_t)(v.z & 0xffff); vp[5 * VT_STRIDE] = (bf16_t)(v.z >> 16); vp[6 * VT_STRIDE] = (bf16_t)(v.w & 0xffff); vp[7 * VT_STRIDE] = (bf16_t)(v.w >> 16);
        if (t >= SEQ - 128) { float* op = p.out + O_PWV + (((size_t)b * 128 + (t - (SEQ - 128))) * 2 + kvh) * 64 + ch * 8;
            *(f32x4*)op = (f32x4){bflo(v.x), bfhi(v.x), bflo(v.y), bfhi(v.y)}; *(f32x4*)(op + 4) = (f32x4){bflo(v.z), bfhi(v.z), bflo(v.w), bfhi(v.w)}; }
    }
    __syncthreads();
    const int head = kvh * 4 + (w >> 1), half = w & 1;
    for (int g = 0; g < 4; ++g) {
        const int i0 = half * 64 + g * 16, i = i0 + (lane & 15), t = qb * 128 + i;
        attn_rows(p, Ks, Vt, (size_t)b * SEQ + t, head, t, i0 >> 4, qb == 0 ? 128 : i, i + 128, true, lane);
    }
    __syncthreads();
}

__device__ __forceinline__ void attn_sample_unit(const Params& p, unsigned char* lds, int u) {
    bf16_t* Ks = (bf16_t*)lds; bf16_t* Vt = (bf16_t*)(lds + ATT_VT_OFF);
    const int tid = opaque_tid(), lane = tid & 63, w = tid >> 6;
    const int sb = u >> 1, kvh = u & 1;
    const bf16_t* KA = (const bf16_t*)(p.ws + WS_KA); const bf16_t* VA = (const bf16_t*)(p.ws + WS_VA);
    const float* rope = (const float*)(p.ws + WS_ROPE);
#pragma unroll
    for (int it = 0; it < 2; ++it) {
        const int j = it * 128 + w * 16 + (lane >> 2), f = lane & 3;
        if (j < 144) {
            const int l = (j >= 128 && j < 136) ? j - 128 : 0;
            const bf16_t* kp = KA + ((size_t)MP + sb * 8 + l) * 128 + kvh * 64 + f * 8;
            float a[8], c[8];
            unpack8(*(const u32x4*)kp, a); unpack8(*(const u32x4*)(kp + 32), c);
            norm_rope16(a, c, p.in[12], rope + (size_t)(8192 + l) * 64, f, 1, 2);
            if (j < 128) { const float* cp = p.in[2] + (((size_t)sb * 128 + j) * 2 + kvh) * 64 + f * 8;
                const f32x4 c0 = *(const f32x4*)cp, c1 = *(const f32x4*)(cp + 4), c2 = *(const f32x4*)(cp + 32), c3 = *(const f32x4*)(cp + 36);
                a[0] = c0.x; a[1] = c0.y; a[2] = c0.z; a[3] = c0.w; a[4] = c1.x; a[5] = c1.y; a[6] = c1.z; a[7] = c1.w;
                c[0] = c2.x; c[1] = c2.y; c[2] = c2.z; c[3] = c2.w; c[4] = c3.x; c[5] = c3.y; c[6] = c3.z; c[7] = c3.w; }
            else if (j >= 136) {
#pragma unroll
                for (int q = 0; q < 8; ++q) { a[q] = 0.f; c[q] = 0.f; } }
            *(u32x4*)(Ks + j * KS_STRIDE + f * 8) = pack8(a); *(u32x4*)(Ks + j * KS_STRIDE + 32 + f * 8) = pack8(c);
            if (j >= 8 && j < 136) { float* op = p.out + O_SWK + (((size_t)sb * 128 + (j - 8)) * 2 + kvh) * 64 + f * 8;
                *(f32x4*)op = (f32x4){a[0], a[1], a[2], a[3]}; *(f32x4*)(op + 4) = (f32x4){a[4], a[5], a[6], a[7]};
                *(f32x4*)(op + 32) = (f32x4){c[0], c[1], c[2], c[3]}; *(f32x4*)(op + 36) = (f32x4){c[4], c[5], c[6], c[7]}; }
        }
    }
#pragma unroll
    for (int it = 0; it < 3; ++it) {
        const int idx = tid + 512 * it, j = idx >> 3, ch = idx & 7;
        if (j < 144) {
            float v[8];
            if (j < 128) { const float* cp = p.in[3] + (((size_t)sb * 128 + j) * 2 + kvh) * 64 + ch * 8;
                const f32x4 c0 = *(const f32x4*)cp, c1 = *(const f32x4*)(cp + 4);
                v[0] = c0.x; v[1] = c0.y; v[2] = c0.z; v[3] = c0.w; v[4] = c1.x; v[5] = c1.y; v[6] = c1.z; v[7] = c1.w; }
            else if (j < 136) unpack8(*(const u32x4*)(VA + ((size_t)MP + sb * 8 + (j - 128)) * 128 + kvh * 64 + ch * 8), v);
            else {
#pragma unroll
                for (int q = 0; q < 8; ++q) v[q] = 0.f; }
            const u32x4 pv = pack8(v);
            bf16_t* vp = Vt + (ch * 8) * VT_STRIDE + j;
            vp[0] = (bf16_t)(pv.x & 0xffff); vp[VT_STRIDE] = (bf16_t)(pv.x >> 16); vp[2 * VT_STRIDE] = (bf16_t)(pv.y & 0xffff); vp[3 * VT_STRIDE] = (bf16_t)(pv.y >> 16);
            vp[4 * VT_STRIDE] = (bf16_t)(pv.z & 0xffff); vp[5 * VT_STRIDE] = (bf16_t)(pv.z >> 16); vp[6 * VT_STRIDE] = (bf16_t)(pv.w & 0xffff); vp[7 * VT_STRIDE] = (bf16_t)(pv.w >> 16);
            if (j >= 8 && j < 136) { float* op = p.out + O_SWV + (((size_t)sb * 128 + (j - 8)) * 2 + kvh) * 64 + ch * 8;
                *(f32x4*)op = (f32x4){v[0], v[1], v[2], v[3]}; *(f32x4*)(op + 4) = (f32x4){v[4], v[5], v[6], v[7]}; }
        }
    }
    __syncthreads();
    if (w < 2) {
        const int q = lane & 15, l = q & 7, head = kvh * 4 + w * 2 + (q >> 3);
        attn_rows(p, Ks, Vt, (size_t)MP + sb * 8 + l, head, 8192 + l, 0, l, l + 128, true, lane);
    }
    __syncthreads();
}

constexpr int G_BC = 0, G_TOT = 16640, G_QT = 18688, G_KT = 27904, G_VT = 37120, G_ST = 55552, G_AM = 73984, G_RED = 83200, G_KT2 = 83712, G_VS = 92928, G_LRS = 110336;
constexpr int GS = 72, VSS = 136;

__device__ __forceinline__ void gla_unit_info(int u, size_t& tok0, int& L, int& h) {
    if (u < 1024) { const int b = u >> 9, c = (u >> 2) & 127; h = u & 3; tok0 = (size_t)b * SEQ + c * 64; L = 64; }
    else { const int v = u - 1024; h = v & 3; tok0 = (size_t)MP + (v >> 2) * 8; L = 8; }
}
struct GlaRaw { u32x4 lr, q, k, v0, v1; float s[16]; u32x2 z[4]; };
template <int MODE> __device__ __forceinline__ void gla_load(const Params& p, int u, GlaRaw& R, int tid) {
    size_t tok0; int L, h; gla_unit_info(u, tok0, L, h);
    const int tok = tid >> 3, c = tid & 7; const bool ok = tok < L; const u32x4 z4 = {0u, 0u, 0u, 0u};
    R.lr = z4;
    if (tid < 128 && (tid >> 1) < L) R.lr = *(const u32x4*)((const bf16_t*)(p.ws + WS_LR) + (tok0 + (tid >> 1)) * 128 + (tid & 1) * 8);
    R.k = z4; R.v0 = z4; R.v1 = z4; R.q = z4;
    if (ok) { R.k = *(const u32x4*)((const bf16_t*)(p.ws + WS_KG) + (tok0 + tok) * 256 + h * 64 + c * 8);
        const bf16_t* vp = (const bf16_t*)(p.ws + WS_VG) + (tok0 + tok) * 512 + h * 128 + c * 16;
        R.v0 = *(const u32x4*)vp; R.v1 = *(const u32x4*)(vp + 8);
        if (MODE & 2) R.q = *(const u32x4*)((const bf16_t*)(p.ws + WS_QG) + (tok0 + tok) * 256 + h * 64 + c * 8); }
    if (MODE & 2) {
        const float* Sp = (u < 1024 ? (const float*)(p.ws + WS_DS) + (size_t)u * 8192 : p.in[4] + (size_t)(u - 1024) * 8192) + (tid & 127) + (tid >> 7) * 16 * 128;
#pragma unroll
        for (int i = 0; i < 16; ++i) R.s[i] = Sp[i * 128];
        const int lane = tid & 63, w = tid >> 6, ti = (w & 3) * 16 + (lane & 15);
        const bf16_t* zp = (const bf16_t*)(p.ws + WS_ZG) + (tok0 + min(ti, L - 1)) * 512 + h * 128 + (w >> 2) * 64 + (lane >> 4) * 4;
#pragma unroll
        for (int d4 = 0; d4 < 4; ++d4) R.z[d4] = *(const u32x2*)(zp + d4 * 16);
    }
}
template <int MODE> __device__ __forceinline__ void gla_process(const Params& p, unsigned char* lds, int u, GlaRaw& R, int unext) {
    size_t tok0; int L, h; gla_unit_info(u, tok0, L, h);
    const int tid = opaque_tid(), lane = tid & 63, w = tid >> 6, fr = lane & 15, fq = lane >> 4;
    float* Bc = (float*)(lds + G_BC); float* TOT = (float*)(lds + G_TOT);
    bf16_t* QS = (bf16_t*)(lds + G_QT); bf16_t* KS = (bf16_t*)(lds + G_KT); bf16_t* VS = (bf16_t*)(lds + G_VS); bf16_t* LRS = (bf16_t*)(lds + G_LRS);
    { const int tok = tid >> 3, c = tid & 7;
      if (tid < 128) *(u32x4*)(LRS + (tid >> 1) * 16 + (tid & 1) * 8) = R.lr;
      *(u32x4*)(KS + tok * GS + c * 8) = R.k;
      if (MODE & 2) *(u32x4*)(QS + tok * GS + c * 8) = R.q;
      *(u32x4*)(VS + tok * VSS + c * 16) = R.v0; *(u32x4*)(VS + tok * VSS + c * 16 + 8) = R.v1; }
    float sreg[16]; u32x2 zreg[4];
    if (MODE & 2) {
#pragma unroll
        for (int i = 0; i < 16; ++i) sreg[i] = R.s[i];
#pragma unroll
        for (int i = 0; i < 4; ++i) zreg[i] = R.z[i]; }
    __syncthreads();
    const int k = tid & 63, tg = tid >> 6;
    { const float* wg = p.in[14] + h * 64 + k;
      float wr[16];
#pragma unroll
      for (int r = 0; r < 16; ++r) wr[r] = wg[r * 256];
      const float bias = p.in[15][h * 64 + k];
      float cs[8]; float run = 0.f;
#pragma unroll
      for (int i = 0; i < 8; ++i) {
          const int tt = tg * 8 + i; float la = 0.f;
          if (tt < L) {
              const u32x4 l0 = *(const u32x4*)(LRS + tt * 16), l1 = *(const u32x4*)(LRS + tt * 16 + 8);
              float g = bias;
              g += bflo(l0.x) * wr[0] + bfhi(l0.x) * wr[1] + bflo(l0.y) * wr[2] + bfhi(l0.y) * wr[3] + bflo(l0.z) * wr[4] + bfhi(l0.z) * wr[5] + bflo(l0.w) * wr[6] + bfhi(l0.w) * wr[7];
              g += bflo(l1.x) * wr[8] + bfhi(l1.x) * wr[9] + bflo(l1.y) * wr[10] + bfhi(l1.y) * wr[11] + bflo(l1.z) * wr[12] + bfhi(l1.z) * wr[13] + bflo(l1.w) * wr[14] + bfhi(l1.w) * wr[15];
              la = (fminf(g, 0.f) - __logf(1.f + __expf(-fabsf(g)))) * (1.f / 16.f);
          }
          run += la; cs[i] = run;
      }
      TOT[tg * 64 + k] = run;
      __syncthreads();
      float pre = 0.f;
#pragma unroll
      for (int j = 0; j < 8; ++j) if (j < tg) pre += TOT[j * 64 + k];
#pragma unroll
      for (int i = 0; i < 8; ++i) Bc[(tg * 8 + i) * 65 + k] = pre + cs[i];
      __syncthreads(); }
    { const float bl = Bc[63 * 65 + k], bm = Bc[31 * 65 + k];
      float kd[8];
#pragma unroll
      for (int i = 0; i < 8; ++i) { const int tt = tg * 8 + i; const float bb = Bc[tt * 65 + k]; const float kv = bf2f(KS[tt * GS + k]);
          if (MODE & 1) kd[i] = kv * __expf(bl - bb);
          if (MODE & 2) { const float qv = bf2f(QS[tt * GS + k]);
              QS[tt * GS + k] = (bf16_t)(pk2(qv * __expf(bb - bm), 0.f) & 0xffff); KS[tt * GS + k] = (bf16_t)(pk2(kv * __expf(bm - bb), 0.f) & 0xffff); } }
      if (MODE & 1) *(u32x4*)((bf16_t*)(lds + G_KT2) + k * GS + tg * 8) = pack8(kd); }
    { const int dv = tid & 127, t4 = tid >> 7; unsigned wv[8];
#pragma unroll
      for (int i = 0; i < 8; ++i) wv[i] = (unsigned)VS[(t4 * 16 + 2 * i) * VSS + dv] | ((unsigned)VS[(t4 * 16 + 2 * i + 1) * VSS + dv] << 16);
      bf16_t* VT = (bf16_t*)(lds + G_VT) + dv * GS + t4 * 16;
      *(u32x4*)VT = (u32x4){wv[0], wv[1], wv[2], wv[3]}; *(u32x4*)(VT + 8) = (u32x4){wv[4], wv[5], wv[6], wv[7]};
      if (MODE & 2) { float v[16];
#pragma unroll
          for (int i = 0; i < 16; ++i) v[i] = sreg[i] * __expf(Bc[31 * 65 + t4 * 16 + i]);
          bf16_t* ST = (bf16_t*)(lds + G_ST) + dv * GS + t4 * 16;
          u32x4 w0, w1; w0.x = pk2(v[0], v[1]); w0.y = pk2(v[2], v[3]); w0.z = pk2(v[4], v[5]); w0.w = pk2(v[6], v[7]);
          w1.x = pk2(v[8], v[9]); w1.y = pk2(v[10], v[11]); w1.z = pk2(v[12], v[13]); w1.w = pk2(v[14], v[15]);
          *(u32x4*)ST = w0; *(u32x4*)(ST + 8) = w1; } }
    if (unext >= 0) gla_load<MODE>(p, unext, R, tid);
    __syncthreads();
    if (MODE & 1) {
        const bf16_t* VT = (const bf16_t*)(lds + G_VT) + (w * 16 + fr) * GS + fq * 8;
        const bf16x8 a0 = *(const bf16x8*)VT, a1 = *(const bf16x8*)(VT + 32);
#pragma unroll
        for (int kt = 0; kt < 4; ++kt) {
            const bf16_t* KT = (const bf16_t*)(lds + G_KT2) + (kt * 16 + fr) * GS + fq * 8;
            f32x4 acc = {0.f, 0.f, 0.f, 0.f};
            acc = mfma16(a0, *(const bf16x8*)KT, acc); acc = mfma16(a1, *(const bf16x8*)(KT + 32), acc);
            const int kk = kt * 16 + fr, dv = w * 16 + fq * 4;
            if (u < 1024) *(f32x4*)((float*)(p.ws + WS_DS) + (size_t)u * 8192 + kk * 128 + dv) = acc;
            else { const size_t so = ((size_t)(u - 1024) * 64 + kk) * 128 + dv;
                const float d = __expf(Bc[63 * 65 + kk]); const f32x4 s0 = *(const f32x4*)(p.in[4] + so);
                *(f32x4*)(p.out + O_SGS + so) = s0 * d + acc; }
        }
        if (u < 1024 && tid < 64) ((float*)(p.ws + WS_DEC))[(size_t)u * 64 + tid] = __expf(Bc[63 * 65 + tid]);
    }
    if (MODE & 2) {
        const int tt = w & 3, hh = w >> 2;
        const bf16_t* QTr = QS + (tt * 16 + fr) * GS + fq * 8;
        const bf16x8 bq0 = *(const bf16x8*)QTr, bq1 = *(const bf16x8*)(QTr + 32);
#pragma unroll
        for (int q = 0; q < 2; ++q) { const int st = hh * 2 + q;
            const bf16_t* KTr = KS + (st * 16 + fr) * GS + fq * 8;
            f32x4 acc = {0.f, 0.f, 0.f, 0.f};
            acc = mfma16(*(const bf16x8*)KTr, bq0, acc); acc = mfma16(*(const bf16x8*)(KTr + 32), bq1, acc);
            const int ti = tt * 16 + fr, s0 = st * 16 + fq * 4;
            u32x2 wv; wv.x = pk2(s0 <= ti ? acc[0] : 0.f, s0 + 1 <= ti ? acc[1] : 0.f); wv.y = pk2(s0 + 2 <= ti ? acc[2] : 0.f, s0 + 3 <= ti ? acc[3] : 0.f);
            *(u32x2*)((bf16_t*)(lds + G_AM) + ti * GS + s0) = wv; }
        __syncthreads();
        const bf16_t* AMr = (const bf16_t*)(lds + G_AM) + (tt * 16 + fr) * GS + fq * 8;
        const bf16x8 ba0 = *(const bf16x8*)AMr, ba1 = *(const bf16x8*)(AMr + 32);
        f32x4 o[4]; float ss = 0.f;
#pragma unroll
        for (int d4 = 0; d4 < 4; ++d4) { const int row = (hh * 4 + d4) * 16 + fr;
            const bf16_t* VT = (const bf16_t*)(lds + G_VT) + row * GS + fq * 8; const bf16_t* ST = (const bf16_t*)(lds + G_ST) + row * GS + fq * 8;
            f32x4 acc = {0.f, 0.f, 0.f, 0.f};
            acc = mfma16(*(const bf16x8*)VT, ba0, acc); acc = mfma16(*(const bf16x8*)(VT + 32), ba1, acc);
            acc = mfma16(*(const bf16x8*)ST, bq0, acc); acc = mfma16(*(const bf16x8*)(ST + 32), bq1, acc);
            o[d4] = acc; ss += (acc[0] * acc[0] + acc[1] * acc[1]) + (acc[2] * acc[2] + acc[3] * acc[3]); }
        ss += __shfl_xor(ss, 16); ss += __shfl_xor(ss, 32);
        float* RED = (float*)(lds + G_RED);
        if (fq == 0) RED[hh * 64 + tt * 16 + fr] = ss;
        __syncthreads();
        const float rstd = rsqrtf((RED[tt * 16 + fr] + RED[64 + tt * 16 + fr]) * (1.f / 128.f) + EPS);
        const int ti = tt * 16 + fr;
        if (ti < L) {
            const size_t tok = tok0 + ti;
#pragma unroll
            for (int d4 = 0; d4 < 4; ++d4) { const int dv = (hh * 4 + d4) * 16 + fq * 4;
                const f32x4 g = *(const f32x4*)(p.in[16] + dv);
                const u32x2 z = zreg[d4];
                u32x2 wv; wv.x = pk2(o[d4][0] * rstd * g.x * bflo(z.x), o[d4][1] * rstd * g.y * bfhi(z.x));
                wv.y = pk2(o[d4][2] * rstd * g.z * bflo(z.y), o[d4][3] * rstd * g.w * bfhi(z.y));
                *(u32x2*)((bf16_t*)(p.ws + WS_OG) + tok * 512 + h * 128 + dv) = wv; }
        }
    }
    __syncthreads();
}
template <int MODE> __device__ __forceinline__ void gla_units(const Params& p, unsigned char* lds, int ubase, int uend) {
    const int tid = opaque_tid();
    int u = ubase + blockIdx.x;
    if (u >= uend) return;
    GlaRaw R; gla_load<MODE>(p, u, R, tid);
    for (; u < uend; u += gridDim.x) { const int un = u + gridDim.x; gla_process<MODE>(p, lds, u, R, un < uend ? un : -1); }
}
__device__ __forceinline__ void gla_scan_dummy(const Params& p) {
    if (threadIdx.x >= 256) return;
    const int e = blockIdx.x * 256 + threadIdx.x;
    if (e >= 65536) return;
    const int b = e >> 15, h = (e >> 13) & 3, k = (e >> 7) & 63, dv = e & 127;
    float* DS = (float*)(p.ws + WS_DS); const float* DEC = (const float*)(p.ws + WS_DEC);
    float S = 0.f;
#pragma unroll 8
    for (int c = 0; c < 128; ++c) { const size_t u = (size_t)b * 512 + c * 4 + h;
        const float d = DEC[u * 64 + k]; float* sp = DS + u * 8192 + k * 128 + dv; const float ds = *sp; *sp = ds; S = d * S + ds; }
    if (S == 123.456f) p.out[O_PGS + e] = S;
}
__device__ __forceinline__ void gla_scan(const Params& p) {
    if (threadIdx.x >= 256) return;
    const int e = blockIdx.x * 256 + threadIdx.x;
    if (e >= 65536) return;
    const int b = e >> 15, h = (e >> 13) & 3, k = (e >> 7) & 63, dv = e & 127;
    float* DS = (float*)(p.ws + WS_DS); const float* DEC = (const float*)(p.ws + WS_DEC);
    float S = 0.f;
#pragma unroll 8
    for (int c = 0; c < 128; ++c) { const size_t u = (size_t)b * 512 + c * 4 + h;
        const float d = DEC[u * 64 + k]; float* sp = DS + u * 8192 + k * 128 + dv; const float ds = *sp; *sp = S; S = d * S + ds; }
    p.out[O_PGS + e] = S;
}

template <int KK> __device__ __forceinline__ void small_tile_acc(const bf16_t* A, int lda, const bf16_t* Bt, int ldb, int row0, int col0, f32x4 (&acc)[2], int lane, int w) {
    const int fr = lane & 15, fq = lane >> 4, rt = w & 3, ch = w >> 2;
    const bf16_t* ap = A + (size_t)(row0 + rt * 16 + fr) * lda + fq * 8;
    const bf16_t* bp0 = Bt + (size_t)(col0 + ch * 32 + fr) * ldb + fq * 8;
    const bf16_t* bp1 = bp0 + (size_t)16 * ldb;
#pragma unroll 8
    for (int k = 0; k < KK; k += 32) {
        const bf16x8 a = *(const bf16x8*)(ap + k), b0 = *(const bf16x8*)(bp0 + k), b1 = *(const bf16x8*)(bp1 + k);
        acc[0] = mfma16(b0, a, acc[0]); acc[1] = mfma16(b1, a, acc[1]);
    }
}
__device__ __forceinline__ void small_merge_tiles(const Params& p) {
    const int tid = opaque_tid(), lane = tid & 63, w = tid >> 6, fr = lane & 15, fq = lane >> 4;
    for (int t = blockIdx.x; t < 256; t += gridDim.x) {
        const int row0 = MP + (t >> 4) * 64, col0 = (t & 15) * 64;
        f32x4 aa[2] = {{0.f, 0.f, 0.f, 0.f}, {0.f, 0.f, 0.f, 0.f}}, ag[2] = {{0.f, 0.f, 0.f, 0.f}, {0.f, 0.f, 0.f, 0.f}};
        small_tile_acc<512>((const bf16_t*)(p.ws + WS_OA), 512, (const bf16_t*)(p.ws + WS_WBA), 512, row0, col0, aa, lane, w);
        small_tile_acc<512>((const bf16_t*)(p.ws + WS_OG), 512, (const bf16_t*)(p.ws + WS_WBG), 512, row0, col0, ag, lane, w);
        const size_t o = (size_t)(row0 + (w & 3) * 16 + fr) * 1024 + col0 + (w >> 2) * 32 + fq * 4;
#pragma unroll
        for (int nt = 0; nt < 2; ++nt) {
            const u32x2 ma = *(const u32x2*)((const bf16_t*)(p.ws + WS_MA) + o + nt * 16), mg = *(const u32x2*)((const bf16_t*)(p.ws + WS_MG) + o + nt * 16);
            u32x2 wv; wv.x = pk2(bflo(ma.x) * aa[nt][0] + bflo(mg.x) * ag[nt][0], bfhi(ma.x) * aa[nt][1] + bfhi(mg.x) * ag[nt][1]);
            wv.y = pk2(bflo(ma.y) * aa[nt][2] + bflo(mg.y) * ag[nt][2], bfhi(ma.y) * aa[nt][3] + bfhi(mg.y) * ag[nt][3]);
            *(u32x2*)((bf16_t*)(p.ws + WS_MRG) + o + nt * 16) = wv; }
    }
}
__device__ __forceinline__ void small_out_tiles(const Params& p) {
    const int tid = opaque_tid(), lane = tid & 63, w = tid >> 6, fr = lane & 15, fq = lane >> 4;
    for (int t = blockIdx.x; t < 256; t += gridDim.x) {
        const int row0 = MP + (t >> 4) * 64, col0 = (t & 15) * 64;
        f32x4 acc[2] = {{0.f, 0.f, 0.f, 0.f}, {0.f, 0.f, 0.f, 0.f}};
        small_tile_acc<1024>((const bf16_t*)(p.ws + WS_MRG), 1024, (const bf16_t*)(p.ws + WS_WOUT), 1024, row0, col0, acc, lane, w);
        const int row = row0 + (w & 3) * 16 + fr, c = col0 + (w >> 2) * 32 + fq * 4;
        const float* xrow = p.in[1] + (size_t)(row - MP) * 1024; const float* grow = (const float*)(p.ws + WS_MOD) + (size_t)mod_row(row) * 3072 + 2048;
#pragma unroll
        for (int nt = 0; nt < 2; ++nt) { const f32x4 x4 = *(const f32x4*)(xrow + c + nt * 16), g4 = *(const f32x4*)(grow + c + nt * 16);
            *(f32x4*)(p.out + O_Y + (size_t)row * 1024 + c + nt * 16) = x4 + g4 * acc[nt]; }
    }
}

__global__ void __launch_bounds__(512) mega_fwd(Params p) {
    extern __shared__ __attribute__((aligned(16))) unsigned char lds[];
    cg::grid_group grid = cg::this_grid();
    const int lo = p.ph_lo, hi = p.ph_hi;
#define IN(k) (lo <= (k) && (k) < hi)
    PG8_LAS unsigned char* glds = (PG8_LAS unsigned char*)lds;
    volatile LAS unsigned* xst = (volatile LAS unsigned*)(glds + 131072);
    if (threadIdx.x == 0) { xst[0] = 0u; xst[1] = 0u; }
    __syncthreads();
    const XcdBarrier xbar = xcd_barrier_post((unsigned*)(p.ws + WS_BAR), xst);
#define SEAM(k) do { if (IN(k) && IN((k) + 1)) { if ((k) == 0) grid.sync(); else xcd_barrier(xbar); } } while (0)
#ifndef PROBE_MASK
#define PROBE_MASK 0
#endif
#define REP(bit) ((((PROBE_MASK) >> (bit)) & 1) + 1)
    if (IN(0)) for (int rep = 0; rep < REP(0); ++rep) phase0(p, lds);
    SEAM(0);
    if (REP(11) > 1) { grid.sync(); grid.sync(); grid.sync(); grid.sync(); }
    if (IN(1)) for (int rep = 0; rep < REP(1); ++rep) { phase0b(p, lds); phase1(p); }
    SEAM(1);
    if (IN(2)) for (int rep = 0; rep < REP(2); ++rep) { pg8::Gemm g{(const bf16_t*)(p.ws + WS_H), (const bf16_t*)(p.ws + WS_WIN), MT, NINP, 1024}; pg8::StaticOrder S; S.init(MT, NINP, gridDim.x, blockIdx.x);
        EpiProj E{p.ws}; pg8::gemm_phase<EpiProj, pg8::StaticOrder, true, true>(glds, g, S, E); }
    SEAM(2);
    if (IN(3)) {
        for (int u = blockIdx.x; u < 512; u += gridDim.x) {
            if (u < 256) { for (int rep = 0; rep < REP(3); ++rep) attn_prompt_unit(p, lds, u); }
            else { for (int rep = 0; rep < REP(4); ++rep) attn_sample_unit(p, lds, u - 256); }
        }
        for (int rep = 0; rep < REP(5); ++rep) gla_units<1>(p, lds, 0, 1024);
        for (int rep = 0; rep < REP(10); ++rep) gla_units<3>(p, lds, 1024, 1536);
    }
    SEAM(3);
    if (IN(4)) { gla_scan(p); if (REP(9) > 1) gla_scan_dummy(p); }
    SEAM(4);
    if (IN(5)) for (int rep = 0; rep < REP(6); ++rep) gla_units<2>(p, lds, 0, 1024);
    SEAM(5);
    if (IN(6)) for (int rep = 0; rep < REP(7); ++rep) {
        pg8::StaticOrder S; S.init(MP, 1024, gridDim.x, blockIdx.x);
        { pg8::Gemm g{(const bf16_t*)(p.ws + WS_OA), (const bf16_t*)(p.ws + WS_WBA), MP, 1024, 512};
          EpiBranch<0> E{(const bf16_t*)(p.ws + WS_MA), nullptr, (bf16_t*)(p.ws + WS_TMP)};
          pg8::gemm_phase<EpiBranch<0>, pg8::StaticOrder, true, true>(glds, g, S, E); }
        { pg8::Gemm g{(const bf16_t*)(p.ws + WS_OG), (const bf16_t*)(p.ws + WS_WBG), MP, 1024, 512};
          EpiBranch<1> E{(const bf16_t*)(p.ws + WS_MG), (const bf16_t*)(p.ws + WS_TMP), (bf16_t*)(p.ws + WS_MRG)};
          pg8::gemm_phase<EpiBranch<1>, pg8::StaticOrder, true, true>(glds, g, S, E); }
        small_merge_tiles(p);
    }
    SEAM(6);
    if (IN(7)) for (int rep = 0; rep < REP(8); ++rep) { pg8::Gemm g{(const bf16_t*)(p.ws + WS_MRG), (const bf16_t*)(p.ws + WS_WOUT), MP, 1024, 1024}; pg8::StaticOrder S; S.init(MP, 1024, gridDim.x, blockIdx.x);
        EpiOut E{p.in[0], p.in[1], (const float*)(p.ws + WS_MOD), p.out + O_Y};
        pg8::gemm_phase<EpiOut, pg8::StaticOrder, true, true>(glds, g, S, E);
        small_out_tiles(p); }
#undef IN
#undef SEAM
}

constexpr int LDS_BYTES = 131072 + 16;
#ifndef N_LAUNCH_MODE
#define N_LAUNCH_MODE 1
#endif

extern "C" void kernel_launch(void* const* d_in, const int* in_sizes, int n_in, void* d_out, int out_size, void* d_ws, size_t ws_size, hipStream_t stream) {
    static int grid = 0;
    if (grid == 0) {
        if (n_in != 20 || ws_size < WS_END) { fprintf(stderr, "kernel_launch: unexpected n_in %d / ws_size %zu (need %zu)\n", n_in, ws_size, (size_t)WS_END); grid = -1; return; }
        int dev = 0, cus = 0, per_cu = 0;
        hipGetDevice(&dev);
        hipDeviceGetAttribute(&cus, hipDeviceAttributeMultiprocessorCount, dev);
        if (hipFuncSetAttribute((const void*)mega_fwd, hipFuncAttributeMaxDynamicSharedMemorySize, LDS_BYTES) != hipSuccess) { fprintf(stderr, "kernel_launch: hipFuncSetAttribute failed\n"); grid = -1; return; }
        if (hipOccupancyMaxActiveBlocksPerMultiprocessor(&per_cu, (const void*)mega_fwd, 512, LDS_BYTES) != hipSuccess || per_cu < 1) { fprintf(stderr, "kernel_launch: occupancy query gives %d\n", per_cu); per_cu = 1; }
        (void)hipGetLastError();
        grid = cus * 1;
        if (grid > cus * per_cu) grid = cus * per_cu;
    }
    if (grid < 0) return;
    Params p{};
    for (int i = 0; i < 20; ++i) p.in[i] = (const float*)d_in[i];
    p.out = (float*)d_out; p.ws = (unsigned char*)d_ws;
    for (int i = 0; i < 32; ++i) { const float e = (float)i / 32.0f; const float pw = powf(10000.0f, e); p.inv[i] = 1.0f / pw; }
    if (hipMemsetAsync((unsigned char*)d_ws + WS_BAR, 0, 16384, stream) != hipSuccess) { fprintf(stderr, "kernel_launch: memset of barrier words failed\n"); return; }
#if N_LAUNCH_MODE == 1
    p.ph_lo = 0; p.ph_hi = 8;
    void* args[] = {&p};
    hipError_t e = hipLaunchCooperativeKernel((const void*)mega_fwd, dim3(grid), dim3(512), args, LDS_BYTES, stream);
    if (e != hipSuccess) fprintf(stderr, "cooperative launch failed: %s (grid %d)\n", hipGetErrorString(e), grid);
#else
    for (int ph = 0; ph < 8; ++ph) { p.ph_lo = ph; p.ph_hi = ph + 1;
        hipLaunchKernelGGL(mega_fwd, dim3(grid), dim3(512), LDS_BYTES, stream, p); }
#endif
}
```

```cpp
#define PROBE_MASK 0
#include <hip/hip_runtime.h>
#include <hip/hip_cooperative_groups.h>
#include <cstdio>
#include <cstdint>
#include <cmath>
namespace cg = cooperative_groups;
__device__ __forceinline__ int opaque_tid() { int t = threadIdx.x; asm volatile("" : "+v"(t)); return t; }
namespace pg8 {
#define PG8_LAS __attribute__((address_space(3)))
typedef unsigned short bf16_t;
typedef short bf16x8 __attribute__((ext_vector_type(8)));
typedef float f32x4 __attribute__((ext_vector_type(4)));
typedef unsigned u32x4 __attribute__((ext_vector_type(4)));
constexpr int BM = 256, BK = 64, HALF = 128, HTB = HALF * BK * 2  , STAGE_BYTES = 8 * HTB, NXCD = 8, WGM = 8;

__host__ __device__ __forceinline__ int lds_byte(int r, int c) { const int st = (r >> 4) * 2 + (c >> 5), rr = r & 15, cc = c & 31, ob = rr * 64 + cc * 2; return st * 1024 + (ob ^ (((ob >> 9) & 1) << 5)); }
__host__ __device__ __forceinline__ void stage_rc(int b, int& R, int& C) { const int st = b / 1024, sb = b % 1024, swz = sb ^ (((sb >> 9) & 1) << 5); R = (st >> 1) * 16 + swz / 64; C = (st & 1) * 32 + (swz % 64) / 2; }
__host__ __device__ __forceinline__ int perm32(int rho) { const int n = rho >> 4, i = rho & 15; return 8 * (i >> 2) + 4 * n + (i & 3); }

struct Unit { int pm, pn; };
struct Gemm { const bf16_t* A; const bf16_t* Bt; int M, N, K; };

struct StaticOrder {
    int nM, nN, nwg, G, c;
    __host__ __device__ void init(int M, int N, int G_, int c_) { nM = M / BM; nN = N / BM; nwg = nM * nN; G = G_; c = c_; }
    __host__ __device__ bool next(int i, Unit& u) const {
        const long L = (long)i * G + c; if (L >= nwg) return false;
        int wgid = (int)L; { const int q = nwg / NXCD, r = nwg % NXCD, xcd = wgid % NXCD, off = wgid / NXCD; wgid = (xcd < r ? xcd * (q + 1) : r * (q + 1) + (xcd - r) * q) + off; }
        const int nig = WGM * nN, gid = wgid / nig, fm = gid * WGM, gsz = (nM - fm) < WGM ? (nM - fm) : WGM;
        u.pm = fm + ((wgid % nig) % gsz); u.pn = (wgid % nig) / gsz; return true;
    }
    __device__ __forceinline__ void a_ready(const Unit&) const {}
    __device__ __forceinline__ void done(const Unit&) const {}
};
__device__ __forceinline__ unsigned cvt_pk_bf16(float lo, float hi) { unsigned r; asm volatile("v_cvt_pk_bf16_f32 %0, %1, %2" : "=v"(r) : "v"(lo), "v"(hi)); return r; }
typedef float f32x2 __attribute__((ext_vector_type(2)));
template <class Epi, class Sched, bool ALIGN_EPI = false, bool SP2 = false>
__device__ __forceinline__ void gemm_phase(PG8_LAS unsigned char* lds, const Gemm g, const Sched& S, const Epi& E) {
    const int tid = opaque_tid(), wid = __builtin_amdgcn_readfirstlane(tid >> 6), lane = tid & 63, wr = wid >> 2, wc = wid & 3, fr = lane & 15, fq = lane >> 4;
    const int K = g.K, nt = K / BK;
    unsigned voffA[2], voffB[2];
#pragma unroll
    for (int i = 0; i < 2; ++i) { int R, C; stage_rc(tid * 16 + i * 8192, R, C); const int Rb = Epi::PERM ? ((R & ~31) + perm32(R & 31)) : R;
        voffA[i] = (unsigned)(R * K + C) * 2u; voffB[i] = (unsigned)(Rb * K + C) * 2u; }
    const size_t kstep = (size_t)(BK * 2);
    const size_t hstep = (size_t)HALF * K * 2;
    const size_t tstep = 2 * hstep;
    const unsigned ldsw = (unsigned)wid * 1024u;
    const int aoff = lds_byte(wr * 64 + fr, fq * 8), boff = lds_byte(wc * 32 + fr, fq * 8);
#define PG8_SA(b, h) (((b) * 2 + (h)) * HTB)
#define PG8_SB(b, h) ((4 + (b) * 2 + (h)) * HTB)
#define PG8_STAGE(bufoff, gbase, voff) do { _Pragma("unroll") for (int _i = 0; _i < 2; ++_i) \
        __builtin_amdgcn_global_load_lds((const unsigned*)((const char*)(gbase) + (voff)[_i]), (PG8_LAS unsigned*)(lds + (bufoff) + ldsw + _i * 8192), 16, 0, 0); } while (0)
#define PG8_LDA(dst, b, h) do { _Pragma("unroll") for (int m = 0; m < 4; ++m) _Pragma("unroll") for (int k = 0; k < 2; ++k) dst[m][k] = *(const PG8_LAS bf16x8*)(lds + PG8_SA(b, h) + aoff + m * 2048 + k * 1024); } while (0)
#define PG8_LDB(dst, b, h) do { _Pragma("unroll") for (int n = 0; n < 2; ++n) _Pragma("unroll") for (int k = 0; k < 2; ++k) dst[n][k] = *(const PG8_LAS bf16x8*)(lds + PG8_SB(b, h) + boff + n * 2048 + k * 1024); } while (0)
#define PG8_MMA(ai, bj, At, Bt) do { __builtin_amdgcn_s_setprio(1); _Pragma("unroll") for (int m = 0; m < 4; ++m) _Pragma("unroll") for (int n = 0; n < 2; ++n) _Pragma("unroll") for (int k = 0; k < 2; ++k) \
        acc[ai][bj][m][n] = __builtin_amdgcn_mfma_f32_16x16x32_bf16(Bt[n][k], At[m][k], acc[ai][bj][m][n], 0, 0, 0); __builtin_amdgcn_s_setprio(0); } while (0)
#define PG8_WAIT_V(n) asm volatile("s_waitcnt vmcnt(" #n ")" ::: "memory")
#define PG8_WAIT_L(n) asm volatile("s_waitcnt lgkmcnt(" #n ")" ::: "memory")
#define PG8_BAR __builtin_amdgcn_s_barrier()
#define PG8_SCHED __builtin_amdgcn_sched_barrier(0)
    Unit cur, nxt; int ui = 0;
    if (!S.next(0, cur)) return;
    f32x4 acc[2][2][4][2];
#pragma unroll
    for (int a = 0; a < 2; ++a)
#pragma unroll
        for (int b = 0; b < 2; ++b)
#pragma unroll
            for (int m = 0; m < 4; ++m)
#pragma unroll
                for (int n = 0; n < 2; ++n) acc[a][b][m][n] = (f32x4){0.f, 0.f, 0.f, 0.f};
    bf16x8 At[4][2], B0[2][2], B1[2][2];
    const char* cA = (const char*)g.A + (size_t)cur.pm * tstep; const char* cB = (const char*)g.Bt + (size_t)cur.pn * tstep;
    S.a_ready(cur);
    if constexpr (SP2) {
        PG8_STAGE(PG8_SB(0, 0), cB, voffB); PG8_STAGE(PG8_SB(0, 1), cB + hstep, voffB); PG8_STAGE(PG8_SA(0, 0), cA, voffA); PG8_STAGE(PG8_SA(0, 1), cA + hstep, voffA);
        if (wr == 1) PG8_BAR;
        PG8_WAIT_V(2); PG8_BAR;
        PG8_STAGE(PG8_SB(1, 0), cB + kstep, voffB); PG8_STAGE(PG8_SA(1, 0), cA + kstep, voffA); PG8_STAGE(PG8_SB(1, 1), cB + hstep + kstep, voffB);
        PG8_WAIT_V(6); PG8_BAR;
    } else {
        PG8_STAGE(PG8_SB(0, 0), cB, voffB); PG8_STAGE(PG8_SA(0, 0), cA, voffA); PG8_STAGE(PG8_SB(0, 1), cB + hstep, voffB); PG8_STAGE(PG8_SA(0, 1), cA + hstep, voffA);
        if (wr == 1) PG8_BAR;
        PG8_WAIT_V(4); PG8_BAR;
        PG8_STAGE(PG8_SB(1, 0), cB + kstep, voffB); PG8_STAGE(PG8_SA(1, 0), cA + kstep, voffA); PG8_STAGE(PG8_SB(1, 1), cB + hstep + kstep, voffB);
        PG8_WAIT_V(6); PG8_BAR;
    }
    for (;;) {
        const bool has_next = S.next(ui + 1, nxt);
        const char* nA = has_next ? (const char*)g.A + (size_t)nxt.pm * tstep : cA; const char* nB = has_next ? (const char*)g.Bt + (size_t)nxt.pn * tstep : cB;
        for (int t = 0; t < nt; t += 2) {
            const bool last = (t == nt - 2);
            const char* a1 = cA + (size_t)(t + 1) * kstep;
            const char* a2 = last ? nA : cA + (size_t)(t + 2) * kstep; const char* b2 = last ? nB : cB + (size_t)(t + 2) * kstep;
            const char* a3 = a2 + kstep; const char* b3 = b2 + kstep;
            if (last && has_next) S.a_ready(nxt);
            if constexpr (SP2) {
            PG8_LDB(B0, 0, 0); PG8_LDB(B1, 0, 1); PG8_SCHED; PG8_LDA(At, 0, 0); PG8_STAGE(PG8_SA(1, 1), a1 + hstep, voffA);
            PG8_WAIT_V(8); PG8_WAIT_L(0); PG8_BAR; PG8_MMA(0, 0, At, B0); PG8_MMA(0, 1, At, B1); PG8_BAR; PG8_SCHED;
            PG8_LDA(At, 0, 1); PG8_STAGE(PG8_SB(0, 0), b2, voffB); PG8_STAGE(PG8_SB(0, 1), b2 + hstep, voffB); PG8_STAGE(PG8_SA(0, 0), a2, voffA);
            PG8_WAIT_V(8); PG8_WAIT_L(0); PG8_BAR; PG8_MMA(1, 0, At, B0); PG8_MMA(1, 1, At, B1); PG8_BAR; PG8_SCHED;
            PG8_LDB(B0, 1, 0); PG8_LDB(B1, 1, 1); PG8_SCHED; PG8_LDA(At, 1, 0); PG8_STAGE(PG8_SA(0, 1), a2 + hstep, voffA);
            PG8_WAIT_V(8); PG8_WAIT_L(0); PG8_BAR; PG8_MMA(0, 0, At, B0); PG8_MMA(0, 1, At, B1); PG8_BAR; PG8_SCHED;
            PG8_LDA(At, 1, 1); PG8_STAGE(PG8_SB(1, 0), b3, voffB); PG8_STAGE(PG8_SB(1, 1), b3 + hstep, voffB); PG8_STAGE(PG8_SA(1, 0), a3, voffA);
            PG8_WAIT_V(8); PG8_WAIT_L(0); PG8_BAR; PG8_MMA(1, 0, At, B0); PG8_MMA(1, 1, At, B1); PG8_BAR; PG8_SCHED;
            } else {
            PG8_LDB(B0, 0, 0); PG8_SCHED; PG8_LDA(At, 0, 0); PG8_STAGE(PG8_SA(1, 1), a1 + hstep, voffA);
            PG8_WAIT_L(8); PG8_BAR; PG8_WAIT_L(0); PG8_MMA(0, 0, At, B0); PG8_BAR; PG8_SCHED;
            PG8_LDB(B1, 0, 1); PG8_STAGE(PG8_SB(0, 0), b2, voffB);
            PG8_BAR; PG8_WAIT_L(0); PG8_MMA(0, 1, At, B1); PG8_BAR;
            PG8_LDA(At, 0, 1); PG8_STAGE(PG8_SA(0, 0), a2, voffA);
            PG8_BAR; PG8_WAIT_L(0); PG8_MMA(1, 0, At, B0); PG8_BAR; PG8_SCHED;
            PG8_STAGE(PG8_SB(0, 1), b2 + hstep, voffB);
            PG8_WAIT_V(6); PG8_BAR; PG8_MMA(1, 1, At, B1); PG8_BAR;
            PG8_LDB(B0, 1, 0); PG8_SCHED; PG8_LDA(At, 1, 0); PG8_STAGE(PG8_SA(0, 1), a2 + hstep, voffA);
            PG8_WAIT_L(8); PG8_BAR; PG8_WAIT_L(0); PG8_MMA(0, 0, At, B0); PG8_BAR; PG8_SCHED;
            PG8_LDB(B1, 1, 1); PG8_STAGE(PG8_SB(1, 0), b3, voffB);
            PG8_BAR; PG8_WAIT_L(0); PG8_MMA(0, 1, At, B1); PG8_BAR;
            PG8_LDA(At, 1, 1); PG8_STAGE(PG8_SA(1, 0), a3, voffA);
            PG8_BAR; PG8_WAIT_L(0); PG8_MMA(1, 0, At, B0); PG8_BAR; PG8_SCHED;
            PG8_STAGE(PG8_SB(1, 1), b3 + hstep, voffB);
            PG8_WAIT_V(6); PG8_BAR; PG8_MMA(1, 1, At, B1); PG8_BAR;
            }
        }
        if constexpr (ALIGN_EPI) { if (wr == 0) PG8_BAR; }
        if constexpr (!Epi::AFTER_DRAIN) { E(acc, cur, wr, wc, fr, fq); S.done(cur); }
        if (!has_next) break;
#pragma unroll
        for (int a = 0; a < 2; ++a)
#pragma unroll
            for (int b = 0; b < 2; ++b)
#pragma unroll
                for (int m = 0; m < 4; ++m)
#pragma unroll
                    for (int n = 0; n < 2; ++n) acc[a][b][m][n] = (f32x4){0.f, 0.f, 0.f, 0.f};
        cur = nxt; cA = nA; cB = nB; ++ui;
        if constexpr (ALIGN_EPI) { if (wr == 1) PG8_BAR; }
    }
    PG8_WAIT_V(0);
    if constexpr (!ALIGN_EPI) { if (wr == 0) PG8_BAR; }
    PG8_BAR;
    if constexpr (Epi::AFTER_DRAIN) { E.fused(acc, cur, wr, wc, fr, fq, lds, wid, lane); S.done(cur); }
#undef PG8_SA
#undef PG8_SB
#undef PG8_STAGE
#undef PG8_LDA
#undef PG8_LDB
#undef PG8_MMA
#undef PG8_WAIT_V
#undef PG8_WAIT_L
#undef PG8_BAR
#undef PG8_SCHED
}
}
#define XB_TMO      128
#define XB_XCNT(j)  (256  + 64 * (j))
#define XB_XSUB(j)  (1280 + 64 * (j))
#define XB_XGEN(j)  (2304 + 64 * (j))
#define XB_TOP      3328
#define XB_TOPGEN   3392
#define XCD_BAR_WORDS 3456
#define XB_SPIN_CAP (1u << 18)
#define LAS __attribute__((address_space(3)))

__device__ __forceinline__ unsigned xb_ld(unsigned* p)              { return __hip_atomic_load(p, __ATOMIC_RELAXED, __HIP_MEMORY_SCOPE_AGENT); }
__device__ __forceinline__ unsigned xb_add(unsigned* p, unsigned v) { return __hip_atomic_fetch_add(p, v, __ATOMIC_RELAXED, __HIP_MEMORY_SCOPE_AGENT); }
__device__ __forceinline__ unsigned xb_xcc_id() { return (unsigned)__builtin_amdgcn_s_getreg((3 << 11) | 20) & 0xFu; }
#define XB_SPIN(cond, bar) do { unsigned _sp = 0; while (cond) { __builtin_amdgcn_s_sleep(1); \
    if ((++_sp & 255u) == 0u) { if (xb_ld(&(bar)[XB_TMO])) break; if (_sp > XB_SPIN_CAP) { atomicAdd(&(bar)[XB_TMO], 1u); break; } } } } while (0)

struct XcdBarrier {
    unsigned* bar; unsigned x;
    volatile LAS unsigned* st;
};

__device__ __forceinline__ XcdBarrier xcd_barrier_post(unsigned* bar, volatile LAS unsigned* st) {
    XcdBarrier b; b.bar = bar; b.x = xb_xcc_id(); b.st = st;
    if (threadIdx.x == 0) (void)xb_add(&bar[XB_XCNT(b.x)], 1u);
    return b;
}
__device__ __forceinline__ void xcd_barrier_complete(unsigned* bar, unsigned x, unsigned& nloc, unsigned& nx) {
    const unsigned G = gridDim.x * gridDim.y * gridDim.z;
    unsigned sum, cnt, mine, sp = 0u;
    for (;;) {
        sum = 0u; cnt = 0u; mine = 0u;
#pragma unroll
        for (unsigned j = 0; j < 16; ++j) { const unsigned c = xb_ld(&bar[XB_XCNT(j)]); sum += c; cnt += (c > 0u) ? 1u : 0u; mine = (j == x) ? c : mine; }
        if (sum == G) break;
        __builtin_amdgcn_s_sleep(1);
        if ((++sp & 255u) == 0u) { if (xb_ld(&bar[XB_TMO])) break; if (sp > XB_SPIN_CAP) { atomicAdd(&bar[XB_TMO], 1u); break; } }
    }
    nloc = mine > 0u ? mine : 1u; nx = cnt > 0u ? cnt : 1u;
}

__device__ __forceinline__ void xcd_barrier(const XcdBarrier& b) {
    asm volatile("s_waitcnt vmcnt(0)" ::: "memory");
    __syncthreads();
    if (threadIdx.x == 0) {
        unsigned* bar = b.bar;
        __builtin_amdgcn_s_waitcnt(0);
        unsigned nloc = b.st[0], nx = b.st[1];
        if (nloc == 0u) { xcd_barrier_complete(bar, b.x, nloc, nx); b.st[0] = nloc; b.st[1] = nx; }
        const unsigned old = xb_add(&bar[XB_XSUB(b.x)], 1u);
        const unsigned gen = old / nloc;
        if (old + 1u == (gen + 1u) * nloc) {
            __builtin_amdgcn_fence(__ATOMIC_RELEASE, "agent");
            asm volatile("s_waitcnt vmcnt(0)" ::: "memory");
            const unsigned og = xb_add(&bar[XB_TOP], 1u);
            const unsigned tg = og / nx;
            if (og + 1u == (tg + 1u) * nx) xb_add(&bar[XB_TOPGEN], 1u);
            else XB_SPIN(xb_ld(&bar[XB_TOPGEN]) == tg, bar);
            __builtin_amdgcn_fence(__ATOMIC_ACQUIRE, "agent");
            xb_add(&bar[XB_XGEN(b.x)], 1u);
            asm volatile("s_waitcnt vmcnt(0)" ::: "memory");
        } else {
            XB_SPIN(xb_ld(&bar[XB_XGEN(b.x)]) == gen, bar);
            __builtin_amdgcn_fence(__ATOMIC_ACQUIRE, "agent");
            asm volatile("s_waitcnt vmcnt(0)" ::: "memory");
        }
    }
    __syncthreads();
}

using pg8::bf16_t; using pg8::bf16x8; using pg8::f32x4; using pg8::u32x4; using pg8::Unit;
typedef unsigned u32x2 __attribute__((ext_vector_type(2)));
typedef float f32x2v __attribute__((ext_vector_type(2)));
typedef __bf16 bf16x2v __attribute__((ext_vector_type(2)));

constexpr int DM = 1024, SEQ = 8192, MP = 16384, MS = 1024, MT = MP + MS;
constexpr int NIN = 4880, NINP = 5120;
constexpr float EPS = 1e-6f;
constexpr float LOG2E = 1.4426950408889634f;

constexpr size_t WS_MOD = 0;
constexpr size_t WS_ROPE = WS_MOD + 1597440;
constexpr size_t WS_WIN = WS_ROPE + 2099200;
constexpr size_t WS_WBA = WS_WIN + 10485760;
constexpr size_t WS_WBG = WS_WBA + 1048576;
constexpr size_t WS_WOUT = WS_WBG + 1048576;
constexpr size_t WS_H = WS_WOUT + 2097152;
constexpr size_t WS_OA = WS_H;
constexpr size_t WS_OG = WS_H + 17825792;
constexpr size_t WS_QA = WS_H + 35651584;
constexpr size_t WS_KA = WS_QA + 17825792;
constexpr size_t WS_VA = WS_KA + 4456448;
constexpr size_t WS_QG = WS_VA + 4456448;
constexpr size_t WS_TMP = WS_QA;
constexpr size_t WS_KG = WS_QG + 8912896;
constexpr size_t WS_VG = WS_KG + 8912896;
constexpr size_t WS_ZG = WS_VG + 17825792;
constexpr size_t WS_MRG = WS_KG;
constexpr size_t WS_ZA = WS_ZG + 17825792;
constexpr size_t WS_MA = WS_ZA + 17825792;
constexpr size_t WS_MG = WS_MA + 35651584;
constexpr size_t WS_LR = WS_MG + 35651584;
constexpr size_t WS_DS = WS_LR + 4456448;
constexpr size_t WS_DEC = WS_DS + 33554432;
constexpr size_t WS_BAR = WS_DEC + 262144;
constexpr size_t WS_END = WS_BAR + 16384;

constexpr size_t O_Y = 0;
constexpr size_t O_PWK = 17825792;
constexpr size_t O_PWV = O_PWK + 32768;
constexpr size_t O_PGS = O_PWV + 32768;
constexpr size_t O_SWK = O_PGS + 65536;
constexpr size_t O_SWV = O_SWK + 2097152;
constexpr size_t O_SGS = O_SWV + 2097152;

struct Params {
    const float* in[20];
    float* out; unsigned char* ws;
    float inv[32];
    int ph_lo, ph_hi;
};

__device__ __forceinline__ unsigned pk2(float lo, float hi) { f32x2v v = {lo, hi}; bf16x2v b = __builtin_convertvector(v, bf16x2v); return __builtin_bit_cast(unsigned, b); }
__device__ __forceinline__ float bflo(unsigned w) { return __uint_as_float(w << 16); }
__device__ __forceinline__ float bfhi(unsigned w) { return __uint_as_float(w & 0xffff0000u); }
__device__ __forceinline__ float bf2f(bf16_t h) { return __uint_as_float((unsigned)h << 16); }
__device__ __forceinline__ float fast_rcp(float x) { return __builtin_amdgcn_rcpf(x); }
__device__ __forceinline__ float sigmoidf_(float x) { return fast_rcp(1.f + __expf(-x)); }
__device__ __forceinline__ float siluf_(float x) { return x * fast_rcp(1.f + __expf(-x)); }
__device__ __forceinline__ float wave_sum(float v) {
#pragma unroll
    for (int o = 1; o < 64; o <<= 1) v += __shfl_xor(v, o);
    return v;
}
__device__ __forceinline__ f32x4 mfma16(bf16x8 a, bf16x8 b, f32x4 c) { return __builtin_amdgcn_mfma_f32_16x16x32_bf16(a, b, c, 0, 0, 0); }
__device__ __forceinline__ void unpack8(const u32x4 w, float (&a)[8]) {
    a[0] = bflo(w.x); a[1] = bfhi(w.x); a[2] = bflo(w.y); a[3] = bfhi(w.y); a[4] = bflo(w.z); a[5] = bfhi(w.z); a[6] = bflo(w.w); a[7] = bfhi(w.w);
}
__device__ __forceinline__ u32x4 pack8(const float (&a)[8]) { u32x4 w; w.x = pk2(a[0], a[1]); w.y = pk2(a[2], a[3]); w.z = pk2(a[4], a[5]); w.w = pk2(a[6], a[7]); return w; }
__device__ __forceinline__ u32x4 pack8s(const float (&a)[8], float sc) { u32x4 w; w.x = pk2(a[0] * sc, a[1] * sc); w.y = pk2(a[2] * sc, a[3] * sc); w.z = pk2(a[4] * sc, a[5] * sc); w.w = pk2(a[6] * sc, a[7] * sc); return w; }
__device__ __forceinline__ int mod_row(int r) { return r < MP ? (r >> 13) : 2 + ((r - MP) >> 3); }

struct EpiProj {
    static constexpr bool PERM = true, AFTER_DRAIN = false;
    unsigned char* ws;
    __device__ __forceinline__ void operator()(const f32x4 (&acc)[2][2][4][2], const Unit& u, int wr, int wc, int fr, int fq) const {
        const int row0 = u.pm * 256 + wr * 64 + fr;
#pragma unroll
        for (int bj = 0; bj < 2; ++bj) {
            const int cb = u.pn * 2 + bj;
            size_t off; int ld, cbase, act;
            if (cb < 4) { off = WS_QA; ld = 512; cbase = cb * 128; act = 0; }
            else if (cb == 4) { off = WS_KA; ld = 128; cbase = 0; act = 0; }
            else if (cb == 5) { off = WS_VA; ld = 128; cbase = 0; act = 0; }
            else if (cb < 10) { off = WS_ZA; ld = 512; cbase = (cb - 6) * 128; act = 1; }
            else if (cb < 12) { off = WS_QG; ld = 256; cbase = (cb - 10) * 128; act = 3; }
            else if (cb < 14) { off = WS_KG; ld = 256; cbase = (cb - 12) * 128; act = 0; }
            else if (cb < 18) { off = WS_VG; ld = 512; cbase = (cb - 14) * 128; act = 0; }
            else if (cb < 22) { off = WS_ZG; ld = 512; cbase = (cb - 18) * 128; act = 1; }
            else if (cb < 30) { off = WS_MA; ld = 1024; cbase = (cb - 22) * 128; act = 2; }
            else if (cb < 38) { off = WS_MG; ld = 1024; cbase = (cb - 30) * 128; act = 2; }
            else if (cb == 38) { off = WS_LR; ld = 128; cbase = 0; act = 0; }
            else continue;
            bf16_t* base = (bf16_t*)(ws + off) + cbase + wc * 32 + 8 * fq;
#pragma unroll
            for (int ai = 0; ai < 2; ++ai)
#pragma unroll
                for (int m = 0; m < 4; ++m) {
                    f32x4 v0 = acc[ai][bj][m][0], v1 = acc[ai][bj][m][1];
                    if (act == 1) { for (int j = 0; j < 4; ++j) { v0[j] = siluf_(v0[j]); v1[j] = siluf_(v1[j]); } }
                    else if (act == 2) { for (int j = 0; j < 4; ++j) { v0[j] = sigmoidf_(v0[j]); v1[j] = sigmoidf_(v1[j]); } }
                    else if (act == 3) { v0 = v0 * 0.125f; v1 = v1 * 0.125f; }
                    u32x4 w; w.x = pk2(v0[0], v0[1]); w.y = pk2(v0[2], v0[3]); w.z = pk2(v1[0], v1[1]); w.w = pk2(v1[2], v1[3]);
                    *(u32x4*)(base + (size_t)(row0 + ai * 128 + m * 16) * ld) = w;
                }
        }
    }
};
template <int MODE> struct EpiBranch {
    static constexpr bool PERM = true, AFTER_DRAIN = false;
    const bf16_t* gate; const bf16_t* prev; bf16_t* dst;
    __device__ __forceinline__ void operator()(const f32x4 (&acc)[2][2][4][2], const Unit& u, int wr, int wc, int fr, int fq) const {
        const int row0 = u.pm * 256 + wr * 64 + fr, col0 = u.pn * 256 + wc * 32 + 8 * fq;
#pragma unroll
        for (int ai = 0; ai < 2; ++ai)
#pragma unroll
            for (int m = 0; m < 4; ++m)
#pragma unroll
                for (int bj = 0; bj < 2; ++bj) {
                    const size_t o = (size_t)(row0 + ai * 128 + m * 16) * 1024 + col0 + bj * 128;
                    const u32x4 g = *(const u32x4*)(gate + o);
                    f32x4 v0 = acc[ai][bj][m][0], v1 = acc[ai][bj][m][1];
                    v0[0] *= bflo(g.x); v0[1] *= bfhi(g.x); v0[2] *= bflo(g.y); v0[3] *= bfhi(g.y);
                    v1[0] *= bflo(g.z); v1[1] *= bfhi(g.z); v1[2] *= bflo(g.w); v1[3] *= bfhi(g.w);
                    if (MODE == 1) { const u32x4 t = *(const u32x4*)(prev + o);
                        v0[0] += bflo(t.x); v0[1] += bfhi(t.x); v0[2] += bflo(t.y); v0[3] += bfhi(t.y);
                        v1[0] += bflo(t.z); v1[1] += bfhi(t.z); v1[2] += bflo(t.w); v1[3] += bfhi(t.w); }
                    u32x4 w; w.x = pk2(v0[0], v0[1]); w.y = pk2(v0[2], v0[3]); w.z = pk2(v1[0], v1[1]); w.w = pk2(v1[2], v1[3]);
                    *(u32x4*)(dst + o) = w;
                }
    }
};
struct EpiOut {
    static constexpr bool PERM = false, AFTER_DRAIN = false;
    const float* xp; const float* xs; const float* mod; float* out;
    __device__ __forceinline__ void operator()(const f32x4 (&acc)[2][2][4][2], const Unit& u, int wr, int wc, int fr, int fq) const {
        const int col0 = u.pn * 256 + wc * 32 + 4 * fq;
#pragma unroll
        for (int ai = 0; ai < 2; ++ai)
#pragma unroll
            for (int m = 0; m < 4; ++m) {
                const int row = u.pm * 256 + ai * 128 + wr * 64 + m * 16 + fr;
                const float* xrow = row < MP ? xp + (size_t)row * 1024 : xs + (size_t)(row - MP) * 1024;
                const float* grow = mod + (size_t)mod_row(row) * 3072 + 2048;
                float* orow = out + (size_t)row * 1024;
#pragma unroll
                for (int bj = 0; bj < 2; ++bj)
#pragma unroll
                    for (int n = 0; n < 2; ++n) { const int c = col0 + bj * 128 + n * 16;
                        const f32x4 x4 = *(const f32x4*)(xrow + c), g4 = *(const f32x4*)(grow + c);
                        *(f32x4*)(orow + c) = x4 + g4 * acc[ai][bj][m][n]; }
            }
    }
};

__device__ __forceinline__ void p0_ada(const Params& p, unsigned char* lds, int unit) {
    const int tid = opaque_tid(), lane = tid & 63, w = tid >> 6, fr = lane & 15, fq = lane >> 4;
    const int c0 = unit * 16;
    const float* wa = p.in[8];
    f32x4 acc[9];
#pragma unroll
    for (int i = 0; i < 9; ++i) acc[i] = (f32x4){0.f, 0.f, 0.f, 0.f};
#pragma unroll 1
    for (int ks = 0; ks < 4; ++ks) {
        const int k0 = w * 128 + ks * 32 + fq * 8;
        float bv[8];
#pragma unroll
        for (int j = 0; j < 8; ++j) bv[j] = wa[(size_t)(k0 + j) * 3072 + c0 + fr];
        const bf16x8 bfrag = __builtin_bit_cast(bf16x8, pack8(bv));
#pragma unroll
        for (int rt = 0; rt < 9; ++rt) {
            const int row = min(rt * 16 + fr, 129);
            const float* cp = (row < 2 ? p.in[5] + row * 1024 : p.in[6] + (row - 2) * 1024) + k0;
            const f32x4 x0 = *(const f32x4*)cp, x1 = *(const f32x4*)(cp + 4);
            float av[8] = {x0.x, x0.y, x0.z, x0.w, x1.x, x1.y, x1.z, x1.w};
#pragma unroll
            for (int j = 0; j < 8; ++j) av[j] = av[j] * fast_rcp(1.f + __expf(-av[j]));
            acc[rt] = mfma16(__builtin_bit_cast(bf16x8, pack8(av)), bfrag, acc[rt]);
            if (rt % 3 == 2) asm volatile("" ::: "memory");
        }
    }
    f32x4* red = (f32x4*)lds;
#pragma unroll
    for (int rt = 0; rt < 9; ++rt) red[(w * 9 + rt) * 64 + lane] = acc[rt];
    __syncthreads();
    float* mod = (float*)(p.ws + WS_MOD);
    for (int idx = tid; idx < 576; idx += 512) { const int rt = idx >> 6, ln = idx & 63;
        f32x4 sum = red[rt * 64 + ln];
#pragma unroll
        for (int ww = 1; ww < 8; ++ww) sum = sum + red[(ww * 9 + rt) * 64 + ln];
        const int col = c0 + (ln & 15); const float bias = p.in[9][col];
#pragma unroll
        for (int r = 0; r < 4; ++r) { const int row = rt * 16 + (ln >> 4) * 4 + r; if (row < 130) mod[(size_t)row * 3072 + col] = sum[r] + bias; } }
    __syncthreads();
}
__device__ __forceinline__ void p0_transpose_item(const float* W, int N, int n0, int nvalid, bf16_t* WT, int K, int n0p, int k0, float* scr, int lane) {
    const int c = lane & 31; const bool ok = c < nvalid;
#pragma unroll 8
    for (int i = 0; i < 32; ++i) { const int kk = 2 * i + (lane >> 5); scr[kk * 33 + c] = ok ? W[(size_t)(k0 + kk) * N + n0 + c] : 0.f; }
    asm volatile("s_waitcnt lgkmcnt(0)" ::: "memory");
    const int c8 = lane & 7;
#pragma unroll
    for (int j = 0; j < 4; ++j) { const int n = (lane >> 3) + 8 * j; const float* s = scr + (8 * c8) * 33 + n;
        u32x4 o; o.x = pk2(s[0], s[33]); o.y = pk2(s[66], s[99]); o.z = pk2(s[132], s[165]); o.w = pk2(s[198], s[231]);
        *(u32x4*)(WT + (size_t)(n0p + n) * K + k0 + 8 * c8) = o; }
    asm volatile("s_waitcnt lgkmcnt(0)" ::: "memory");
}
__device__ __forceinline__ void phase0(const Params& p, unsigned char* lds) {
    { int u0 = gridDim.x >= 192 ? (int)blockIdx.x - ((int)gridDim.x - 192) : (int)blockIdx.x;
      for (int u = u0; u < 192; u += gridDim.x) if (u >= 0) p0_ada(p, lds, u); }
}
__device__ __forceinline__ void phase0b(const Params& p, unsigned char* lds) {
    const int tid_ = opaque_tid(); const int lane = tid_ & 63, wave = tid_ >> 6;
    float* scr = (float*)(lds + wave * 8448);
    constexpr int I_IN = 16 * 160, I_B = 8 * 32, I_O = 16 * 32, TOT = I_IN + 2 * I_B + I_O;
    for (int it = blockIdx.x * 8 + wave; it < TOT; it += gridDim.x * 8) {
        int r = it;
        if (r < I_IN) { const int kb = r / 160, nb = r % 160; int n0, nv;
            if (nb < 72) { n0 = nb * 32; nv = 32; } else if (nb < 152) { n0 = nb * 32 + 16; nv = 32; } else if (nb == 152) { n0 = 2304; nv = 16; } else { n0 = 0; nv = 0; }
            p0_transpose_item(p.in[10], NIN, n0, nv, (bf16_t*)(p.ws + WS_WIN), 1024, nb * 32, kb * 64, scr, lane); continue; } r -= I_IN;
        if (r < I_B) { p0_transpose_item(p.in[17], 1024, (r % 32) * 32, 32, (bf16_t*)(p.ws + WS_WBA), 512, (r % 32) * 32, (r / 32) * 64, scr, lane); continue; } r -= I_B;
        if (r < I_B) { p0_transpose_item(p.in[18], 1024, (r % 32) * 32, 32, (bf16_t*)(p.ws + WS_WBG), 512, (r % 32) * 32, (r / 32) * 64, scr, lane); continue; } r -= I_B;
        p0_transpose_item(p.in[19], 1024, (r % 32) * 32, 32, (bf16_t*)(p.ws + WS_WOUT), 1024, (r % 32) * 32, (r / 32) * 64, scr, lane);
    }
    float* rope = (float*)(p.ws + WS_ROPE);
    for (int e = blockIdx.x * 512 + tid_; e < 8200 * 32; e += gridDim.x * 512) {
        const int pp = e >> 5, i = e & 31; const int pos = pp < 8192 ? pp : pp + 8192;
        const float ang = (float)pos * p.inv[i];
        const double a = (double)ang; const double n = rint(a * 0.15915494309189535);
        const float r = (float)fma(-n, 6.283185307179586, a);
        rope[(size_t)pp * 64 + i] = __cosf(r); rope[(size_t)pp * 64 + 32 + i] = __sinf(r); }
    __syncthreads();
}

__device__ __forceinline__ void phase1(const Params& p) {
    const int tid_ = opaque_tid(); const int lane = tid_ & 63, wave = tid_ >> 6;
    const float* mod = (const float*)(p.ws + WS_MOD);
    bf16_t* H = (bf16_t*)(p.ws + WS_H);
    for (int r = blockIdx.x * 8 + wave; r < MT; r += gridDim.x * 8) {
        const float* xrow = r < MP ? p.in[0] + (size_t)r * 1024 : p.in[1] + (size_t)(r - MP) * 1024;
        const float* mr = mod + (size_t)mod_row(r) * 3072;
        f32x4 v[4]; float ss = 0.f;
#pragma unroll
        for (int j = 0; j < 4; ++j) { v[j] = *(const f32x4*)(xrow + 4 * lane + 256 * j); ss += (v[j].x * v[j].x + v[j].y * v[j].y) + (v[j].z * v[j].z + v[j].w * v[j].w); }
        const float rstd = rsqrtf(wave_sum(ss) * (1.f / 1024.f) + EPS);
#pragma unroll
        for (int j = 0; j < 4; ++j) { const int c = 4 * lane + 256 * j;
            const f32x4 g = *(const f32x4*)(p.in[7] + c), sh = *(const f32x4*)(mr + c), sc = *(const f32x4*)(mr + 1024 + c);
            const f32x4 h = v[j] * rstd * g * (sc + 1.f) + sh;
            u32x2 w; w.x = pk2(h.x, h.y); w.y = pk2(h.z, h.w);
            *(u32x2*)(H + (size_t)r * 1024 + c) = w; }
    }
}

constexpr int KS_STRIDE = 72, VT_STRIDE = 264, ATT_VT_OFF = 256 * 72 * 2;
constexpr float QSCALE = 0.125f * LOG2E;

__device__ __forceinline__ void attn_group(const bf16_t* Ks, const bf16_t* Vt, int kt0, int lo, int hi, bf16x8 qf0, bf16x8 qf1, float sinkv, f32x4 (&o)[4], int lane) {
    const int fr = lane & 15, fq = lane >> 4;
    f32x4 s[9];
#pragma unroll
    for (int t = 0; t < 9; ++t) {
        const bf16_t* kp = Ks + ((kt0 + t) * 16 + fr) * KS_STRIDE + fq * 8;
        const bf16x8 k0 = *(const bf16x8*)kp, k1 = *(const bf16x8*)(kp + 32);
        f32x4 a = {0.f, 0.f, 0.f, 0.f};
        a = mfma16(k0, qf0, a); a = mfma16(k1, qf1, a);
        s[t] = a;
    }
    float m = sinkv;
#pragma unroll
    for (int t = 0; t < 9; ++t)
#pragma unroll
        for (int r = 0; r < 4; ++r) { const int j = (kt0 + t) * 16 + fq * 4 + r; const float v = (j >= lo && j <= hi) ? s[t][r] : -1e30f; s[t][r] = v; m = fmaxf(m, v); }
    m = fmaxf(m, __shfl_xor(m, 16)); m = fmaxf(m, __shfl_xor(m, 32));
    float l = 0.f;
#pragma unroll
    for (int t = 0; t < 9; ++t)
#pragma unroll
        for (int r = 0; r < 4; ++r) { const float pv = exp2f(s[t][r] - m); l += pv; s[t][r] = pv; }
    l += __shfl_xor(l, 16); l += __shfl_xor(l, 32);
    l += exp2f(sinkv - m);
#pragma unroll
    for (int dt = 0; dt < 4; ++dt) o[dt] = (f32x4){0.f, 0.f, 0.f, 0.f};
#pragma unroll
    for (int ks = 0; ks < 5; ++ks) {
        u32x4 pw; pw.x = pk2(s[2 * ks][0], s[2 * ks][1]); pw.y = pk2(s[2 * ks][2], s[2 * ks][3]);
        if (ks < 4) { pw.z = pk2(s[2 * ks + 1][0], s[2 * ks + 1][1]); pw.w = pk2(s[2 * ks + 1][2], s[2 * ks + 1][3]); } else { pw.z = 0u; pw.w = 0u; }
        const bf16x8 pb = __builtin_bit_cast(bf16x8, pw);
#pragma unroll
        for (int dt = 0; dt < 4; ++dt) {
            const bf16_t* vp = Vt + (dt * 16 + fr) * VT_STRIDE + (kt0 + 2 * ks) * 16 + fq * 4;
            const u32x2 a0 = *(const u32x2*)vp; u32x2 a1 = {0u, 0u};
            if (ks < 4) a1 = *(const u32x2*)(vp + 16);
            u32x4 aw; aw.x = a0.x; aw.y = a0.y; aw.z = a1.x; aw.w = a1.y;
            o[dt] = mfma16(__builtin_bit_cast(bf16x8, aw), pb, o[dt]);
        }
    }
    const float inv = 1.f / l;
#pragma unroll
    for (int dt = 0; dt < 4; ++dt) o[dt] = o[dt] * inv;
}
__device__ __forceinline__ void norm_rope16(float (&a)[8], float (&b)[8], const float* g, const float* rp, int f, int sx1, int sx2) {
    float ss = 0.f;
#pragma unroll
    for (int j = 0; j < 8; ++j) ss += a[j] * a[j] + b[j] * b[j];
    ss += __shfl_xor(ss, sx1); ss += __shfl_xor(ss, sx2);
    const float rstd = rsqrtf(ss * (1.f / 64.f) + EPS);
#pragma unroll
    for (int j = 0; j < 8; ++j) {
        const float y1 = a[j] * rstd * g[f * 8 + j], y2 = b[j] * rstd * g[32 + f * 8 + j];
        const float c = rp[f * 8 + j], s = rp[32 + f * 8 + j];
        a[j] = y1 * c - y2 * s; b[j] = y2 * c + y1 * s;
    }
}

__device__ __forceinline__ void attn_rows(const Params& p, const bf16_t* Ks, const bf16_t* Vt, size_t tok, int head, int prow, int kt0, int lo, int hi, bool store, int lane) {
    const int fq = lane >> 4;
    const bf16_t* qp = (const bf16_t*)(p.ws + WS_QA) + tok * 512 + head * 64 + fq * 8;
    float a[8], b[8];
    unpack8(*(const u32x4*)qp, a); unpack8(*(const u32x4*)(qp + 32), b);
    norm_rope16(a, b, p.in[11], (const float*)(p.ws + WS_ROPE) + (size_t)prow * 64, fq, 16, 32);
    const bf16x8 qf0 = __builtin_bit_cast(bf16x8, pack8s(a, QSCALE)), qf1 = __builtin_bit_cast(bf16x8, pack8s(b, QSCALE));
    f32x4 o[4];
    attn_group(Ks, Vt, kt0, lo, hi, qf0, qf1, p.in[13][head] * LOG2E, o, lane);
    if (store) {
        const bf16_t* zp = (const bf16_t*)(p.ws + WS_ZA) + tok * 512 + head * 64 + fq * 4;
        bf16_t* op = (bf16_t*)(p.ws + WS_OA) + tok * 512 + head * 64 + fq * 4;
#pragma unroll
        for (int dt = 0; dt < 4; ++dt) { const u32x2 z = *(const u32x2*)(zp + dt * 16);
            u32x2 w; w.x = pk2(o[dt][0] * bflo(z.x), o[dt][1] * bfhi(z.x)); w.y = pk2(o[dt][2] * bflo(z.y), o[dt][3] * bfhi(z.y));
            *(u32x2*)(op + dt * 16) = w; }
    }
}

__device__ __forceinline__ void attn_prompt_unit(const Params& p, unsigned char* lds, int u) {
    bf16_t* Ks = (bf16_t*)lds; bf16_t* Vt = (bf16_t*)(lds + ATT_VT_OFF);
    const int tid = opaque_tid(), lane = tid & 63, w = tid >> 6;
    const int b = u >> 7, qb = (u & 127) >> 1, kvh = u & 1;
    const bf16_t* KA = (const bf16_t*)(p.ws + WS_KA); const bf16_t* VA = (const bf16_t*)(p.ws + WS_VA);
    const float* rope = (const float*)(p.ws + WS_ROPE);
#pragma unroll
    for (int it = 0; it < 2; ++it) {
        const int j = it * 128 + w * 16 + (lane >> 2), f = lane & 3;
        const int t = (qb - 1) * 128 + j; const int tc = t < 0 ? 0 : t;
        const bf16_t* kp = KA + ((size_t)b * SEQ + tc) * 128 + kvh * 64 + f * 8;
        float a[8], c[8];
        unpack8(*(const u32x4*)kp, a); unpack8(*(const u32x4*)(kp + 32), c);
        norm_rope16(a, c, p.in[12], rope + (size_t)tc * 64, f, 1, 2);
        if (t < 0) {
#pragma unroll
            for (int q = 0; q < 8; ++q) { a[q] = 0.f; c[q] = 0.f; } }
        *(u32x4*)(Ks + j * KS_STRIDE + f * 8) = pack8(a); *(u32x4*)(Ks + j * KS_STRIDE + 32 + f * 8) = pack8(c);
        if (t >= SEQ - 128) { float* op = p.out + O_PWK + (((size_t)b * 128 + (t - (SEQ - 128))) * 2 + kvh) * 64 + f * 8;
            *(f32x4*)op = (f32x4){a[0], a[1], a[2], a[3]}; *(f32x4*)(op + 4) = (f32x4){a[4], a[5], a[6], a[7]};
            *(f32x4*)(op + 32) = (f32x4){c[0], c[1], c[2], c[3]}; *(f32x4*)(op + 36) = (f32x4){c[4], c[5], c[6], c[7]}; }
    }
#pragma unroll
    for (int it = 0; it < 4; ++it) {
        const int idx = tid + 512 * it, j = idx >> 3, ch = idx & 7;
        const int t = (qb - 1) * 128 + j; const int tc = t < 0 ? 0 : t;
        u32x4 v = *(const u32x4*)(VA + ((size_t)b * SEQ + tc) * 128 + kvh * 64 + ch * 8);
        if (t < 0) v = (u32x4){0u, 0u, 0u, 0u};
        bf16_t* vp = Vt + (ch * 8) * VT_STRIDE + j;
        vp[0] = (bf16_t)(v.x & 0xffff); vp[VT_STRIDE] = (bf16_t)(v.x >> 16); vp[2 * VT_STRIDE] = (bf16_t)(v.y & 0xffff); vp[3 * VT_STRIDE] = (bf16_t)(v.y >> 16);
        vp[4 * VT_STRIDE] = (bf16_t)(v.z & 0xffff); vp[5 * VT_STRIDE] = (bf16_t)(v.z >> 16); vp[6 * VT_STRIDE] = (bf16_t)(v.w & 0xffff); vp[7 * VT_STRIDE] = (bf16_t)(v.w >> 16);
        if (t >= SEQ - 128) { float* op = p.out + O_PWV + (((size_t)b * 128 + (t - (SEQ - 128))) * 2 + kvh) * 64 + ch * 8;
            *(f32x4*)op = (f32x4){bflo(v.x), bfhi(v.x), bflo(v.y), bfhi(v.y)}; *(f32x4*)(op + 4) = (f32x4){bflo(v.z), bfhi(v.z), bflo(v.w), bfhi(v.w)}; }
    }
    __syncthreads();
    const int head = kvh * 4 + (w >> 1), half = w & 1;
    for (int g = 0; g < 4; ++g) {
        const int i0 = half * 64 + g * 16, i = i0 + (lane & 15), t = qb * 128 + i;
        attn_rows(p, Ks, Vt, (size_t)b * SEQ + t, head, t, i0 >> 4, qb == 0 ? 128 : i, i + 128, true, lane);
    }
    __syncthreads();
}

__device__ __forceinline__ void attn_sample_unit(const Params& p, unsigned char* lds, int u) {
    bf16_t* Ks = (bf16_t*)lds; bf16_t* Vt = (bf16_t*)(lds + ATT_VT_OFF);
    const int tid = opaque_tid(), lane = tid & 63, w = tid >> 6;
    const int sb = u >> 1, kvh = u & 1;
    const bf16_t* KA = (const bf16_t*)(p.ws + WS_KA); const bf16_t* VA = (const bf16_t*)(p.ws + WS_VA);
    const float* rope = (const float*)(p.ws + WS_ROPE);
#pragma unroll
    for (int it = 0; it < 2; ++it) {
        const int j = it * 128 + w * 16 + (lane >> 2), f = lane & 3;
        if (j < 144) {
            const int l = (j >= 128 && j < 136) ? j - 128 : 0;
            const bf16_t* kp = KA + ((size_t)MP + sb * 8 + l) * 128 + kvh * 64 + f * 8;
            float a[8], c[8];
            unpack8(*(const u32x4*)kp, a); unpack8(*(const u32x4*)(kp + 32), c);
            norm_rope16(a, c, p.in[12], rope + (size_t)(8192 + l) * 64, f, 1, 2);
            if (j < 128) { const float* cp = p.in[2] + (((size_t)sb * 128 + j) * 2 + kvh) * 64 + f * 8;
                const f32x4 c0 = *(const f32x4*)cp, c1 = *(const f32x4*)(cp + 4), c2 = *(const f32x4*)(cp + 32), c3 = *(const f32x4*)(cp + 36);
                a[0] = c0.x; a[1] = c0.y; a[2] = c0.z; a[3] = c0.w; a[4] = c1.x; a[5] = c1.y; a[6] = c1.z; a[7] = c1.w;
                c[0] = c2.x; c[1] = c2.y; c[2] = c2.z; c[3] = c2.w; c[4] = c3.x; c[5] = c3.y; c[6] = c3.z; c[7] = c3.w; }
            else if (j >= 136) {
#pragma unroll
                for (int q = 0; q < 8; ++q) { a[q] = 0.f; c[q] = 0.f; } }
            *(u32x4*)(Ks + j * KS_STRIDE + f * 8) = pack8(a); *(u32x4*)(Ks + j * KS_STRIDE + 32 + f * 8) = pack8(c);
            if (j >= 8 && j < 136) { float* op = p.out + O_SWK + (((size_t)sb * 128 + (j - 8)) * 2 + kvh) * 64 + f * 8;
                *(f32x4*)op = (f32x4){a[0], a[1], a[2], a[3]}; *(f32x4*)(op + 4) = (f32x4){a[4], a[5], a[6], a[7]};
                *(f32x4*)(op + 32) = (f32x4){c[0], c[1], c[2], c[3]}; *(f32x4*)(op + 36) = (f32x4){c[4], c[5], c[6], c[7]}; }
        }
    }
#pragma unroll
    for (int it = 0; it < 3; ++it) {
        const int idx = tid + 512 * it, j = idx >> 3, ch = idx & 7;
        if (j < 144) {
            float v[8];
            if (j < 128) { const float* cp = p.in[3] + (((size_t)sb * 128 + j) * 2 + kvh) * 64 + ch * 8;
                const f32x4 c0 = *(const f32x4*)cp, c1 = *(const f32x4*)(cp + 4);
                v[0] = c0.x; v[1] = c0.y; v[2] = c0.z; v[3] = c0.w; v[4] = c1.x; v[5] = c1.y; v[6] = c1.z; v[7] = c1.w; }
            else if (j < 136) unpack8(*(const u32x4*)(VA + ((size_t)MP + sb * 8 + (j - 128)) * 128 + kvh * 64 + ch * 8), v);
            else {
#pragma unroll
                for (int q = 0; q < 8; ++q) v[q] = 0.f; }
            const u32x4 pv = pack8(v);
            bf16_t* vp = Vt + (ch * 8) * VT_STRIDE + j;
            vp[0] = (bf16_t)(pv.x & 0xffff); vp[VT_STRIDE] = (bf16_t)(pv.x >> 16); vp[2 * VT_STRIDE] = (bf16_t)(pv.y & 0xffff); vp[3 * VT_STRIDE] = (bf16_t)(pv.y >> 16);
            vp[4 * VT_STRIDE] = (bf16_t)(pv.z & 0xffff); vp[5 * VT_STRIDE] = (bf16_t)(pv.z >> 16); vp[6 * VT_STRIDE] = (bf16_t)(pv.w & 0xffff); vp[7 * VT_STRIDE] = (bf16_t)(pv.w >> 16);
            if (j >= 8 && j < 136) { float* op = p.out + O_SWV + (((size_t)sb * 128 + (j - 8)) * 2 + kvh) * 64 + ch * 8;
                *(f32x4*)op = (f32x4){v[0], v[1], v[2], v[3]}; *(f32x4*)(op + 4) = (f32x4){v[4], v[5], v[6], v[7]}; }
        }
    }
    __syncthreads();
    if (w < 2) {
        const int q = lane & 15, l = q & 7, head = kvh * 4 + w * 2 + (q >> 3);
        attn_rows(p, Ks, Vt, (size_t)MP + sb * 8 + l, head, 8192 + l, 0, l, l + 128, true, lane);
    }
    __syncthreads();
}

constexpr int G_BC = 0, G_TOT = 16640, G_QT = 18688, G_KT = 27904, G_VT = 37120, G_ST = 55552, G_AM = 73984, G_RED = 83200, G_KT2 = 83712, G_VS = 92928, G_LRS = 110336;
constexpr int GS = 72, VSS = 136;

__device__ __forceinline__ void gla_unit_info(int u, size_t& tok0, int& L, int& h) {
    if (u < 1024) { const int b = u >> 9, c = (u >> 2) & 127; h = u & 3; tok0 = (size_t)b * SEQ + c * 64; L = 64; }
    else { const int v = u - 1024; h = v & 3; tok0 = (size_t)MP + (v >> 2) * 8; L = 8; }
}
struct GlaRaw { u32x4 lr, q, k, v0, v1; float s[16]; u32x2 z[4]; };
template <int MODE> __device__ __forceinline__ void gla_load(const Params& p, int u, GlaRaw& R, int tid) {
    size_t tok0; int L, h; gla_unit_info(u, tok0, L, h);
    const int tok = tid >> 3, c = tid & 7; const bool ok = tok < L; const u32x4 z4 = {0u, 0u, 0u, 0u};
    R.lr = z4;
    if (tid < 128 && (tid >> 1) < L) R.lr = *(const u32x4*)((const bf16_t*)(p.ws + WS_LR) + (tok0 + (tid >> 1)) * 128 + (tid & 1) * 8);
    R.k = z4; R.v0 = z4; R.v1 = z4; R.q = z4;
    if (ok) { R.k = *(const u32x4*)((const bf16_t*)(p.ws + WS_KG) + (tok0 + tok) * 256 + h * 64 + c * 8);
        const bf16_t* vp = (const bf16_t*)(p.ws + WS_VG) + (tok0 + tok) * 512 + h * 128 + c * 16;
        R.v0 = *(const u32x4*)vp; R.v1 = *(const u32x4*)(vp + 8);
        if (MODE & 2) R.q = *(const u32x4*)((const bf16_t*)(p.ws + WS_QG) + (tok0 + tok) * 256 + h * 64 + c * 8); }
    if (MODE & 2) {
        const float* Sp = (u < 1024 ? (const float*)(p.ws + WS_DS) + (size_t)u * 8192 : p.in[4] + (size_t)(u - 1024) * 8192) + (tid & 127) + (tid >> 7) * 16 * 128;
#pragma unroll
        for (int i = 0; i < 16; ++i) R.s[i] = Sp[i * 128];
        const int lane = tid & 63, w = tid >> 6, ti = (w & 3) * 16 + (lane & 15);
        const bf16_t* zp = (const bf16_t*)(p.ws + WS_ZG) + (tok0 + min(ti, L - 1)) * 512 + h * 128 + (w >> 2) * 64 + (lane >> 4) * 4;
#pragma unroll
        for (int d4 = 0; d4 < 4; ++d4) R.z[d4] = *(const u32x2*)(zp + d4 * 16);
    }
}
template <int MODE> __device__ __forceinline__ void gla_process(const Params& p, unsigned char* lds, int u, GlaRaw& R, int unext) {
    size_t tok0; int L, h; gla_unit_info(u, tok0, L, h);
    const int tid = opaque_tid(), lane = tid & 63, w = tid >> 6, fr = lane & 15, fq = lane >> 4;
    float* Bc = (float*)(lds + G_BC); float* TOT = (float*)(lds + G_TOT);
    bf16_t* QS = (bf16_t*)(lds + G_QT); bf16_t* KS = (bf16_t*)(lds + G_KT); bf16_t* VS = (bf16_t*)(lds + G_VS); bf16_t* LRS = (bf16_t*)(lds + G_LRS);
    { const int tok = tid >> 3, c = tid & 7;
      if (tid < 128) *(u32x4*)(LRS + (tid >> 1) * 16 + (tid & 1) * 8) = R.lr;
      *(u32x4*)(KS + tok * GS + c * 8) = R.k;
      if (MODE & 2) *(u32x4*)(QS + tok * GS + c * 8) = R.q;
      *(u32x4*)(VS + tok * VSS + c * 16) = R.v0; *(u32x4*)(VS + tok * VSS + c * 16 + 8) = R.v1; }
    float sreg[16]; u32x2 zreg[4];
    if (MODE & 2) {
#pragma unroll
        for (int i = 0; i < 16; ++i) sreg[i] = R.s[i];
#pragma unroll
        for (int i = 0; i < 4; ++i) zreg[i] = R.z[i]; }
    __syncthreads();
    const int k = tid & 63, tg = tid >> 6;
    { const float* wg = p.in[14] + h * 64 + k;
      float wr[16];
#pragma unroll
      for (int r = 0; r < 16; ++r) wr[r] = wg[r * 256];
      const float bias = p.in[15][h * 64 + k];
      float cs[8]; float run = 0.f;
#pragma unroll
      for (int i = 0; i < 8; ++i) {
          const int tt = tg * 8 + i; float la = 0.f;
          if (tt < L) {
              const u32x4 l0 = *(const u32x4*)(LRS + tt * 16), l1 = *(const u32x4*)(LRS + tt * 16 + 8);
              float g = bias;
              g += bflo(l0.x) * wr[0] + bfhi(l0.x) * wr[1] + bflo(l0.y) * wr[2] + bfhi(l0.y) * wr[3] + bflo(l0.z) * wr[4] + bfhi(l0.z) * wr[5] + bflo(l0.w) * wr[6] + bfhi(l0.w) * wr[7];
              g += bflo(l1.x) * wr[8] + bfhi(l1.x) * wr[9] + bflo(l1.y) * wr[10] + bfhi(l1.y) * wr[11] + bflo(l1.z) * wr[12] + bfhi(l1.z) * wr[13] + bflo(l1.w) * wr[14] + bfhi(l1.w) * wr[15];
              la = (fminf(g, 0.f) - __logf(1.f + __expf(-fabsf(g)))) * (1.f / 16.f);
          }
          run += la; cs[i] = run;
      }
      TOT[tg * 64 + k] = run;
      __syncthreads();
      float pre = 0.f;
#pragma unroll
      for (int j = 0; j < 8; ++j) if (j < tg) pre += TOT[j * 64 + k];
#pragma unroll
      for (int i = 0; i < 8; ++i) Bc[(tg * 8 + i) * 65 + k] = pre + cs[i];
      __syncthreads(); }
    { const float bl = Bc[63 * 65 + k], bm = Bc[31 * 65 + k];
      float kd[8];
#pragma unroll
      for (int i = 0; i < 8; ++i) { const int tt = tg * 8 + i; const float bb = Bc[tt * 65 + k]; const float kv = bf2f(KS[tt * GS + k]);
          if (MODE & 1) kd[i] = kv * __expf(bl - bb);
          if (MODE & 2) { const float qv = bf2f(QS[tt * GS + k]);
              QS[tt * GS + k] = (bf16_t)(pk2(qv * __expf(bb - bm), 0.f) & 0xffff); KS[tt * GS + k] = (bf16_t)(pk2(kv * __expf(bm - bb), 0.f) & 0xffff); } }
      if (MODE & 1) *(u32x4*)((bf16_t*)(lds + G_KT2) + k * GS + tg * 8) = pack8(kd); }
    { const int dv = tid & 127, t4 = tid >> 7; unsigned wv[8];
#pragma unroll
      for (int i = 0; i < 8; ++i) wv[i] = (unsigned)VS[(t4 * 16 + 2 * i) * VSS + dv] | ((unsigned)VS[(t4 * 16 + 2 * i + 1) * VSS + dv] << 16);
      bf16_t* VT = (bf16_t*)(lds + G_VT) + dv * GS + t4 * 16;
      *(u32x4*)VT = (u32x4){wv[0], wv[1], wv[2], wv[3]}; *(u32x4*)(VT + 8) = (u32x4){wv[4], wv[5], wv[6], wv[7]};
      if (MODE & 2) { float v[16];
#pragma unroll
          for (int i = 0; i < 16; ++i) v[i] = sreg[i] * __expf(Bc[31 * 65 + t4 * 16 + i]);
          bf16_t* ST = (bf16_t*)(lds + G_ST) + dv * GS + t4 * 16;
          u32x4 w0, w1; w0.x = pk2(v[0], v[1]); w0.y = pk2(v[2], v[3]); w0.z = pk2(v[4], v[5]); w0.w = pk2(v[6], v[7]);
          w1.x = pk2(v[8], v[9]); w1.y = pk2(v[10], v[11]); w1.z = pk2(v[12], v[13]); w1.w = pk2(v[14], v[15]);
          *(u32x4*)ST = w0; *(u32x4*)(ST + 8) = w1; } }
    if (unext >= 0) gla_load<MODE>(p, unext, R, tid);
    __syncthreads();
    if (MODE & 1) {
        const bf16_t* VT = (const bf16_t*)(lds + G_VT) + (w * 16 + fr) * GS + fq * 8;
        const bf16x8 a0 = *(const bf16x8*)VT, a1 = *(const bf16x8*)(VT + 32);
#pragma unroll
        for (int kt = 0; kt < 4; ++kt) {
            const bf16_t* KT = (const bf16_t*)(lds + G_KT2) + (kt * 16 + fr) * GS + fq * 8;
            f32x4 acc = {0.f, 0.f, 0.f, 0.f};
            acc = mfma16(a0, *(const bf16x8*)KT, acc); acc = mfma16(a1, *(const bf16x8*)(KT + 32), acc);
            const int kk = kt * 16 + fr, dv = w * 16 + fq * 4;
            if (u < 1024) *(f32x4*)((float*)(p.ws + WS_DS) + (size_t)u * 8192 + kk * 128 + dv) = acc;
            else { const size_t so = ((size_t)(u - 1024) * 64 + kk) * 128 + dv;
                const float d = __expf(Bc[63 * 65 + kk]); const f32x4 s0 = *(const f32x4*)(p.in[4] + so);
                *(f32x4*)(p.out + O_SGS + so) = s0 * d + acc; }
        }
        if (u < 1024 && tid < 64) ((float*)(p.ws + WS_DEC))[(size_t)u * 64 + tid] = __expf(Bc[63 * 65 + tid]);
    }
    if (MODE & 2) {
        const int tt = w & 3, hh = w >> 2;
        const bf16_t* QTr = QS + (tt * 16 + fr) * GS + fq * 8;
        const bf16x8 bq0 = *(const bf16x8*)QTr, bq1 = *(const bf16x8*)(QTr + 32);
#pragma unroll
        for (int q = 0; q < 2; ++q) { const int st = hh * 2 + q;
            const bf16_t* KTr = KS + (st * 16 + fr) * GS + fq * 8;
            f32x4 acc = {0.f, 0.f, 0.f, 0.f};
            acc = mfma16(*(const bf16x8*)KTr, bq0, acc); acc = mfma16(*(const bf16x8*)(KTr + 32), bq1, acc);
            const int ti = tt * 16 + fr, s0 = st * 16 + fq * 4;
            u32x2 wv; wv.x = pk2(s0 <= ti ? acc[0] : 0.f, s0 + 1 <= ti ? acc[1] : 0.f); wv.y = pk2(s0 + 2 <= ti ? acc[2] : 0.f, s0 + 3 <= ti ? acc[3] : 0.f);
            *(u32x2*)((bf16_t*)(lds + G_AM) + ti * GS + s0) = wv; }
        __syncthreads();
        const bf16_t* AMr = (const bf16_t*)(lds + G_AM) + (tt * 16 + fr) * GS + fq * 8;
        const bf16x8 ba0 = *(const bf16x8*)AMr, ba1 = *(const bf16x8*)(AMr + 32);
        f32x4 o[4]; float ss = 0.f;
#pragma unroll
        for (int d4 = 0; d4 < 4; ++d4) { const int row = (hh * 4 + d4) * 16 + fr;
            const bf16_t* VT = (const bf16_t*)(lds + G_VT) + row * GS + fq * 8; const bf16_t* ST = (const bf16_t*)(lds + G_ST) + row * GS + fq * 8;
            f32x4 acc = {0.f, 0.f, 0.f, 0.f};
            acc = mfma16(*(const bf16x8*)VT, ba0, acc); acc = mfma16(*(const bf16x8*)(VT + 32), ba1, acc);
            acc = mfma16(*(const bf16x8*)ST, bq0, acc); acc = mfma16(*(const bf16x8*)(ST + 32), bq1, acc);
            o[d4] = acc; ss += (acc[0] * acc[0] + acc[1] * acc[1]) + (acc[2] * acc[2] + acc[3] * acc[3]); }
        ss += __shfl_xor(ss, 16); ss += __shfl_xor(ss, 32);
        float* RED = (float*)(lds + G_RED);
        if (fq == 0) RED[hh * 64 + tt * 16 + fr] = ss;
        __syncthreads();
        const float rstd = rsqrtf((RED[tt * 16 + fr] + RED[64 + tt * 16 + fr]) * (1.f / 128.f) + EPS);
        const int ti = tt * 16 + fr;
        if (ti < L) {
            const size_t tok = tok0 + ti;
#pragma unroll
            for (int d4 = 0; d4 < 4; ++d4) { const int dv = (hh * 4 + d4) * 16 + fq * 4;
                const f32x4 g = *(const f32x4*)(p.in[16] + dv);
                const u32x2 z = zreg[d4];
                u32x2 wv; wv.x = pk2(o[d4][0] * rstd * g.x * bflo(z.x), o[d4][1] * rstd * g.y * bfhi(z.x));
                wv.y = pk2(o[d4][2] * rstd * g.z * bflo(z.y), o[d4][3] * rstd * g.w * bfhi(z.y));
                *(u32x2*)((bf16_t*)(p.ws + WS_OG) + tok * 512 + h * 128 + dv) = wv; }
        }
    }
    __syncthreads();
}
template <int MODE> __device__ __forceinline__ void gla_units(const Params& p, unsigned char* lds, int ubase, int uend) {
    const int tid = opaque_tid();
    int u = ubase + blockIdx.x;
    if (u >= uend) return;
    GlaRaw R; gla_load<MODE>(p, u, R, tid);
    for (; u < uend; u += gridDim.x) { const int un = u + gridDim.x; gla_process<MODE>(p, lds, u, R, un < uend ? un : -1); }
}
__device__ __forceinline__ void gla_scan_dummy(const Params& p) {
    if (threadIdx.x >= 256) return;
    const int e = blockIdx.x * 256 + threadIdx.x;
    if (e >= 65536) return;
    const int b = e >> 15, h = (e >> 13) & 3, k = (e >> 7) & 63, dv = e & 127;
    float* DS = (float*)(p.ws + WS_DS); const float* DEC = (const float*)(p.ws + WS_DEC);
    float S = 0.f;
#pragma unroll 8
    for (int c = 0; c < 128; ++c) { const size_t u = (size_t)b * 512 + c * 4 + h;
        const float d = DEC[u * 64 + k]; float* sp = DS + u * 8192 + k * 128 + dv; const float ds = *sp; *sp = ds; S = d * S + ds; }
    if (S == 123.456f) p.out[O_PGS + e] = S;
}
__device__ __forceinline__ void gla_scan(const Params& p) {
    if (threadIdx.x >= 256) return;
    const int e = blockIdx.x * 256 + threadIdx.x;
    if (e >= 65536) return;
    const int b = e >> 15, h = (e >> 13) & 3, k = (e >> 7) & 63, dv = e & 127;
    float* DS = (float*)(p.ws + WS_DS); const float* DEC = (const float*)(p.ws + WS_DEC);
    float S = 0.f;
#pragma unroll 1
    for (int c0 = 0; c0 < 128; c0 += 32) {
        float d[32], ds[32];
#pragma unroll
        for (int i = 0; i < 32; ++i) { const size_t u = (size_t)b * 512 + (c0 + i) * 4 + h; d[i] = DEC[u * 64 + k]; ds[i] = DS[u * 8192 + k * 128 + dv]; }
#pragma unroll
        for (int i = 0; i < 32; ++i) { const size_t u = (size_t)b * 512 + (c0 + i) * 4 + h; DS[u * 8192 + k * 128 + dv] = S; S = d[i] * S + ds[i]; }
    }
    p.out[O_PGS + e] = S;
}

template <int KK> __device__ __forceinline__ void small_tile_acc(const bf16_t* A, int lda, const bf16_t* Bt, int ldb, int row0, int col0, f32x4 (&acc)[2], int lane, int w) {
    const int fr = lane & 15, fq = lane >> 4, rt = w & 3, ch = w >> 2;
    const bf16_t* ap = A + (size_t)(row0 + rt * 16 + fr) * lda + fq * 8;
    const bf16_t* bp0 = Bt + (size_t)(col0 + ch * 32 + fr) * ldb + fq * 8;
    const bf16_t* bp1 = bp0 + (size_t)16 * ldb;
#pragma unroll 8
    for (int k = 0; k < KK; k += 32) {
        const bf16x8 a = *(const bf16x8*)(ap + k), b0 = *(const bf16x8*)(bp0 + k), b1 = *(const bf16x8*)(bp1 + k);
        acc[0] = mfma16(b0, a, acc[0]); acc[1] = mfma16(b1, a, acc[1]);
    }
}
__device__ __forceinline__ void small_merge_tiles(const Params& p) {
    const int tid = opaque_tid(), lane = tid & 63, w = tid >> 6, fr = lane & 15, fq = lane >> 4;
    for (int t = blockIdx.x; t < 256; t += gridDim.x) {
        const int row0 = MP + (t >> 4) * 64, col0 = (t & 15) * 64;
        f32x4 aa[2] = {{0.f, 0.f, 0.f, 0.f}, {0.f, 0.f, 0.f, 0.f}}, ag[2] = {{0.f, 0.f, 0.f, 0.f}, {0.f, 0.f, 0.f, 0.f}};
        small_tile_acc<512>((const bf16_t*)(p.ws + WS_OA), 512, (const bf16_t*)(p.ws + WS_WBA), 512, row0, col0, aa, lane, w);
        small_tile_acc<512>((const bf16_t*)(p.ws + WS_OG), 512, (const bf16_t*)(p.ws + WS_WBG), 512, row0, col0, ag, lane, w);
        const size_t o = (size_t)(row0 + (w & 3) * 16 + fr) * 1024 + col0 + (w >> 2) * 32 + fq * 4;
#pragma unroll
        for (int nt = 0; nt < 2; ++nt) {
            const u32x2 ma = *(const u32x2*)((const bf16_t*)(p.ws + WS_MA) + o + nt * 16), mg = *(const u32x2*)((const bf16_t*)(p.ws + WS_MG) + o + nt * 16);
            u32x2 wv; wv.x = pk2(bflo(ma.x) * aa[nt][0] + bflo(mg.x) * ag[nt][0], bfhi(ma.x) * aa[nt][1] + bfhi(mg.x) * ag[nt][1]);
            wv.y = pk2(bflo(ma.y) * aa[nt][2] + bflo(mg.y) * ag[nt][2], bfhi(ma.y) * aa[nt][3] + bfhi(mg.y) * ag[nt][3]);
            *(u32x2*)((bf16_t*)(p.ws + WS_MRG) + o + nt * 16) = wv; }
    }
}
__device__ __forceinline__ void small_out_tiles(const Params& p) {
    const int tid = opaque_tid(), lane = tid & 63, w = tid >> 6, fr = lane & 15, fq = lane >> 4;
    for (int t = blockIdx.x; t < 256; t += gridDim.x) {
        const int row0 = MP + (t >> 4) * 64, col0 = (t & 15) * 64;
        f32x4 acc[2] = {{0.f, 0.f, 0.f, 0.f}, {0.f, 0.f, 0.f, 0.f}};
        small_tile_acc<1024>((const bf16_t*)(p.ws + WS_MRG), 1024, (const bf16_t*)(p.ws + WS_WOUT), 1024, row0, col0, acc, lane, w);
        const int row = row0 + (w & 3) * 16 + fr, c = col0 + (w >> 2) * 32 + fq * 4;
        const float* xrow = p.in[1] + (size_t)(row - MP) * 1024; const float* grow = (const float*)(p.ws + WS_MOD) + (size_t)mod_row(row) * 3072 + 2048;
#pragma unroll
        for (int nt = 0; nt < 2; ++nt) { const f32x4 x4 = *(const f32x4*)(xrow + c + nt * 16), g4 = *(const f32x4*)(grow + c + nt * 16);
            *(f32x4*)(p.out + O_Y + (size_t)row * 1024 + c + nt * 16) = x4 + g4 * acc[nt]; }
    }
}

__global__ void __launch_bounds__(512) mega_fwd(Params p) {
    extern __shared__ __attribute__((aligned(16))) unsigned char lds[];
    cg::grid_group grid = cg::this_grid();
    const int lo = p.ph_lo, hi = p.ph_hi;
#define IN(k) (lo <= (k) && (k) < hi)
    PG8_LAS unsigned char* glds = (PG8_LAS unsigned char*)lds;
    volatile LAS unsigned* xst = (volatile LAS unsigned*)(glds + 131072);
    if (threadIdx.x == 0) { xst[0] = 0u; xst[1] = 0u; }
    __syncthreads();
    const XcdBarrier xbar = xcd_barrier_post((unsigned*)(p.ws + WS_BAR), xst);
#define SEAM(k) do { if (IN(k) && IN((k) + 1)) xcd_barrier(xbar); } while (0)
#ifndef PROBE_MASK
#define PROBE_MASK 0
#endif
#define REP(bit) ((((PROBE_MASK) >> (bit)) & 1) + 1)
    if (IN(0)) for (int rep = 0; rep < REP(0); ++rep) phase0(p, lds);
    SEAM(0);
    if (REP(11) > 1) { grid.sync(); grid.sync(); grid.sync(); grid.sync(); }
    if (REP(12) > 1) { xcd_barrier(xbar); xcd_barrier(xbar); xcd_barrier(xbar); xcd_barrier(xbar); }
    if (IN(1)) for (int rep = 0; rep < REP(1); ++rep) { phase0b(p, lds); phase1(p); }
    SEAM(1);
    if (IN(2)) for (int rep = 0; rep < REP(2); ++rep) { pg8::Gemm g{(const bf16_t*)(p.ws + WS_H), (const bf16_t*)(p.ws + WS_WIN), MT, NINP, 1024}; pg8::StaticOrder S; S.init(MT, NINP, gridDim.x, blockIdx.x);
        EpiProj E{p.ws}; pg8::gemm_phase<EpiProj, pg8::StaticOrder, true, true>(glds, g, S, E); }
    SEAM(2);
    if (IN(3)) {
        for (int u = blockIdx.x; u < 512; u += gridDim.x) {
            if (u < 256) { for (int rep = 0; rep < REP(3); ++rep) attn_prompt_unit(p, lds, u); }
            else { for (int rep = 0; rep < REP(4); ++rep) attn_sample_unit(p, lds, u - 256); }
        }
        for (int rep = 0; rep < REP(5); ++rep) gla_units<1>(p, lds, 0, 1024);
        for (int rep = 0; rep < REP(10); ++rep) gla_units<3>(p, lds, 1024, 1536);
    }
    SEAM(3);
    if (IN(4)) { gla_scan(p); if (REP(9) > 1) gla_scan_dummy(p); }
    SEAM(4);
    if (IN(5)) for (int rep = 0; rep < REP(6); ++rep) gla_units<2>(p, lds, 0, 1024);
    SEAM(5);
    if (IN(6)) for (int rep = 0; rep < REP(7); ++rep) {
        pg8::StaticOrder S; S.init(MP, 1024, gridDim.x, blockIdx.x);
        { pg8::Gemm g{(const bf16_t*)(p.ws + WS_OA), (const bf16_t*)(p.ws + WS_WBA), MP, 1024, 512};
          EpiBranch<0> E{(const bf16_t*)(p.ws + WS_MA), nullptr, (bf16_t*)(p.ws + WS_TMP)};
          pg8::gemm_phase<EpiBranch<0>, pg8::StaticOrder, true, true>(glds, g, S, E); }
        { pg8::Gemm g{(const bf16_t*)(p.ws + WS_OG), (const bf16_t*)(p.ws + WS_WBG), MP, 1024, 512};
          EpiBranch<1> E{(const bf16_t*)(p.ws + WS_MG), (const bf16_t*)(p.ws + WS_TMP), (bf16_t*)(p.ws + WS_MRG)};
          pg8::gemm_phase<EpiBranch<1>, pg8::StaticOrder, true, true>(glds, g, S, E); }
        small_merge_tiles(p);
    }
    SEAM(6);
    if (IN(7)) for (int rep = 0; rep < REP(8); ++rep) { pg8::Gemm g{(const bf16_t*)(p.ws + WS_MRG), (const bf16_t*)(p.ws + WS_WOUT), MP, 1024, 1024}; pg8::StaticOrder S; S.init(MP, 1024, gridDim.x, blockIdx.x);
        EpiOut E{p.in[0], p.in[1], (const float*)(p.ws + WS_MOD), p.out + O_Y};
        pg8::gemm_phase<EpiOut, pg8::StaticOrder, true, true>(glds, g, S, E);
        small_out_tiles(p); }
    if (hi > 1000) grid.sync();
#undef IN
#undef SEAM
}

constexpr int LDS_BYTES = 131072 + 16;
#ifndef N_LAUNCH_MODE
#define N_LAUNCH_MODE 1
#endif

extern "C" void kernel_launch(void* const* d_in, const int* in_sizes, int n_in, void* d_out, int out_size, void* d_ws, size_t ws_size, hipStream_t stream) {
    static int grid = 0;
    if (grid == 0) {
        if (n_in != 20 || ws_size < WS_END) { fprintf(stderr, "kernel_launch: unexpected n_in %d / ws_size %zu (need %zu)\n", n_in, ws_size, (size_t)WS_END); grid = -1; return; }
        int dev = 0, cus = 0, per_cu = 0;
        hipGetDevice(&dev);
        hipDeviceGetAttribute(&cus, hipDeviceAttributeMultiprocessorCount, dev);
        if (hipFuncSetAttribute((const void*)mega_fwd, hipFuncAttributeMaxDynamicSharedMemorySize, LDS_BYTES) != hipSuccess) { fprintf(stderr, "kernel_launch: hipFuncSetAttribute failed\n"); grid = -1; return; }
        if (hipOccupancyMaxActiveBlocksPerMultiprocessor(&per_cu, (const void*)mega_fwd, 512, LDS_BYTES) != hipSuccess || per_cu < 1) { fprintf(stderr, "kernel_launch: occupancy query gives %d\n", per_cu); per_cu = 1; }
        (void)hipGetLastError();
        grid = cus * 1;
        if (grid > cus * per_cu) grid = cus * per_cu;
    }
    if (grid < 0) return;
    Params p{};
    for (int i = 0; i < 20; ++i) p.in[i] = (const float*)d_in[i];
    p.out = (float*)d_out; p.ws = (unsigned char*)d_ws;
    for (int i = 0; i < 32; ++i) { const float e = (float)i / 32.0f; const float pw = powf(10000.0f, e); p.inv[i] = 1.0f / pw; }
    if (hipMemsetAsync((unsigned char*)d_ws + WS_BAR, 0, 16384, stream) != hipSuccess) { fprintf(stderr, "kernel_launch: memset of barrier words failed\n"); return; }
#if N_LAUNCH_MODE == 1
    p.ph_lo = 0; p.ph_hi = 8;
    void* args[] = {&p};
    hipError_t e = hipLaunchCooperativeKernel((const void*)mega_fwd, dim3(grid), dim3(512), args, LDS_BYTES, stream);
    if (e != hipSuccess) fprintf(stderr, "cooperative launch failed: %s (grid %d)\n", hipGetErrorString(e), grid);
#else
    for (int ph = 0; ph < 8; ++ph) { p.ph_lo = ph; p.ph_hi = ph + 1;
        hipLaunchKernelGGL(mega_fwd, dim3(grid), dim3(512), LDS_BYTES, stream, p); }
#endif
}
```

```cpp
#include <hip/hip_runtime.h>
#include <hip/hip_cooperative_groups.h>
#include <cstdio>
#include <cstdint>
#include <cmath>
namespace cg = cooperative_groups;
__device__ __forceinline__ int opaque_tid() { int t = threadIdx.x; asm volatile("" : "+v"(t)); return t; }
#define PROBE_MASK 0
#define PROBE_T -1
namespace pg8 {
#define PG8_LAS __attribute__((address_space(3)))
typedef unsigned short bf16_t;
typedef short bf16x8 __attribute__((ext_vector_type(8)));
typedef float f32x4 __attribute__((ext_vector_type(4)));
typedef unsigned u32x4 __attribute__((ext_vector_type(4)));
constexpr int BM = 256, BK = 64, HALF = 128, HTB = HALF * BK * 2  , STAGE_BYTES = 8 * HTB, NXCD = 8, WGM = 8;

__host__ __device__ __forceinline__ int lds_byte(int r, int c) { const int st = (r >> 4) * 2 + (c >> 5), rr = r & 15, cc = c & 31, ob = rr * 64 + cc * 2; return st * 1024 + (ob ^ (((ob >> 9) & 1) << 5)); }
__host__ __device__ __forceinline__ void stage_rc(int b, int& R, int& C) { const int st = b / 1024, sb = b % 1024, swz = sb ^ (((sb >> 9) & 1) << 5); R = (st >> 1) * 16 + swz / 64; C = (st & 1) * 32 + (swz % 64) / 2; }
__host__ __device__ __forceinline__ int perm32(int rho) { const int n = rho >> 4, i = rho & 15; return 8 * (i >> 2) + 4 * n + (i & 3); }

struct Unit { int pm, pn; };
struct Gemm { const bf16_t* A; const bf16_t* Bt; int M, N, K; };

struct StaticOrder {
    int nM, nN, nwg, G, c;
    __host__ __device__ void init(int M, int N, int G_, int c_) { nM = M / BM; nN = N / BM; nwg = nM * nN; G = G_; c = c_; }
    __host__ __device__ bool next(int i, Unit& u) const {
        const long L = (long)i * G + c; if (L >= nwg) return false;
        int wgid = (int)L; { const int q = nwg / NXCD, r = nwg % NXCD, xcd = wgid % NXCD, off = wgid / NXCD; wgid = (xcd < r ? xcd * (q + 1) : r * (q + 1) + (xcd - r) * q) + off; }
        const int nig = WGM * nN, gid = wgid / nig, fm = gid * WGM, gsz = (nM - fm) < WGM ? (nM - fm) : WGM;
        u.pm = fm + ((wgid % nig) % gsz); u.pn = (wgid % nig) / gsz; return true;
    }
    __device__ __forceinline__ void a_ready(const Unit&) const {}
    __device__ __forceinline__ void done(const Unit&) const {}
};
__device__ __forceinline__ unsigned cvt_pk_bf16(float lo, float hi) { unsigned r; asm volatile("v_cvt_pk_bf16_f32 %0, %1, %2" : "=v"(r) : "v"(lo), "v"(hi)); return r; }
typedef float f32x2 __attribute__((ext_vector_type(2)));
template <class Epi, class Sched, bool ALIGN_EPI = false, bool SP2 = false>
__device__ __forceinline__ void gemm_phase(PG8_LAS unsigned char* lds, const Gemm g, const Sched& S, const Epi& E) {
    const int tid = opaque_tid(), wid = __builtin_amdgcn_readfirstlane(tid >> 6), lane = tid & 63, wr = wid >> 2, wc = wid & 3, fr = lane & 15, fq = lane >> 4;
    const int K = g.K, nt = K / BK;
    unsigned voffA[2], voffB[2];
#pragma unroll
    for (int i = 0; i < 2; ++i) { int R, C; stage_rc(tid * 16 + i * 8192, R, C); const int Rb = Epi::PERM ? ((R & ~31) + perm32(R & 31)) : R;
        voffA[i] = (unsigned)(R * K + C) * 2u; voffB[i] = (unsigned)(Rb * K + C) * 2u; }
    const size_t kstep = (size_t)(BK * 2);
    const size_t hstep = (size_t)HALF * K * 2;
    const size_t tstep = 2 * hstep;
    const unsigned ldsw = (unsigned)wid * 1024u;
    const int aoff = lds_byte(wr * 64 + fr, fq * 8), boff = lds_byte(wc * 32 + fr, fq * 8);
#define PG8_SA(b, h) (((b) * 2 + (h)) * HTB)
#define PG8_SB(b, h) ((4 + (b) * 2 + (h)) * HTB)
#define PG8_STAGE(bufoff, gbase, voff) do { _Pragma("unroll") for (int _i = 0; _i < 2; ++_i) \
        __builtin_amdgcn_global_load_lds((const unsigned*)((const char*)(gbase) + (voff)[_i]), (PG8_LAS unsigned*)(lds + (bufoff) + ldsw + _i * 8192), 16, 0, 0); } while (0)
#define PG8_LDA(dst, b, h) do { _Pragma("unroll") for (int m = 0; m < 4; ++m) _Pragma("unroll") for (int k = 0; k < 2; ++k) dst[m][k] = *(const PG8_LAS bf16x8*)(lds + PG8_SA(b, h) + aoff + m * 2048 + k * 1024); } while (0)
#define PG8_LDB(dst, b, h) do { _Pragma("unroll") for (int n = 0; n < 2; ++n) _Pragma("unroll") for (int k = 0; k < 2; ++k) dst[n][k] = *(const PG8_LAS bf16x8*)(lds + PG8_SB(b, h) + boff + n * 2048 + k * 1024); } while (0)
#define PG8_MMA(ai, bj, At, Bt) do { __builtin_amdgcn_s_setprio(1); _Pragma("unroll") for (int m = 0; m < 4; ++m) _Pragma("unroll") for (int n = 0; n < 2; ++n) _Pragma("unroll") for (int k = 0; k < 2; ++k) \
        acc[ai][bj][m][n] = __builtin_amdgcn_mfma_f32_16x16x32_bf16(Bt[n][k], At[m][k], acc[ai][bj][m][n], 0, 0, 0); __builtin_amdgcn_s_setprio(0); } while (0)
#define PG8_WAIT_V(n) asm volatile("s_waitcnt vmcnt(" #n ")" ::: "memory")
#define PG8_WAIT_L(n) asm volatile("s_waitcnt lgkmcnt(" #n ")" ::: "memory")
#define PG8_BAR __builtin_amdgcn_s_barrier()
#define PG8_SCHED __builtin_amdgcn_sched_barrier(0)
    Unit cur, nxt; int ui = 0;
    if (!S.next(0, cur)) return;
    f32x4 acc[2][2][4][2];
#pragma unroll
    for (int a = 0; a < 2; ++a)
#pragma unroll
        for (int b = 0; b < 2; ++b)
#pragma unroll
            for (int m = 0; m < 4; ++m)
#pragma unroll
                for (int n = 0; n < 2; ++n) acc[a][b][m][n] = (f32x4){0.f, 0.f, 0.f, 0.f};
    bf16x8 At[4][2], B0[2][2], B1[2][2];
    const char* cA = (const char*)g.A + (size_t)cur.pm * tstep; const char* cB = (const char*)g.Bt + (size_t)cur.pn * tstep;
    S.a_ready(cur);
    if constexpr (SP2) {
        PG8_STAGE(PG8_SB(0, 0), cB, voffB); PG8_STAGE(PG8_SB(0, 1), cB + hstep, voffB); PG8_STAGE(PG8_SA(0, 0), cA, voffA); PG8_STAGE(PG8_SA(0, 1), cA + hstep, voffA);
        if (wr == 1) PG8_BAR;
        PG8_WAIT_V(2); PG8_BAR;
        PG8_STAGE(PG8_SB(1, 0), cB + kstep, voffB); PG8_STAGE(PG8_SA(1, 0), cA + kstep, voffA); PG8_STAGE(PG8_SB(1, 1), cB + hstep + kstep, voffB);
        PG8_WAIT_V(6); PG8_BAR;
    } else {
        PG8_STAGE(PG8_SB(0, 0), cB, voffB); PG8_STAGE(PG8_SA(0, 0), cA, voffA); PG8_STAGE(PG8_SB(0, 1), cB + hstep, voffB); PG8_STAGE(PG8_SA(0, 1), cA + hstep, voffA);
        if (wr == 1) PG8_BAR;
        PG8_WAIT_V(4); PG8_BAR;
        PG8_STAGE(PG8_SB(1, 0), cB + kstep, voffB); PG8_STAGE(PG8_SA(1, 0), cA + kstep, voffA); PG8_STAGE(PG8_SB(1, 1), cB + hstep + kstep, voffB);
        PG8_WAIT_V(6); PG8_BAR;
    }
    for (;;) {
        const bool has_next = S.next(ui + 1, nxt);
        const char* nA = has_next ? (const char*)g.A + (size_t)nxt.pm * tstep : cA; const char* nB = has_next ? (const char*)g.Bt + (size_t)nxt.pn * tstep : cB;
        for (int t = 0; t < nt; t += 2) {
            const bool last = (t == nt - 2);
            const char* a1 = cA + (size_t)(t + 1) * kstep;
            const char* a2 = last ? nA : cA + (size_t)(t + 2) * kstep; const char* b2 = last ? nB : cB + (size_t)(t + 2) * kstep;
            const char* a3 = a2 + kstep; const char* b3 = b2 + kstep;
            if (last && has_next) S.a_ready(nxt);
            if constexpr (SP2) {
            PG8_LDB(B0, 0, 0); PG8_LDB(B1, 0, 1); PG8_SCHED; PG8_LDA(At, 0, 0); PG8_STAGE(PG8_SA(1, 1), a1 + hstep, voffA);
            PG8_WAIT_V(8); PG8_WAIT_L(0); PG8_BAR; PG8_MMA(0, 0, At, B0); PG8_MMA(0, 1, At, B1); PG8_BAR; PG8_SCHED;
            PG8_LDA(At, 0, 1); PG8_STAGE(PG8_SB(0, 0), b2, voffB); PG8_STAGE(PG8_SB(0, 1), b2 + hstep, voffB); PG8_STAGE(PG8_SA(0, 0), a2, voffA);
            PG8_WAIT_V(8); PG8_WAIT_L(0); PG8_BAR; PG8_MMA(1, 0, At, B0); PG8_MMA(1, 1, At, B1); PG8_BAR; PG8_SCHED;
            PG8_LDB(B0, 1, 0); PG8_LDB(B1, 1, 1); PG8_SCHED; PG8_LDA(At, 1, 0); PG8_STAGE(PG8_SA(0, 1), a2 + hstep, voffA);
            PG8_WAIT_V(8); PG8_WAIT_L(0); PG8_BAR; PG8_MMA(0, 0, At, B0); PG8_MMA(0, 1, At, B1); PG8_BAR; PG8_SCHED;
            PG8_LDA(At, 1, 1); PG8_STAGE(PG8_SB(1, 0), b3, voffB); PG8_STAGE(PG8_SB(1, 1), b3 + hstep, voffB); PG8_STAGE(PG8_SA(1, 0), a3, voffA);
            PG8_WAIT_V(8); PG8_WAIT_L(0); PG8_BAR; PG8_MMA(1, 0, At, B0); PG8_MMA(1, 1, At, B1); PG8_BAR; PG8_SCHED;
            } else {
            PG8_LDB(B0, 0, 0); PG8_SCHED; PG8_LDA(At, 0, 0); PG8_STAGE(PG8_SA(1, 1), a1 + hstep, voffA);
            PG8_WAIT_L(8); PG8_BAR; PG8_WAIT_L(0); PG8_MMA(0, 0, At, B0); PG8_BAR; PG8_SCHED;
            PG8_LDB(B1, 0, 1); PG8_STAGE(PG8_SB(0, 0), b2, voffB);
            PG8_BAR; PG8_WAIT_L(0); PG8_MMA(0, 1, At, B1); PG8_BAR;
            PG8_LDA(At, 0, 1); PG8_STAGE(PG8_SA(0, 0), a2, voffA);
            PG8_BAR; PG8_WAIT_L(0); PG8_MMA(1, 0, At, B0); PG8_BAR; PG8_SCHED;
            PG8_STAGE(PG8_SB(0, 1), b2 + hstep, voffB);
            PG8_WAIT_V(6); PG8_BAR; PG8_MMA(1, 1, At, B1); PG8_BAR;
            PG8_LDB(B0, 1, 0); PG8_SCHED; PG8_LDA(At, 1, 0); PG8_STAGE(PG8_SA(0, 1), a2 + hstep, voffA);
            PG8_WAIT_L(8); PG8_BAR; PG8_WAIT_L(0); PG8_MMA(0, 0, At, B0); PG8_BAR; PG8_SCHED;
            PG8_LDB(B1, 1, 1); PG8_STAGE(PG8_SB(1, 0), b3, voffB);
            PG8_BAR; PG8_WAIT_L(0); PG8_MMA(0, 1, At, B1); PG8_BAR;
            PG8_LDA(At, 1, 1); PG8_STAGE(PG8_SA(1, 0), a3, voffA);
            PG8_BAR; PG8_WAIT_L(0); PG8_MMA(1, 0, At, B0); PG8_BAR; PG8_SCHED;
            PG8_STAGE(PG8_SB(1, 1), b3 + hstep, voffB);
            PG8_WAIT_V(6); PG8_BAR; PG8_MMA(1, 1, At, B1); PG8_BAR;
            }
        }
        if constexpr (ALIGN_EPI) { if (wr == 0) PG8_BAR; }
        if constexpr (!Epi::AFTER_DRAIN) { E(acc, cur, wr, wc, fr, fq); S.done(cur); }
        if (!has_next) break;
        if (!(Epi::CHAIN && (ui & 1) == 0)) {
#pragma unroll
        for (int a = 0; a < 2; ++a)
#pragma unroll
            for (int b = 0; b < 2; ++b)
#pragma unroll
                for (int m = 0; m < 4; ++m)
#pragma unroll
                    for (int n = 0; n < 2; ++n) acc[a][b][m][n] = (f32x4){0.f, 0.f, 0.f, 0.f};
        }
        cur = nxt; cA = nA; cB = nB; ++ui;
        if constexpr (ALIGN_EPI) { if (wr == 1) PG8_BAR; }
    }
    PG8_WAIT_V(0);
    if constexpr (!ALIGN_EPI) { if (wr == 0) PG8_BAR; }
    PG8_BAR;
    if constexpr (Epi::AFTER_DRAIN) { E.fused(acc, cur, wr, wc, fr, fq, lds, wid, lane); S.done(cur); }
#undef PG8_SA
#undef PG8_SB
#undef PG8_STAGE
#undef PG8_LDA
#undef PG8_LDB
#undef PG8_MMA
#undef PG8_WAIT_V
#undef PG8_WAIT_L
#undef PG8_BAR
#undef PG8_SCHED
}
}
#define XB_TMO      128
#define XB_XCNT(j)  (256  + 64 * (j))
#define XB_XSUB(j)  (1280 + 64 * (j))
#define XB_XGEN(j)  (2304 + 64 * (j))
#define XB_TOP      3328
#define XB_TOPGEN   3392
#define XCD_BAR_WORDS 3456
#define XB_SPIN_CAP (1u << 18)
#define LAS __attribute__((address_space(3)))

__device__ __forceinline__ unsigned xb_ld(unsigned* p)              { return __hip_atomic_load(p, __ATOMIC_RELAXED, __HIP_MEMORY_SCOPE_AGENT); }
__device__ __forceinline__ unsigned xb_add(unsigned* p, unsigned v) { return __hip_atomic_fetch_add(p, v, __ATOMIC_RELAXED, __HIP_MEMORY_SCOPE_AGENT); }
__device__ __forceinline__ unsigned xb_xcc_id() { return (unsigned)__builtin_amdgcn_s_getreg((3 << 11) | 20) & 0xFu; }
#define XB_SPIN(cond, bar) do { unsigned _sp = 0; while (cond) { __builtin_amdgcn_s_sleep(1); \
    if ((++_sp & 255u) == 0u) { if (xb_ld(&(bar)[XB_TMO])) break; if (_sp > XB_SPIN_CAP) { atomicAdd(&(bar)[XB_TMO], 1u); break; } } } } while (0)

struct XcdBarrier {
    unsigned* bar; unsigned x;
    volatile LAS unsigned* st;
};

__device__ __forceinline__ XcdBarrier xcd_barrier_post(unsigned* bar, volatile LAS unsigned* st) {
    XcdBarrier b; b.bar = bar; b.x = xb_xcc_id(); b.st = st;
    if (threadIdx.x == 0) (void)xb_add(&bar[XB_XCNT(b.x)], 1u);
    return b;
}
__device__ __forceinline__ void xcd_barrier_complete(unsigned* bar, unsigned x, unsigned& nloc, unsigned& nx) {
    const unsigned G = gridDim.x * gridDim.y * gridDim.z;
    unsigned sum, cnt, mine, sp = 0u;
    for (;;) {
        sum = 0u; cnt = 0u; mine = 0u;
#pragma unroll
        for (unsigned j = 0; j < 16; ++j) { const unsigned c = xb_ld(&bar[XB_XCNT(j)]); sum += c; cnt += (c > 0u) ? 1u : 0u; mine = (j == x) ? c : mine; }
        if (sum == G) break;
        __builtin_amdgcn_s_sleep(1);
        if ((++sp & 255u) == 0u) { if (xb_ld(&bar[XB_TMO])) break; if (sp > XB_SPIN_CAP) { atomicAdd(&bar[XB_TMO], 1u); break; } }
    }
    nloc = mine > 0u ? mine : 1u; nx = cnt > 0u ? cnt : 1u;
}

__device__ __forceinline__ void xcd_barrier(const XcdBarrier& b) {
    asm volatile("s_waitcnt vmcnt(0)" ::: "memory");
    __syncthreads();
    if (threadIdx.x == 0) {
        unsigned* bar = b.bar;
        __builtin_amdgcn_s_waitcnt(0);
        unsigned nloc = b.st[0], nx = b.st[1];
        if (nloc == 0u) { xcd_barrier_complete(bar, b.x, nloc, nx); b.st[0] = nloc; b.st[1] = nx; }
        const unsigned old = xb_add(&bar[XB_XSUB(b.x)], 1u);
        const unsigned gen = old / nloc;
        if (old + 1u == (gen + 1u) * nloc) {
            __builtin_amdgcn_fence(__ATOMIC_RELEASE, "agent");
            asm volatile("s_waitcnt vmcnt(0)" ::: "memory");
            const unsigned og = xb_add(&bar[XB_TOP], 1u);
            const unsigned tg = og / nx;
            if (og + 1u == (tg + 1u) * nx) xb_add(&bar[XB_TOPGEN], 1u);
            else XB_SPIN(xb_ld(&bar[XB_TOPGEN]) == tg, bar);
            __builtin_amdgcn_fence(__ATOMIC_ACQUIRE, "agent");
            xb_add(&bar[XB_XGEN(b.x)], 1u);
            asm volatile("s_waitcnt vmcnt(0)" ::: "memory");
        } else {
            XB_SPIN(xb_ld(&bar[XB_XGEN(b.x)]) == gen, bar);
            __builtin_amdgcn_fence(__ATOMIC_ACQUIRE, "agent");
            asm volatile("s_waitcnt vmcnt(0)" ::: "memory");
        }
    }
    __syncthreads();
}

using pg8::bf16_t; using pg8::bf16x8; using pg8::f32x4; using pg8::u32x4; using pg8::Unit;
typedef unsigned u32x2 __attribute__((ext_vector_type(2)));
typedef float f32x2v __attribute__((ext_vector_type(2)));
typedef __bf16 bf16x2v __attribute__((ext_vector_type(2)));

constexpr int DM = 1024, SEQ = 8192, MP = 16384, MS = 1024, MT = MP + MS;
constexpr int NIN = 4880, NINP = 5120;
constexpr float EPS = 1e-6f;
constexpr float LOG2E = 1.4426950408889634f;

constexpr size_t WS_MOD = 0;
constexpr size_t WS_ROPE = WS_MOD + 1597440;
constexpr size_t WS_WIN = WS_ROPE + 2099200;
constexpr size_t WS_WBA = WS_WIN + 10485760;
constexpr size_t WS_WBG = WS_WBA + 1048576;
constexpr size_t WS_WOUT = WS_WBG + 1048576;
constexpr size_t WS_H = WS_WOUT + 2097152;
constexpr size_t WS_OA = WS_H;
constexpr size_t WS_OG = WS_H + 17825792;
constexpr size_t WS_QA = WS_H + 35651584;
constexpr size_t WS_KA = WS_QA + 17825792;
constexpr size_t WS_VA = WS_KA + 4456448;
constexpr size_t WS_QG = WS_VA + 4456448;
constexpr size_t WS_TMP = WS_QA;
constexpr size_t WS_KG = WS_QG + 8912896;
constexpr size_t WS_VG = WS_KG + 8912896;
constexpr size_t WS_ZG = WS_VG + 17825792;
constexpr size_t WS_MRG = WS_KG;
constexpr size_t WS_ZA = WS_ZG + 17825792;
constexpr size_t WS_MA = WS_ZA + 17825792;
constexpr size_t WS_MG = WS_MA + 35651584;
constexpr size_t WS_LR = WS_MG + 35651584;
constexpr size_t WS_DS = WS_LR + 4456448;
constexpr size_t WS_DEC = WS_DS + 33554432;
constexpr size_t WS_BAR = WS_DEC + 262144;
constexpr size_t WS_CS = WS_BAR + 16384;
constexpr size_t WS_END = WS_CS + 294912;

constexpr size_t O_Y = 0;
constexpr size_t O_PWK = 17825792;
constexpr size_t O_PWV = O_PWK + 32768;
constexpr size_t O_PGS = O_PWV + 32768;
constexpr size_t O_SWK = O_PGS + 65536;
constexpr size_t O_SWV = O_SWK + 2097152;
constexpr size_t O_SGS = O_SWV + 2097152;

struct Params {
    const float* in[20];
    float* out; unsigned char* ws;
    float inv[32];
    int ph_lo, ph_hi;
};

__device__ __forceinline__ unsigned pk2(float lo, float hi) { f32x2v v = {lo, hi}; bf16x2v b = __builtin_convertvector(v, bf16x2v); return __builtin_bit_cast(unsigned, b); }
__device__ __forceinline__ float bflo(unsigned w) { return __uint_as_float(w << 16); }
__device__ __forceinline__ float bfhi(unsigned w) { return __uint_as_float(w & 0xffff0000u); }
__device__ __forceinline__ float bf2f(bf16_t h) { return __uint_as_float((unsigned)h << 16); }
__device__ __forceinline__ float fast_rcp(float x) { return __builtin_amdgcn_rcpf(x); }
__device__ __forceinline__ float sigmoidf_(float x) { return fast_rcp(1.f + __expf(-x)); }
__device__ __forceinline__ float siluf_(float x) { return x * fast_rcp(1.f + __expf(-x)); }
__device__ __forceinline__ float wave_sum(float v) {
#pragma unroll
    for (int o = 1; o < 64; o <<= 1) v += __shfl_xor(v, o);
    return v;
}
__device__ __forceinline__ f32x4 mfma16(bf16x8 a, bf16x8 b, f32x4 c) { return __builtin_amdgcn_mfma_f32_16x16x32_bf16(a, b, c, 0, 0, 0); }
__device__ __forceinline__ void unpack8(const u32x4 w, float (&a)[8]) {
    a[0] = bflo(w.x); a[1] = bfhi(w.x); a[2] = bflo(w.y); a[3] = bfhi(w.y); a[4] = bflo(w.z); a[5] = bfhi(w.z); a[6] = bflo(w.w); a[7] = bfhi(w.w);
}
__device__ __forceinline__ u32x4 pack8(const float (&a)[8]) { u32x4 w; w.x = pk2(a[0], a[1]); w.y = pk2(a[2], a[3]); w.z = pk2(a[4], a[5]); w.w = pk2(a[6], a[7]); return w; }
__device__ __forceinline__ u32x4 pack8s(const float (&a)[8], float sc) { u32x4 w; w.x = pk2(a[0] * sc, a[1] * sc); w.y = pk2(a[2] * sc, a[3] * sc); w.z = pk2(a[4] * sc, a[5] * sc); w.w = pk2(a[6] * sc, a[7] * sc); return w; }
__device__ __forceinline__ int mod_row(int r) { return r < MP ? (r >> 13) : 2 + ((r - MP) >> 3); }

struct EpiProj {
    static constexpr bool PERM = true, AFTER_DRAIN = false, CHAIN = false;
    unsigned char* ws;
    __device__ __forceinline__ void operator()(const f32x4 (&acc)[2][2][4][2], const Unit& u, int wr, int wc, int fr, int fq) const {
        const int row0 = u.pm * 256 + wr * 64 + fr;
#pragma unroll
        for (int bj = 0; bj < 2; ++bj) {
            const int cb = u.pn * 2 + bj;
            size_t off; int ld, cbase, act;
            if (cb < 4) { off = WS_QA; ld = 512; cbase = cb * 128; act = 0; }
            else if (cb == 4) { off = WS_KA; ld = 128; cbase = 0; act = 0; }
            else if (cb == 5) { off = WS_VA; ld = 128; cbase = 0; act = 0; }
            else if (cb < 10) { off = WS_ZA; ld = 512; cbase = (cb - 6) * 128; act = 1; }
            else if (cb < 12) { off = WS_QG; ld = 256; cbase = (cb - 10) * 128; act = 3; }
            else if (cb < 14) { off = WS_KG; ld = 256; cbase = (cb - 12) * 128; act = 0; }
            else if (cb < 18) { off = WS_VG; ld = 512; cbase = (cb - 14) * 128; act = 0; }
            else if (cb < 22) { off = WS_ZG; ld = 512; cbase = (cb - 18) * 128; act = 1; }
            else if (cb < 30) { off = WS_MA; ld = 1024; cbase = (cb - 22) * 128; act = 2; }
            else if (cb < 38) { off = WS_MG; ld = 1024; cbase = (cb - 30) * 128; act = 2; }
            else if (cb == 38) { off = WS_LR; ld = 128; cbase = 0; act = 0; }
            else continue;
            bf16_t* base = (bf16_t*)(ws + off) + cbase + wc * 32 + 8 * fq;
#pragma unroll
            for (int ai = 0; ai < 2; ++ai)
#pragma unroll
                for (int m = 0; m < 4; ++m) {
                    f32x4 v0 = acc[ai][bj][m][0], v1 = acc[ai][bj][m][1];
                    if (act == 1) { for (int j = 0; j < 4; ++j) { v0[j] = siluf_(v0[j]); v1[j] = siluf_(v1[j]); } }
                    else if (act == 2) { for (int j = 0; j < 4; ++j) { v0[j] = sigmoidf_(v0[j]); v1[j] = sigmoidf_(v1[j]); } }
                    else if (act == 3) { v0 = v0 * 0.125f; v1 = v1 * 0.125f; }
                    u32x4 w; w.x = pk2(v0[0], v0[1]); w.y = pk2(v0[2], v0[3]); w.z = pk2(v1[0], v1[1]); w.w = pk2(v1[2], v1[3]);
                    if (cb >= 22 && cb < 38) __builtin_nontemporal_store(w, (u32x4*)(base + (size_t)(row0 + ai * 128 + m * 16) * ld)); else *(u32x4*)(base + (size_t)(row0 + ai * 128 + m * 16) * ld) = w;
                }
        }
    }
};
struct EpiBranch {
    static constexpr bool PERM = true, AFTER_DRAIN = false, CHAIN = true;
    unsigned char* ws;
    __device__ __forceinline__ void operator()(f32x4 (&acc)[2][2][4][2], const Unit& u, int wr, int wc, int fr, int fq) const {
        const bool second = u.pm >= 68;
        const int pm = second ? u.pm - 68 : u.pm, pn = second ? u.pn - 4 : u.pn;
        const size_t o0 = (size_t)(pm * 256 + wr * 64 + fr) * 1024 + pn * 256 + wc * 32 + 8 * fq;
        const bf16_t* ma = (const bf16_t*)(ws + WS_MA) + o0; const bf16_t* mg = (const bf16_t*)(ws + WS_MG) + o0;
        bf16_t* dst = (bf16_t*)(ws + WS_MRG) + o0;
#pragma unroll
        for (int ai = 0; ai < 2; ++ai) {
            u32x4 g[4][2], t[4][2];
#pragma unroll
            for (int m = 0; m < 4; ++m)
#pragma unroll
                for (int bj = 0; bj < 2; ++bj) { const size_t o = (size_t)(ai * 128 + m * 16) * 1024 + bj * 128;
                    g[m][bj] = __builtin_nontemporal_load((const u32x4*)(mg + o)); t[m][bj] = (u32x4){0u, 0u, 0u, 0u}; if (!second) t[m][bj] = __builtin_nontemporal_load((const u32x4*)(ma + o)); }
#pragma unroll
            for (int m = 0; m < 4; ++m)
#pragma unroll
                for (int bj = 0; bj < 2; ++bj) { const size_t o = (size_t)(ai * 128 + m * 16) * 1024 + bj * 128;
                    const u32x4 gg = g[m][bj], tt = t[m][bj];
                    f32x4& v0 = acc[ai][bj][m][0]; f32x4& v1 = acc[ai][bj][m][1];
                    if (!second) {
                        v0[0] *= bflo(tt.x) * fast_rcp(bflo(gg.x)); v0[1] *= bfhi(tt.x) * fast_rcp(bfhi(gg.x)); v0[2] *= bflo(tt.y) * fast_rcp(bflo(gg.y)); v0[3] *= bfhi(tt.y) * fast_rcp(bfhi(gg.y));
                        v1[0] *= bflo(tt.z) * fast_rcp(bflo(gg.z)); v1[1] *= bfhi(tt.z) * fast_rcp(bfhi(gg.z)); v1[2] *= bflo(tt.w) * fast_rcp(bflo(gg.w)); v1[3] *= bfhi(tt.w) * fast_rcp(bfhi(gg.w));
                    } else {
                        u32x4 w; w.x = pk2(v0[0] * bflo(gg.x), v0[1] * bfhi(gg.x)); w.y = pk2(v0[2] * bflo(gg.y), v0[3] * bfhi(gg.y));
                        w.z = pk2(v1[0] * bflo(gg.z), v1[1] * bfhi(gg.z)); w.w = pk2(v1[2] * bflo(gg.w), v1[3] * bfhi(gg.w));
                        *(u32x4*)(dst + o) = w; }
                }
        }
    }
};
struct BranchOrder {
    pg8::StaticOrder base;
    __device__ __forceinline__ bool next(int i, Unit& u) const { if (i >= 2) return false; if (!base.next(0, u)) return false; if (i == 1) { u.pm += 68; u.pn += 4; } return true; }
    __device__ __forceinline__ void a_ready(const Unit&) const {}
    __device__ __forceinline__ void done(const Unit&) const {}
};
struct EpiOut {
    static constexpr bool PERM = false, AFTER_DRAIN = false, CHAIN = false;
    const float* xp; const float* mod; float* out;
    __device__ __forceinline__ void operator()(const f32x4 (&acc)[2][2][4][2], const Unit& u, int wr, int wc, int fr, int fq) const {
        const int col0 = u.pn * 256 + wc * 32 + 4 * fq;
        const float* grow = mod + (size_t)((u.pm * 256) >> 13) * 3072 + 2048 + col0;
        f32x4 g4[2][2];
#pragma unroll
        for (int bj = 0; bj < 2; ++bj)
#pragma unroll
            for (int n = 0; n < 2; ++n) g4[bj][n] = *(const f32x4*)(grow + bj * 128 + n * 16);
        const size_t r0 = (size_t)(u.pm * 256 + wr * 64 + fr) * 1024 + col0;
        f32x4 xb[8][2][2];
#pragma unroll
        for (int rg = 0; rg < 4; ++rg)
#pragma unroll
            for (int bj = 0; bj < 2; ++bj)
#pragma unroll
                for (int n = 0; n < 2; ++n) xb[rg][bj][n] = __builtin_nontemporal_load((const f32x4*)(xp + r0 + (size_t)((rg >> 2) * 128 + (rg & 3) * 16) * 1024 + bj * 128 + n * 16));
#pragma unroll
        for (int rg = 0; rg < 8; ++rg) {
            if (rg + 4 < 8) {
#pragma unroll
                for (int bj = 0; bj < 2; ++bj)
#pragma unroll
                    for (int n = 0; n < 2; ++n) xb[rg + 4][bj][n] = __builtin_nontemporal_load((const f32x4*)(xp + r0 + (size_t)(((rg + 4) >> 2) * 128 + ((rg + 4) & 3) * 16) * 1024 + bj * 128 + n * 16));
            }
            const int ai = rg >> 2, m = rg & 3;
#pragma unroll
            for (int bj = 0; bj < 2; ++bj)
#pragma unroll
                for (int n = 0; n < 2; ++n)
                    __builtin_nontemporal_store(xb[rg][bj][n] + g4[bj][n] * acc[ai][bj][m][n], (f32x4*)(out + r0 + (size_t)(ai * 128 + m * 16) * 1024 + bj * 128 + n * 16));
        }
    }
};

__device__ __forceinline__ void p0_ada(const Params& p, unsigned char* lds, int unit) {
    const int tid = opaque_tid(), lane = tid & 63, w = tid >> 6, fr = lane & 15, fq = lane >> 4;
    const int c0 = unit * 16;
    const float* wa = p.in[8];
    f32x4 acc[9];
#pragma unroll
    for (int i = 0; i < 9; ++i) acc[i] = (f32x4){0.f, 0.f, 0.f, 0.f};
    const bf16_t* cs = (const bf16_t*)(p.ws + WS_CS);
#pragma unroll 2
    for (int ks = 0; ks < 4; ++ks) {
        const int k0 = w * 128 + ks * 32 + fq * 8;
        float bv[8];
#pragma unroll
        for (int j = 0; j < 8; ++j) bv[j] = wa[(size_t)(k0 + j) * 3072 + c0 + fr];
        const bf16x8 bfrag = __builtin_bit_cast(bf16x8, pack8(bv));
#pragma unroll
        for (int rt = 0; rt < 9; ++rt) acc[rt] = mfma16(*(const bf16x8*)(cs + (size_t)(rt * 16 + fr) * 1024 + k0), bfrag, acc[rt]);
    }
    f32x4* red = (f32x4*)lds;
#pragma unroll
    for (int rt = 0; rt < 9; ++rt) red[(w * 9 + rt) * 64 + lane] = acc[rt];
    __syncthreads();
    float* mod = (float*)(p.ws + WS_MOD);
    for (int idx = tid; idx < 576; idx += 512) { const int rt = idx >> 6, ln = idx & 63;
        f32x4 sum = red[rt * 64 + ln];
#pragma unroll
        for (int ww = 1; ww < 8; ++ww) sum = sum + red[(ww * 9 + rt) * 64 + ln];
        const int col = c0 + (ln & 15); const float bias = p.in[9][col];
#pragma unroll
        for (int r = 0; r < 4; ++r) { const int row = rt * 16 + (ln >> 4) * 4 + r; if (row < 130) mod[(size_t)row * 3072 + col] = sum[r] + bias; } }
    __syncthreads();
}
__device__ __forceinline__ void p0_transpose_item(const float* W, int N, int n0, int nvalid, bf16_t* WT, int K, int n0p, int k0, float* scr, int lane) {
    const int c = lane & 31; const bool ok = c < nvalid;
    float tv[32];
#pragma unroll
    for (int i = 0; i < 32; ++i) { const int kk = 2 * i + (lane >> 5); tv[i] = ok ? W[(size_t)(k0 + kk) * N + n0 + c] : 0.f; }
#pragma unroll
    for (int i = 0; i < 32; ++i) { const int kk = 2 * i + (lane >> 5); scr[kk * 33 + c] = tv[i]; }
    asm volatile("s_waitcnt lgkmcnt(0)" ::: "memory");
    const int c8 = lane & 7;
#pragma unroll
    for (int j = 0; j < 4; ++j) { const int n = (lane >> 3) + 8 * j; const float* s = scr + (8 * c8) * 33 + n;
        u32x4 o; o.x = pk2(s[0], s[33]); o.y = pk2(s[66], s[99]); o.z = pk2(s[132], s[165]); o.w = pk2(s[198], s[231]);
        *(u32x4*)(WT + (size_t)(n0p + n) * K + k0 + 8 * c8) = o; }
    asm volatile("s_waitcnt lgkmcnt(0)" ::: "memory");
}
__device__ __forceinline__ void phase0a(const Params& p) {
    bf16_t* cs = (bf16_t*)(p.ws + WS_CS);
    for (int e = blockIdx.x * 512 + opaque_tid(); e < 144 * 256; e += gridDim.x * 512) {
        const int r = e >> 8, c4 = (e & 255) * 4;
        f32x4 v = {0.f, 0.f, 0.f, 0.f};
        if (r < 130) v = *(const f32x4*)((r < 2 ? p.in[5] + r * 1024 : p.in[6] + (r - 2) * 1024) + c4);
        u32x2 w; w.x = pk2(v.x * fast_rcp(1.f + __expf(-v.x)), v.y * fast_rcp(1.f + __expf(-v.y))); w.y = pk2(v.z * fast_rcp(1.f + __expf(-v.z)), v.w * fast_rcp(1.f + __expf(-v.w)));
        *(u32x2*)(cs + (size_t)r * 1024 + c4) = w; }
}
__device__ __forceinline__ void phase0(const Params& p, unsigned char* lds) {
    { int u0 = gridDim.x >= 192 ? (int)blockIdx.x - ((int)gridDim.x - 192) : (int)blockIdx.x;
      for (int u = u0; u < 192; u += gridDim.x) if (u >= 0) p0_ada(p, lds, u); }
}
__device__ __forceinline__ void phase0b(const Params& p, unsigned char* lds, int first, int last, int stride) {
    const int tid_ = opaque_tid(); const int lane = tid_ & 63, wave = tid_ >> 6;
    float* scr = (float*)(lds + wave * 8448);
    for (int it = first + wave; it < last; it += stride) {
        const int kb = it / 160, nb = it % 160; int n0, nv;
        if (nb < 72) { n0 = nb * 32; nv = 32; } else if (nb < 152) { n0 = nb * 32 + 16; nv = 32; } else if (nb == 152) { n0 = 2304; nv = 16; } else { n0 = 0; nv = 0; }
        p0_transpose_item(p.in[10], NIN, n0, nv, (bf16_t*)(p.ws + WS_WIN), 1024, nb * 32, kb * 64, scr, lane);
    }
    __syncthreads();
}
__device__ __forceinline__ void phase0c(const Params& p, unsigned char* lds, int myIdx, int nIdle) {
    const int tid_ = opaque_tid(); const int lane = tid_ & 63, wave = tid_ >> 6;
    float* scr = (float*)(lds + wave * 8448);
    constexpr int I_B = 8 * 32, I_O = 16 * 32, TOT = 2 * I_B + I_O;
    for (int it = myIdx * 8 + wave; it < TOT; it += nIdle * 8) {
        int r = it;
        if (r < I_B) { p0_transpose_item(p.in[17], 1024, (r % 32) * 32, 32, (bf16_t*)(p.ws + WS_WBA), 512, (r % 32) * 32, (r / 32) * 64, scr, lane); continue; } r -= I_B;
        if (r < I_B) { p0_transpose_item(p.in[18], 1024, (r % 32) * 32, 32, (bf16_t*)(p.ws + WS_WBG), 512, (r % 32) * 32, (r / 32) * 64, scr, lane); continue; } r -= I_B;
        p0_transpose_item(p.in[19], 1024, (r % 32) * 32, 32, (bf16_t*)(p.ws + WS_WOUT), 1024, (r % 32) * 32, (r / 32) * 64, scr, lane);
    }
    __syncthreads();
}
__device__ __forceinline__ void phase_rope(const Params& p) {
    float* rope = (float*)(p.ws + WS_ROPE);
    for (int e = blockIdx.x * 512 + opaque_tid(); e < 8200 * 32; e += gridDim.x * 512) {
        const int pp = e >> 5, i = e & 31; const int pos = pp < 8192 ? pp : pp + 8192;
        const float ang = (float)pos * p.inv[i];
        const double a = (double)ang; const double n = rint(a * 0.15915494309189535);
        const float r = (float)fma(-n, 6.283185307179586, a);
        rope[(size_t)pp * 64 + i] = __cosf(r); rope[(size_t)pp * 64 + 32 + i] = __sinf(r); }
}

__device__ __forceinline__ void p1_loadx(const Params& p, int r, int lane, f32x4 (&x)[4]) {
    const float* xrow = r < MP ? p.in[0] + (size_t)r * 1024 : p.in[1] + (size_t)(r - MP) * 1024;
#pragma unroll
    for (int j = 0; j < 4; ++j) x[j] = __builtin_nontemporal_load((const f32x4*)(xrow + 4 * lane + 256 * j));
}
__device__ __forceinline__ void phase1(const Params& p) {
    const int tid_ = opaque_tid(); const int lane = tid_ & 63, wave = tid_ >> 6;
    bf16_t* H = (bf16_t*)(p.ws + WS_H);
    const float* mod = (const float*)(p.ws + WS_MOD);
    const int step = gridDim.x * 8;
    int r = blockIdx.x * 8 + wave;
    if (r >= MT) return;
    f32x4 g[4];
#pragma unroll
    for (int j = 0; j < 4; ++j) g[j] = *(const f32x4*)(p.in[7] + 4 * lane + 256 * j);
    f32x4 x0[4], x1[4], x2[4];
    p1_loadx(p, r, lane, x0);
    p1_loadx(p, min(r + step, MT - 1), lane, x1);
    f32x4 sh[4], sc[4]; int mrow = -1;
    for (; r < MT; r += step) {
        p1_loadx(p, min(r + 2 * step, MT - 1), lane, x2);
        const int mr_i = mod_row(r);
        if (mr_i != mrow) { mrow = mr_i; const float* mr = mod + (size_t)mr_i * 3072;
#pragma unroll
            for (int j = 0; j < 4; ++j) { const int c = 4 * lane + 256 * j; sh[j] = *(const f32x4*)(mr + c); sc[j] = *(const f32x4*)(mr + 1024 + c); } }
        float ss = 0.f;
#pragma unroll
        for (int j = 0; j < 4; ++j) ss += (x0[j].x * x0[j].x + x0[j].y * x0[j].y) + (x0[j].z * x0[j].z + x0[j].w * x0[j].w);
        const float rstd = rsqrtf(wave_sum(ss) * (1.f / 1024.f) + EPS);
#pragma unroll
        for (int j = 0; j < 4; ++j) { const int c = 4 * lane + 256 * j;
            const f32x4 h = x0[j] * rstd * g[j] * (sc[j] + 1.f) + sh[j];
            u32x2 w; w.x = pk2(h.x, h.y); w.y = pk2(h.z, h.w);
            *(u32x2*)(H + (size_t)r * 1024 + c) = w; }
#pragma unroll
        for (int j = 0; j < 4; ++j) { x0[j] = x1[j]; x1[j] = x2[j]; }
    }
}

constexpr int KS_STRIDE = 72, VT_STRIDE = 264, ATT_VT_OFF = 256 * 72 * 2;
constexpr float QSCALE = 0.125f * LOG2E;

__device__ __forceinline__ void attn_group(const bf16_t* Ks, const bf16_t* Vt, int kt0, int lo, int hi, bool mid_full, bf16x8 qf0, bf16x8 qf1, float sinkv, f32x4 (&o)[4], int lane) {
    const int fr = lane & 15, fq = lane >> 4;
    f32x4 s[9];
#pragma unroll
    for (int t = 0; t < 9; ++t) {
        const bf16_t* kp = Ks + ((kt0 + t) * 16 + fr) * KS_STRIDE + fq * 8;
        const bf16x8 k0 = *(const bf16x8*)kp, k1 = *(const bf16x8*)(kp + 32);
        f32x4 a = {0.f, 0.f, 0.f, 0.f};
        a = mfma16(k0, qf0, a); a = mfma16(k1, qf1, a);
        s[t] = a;
    }
    float m = sinkv;
#pragma unroll
    for (int t = 0; t < 9; ++t) {
        if (t == 0 || t == 8 || !mid_full) {
#pragma unroll
            for (int r = 0; r < 4; ++r) { const int j = (kt0 + t) * 16 + fq * 4 + r; s[t][r] = (j >= lo && j <= hi) ? s[t][r] : -1e30f; } }
        m = fmaxf(m, fmaxf(fmaxf(s[t][0], s[t][1]), fmaxf(s[t][2], s[t][3])));
    }
    m = fmaxf(m, __shfl_xor(m, 16)); m = fmaxf(m, __shfl_xor(m, 32));
    float l = 0.f;
#pragma unroll
    for (int t = 0; t < 9; ++t)
#pragma unroll
        for (int r = 0; r < 4; ++r) { const float pv = __builtin_amdgcn_exp2f(s[t][r] - m); l += pv; s[t][r] = pv; }
    l += __shfl_xor(l, 16); l += __shfl_xor(l, 32);
    l += __builtin_amdgcn_exp2f(sinkv - m);
#pragma unroll
    for (int dt = 0; dt < 4; ++dt) o[dt] = (f32x4){0.f, 0.f, 0.f, 0.f};
#pragma unroll
    for (int ks = 0; ks < 5; ++ks) {
        u32x4 pw; pw.x = pk2(s[2 * ks][0], s[2 * ks][1]); pw.y = pk2(s[2 * ks][2], s[2 * ks][3]);
        if (ks < 4) { pw.z = pk2(s[2 * ks + 1][0], s[2 * ks + 1][1]); pw.w = pk2(s[2 * ks + 1][2], s[2 * ks + 1][3]); } else { pw.z = 0u; pw.w = 0u; }
        const bf16x8 pb = __builtin_bit_cast(bf16x8, pw);
#pragma unroll
        for (int dt = 0; dt < 4; ++dt) {
            const bf16_t* vp = Vt + (dt * 16 + fr) * VT_STRIDE + (kt0 + 2 * ks) * 16 + fq * 4;
            const u32x2 a0 = *(const u32x2*)vp; u32x2 a1 = {0u, 0u};
            if (ks < 4) a1 = *(const u32x2*)(vp + 16);
            u32x4 aw; aw.x = a0.x; aw.y = a0.y; aw.z = a1.x; aw.w = a1.y;
            o[dt] = mfma16(__builtin_bit_cast(bf16x8, aw), pb, o[dt]);
        }
    }
    const float inv = 1.f / l;
#pragma unroll
    for (int dt = 0; dt < 4; ++dt) o[dt] = o[dt] * inv;
}
__device__ __forceinline__ void norm_rope16(float (&a)[8], float (&b)[8], const float* g, const float* rp, int f, int sx1, int sx2) {
    float ss = 0.f;
#pragma unroll
    for (int j = 0; j < 8; ++j) ss += a[j] * a[j] + b[j] * b[j];
    ss += __shfl_xor(ss, sx1); ss += __shfl_xor(ss, sx2);
    const float rstd = rsqrtf(ss * (1.f / 64.f) + EPS);
#pragma unroll
    for (int j = 0; j < 8; ++j) {
        const float y1 = a[j] * rstd * g[f * 8 + j], y2 = b[j] * rstd * g[32 + f * 8 + j];
        const float c = rp[f * 8 + j], s = rp[32 + f * 8 + j];
        a[j] = y1 * c - y2 * s; b[j] = y2 * c + y1 * s;
    }
}

__device__ __forceinline__ void attn_rows(const Params& p, const bf16_t* Ks, const bf16_t* Vt, size_t tok, int head, int prow, int kt0, int lo, int hi, bool mid_full, const u32x4 q0, const u32x4 q1, const u32x2 (&z)[4], int lane) {
    const int fq = lane >> 4;
    float a[8], b[8];
    unpack8(q0, a); unpack8(q1, b);
    norm_rope16(a, b, p.in[11], (const float*)(p.ws + WS_ROPE) + (size_t)prow * 64, fq, 16, 32);
    const bf16x8 qf0 = __builtin_bit_cast(bf16x8, pack8s(a, QSCALE)), qf1 = __builtin_bit_cast(bf16x8, pack8s(b, QSCALE));
    f32x4 o[4];
    attn_group(Ks, Vt, kt0, lo, hi, mid_full, qf0, qf1, p.in[13][head] * LOG2E, o, lane);
    bf16_t* op = (bf16_t*)(p.ws + WS_OA) + tok * 512 + head * 64 + fq * 4;
#pragma unroll
    for (int dt = 0; dt < 4; ++dt) {
        u32x2 w; w.x = pk2(o[dt][0] * bflo(z[dt].x), o[dt][1] * bfhi(z[dt].x)); w.y = pk2(o[dt][2] * bflo(z[dt].y), o[dt][3] * bfhi(z[dt].y));
        *(u32x2*)(op + dt * 16) = w; }
}
__device__ __forceinline__ void attn_load_qz(const Params& p, size_t tok, int head, int fq, u32x4& q0, u32x4& q1, u32x2 (&z)[4]) {
    const bf16_t* qp = (const bf16_t*)(p.ws + WS_QA) + tok * 512 + head * 64 + fq * 8;
    q0 = *(const u32x4*)qp; q1 = *(const u32x4*)(qp + 32);
    const bf16_t* zp = (const bf16_t*)(p.ws + WS_ZA) + tok * 512 + head * 64 + fq * 4;
#pragma unroll
    for (int dt = 0; dt < 4; ++dt) z[dt] = *(const u32x2*)(zp + dt * 16);
}

__device__ __forceinline__ void attn_prompt_unit(const Params& p, unsigned char* lds, int u) {
    bf16_t* Ks = (bf16_t*)lds; bf16_t* Vt = (bf16_t*)(lds + ATT_VT_OFF);
    const int tid = opaque_tid(), lane = tid & 63, w = tid >> 6;
    const int b = u >> 7, qb = (u & 127) >> 1, kvh = u & 1;
    const bf16_t* KA = (const bf16_t*)(p.ws + WS_KA); const bf16_t* VA = (const bf16_t*)(p.ws + WS_VA);
    const float* rope = (const float*)(p.ws + WS_ROPE);
    const int head = kvh * 4 + (w >> 1), half = w & 1;
    u32x4 pq0[4], pq1[4]; u32x2 pz[4][4];
#pragma unroll
    for (int g = 0; g < 4; ++g) attn_load_qz(p, (size_t)b * SEQ + qb * 128 + half * 64 + g * 16 + (lane & 15), head, lane >> 4, pq0[g], pq1[g], pz[g]);
#pragma unroll
    for (int it = 0; it < 2; ++it) {
        const int j = it * 128 + w * 16 + (lane >> 2), f = lane & 3;
        const int t = (qb - 1) * 128 + j; const int tc = t < 0 ? 0 : t;
        const bf16_t* kp = KA + ((size_t)b * SEQ + tc) * 128 + kvh * 64 + f * 8;
        float a[8], c[8];
        unpack8(*(const u32x4*)kp, a); unpack8(*(const u32x4*)(kp + 32), c);
        norm_rope16(a, c, p.in[12], rope + (size_t)tc * 64, f, 1, 2);
        if (t < 0) {
#pragma unroll
            for (int q = 0; q < 8; ++q) { a[q] = 0.f; c[q] = 0.f; } }
        *(u32x4*)(Ks + j * KS_STRIDE + f * 8) = pack8(a); *(u32x4*)(Ks + j * KS_STRIDE + 32 + f * 8) = pack8(c);
        if (t >= SEQ - 128) { float* op = p.out + O_PWK + (((size_t)b * 128 + (t - (SEQ - 128))) * 2 + kvh) * 64 + f * 8;
            *(f32x4*)op = (f32x4){a[0], a[1], a[2], a[3]}; *(f32x4*)(op + 4) = (f32x4){a[4], a[5], a[6], a[7]};
            *(f32x4*)(op + 32) = (f32x4){c[0], c[1], c[2], c[3]}; *(f32x4*)(op + 36) = (f32x4){c[4], c[5], c[6], c[7]}; }
    }
#pragma unroll
    for (int it = 0; it < 2; ++it) {
        const int idx = tid + 512 * it, jp = idx & 127, ch = idx >> 7, j = 2 * jp;
        const int t = (qb - 1) * 128 + j; const int tc = t < 0 ? 0 : t;
        const bf16_t* vsrc = VA + ((size_t)b * SEQ + tc) * 128 + kvh * 64 + ch * 8;
        u32x4 v0 = *(const u32x4*)vsrc, v1 = *(const u32x4*)(vsrc + 128);
        if (t < 0) { v0 = (u32x4){0u, 0u, 0u, 0u}; v1 = v0; }
        unsigned* vp = (unsigned*)(Vt + (ch * 8) * VT_STRIDE + j);
        vp[0] = (v0.x & 0xffffu) | (v1.x << 16); vp[VT_STRIDE / 2] = (v0.x >> 16) | (v1.x & 0xffff0000u);
        vp[2 * (VT_STRIDE / 2)] = (v0.y & 0xffffu) | (v1.y << 16); vp[3 * (VT_STRIDE / 2)] = (v0.y >> 16) | (v1.y & 0xffff0000u);
        vp[4 * (VT_STRIDE / 2)] = (v0.z & 0xffffu) | (v1.z << 16); vp[5 * (VT_STRIDE / 2)] = (v0.z >> 16) | (v1.z & 0xffff0000u);
        vp[6 * (VT_STRIDE / 2)] = (v0.w & 0xffffu) | (v1.w << 16); vp[7 * (VT_STRIDE / 2)] = (v0.w >> 16) | (v1.w & 0xffff0000u);
        if (t >= SEQ - 128) { float* op = p.out + O_PWV + (((size_t)b * 128 + (t - (SEQ - 128))) * 2 + kvh) * 64 + ch * 8;
            *(f32x4*)op = (f32x4){bflo(v0.x), bfhi(v0.x), bflo(v0.y), bfhi(v0.y)}; *(f32x4*)(op + 4) = (f32x4){bflo(v0.z), bfhi(v0.z), bflo(v0.w), bfhi(v0.w)};
            *(f32x4*)(op + 128) = (f32x4){bflo(v1.x), bfhi(v1.x), bflo(v1.y), bfhi(v1.y)}; *(f32x4*)(op + 132) = (f32x4){bflo(v1.z), bfhi(v1.z), bflo(v1.w), bfhi(v1.w)}; }
    }
    __syncthreads();
#pragma unroll
    for (int g = 0; g < 4; ++g) {
        const int i0 = half * 64 + g * 16, i = i0 + (lane & 15), t = qb * 128 + i;
        attn_rows(p, Ks, Vt, (size_t)b * SEQ + t, head, t, i0 >> 4, qb == 0 ? 128 : i, i + 128, qb != 0, pq0[g], pq1[g], pz[g], lane);
    }
    __syncthreads();
}

__device__ __forceinline__ void attn_sample_unit(const Params& p, unsigned char* lds, int u) {
    bf16_t* Ks = (bf16_t*)lds; bf16_t* Vt = (bf16_t*)(lds + ATT_VT_OFF);
    const int tid = opaque_tid(), lane = tid & 63, w = tid >> 6;
    const int sb = u >> 1, kvh = u & 1;
    const bf16_t* KA = (const bf16_t*)(p.ws + WS_KA); const bf16_t* VA = (const bf16_t*)(p.ws + WS_VA);
    const float* rope = (const float*)(p.ws + WS_ROPE);
    u32x4 sq0 = {0u, 0u, 0u, 0u}, sq1 = sq0; u32x2 sz[4] = {{0u, 0u}, {0u, 0u}, {0u, 0u}, {0u, 0u}};
    if (w < 2) { const int q = lane & 15; attn_load_qz(p, (size_t)MP + sb * 8 + (q & 7), kvh * 4 + w * 2 + (q >> 3), lane >> 4, sq0, sq1, sz); }
#pragma unroll
    for (int it = 0; it < 2; ++it) {
        const int j = it * 128 + w * 16 + (lane >> 2), f = lane & 3;
        if (j < 144) {
            const int l = (j >= 128 && j < 136) ? j - 128 : 0;
            const bf16_t* kp = KA + ((size_t)MP + sb * 8 + l) * 128 + kvh * 64 + f * 8;
            float a[8], c[8];
            unpack8(*(const u32x4*)kp, a); unpack8(*(const u32x4*)(kp + 32), c);
            norm_rope16(a, c, p.in[12], rope + (size_t)(8192 + l) * 64, f, 1, 2);
            if (j < 128) { const float* cp = p.in[2] + (((size_t)sb * 128 + j) * 2 + kvh) * 64 + f * 8;
                const f32x4 c0 = __builtin_nontemporal_load((const f32x4*)cp), c1 = __builtin_nontemporal_load((const f32x4*)(cp + 4)), c2 = __builtin_nontemporal_load((const f32x4*)(cp + 32)), c3 = __builtin_nontemporal_load((const f32x4*)(cp + 36));
                a[0] = c0.x; a[1] = c0.y; a[2] = c0.z; a[3] = c0.w; a[4] = c1.x; a[5] = c1.y; a[6] = c1.z; a[7] = c1.w;
                c[0] = c2.x; c[1] = c2.y; c[2] = c2.z; c[3] = c2.w; c[4] = c3.x; c[5] = c3.y; c[6] = c3.z; c[7] = c3.w; }
            else if (j >= 136) {
#pragma unroll
                for (int q = 0; q < 8; ++q) { a[q] = 0.f; c[q] = 0.f; } }
            *(u32x4*)(Ks + j * KS_STRIDE + f * 8) = pack8(a); *(u32x4*)(Ks + j * KS_STRIDE + 32 + f * 8) = pack8(c);
            if (j >= 8 && j < 136) { float* op = p.out + O_SWK + (((size_t)sb * 128 + (j - 8)) * 2 + kvh) * 64 + f * 8;
                *(f32x4*)op = (f32x4){a[0], a[1], a[2], a[3]}; *(f32x4*)(op + 4) = (f32x4){a[4], a[5], a[6], a[7]};
                *(f32x4*)(op + 32) = (f32x4){c[0], c[1], c[2], c[3]}; *(f32x4*)(op + 36) = (f32x4){c[4], c[5], c[6], c[7]}; }
        }
    }
#pragma unroll
    for (int it = 0; it < 3; ++it) {
        const int idx = tid + 512 * it, j = idx >> 3, ch = idx & 7;
        if (j < 144) {
            float v[8];
            if (j < 128) { const float* cp = p.in[3] + (((size_t)sb * 128 + j) * 2 + kvh) * 64 + ch * 8;
                const f32x4 c0 = __builtin_nontemporal_load((const f32x4*)cp), c1 = __builtin_nontemporal_load((const f32x4*)(cp + 4));
                v[0] = c0.x; v[1] = c0.y; v[2] = c0.z; v[3] = c0.w; v[4] = c1.x; v[5] = c1.y; v[6] = c1.z; v[7] = c1.w; }
            else if (j < 136) unpack8(*(const u32x4*)(VA + ((size_t)MP + sb * 8 + (j - 128)) * 128 + kvh * 64 + ch * 8), v);
            else {
#pragma unroll
                for (int q = 0; q < 8; ++q) v[q] = 0.f; }
            const u32x4 pv = pack8(v);
            bf16_t* vp = Vt + (ch * 8) * VT_STRIDE + j;
            vp[0] = (bf16_t)(pv.x & 0xffff); vp[VT_STRIDE] = (bf16_t)(pv.x >> 16); vp[2 * VT_STRIDE] = (bf16_t)(pv.y & 0xffff); vp[3 * VT_STRIDE] = (bf16_t)(pv.y >> 16);
            vp[4 * VT_STRIDE] = (bf16_t)(pv.z & 0xffff); vp[5 * VT_STRIDE] = (bf16_t)(pv.z >> 16); vp[6 * VT_STRIDE] = (bf16_t)(pv.w & 0xffff); vp[7 * VT_STRIDE] = (bf16_t)(pv.w >> 16);
            if (j >= 8 && j < 136) { float* op = p.out + O_SWV + (((size_t)sb * 128 + (j - 8)) * 2 + kvh) * 64 + ch * 8;
                *(f32x4*)op = (f32x4){v[0], v[1], v[2], v[3]}; *(f32x4*)(op + 4) = (f32x4){v[4], v[5], v[6], v[7]}; }
        }
    }
    __syncthreads();
    if (w < 2) {
        const int q = lane & 15, l = q & 7, head = kvh * 4 + w * 2 + (q >> 3);
        attn_rows(p, Ks, Vt, (size_t)MP + sb * 8 + l, head, 8192 + l, 0, l, l + 128, true, sq0, sq1, sz, lane);
    }
    __syncthreads();
}

constexpr int G_BC = 0, G_TOT = 16640, G_QT = 18688, G_KT = 27904, G_VT = 37120, G_ST = 55552, G_AM = 73984, G_RED = 83200, G_KT2 = 83712, G_VS = 92928, G_LRS = 110336;
constexpr int GS = 72, VSS = 136;

__device__ __forceinline__ void gla_unit_info(int u, size_t& tok0, int& L, int& h) {
    if (u < 1024) { const int b = u >> 9, c = (u >> 2) & 127; h = u & 3; tok0 = (size_t)b * SEQ + c * 64; L = 64; }
    else { const int v = u - 1024; h = v & 3; tok0 = (size_t)MP + (v >> 2) * 8; L = 8; }
}
struct GlaRaw { u32x4 lr, q, k, v0, v1; float s[16]; u32x2 z[4]; f32x4 b0, b1; };
template <int MODE> __device__ __forceinline__ void gla_load(const Params& p, int u, GlaRaw& R, int tid) {
    size_t tok0; int L, h; gla_unit_info(u, tok0, L, h);
    const int tok = tid >> 3, c = tid & 7; const bool ok = tok < L; const u32x4 z4 = {0u, 0u, 0u, 0u};
    R.lr = z4;
    if (MODE == 2) {
        const float* bp = p.out + O_Y + (size_t)u * 4096 + tok * 64 + c * 8;
        R.b0 = *(const f32x4*)bp; R.b1 = *(const f32x4*)(bp + 4);
    } else if (tid < 128 && (tid >> 1) < L) R.lr = *(const u32x4*)((const bf16_t*)(p.ws + WS_LR) + (tok0 + (tid >> 1)) * 128 + (tid & 1) * 8);
    R.k = z4; R.v0 = z4; R.v1 = z4; R.q = z4;
    if (ok) { R.k = *(const u32x4*)((const bf16_t*)(p.ws + WS_KG) + (tok0 + tok) * 256 + h * 64 + c * 8);
        const bf16_t* vp = (const bf16_t*)(p.ws + WS_VG) + (tok0 + tok) * 512 + h * 128 + c * 16;
        R.v0 = *(const u32x4*)vp; R.v1 = *(const u32x4*)(vp + 8);
        if (MODE & 2) R.q = *(const u32x4*)((const bf16_t*)(p.ws + WS_QG) + (tok0 + tok) * 256 + h * 64 + c * 8); }
    if (MODE & 2) {
        const float* Sp = (u < 1024 ? (const float*)(p.ws + WS_DS) + (size_t)u * 8192 : p.in[4] + (size_t)(u - 1024) * 8192) + (tid & 127) + (tid >> 7) * 16 * 128;
#pragma unroll
        for (int i = 0; i < 16; ++i) R.s[i] = Sp[i * 128];
        const int lane = tid & 63, w = tid >> 6, ti = (w & 3) * 16 + (lane & 15);
        const bf16_t* zp = (const bf16_t*)(p.ws + WS_ZG) + (tok0 + min(ti, L - 1)) * 512 + h * 128 + (w >> 2) * 64 + (lane >> 4) * 4;
#pragma unroll
        for (int d4 = 0; d4 < 4; ++d4) R.z[d4] = *(const u32x2*)(zp + d4 * 16);
    }
}
struct GlaConst { bf16x8 wgf[2]; float biasv[2]; f32x4 g[4]; };
__device__ __forceinline__ void gla_const_load(const Params& p, int h, int tid, GlaConst& C) {
    const int lane = tid & 63, w = tid >> 6, fr = lane & 15, fq = lane >> 4;
#pragma unroll
    for (int q = 0; q < 2; ++q) { const int kc = h * 64 + ((w >> 2) * 2 + q) * 16 + fr;
        float v[8];
#pragma unroll
        for (int j = 0; j < 8; ++j) v[j] = fq < 2 ? p.in[14][(fq * 8 + j) * 256 + kc] : 0.f;
        C.wgf[q] = __builtin_bit_cast(bf16x8, pack8(v)); C.biasv[q] = p.in[15][kc]; }
#pragma unroll
    for (int d4 = 0; d4 < 4; ++d4) C.g[d4] = *(const f32x4*)(p.in[16] + ((w >> 2) * 4 + d4) * 16 + (lane >> 4) * 4);
}
template <int MODE> __device__ __forceinline__ void gla_process(const Params& p, unsigned char* lds, int u, GlaRaw& R, int unext, const GlaConst& C) {
    size_t tok0; int L, h; gla_unit_info(u, tok0, L, h);
    const int tid = opaque_tid(), lane = tid & 63, w = tid >> 6, fr = lane & 15, fq = lane >> 4;
    float* Bc = (float*)(lds + G_BC); float* TOT = (float*)(lds + G_TOT);
    bf16_t* QS = (bf16_t*)(lds + G_QT); bf16_t* KS = (bf16_t*)(lds + G_KT); bf16_t* VS = (bf16_t*)(lds + G_VS); bf16_t* LRS = (bf16_t*)(lds + G_LRS);
    { const int tok = tid >> 3, c = tid & 7;
      if (MODE == 2) { float* bc = Bc + tok * 65 + c * 8;
          bc[0] = R.b0[0]; bc[1] = R.b0[1]; bc[2] = R.b0[2]; bc[3] = R.b0[3]; bc[4] = R.b1[0]; bc[5] = R.b1[1]; bc[6] = R.b1[2]; bc[7] = R.b1[3]; }
      else if (tid < 128) *(u32x4*)(LRS + (tid >> 1) * 16 + (tid & 1) * 8) = R.lr;
      *(u32x4*)(KS + tok * GS + c * 8) = R.k;
      if (MODE & 2) *(u32x4*)(QS + tok * GS + c * 8) = R.q;
      *(u32x4*)(VS + tok * VSS + c * 16) = R.v0; *(u32x4*)(VS + tok * VSS + c * 16 + 8) = R.v1; }
    float sreg[16]; u32x2 zreg[4];
    if (MODE & 2) {
#pragma unroll
        for (int i = 0; i < 16; ++i) sreg[i] = R.s[i];
#pragma unroll
        for (int i = 0; i < 4; ++i) zreg[i] = R.z[i]; }
    __syncthreads();
    const int k = tid & 63, tg = tid >> 6;
    if (MODE != 2)
    {
      const int tt = w & 3, kh = w >> 2;
      u32x4 az = {0u, 0u, 0u, 0u};
      if (fq < 2) az = *(const u32x4*)(LRS + (tt * 16 + fr) * 16 + fq * 8);
      const bf16x8 afr = __builtin_bit_cast(bf16x8, az);
      float inc[2][4], excl[2], tot[2];
#pragma unroll
      for (int q = 0; q < 2; ++q) {
          const f32x4 acc = mfma16(afr, C.wgf[q], (f32x4){0.f, 0.f, 0.f, 0.f});
          float run = 0.f;
#pragma unroll
          for (int r = 0; r < 4; ++r) { const int t = tt * 16 + fq * 4 + r; const float g = acc[r] + C.biasv[q];
              const float la = t < L ? (fminf(g, 0.f) - __logf(1.f + __expf(-fabsf(g)))) * (1.f / 16.f) : 0.f;
              run += la; inc[q][r] = run; }
          const float t0 = __shfl(run, fr), t1 = __shfl(run, fr + 16), t2 = __shfl(run, fr + 32), t3 = __shfl(run, fr + 48);
          excl[q] = (fq > 0 ? t0 : 0.f) + (fq > 1 ? t1 : 0.f) + (fq > 2 ? t2 : 0.f); tot[q] = (t0 + t1) + (t2 + t3);
          if (fq == 0) TOT[tt * 64 + (kh * 2 + q) * 16 + fr] = tot[q];
      }
      __syncthreads();
#pragma unroll
      for (int q = 0; q < 2; ++q) { const int kc = (kh * 2 + q) * 16 + fr; float pre = excl[q];
#pragma unroll
          for (int j = 0; j < 3; ++j) if (j < tt) pre += TOT[j * 64 + kc];
#pragma unroll
          for (int r = 0; r < 4; ++r) { const float bv = pre + inc[q][r]; Bc[(tt * 16 + fq * 4 + r) * 65 + kc] = bv;
              if (MODE == 1) p.out[O_Y + (size_t)u * 4096 + (tt * 16 + fq * 4 + r) * 64 + kc] = bv; } }
      __syncthreads(); }
    if (MODE == 3 && tg != 0) {
      *(u32x4*)((bf16_t*)(lds + G_KT2) + k * GS + tg * 8) = (u32x4){0u, 0u, 0u, 0u};
    } else
    { const float bl = Bc[63 * 65 + k], bm = Bc[31 * 65 + k];
      float kd[8];
#pragma unroll
      for (int i = 0; i < 8; ++i) { const int tt = tg * 8 + i; const float bb = Bc[tt * 65 + k]; const float kv = bf2f(KS[tt * GS + k]);
          if (MODE & 1) kd[i] = kv * __expf(bl - bb);
          if (MODE & 2) { const float qv = bf2f(QS[tt * GS + k]);
              QS[tt * GS + k] = (bf16_t)(pk2(qv * __expf(bb - bm), 0.f) & 0xffff); KS[tt * GS + k] = (bf16_t)(pk2(kv * __expf(bm - bb), 0.f) & 0xffff); } }
      if (MODE & 1) *(u32x4*)((bf16_t*)(lds + G_KT2) + k * GS + tg * 8) = pack8(kd); }
    { const int dv = tid & 127, t4 = tid >> 7; unsigned wv[8];
#pragma unroll
      for (int i = 0; i < 8; ++i) wv[i] = (unsigned)VS[(t4 * 16 + 2 * i) * VSS + dv] | ((unsigned)VS[(t4 * 16 + 2 * i + 1) * VSS + dv] << 16);
      bf16_t* VT = (bf16_t*)(lds + G_VT) + dv * GS + t4 * 16;
      *(u32x4*)VT = (u32x4){wv[0], wv[1], wv[2], wv[3]}; *(u32x4*)(VT + 8) = (u32x4){wv[4], wv[5], wv[6], wv[7]};
      if (MODE & 2) { float v[16];
#pragma unroll
          for (int i = 0; i < 16; ++i) v[i] = sreg[i] * __expf(Bc[31 * 65 + t4 * 16 + i]);
          bf16_t* ST = (bf16_t*)(lds + G_ST) + dv * GS + t4 * 16;
          u32x4 w0, w1; w0.x = pk2(v[0], v[1]); w0.y = pk2(v[2], v[3]); w0.z = pk2(v[4], v[5]); w0.w = pk2(v[6], v[7]);
          w1.x = pk2(v[8], v[9]); w1.y = pk2(v[10], v[11]); w1.z = pk2(v[12], v[13]); w1.w = pk2(v[14], v[15]);
          *(u32x4*)ST = w0; *(u32x4*)(ST + 8) = w1; } }
    if (unext >= 0) gla_load<MODE>(p, unext, R, tid);
    __syncthreads();
    if (MODE & 1) {
        const bf16_t* VT = (const bf16_t*)(lds + G_VT) + (w * 16 + fr) * GS + fq * 8;
        const bf16x8 a0 = *(const bf16x8*)VT, a1 = *(const bf16x8*)(VT + 32);
#pragma unroll
        for (int kt = 0; kt < 4; ++kt) {
            const bf16_t* KT = (const bf16_t*)(lds + G_KT2) + (kt * 16 + fr) * GS + fq * 8;
            f32x4 acc = {0.f, 0.f, 0.f, 0.f};
            acc = mfma16(a0, *(const bf16x8*)KT, acc); acc = mfma16(a1, *(const bf16x8*)(KT + 32), acc);
            const int kk = kt * 16 + fr, dv = w * 16 + fq * 4;
            if (MODE == 1) *(f32x4*)((float*)(p.ws + WS_DS) + (size_t)u * 8192 + kk * 128 + dv) = acc;
            else *(f32x4*)((float*)(lds + G_VS) + kk * 128 + dv) = acc;
        }
        if (u < 1024 && tid < 64) ((float*)(p.ws + WS_DEC))[(size_t)u * 64 + tid] = __expf(Bc[63 * 65 + tid]);
    }
    if (MODE & 2) {
        const int tt = w & 3, hh = w >> 2;
        const bool live = (MODE != 3) || tt == 0;
        const bf16_t* QTr = QS + (tt * 16 + fr) * GS + fq * 8;
        const bf16x8 bq0 = *(const bf16x8*)QTr, bq1 = *(const bf16x8*)(QTr + 32);
#pragma unroll
        for (int q = 0; q < 2; ++q) { if (!live) break; const int st = hh * 2 + q;
            const bf16_t* KTr = KS + (st * 16 + fr) * GS + fq * 8;
            f32x4 acc = {0.f, 0.f, 0.f, 0.f};
            if (st <= tt) { acc = mfma16(*(const bf16x8*)KTr, bq0, acc); acc = mfma16(*(const bf16x8*)(KTr + 32), bq1, acc); }
            const int ti = tt * 16 + fr, s0 = st * 16 + fq * 4;
            u32x2 wv; wv.x = pk2(s0 <= ti ? acc[0] : 0.f, s0 + 1 <= ti ? acc[1] : 0.f); wv.y = pk2(s0 + 2 <= ti ? acc[2] : 0.f, s0 + 3 <= ti ? acc[3] : 0.f);
            *(u32x2*)((bf16_t*)(lds + G_AM) + ti * GS + s0) = wv; }
        __syncthreads();
        if (MODE == 3) {
            const int dv = tid & 127, t4 = tid >> 7; const float* dsl = (const float*)(lds + G_VS) + dv;
            float* so = p.out + O_SGS + (size_t)(u - 1024) * 8192 + (size_t)(t4 * 16) * 128 + dv;
#pragma unroll
            for (int i = 0; i < 16; ++i) __builtin_nontemporal_store(__expf(Bc[63 * 65 + t4 * 16 + i]) * sreg[i] + dsl[(t4 * 16 + i) * 128], so + i * 128);
        }
        const bf16_t* AMr = (const bf16_t*)(lds + G_AM) + (tt * 16 + fr) * GS + fq * 8;
        const bf16x8 ba0 = *(const bf16x8*)AMr, ba1 = *(const bf16x8*)(AMr + 32);
        f32x4 o[4]; float ss = 0.f;
#pragma unroll
        for (int d4 = 0; d4 < 4; ++d4) { o[d4] = (f32x4){0.f, 0.f, 0.f, 0.f}; if (!live) continue; const int row = (hh * 4 + d4) * 16 + fr;
            const bf16_t* VT = (const bf16_t*)(lds + G_VT) + row * GS + fq * 8; const bf16_t* ST = (const bf16_t*)(lds + G_ST) + row * GS + fq * 8;
            f32x4 acc = {0.f, 0.f, 0.f, 0.f};
            acc = mfma16(*(const bf16x8*)VT, ba0, acc); acc = mfma16(*(const bf16x8*)(VT + 32), ba1, acc);
            acc = mfma16(*(const bf16x8*)ST, bq0, acc); acc = mfma16(*(const bf16x8*)(ST + 32), bq1, acc);
            o[d4] = acc; ss += (acc[0] * acc[0] + acc[1] * acc[1]) + (acc[2] * acc[2] + acc[3] * acc[3]); }
        ss += __shfl_xor(ss, 16); ss += __shfl_xor(ss, 32);
        float* RED = (float*)(lds + G_RED);
        if (fq == 0) RED[hh * 64 + tt * 16 + fr] = ss;
        __syncthreads();
        const float rstd = rsqrtf((RED[tt * 16 + fr] + RED[64 + tt * 16 + fr]) * (1.f / 128.f) + EPS);
        const int ti = tt * 16 + fr;
        if (ti < L) {
            const size_t tok = tok0 + ti;
#pragma unroll
            for (int d4 = 0; d4 < 4; ++d4) { const int dv = (hh * 4 + d4) * 16 + fq * 4;
                const f32x4 g = C.g[d4];
                const u32x2 z = zreg[d4];
                u32x2 wv; wv.x = pk2(o[d4][0] * rstd * g.x * bflo(z.x), o[d4][1] * rstd * g.y * bfhi(z.x));
                wv.y = pk2(o[d4][2] * rstd * g.z * bflo(z.y), o[d4][3] * rstd * g.w * bfhi(z.y));
                *(u32x2*)((bf16_t*)(p.ws + WS_OG) + tok * 512 + h * 128 + dv) = wv; }
        }
    }
    __syncthreads();
}
template <int MODE> __device__ __forceinline__ void gla_units(const Params& p, unsigned char* lds, int ufirst, int uend, int ustride) {
    const int tid = opaque_tid();
    int u = ufirst;
    if (u >= uend) return;
    GlaRaw R; gla_load<MODE>(p, u, R, tid);
    if ((ustride & 3) == 0) {
        GlaConst C; gla_const_load(p, u & 3, tid, C);
        for (; u < uend; u += ustride) { const int un = u + ustride; gla_process<MODE>(p, lds, u, R, un < uend ? un : -1, C); }
    } else {
        for (; u < uend; u += ustride) { const int un = u + ustride; GlaConst C; gla_const_load(p, u & 3, tid, C); gla_process<MODE>(p, lds, u, R, un < uend ? un : -1, C); }
    }
}
struct SampleOrder {
    int c;
    __device__ __forceinline__ bool next(int i, Unit& u) const { if (i > 0 || c >= 80) return false; u.pm = 64 + c / 20; u.pn = c % 20; return true; }
    __device__ __forceinline__ void a_ready(const Unit&) const {}
    __device__ __forceinline__ void done(const Unit&) const {}
};
__device__ __forceinline__ void gla_scan_dummy(const Params& p) {
    if (threadIdx.x >= 256) return;
    const int e = blockIdx.x * 256 + threadIdx.x;
    if (e >= 65536) return;
    const int b = e >> 15, h = (e >> 13) & 3, k = (e >> 7) & 63, dv = e & 127;
    float* DS = (float*)(p.ws + WS_DS); const float* DEC = (const float*)(p.ws + WS_DEC);
    float S = 0.f;
#pragma unroll 8
    for (int c = 0; c < 128; ++c) { const size_t u = (size_t)b * 512 + c * 4 + h;
        const float d = DEC[u * 64 + k]; float* sp = DS + u * 8192 + k * 128 + dv; const float ds = *sp; *sp = ds; S = d * S + ds; }
    if (S == 123.456f) p.out[O_PGS + e] = S;
}
__device__ __forceinline__ void gla_scan(const Params& p) {
    if (threadIdx.x >= 256) return;
    const int e = blockIdx.x * 256 + threadIdx.x;
    if (e >= 65536) return;
    const int b = e >> 15, h = (e >> 13) & 3, k = (e >> 7) & 63, dv = e & 127;
    float* DS = (float*)(p.ws + WS_DS); const float* DEC = (const float*)(p.ws + WS_DEC);
    float S = 0.f;
#pragma unroll 1
    for (int c0 = 0; c0 < 128; c0 += 32) {
        float d[32], ds[32];
#pragma unroll
        for (int i = 0; i < 32; ++i) { const size_t u = (size_t)b * 512 + (c0 + i) * 4 + h; d[i] = DEC[u * 64 + k]; ds[i] = DS[u * 8192 + k * 128 + dv]; }
#pragma unroll
        for (int i = 0; i < 32; ++i) { const size_t u = (size_t)b * 512 + (c0 + i) * 4 + h; DS[u * 8192 + k * 128 + dv] = S; S = d[i] * S + ds[i]; }
    }
    p.out[O_PGS + e] = S;
}

template <int KK> __device__ __forceinline__ void splitk_tile(const bf16_t* A, int lda, const bf16_t* Bt, int ldb, int row0, int col0, unsigned char* lds, f32x4 (&res)[2], int tid) {
    const int lane = tid & 63, w = tid >> 6, fr = lane & 15, fq = lane >> 4;
    constexpr int KS = KK / 8 / 32;
    f32x4 acc[4][4];
#pragma unroll
    for (int i = 0; i < 4; ++i)
#pragma unroll
        for (int j = 0; j < 4; ++j) acc[i][j] = (f32x4){0.f, 0.f, 0.f, 0.f};
    const bf16_t* ap = A + (size_t)(row0 + fr) * lda + w * (KK / 8) + fq * 8;
    const bf16_t* bp = Bt + (size_t)(col0 + fr) * ldb + w * (KK / 8) + fq * 8;
    bf16x8 af[KS][4], bfr[KS][4];
#pragma unroll
    for (int ks = 0; ks < KS; ++ks)
#pragma unroll
        for (int i = 0; i < 4; ++i) { af[ks][i] = *(const bf16x8*)(ap + (size_t)(i * 16) * lda + ks * 32); bfr[ks][i] = *(const bf16x8*)(bp + (size_t)(i * 16) * ldb + ks * 32); }
#pragma unroll
    for (int ks = 0; ks < KS; ++ks)
#pragma unroll
        for (int i = 0; i < 4; ++i)
#pragma unroll
            for (int j = 0; j < 4; ++j) acc[i][j] = mfma16(bfr[ks][j], af[ks][i], acc[i][j]);
    f32x4* red = (f32x4*)lds;
#pragma unroll
    for (int i = 0; i < 4; ++i)
#pragma unroll
        for (int j = 0; j < 4; ++j) red[(w * 16 + i * 4 + j) * 64 + lane] = acc[i][j];
    __syncthreads();
#pragma unroll
    for (int i = 0; i < 2; ++i) { const int item = tid + 512 * i;
        f32x4 sum = red[item];
#pragma unroll
        for (int ww = 1; ww < 8; ++ww) sum = sum + red[ww * 1024 + item];
        res[i] = sum; }
    __syncthreads();
}
__device__ __forceinline__ void small_merge_tiles(const Params& p, unsigned char* lds) {
    const int tid = opaque_tid();
    for (int t = blockIdx.x; t < 256; t += gridDim.x) {
        const int row0 = MP + (t >> 4) * 64, col0 = (t & 15) * 64;
        f32x4 ra[2], rg[2];
        splitk_tile<512>((const bf16_t*)(p.ws + WS_OA), 512, (const bf16_t*)(p.ws + WS_WBA), 512, row0, col0, lds, ra, tid);
        splitk_tile<512>((const bf16_t*)(p.ws + WS_OG), 512, (const bf16_t*)(p.ws + WS_WBG), 512, row0, col0, lds, rg, tid);
#pragma unroll
        for (int i = 0; i < 2; ++i) { const int item = tid + 512 * i, tile = item >> 6, ln = item & 63;
            const size_t o = (size_t)(row0 + (tile >> 2) * 16 + (ln & 15)) * 1024 + col0 + (tile & 3) * 16 + (ln >> 4) * 4;
            const u32x2 ma = *(const u32x2*)((const bf16_t*)(p.ws + WS_MA) + o), mg = *(const u32x2*)((const bf16_t*)(p.ws + WS_MG) + o);
            u32x2 wv; wv.x = pk2(bflo(ma.x) * ra[i][0] + bflo(mg.x) * rg[i][0], bfhi(ma.x) * ra[i][1] + bfhi(mg.x) * rg[i][1]);
            wv.y = pk2(bflo(ma.y) * ra[i][2] + bflo(mg.y) * rg[i][2], bfhi(ma.y) * ra[i][3] + bfhi(mg.y) * rg[i][3]);
            *(u32x2*)((bf16_t*)(p.ws + WS_MRG) + o) = wv; }
    }
}
__device__ __forceinline__ void small_out_tiles(const Params& p, unsigned char* lds) {
    const int tid = opaque_tid();
    for (int t = blockIdx.x; t < 256; t += gridDim.x) {
        const int row0 = MP + (t >> 4) * 64, col0 = (t & 15) * 64;
        f32x4 r[2];
        splitk_tile<1024>((const bf16_t*)(p.ws + WS_MRG), 1024, (const bf16_t*)(p.ws + WS_WOUT), 1024, row0, col0, lds, r, tid);
#pragma unroll
        for (int i = 0; i < 2; ++i) { const int item = tid + 512 * i, tile = item >> 6, ln = item & 63;
            const int row = row0 + (tile >> 2) * 16 + (ln & 15), c = col0 + (tile & 3) * 16 + (ln >> 4) * 4;
            const f32x4 x4 = __builtin_nontemporal_load((const f32x4*)(p.in[1] + (size_t)(row - MP) * 1024 + c)), g4 = *(const f32x4*)((const float*)(p.ws + WS_MOD) + (size_t)mod_row(row) * 3072 + 2048 + c);
            __builtin_nontemporal_store(x4 + g4 * r[i], (f32x4*)(p.out + O_Y + (size_t)row * 1024 + c)); }
    }
}

__global__ void __launch_bounds__(512) mega_fwd(Params p) {
    extern __shared__ __attribute__((aligned(16))) unsigned char lds[];
    cg::grid_group grid = cg::this_grid();
    const int lo = p.ph_lo, hi = p.ph_hi;
#define IN(k) (lo <= (k) && (k) < hi)
    PG8_LAS unsigned char* glds = (PG8_LAS unsigned char*)lds;
    volatile LAS unsigned* xst = (volatile LAS unsigned*)(glds + 131072);
    if (threadIdx.x == 0) { xst[0] = 0u; xst[1] = 0u; }
    __syncthreads();
    const XcdBarrier xbar = xcd_barrier_post((unsigned*)(p.ws + WS_BAR), xst);
#ifndef PROBE_T
#define PROBE_T -1
#endif
    volatile LAS unsigned long long* tsl = (volatile LAS unsigned long long*)(glds + 131072 + 16);
#define STAMP(i) do { if (PROBE_T >= 0 && blockIdx.x == 0 && threadIdx.x == 0) tsl[i] = __builtin_amdgcn_s_memrealtime(); } while (0)
#define SEAM(k) do { if (IN(k) && IN((k) + 1)) xcd_barrier(xbar); STAMP((k) + 1); } while (0)
    STAMP(0);
#ifndef PROBE_MASK
#define PROBE_MASK 0
#endif
#define REP(bit) ((((PROBE_MASK) >> (bit)) & 1) + 1)
    if (IN(0)) { phase0a(p); xcd_barrier(xbar); for (int rep = 0; rep < REP(0); ++rep) phase0(p, lds);
        constexpr int I_IN = 16 * 160;
        if (gridDim.x == 256) { if (blockIdx.x < 64) phase0b(p, lds, blockIdx.x * 8, 1536, 512); else phase0b(p, lds, 1536 + (blockIdx.x - 64) * 8, I_IN, 1536); }
        else phase0b(p, lds, blockIdx.x * 8, I_IN, gridDim.x * 8); }
    SEAM(0);
    if (REP(11) > 1) { grid.sync(); grid.sync(); grid.sync(); grid.sync(); }
    if (REP(12) > 1) { xcd_barrier(xbar); xcd_barrier(xbar); xcd_barrier(xbar); xcd_barrier(xbar); }
    if (IN(1)) for (int rep = 0; rep < REP(1); ++rep) { phase1(p); phase_rope(p); }
    SEAM(1);
    const bool split = gridDim.x > 80 && ((gridDim.x - 80) & 3) == 0;
    if (IN(2)) { pg8::Gemm g{(const bf16_t*)(p.ws + WS_H), (const bf16_t*)(p.ws + WS_WIN), MT, NINP, 1024}; pg8::StaticOrder S; S.init(split ? MP : MT, NINP, gridDim.x, blockIdx.x);
        EpiProj E{p.ws}; pg8::gemm_phase<EpiProj, pg8::StaticOrder, true, true>(glds, g, S, E); STAMP(15);
        if (!split) phase0c(p, lds, blockIdx.x, gridDim.x); }
    SEAM(2);
    if (IN(3)) {
        if (split) {
            if (blockIdx.x < 80) { pg8::Gemm g{(const bf16_t*)(p.ws + WS_H), (const bf16_t*)(p.ws + WS_WIN), MT, NINP, 1024}; SampleOrder S{(int)blockIdx.x};
                EpiProj E{p.ws}; pg8::gemm_phase<EpiProj, SampleOrder, true, true>(glds, g, S, E); }
            else phase0c(p, lds, blockIdx.x - 80, gridDim.x - 80);
            for (int u = blockIdx.x; u < 256; u += gridDim.x) attn_prompt_unit(p, lds, u);
            STAMP(12);
            if (blockIdx.x >= 80) gla_units<1>(p, lds, blockIdx.x - 80, 1024, gridDim.x - 80);
            STAMP(13);
            xcd_barrier(xbar);
            gla_scan(p);
            for (int u = blockIdx.x; u < 256; u += gridDim.x) attn_sample_unit(p, lds, u);
            gla_units<3>(p, lds, 1024 + blockIdx.x, 1536, gridDim.x);
            STAMP(14);
        } else {
            for (int u = blockIdx.x; u < 512; u += gridDim.x) { if (u < 256) attn_prompt_unit(p, lds, u); else attn_sample_unit(p, lds, u - 256); }
            gla_units<1>(p, lds, blockIdx.x, 1024, gridDim.x);
            gla_units<3>(p, lds, 1024 + blockIdx.x, 1536, gridDim.x);
        }
    }
    if (!split) { SEAM(3); if (IN(4)) gla_scan(p); }
    SEAM(4);
    if (IN(5)) gla_units<2>(p, lds, blockIdx.x, 1024, gridDim.x);
    SEAM(5);
    if (IN(6)) for (int rep = 0; rep < REP(7); ++rep) {
        BranchOrder S; S.base.init(MP, 1024, gridDim.x, blockIdx.x);
        pg8::Gemm g{(const bf16_t*)(p.ws + WS_OA), (const bf16_t*)(p.ws + WS_WBA), 2 * MT, 2048, 512};
        EpiBranch E{p.ws};
        const bool small_first = (blockIdx.x & 4) != 0;
        if (small_first) small_merge_tiles(p, lds);
        pg8::gemm_phase<EpiBranch, BranchOrder, true, true>(glds, g, S, E);
        if (!small_first) small_merge_tiles(p, lds);
    }
    SEAM(6);
    if (IN(7)) for (int rep = 0; rep < REP(8); ++rep) { pg8::Gemm g{(const bf16_t*)(p.ws + WS_MRG), (const bf16_t*)(p.ws + WS_WOUT), MP, 1024, 1024}; pg8::StaticOrder S; S.init(MP, 1024, gridDim.x, blockIdx.x);
        EpiOut E{p.in[0], (const float*)(p.ws + WS_MOD), p.out + O_Y};
        const bool small_first = (blockIdx.x & 4) != 0;
        if (small_first) small_out_tiles(p, lds);
        pg8::gemm_phase<EpiOut, pg8::StaticOrder, false, true>(glds, g, S, E);
        if (!small_first) small_out_tiles(p, lds); }
    STAMP(8);
    if (PROBE_T >= 0 && blockIdx.x == 0 && threadIdx.x == 0) {
#ifndef PROBE_A
#define PROBE_A PROBE_T
#define PROBE_B (PROBE_T + 1)
#endif
        const unsigned long long d = tsl[PROBE_B] - tsl[PROBE_A], t0 = __builtin_amdgcn_s_memrealtime();
        while (__builtin_amdgcn_s_memrealtime() - t0 < 4ull * d) __builtin_amdgcn_s_sleep(16);
    }
    if (hi > 1000) grid.sync();
#undef IN
#undef SEAM
}

constexpr int LDS_BYTES = 131072 + 16 + 128;
#ifndef N_LAUNCH_MODE
#define N_LAUNCH_MODE 1
#endif

extern "C" void kernel_launch(void* const* d_in, const int* in_sizes, int n_in, void* d_out, int out_size, void* d_ws, size_t ws_size, hipStream_t stream) {
    static int grid = 0;
    if (grid == 0) {
        if (n_in != 20 || ws_size < WS_END) { fprintf(stderr, "kernel_launch: unexpected n_in %d / ws_size %zu (need %zu)\n", n_in, ws_size, (size_t)WS_END); grid = -1; return; }
        int dev = 0, cus = 0, per_cu = 0;
        hipGetDevice(&dev);
        hipDeviceGetAttribute(&cus, hipDeviceAttributeMultiprocessorCount, dev);
        if (hipFuncSetAttribute((const void*)mega_fwd, hipFuncAttributeMaxDynamicSharedMemorySize, LDS_BYTES) != hipSuccess) { fprintf(stderr, "kernel_launch: hipFuncSetAttribute failed\n"); grid = -1; return; }
        if (hipOccupancyMaxActiveBlocksPerMultiprocessor(&per_cu, (const void*)mega_fwd, 512, LDS_BYTES) != hipSuccess || per_cu < 1) { fprintf(stderr, "kernel_launch: occupancy query gives %d\n", per_cu); per_cu = 1; }
        (void)hipGetLastError();
        grid = cus * 1;
        if (grid > cus * per_cu) grid = cus * per_cu;
    }
    if (grid < 0) return;
    Params p{};
    for (int i = 0; i < 20; ++i) p.in[i] = (const float*)d_in[i];
    p.out = (float*)d_out; p.ws = (unsigned char*)d_ws;
    for (int i = 0; i < 32; ++i) { const float e = (float)i / 32.0f; const float pw = powf(10000.0f, e); p.inv[i] = 1.0f / pw; }
    if (hipMemsetAsync((unsigned char*)d_ws + WS_BAR, 0, 16384, stream) != hipSuccess) { fprintf(stderr, "kernel_launch: memset of barrier words failed\n"); return; }
#if N_LAUNCH_MODE == 1
    p.ph_lo = 0; p.ph_hi = 8;
    void* args[] = {&p};
    hipError_t e = hipLaunchCooperativeKernel((const void*)mega_fwd, dim3(grid), dim3(512), args, LDS_BYTES, stream);
    if (e != hipSuccess) fprintf(stderr, "cooperative launch failed: %s (grid %d)\n", hipGetErrorString(e), grid);
#else
    for (int ph = 0; ph < 8; ++ph) { p.ph_lo = ph; p.ph_hi = ph + 1;
        hipLaunchKernelGGL(mega_fwd, dim3(grid), dim3(512), LDS_BYTES, stream, p); }
#endif
}
```

```cpp
#include <hip/hip_runtime.h>
#include <hip/hip_cooperative_groups.h>
#include <cstdio>
#include <cstdint>
#include <cmath>
namespace cg = cooperative_groups;
__device__ __forceinline__ int opaque_tid() { int t = threadIdx.x; asm volatile("" : "+v"(t)); return t; }
#define PROBE_MASK 0
#define PROBE_T -1
namespace pg8 {
#define PG8_LAS __attribute__((address_space(3)))
typedef unsigned short bf16_t;
typedef short bf16x8 __attribute__((ext_vector_type(8)));
typedef float f32x4 __attribute__((ext_vector_type(4)));
typedef unsigned u32x4 __attribute__((ext_vector_type(4)));
constexpr int BM = 256, BK = 64, HALF = 128, HTB = HALF * BK * 2  , STAGE_BYTES = 8 * HTB, NXCD = 8, WGM = 8;

__host__ __device__ __forceinline__ int lds_byte(int r, int c) { const int st = (r >> 4) * 2 + (c >> 5), rr = r & 15, cc = c & 31, ob = rr * 64 + cc * 2; return st * 1024 + (ob ^ (((ob >> 9) & 1) << 5)); }
__host__ __device__ __forceinline__ void stage_rc(int b, int& R, int& C) { const int st = b / 1024, sb = b % 1024, swz = sb ^ (((sb >> 9) & 1) << 5); R = (st >> 1) * 16 + swz / 64; C = (st & 1) * 32 + (swz % 64) / 2; }
__host__ __device__ __forceinline__ int perm32(int rho) { const int n = rho >> 4, i = rho & 15; return 8 * (i >> 2) + 4 * n + (i & 3); }

struct Unit { int pm, pn; };
struct Gemm { const bf16_t* A; const bf16_t* Bt; int M, N, K; };

struct StaticOrder {
    int nM, nN, nwg, G, c;
    __host__ __device__ void init(int M, int N, int G_, int c_) { nM = M / BM; nN = N / BM; nwg = nM * nN; G = G_; c = c_; }
    __host__ __device__ bool next(int i, Unit& u) const {
        const long L = (long)i * G + c; if (L >= nwg) return false;
        int wgid = (int)L; { const int q = nwg / NXCD, r = nwg % NXCD, xcd = wgid % NXCD, off = wgid / NXCD; wgid = (xcd < r ? xcd * (q + 1) : r * (q + 1) + (xcd - r) * q) + off; }
        const int nig = WGM * nN, gid = wgid / nig, fm = gid * WGM, gsz = (nM - fm) < WGM ? (nM - fm) : WGM;
        u.pm = fm + ((wgid % nig) % gsz); u.pn = (wgid % nig) / gsz; return true;
    }
    __device__ __forceinline__ void a_ready(const Unit&) const {}
    __device__ __forceinline__ void done(const Unit&) const {}
};
__device__ __forceinline__ unsigned cvt_pk_bf16(float lo, float hi) { unsigned r; asm volatile("v_cvt_pk_bf16_f32 %0, %1, %2" : "=v"(r) : "v"(lo), "v"(hi)); return r; }
typedef float f32x2 __attribute__((ext_vector_type(2)));
template <class Epi, class Sched, bool ALIGN_EPI = false, bool SP2 = false>
__device__ __forceinline__ void gemm_phase(PG8_LAS unsigned char* lds, const Gemm g, const Sched& S, const Epi& E) {
    const int tid = opaque_tid(), wid = __builtin_amdgcn_readfirstlane(tid >> 6), lane = tid & 63, wr = wid >> 2, wc = wid & 3, fr = lane & 15, fq = lane >> 4;
    const int K = g.K, nt = K / BK;
    unsigned voffA[2], voffB[2];
#pragma unroll
    for (int i = 0; i < 2; ++i) { int R, C; stage_rc(tid * 16 + i * 8192, R, C); const int Rb = Epi::PERM ? ((R & ~31) + perm32(R & 31)) : R;
        voffA[i] = (unsigned)(R * K + C) * 2u; voffB[i] = (unsigned)(Rb * K + C) * 2u; }
    const size_t kstep = (size_t)(BK * 2);
    const size_t hstep = (size_t)HALF * K * 2;
    const size_t tstep = 2 * hstep;
    const unsigned ldsw = (unsigned)wid * 1024u;
    const int aoff = lds_byte(wr * 64 + fr, fq * 8), boff = lds_byte(wc * 32 + fr, fq * 8);
#define PG8_SA(b, h) (((b) * 2 + (h)) * HTB)
#define PG8_SB(b, h) ((4 + (b) * 2 + (h)) * HTB)
#define PG8_STAGE(bufoff, gbase, voff) do { _Pragma("unroll") for (int _i = 0; _i < 2; ++_i) \
        __builtin_amdgcn_global_load_lds((const unsigned*)((const char*)(gbase) + (voff)[_i]), (PG8_LAS unsigned*)(lds + (bufoff) + ldsw + _i * 8192), 16, 0, 0); } while (0)
#define PG8_LDA(dst, b, h) do { _Pragma("unroll") for (int m = 0; m < 4; ++m) _Pragma("unroll") for (int k = 0; k < 2; ++k) dst[m][k] = *(const PG8_LAS bf16x8*)(lds + PG8_SA(b, h) + aoff + m * 2048 + k * 1024); } while (0)
#define PG8_LDB(dst, b, h) do { _Pragma("unroll") for (int n = 0; n < 2; ++n) _Pragma("unroll") for (int k = 0; k < 2; ++k) dst[n][k] = *(const PG8_LAS bf16x8*)(lds + PG8_SB(b, h) + boff + n * 2048 + k * 1024); } while (0)
#define PG8_MMA(ai, bj, At, Bt) do { __builtin_amdgcn_s_setprio(1); _Pragma("unroll") for (int m = 0; m < 4; ++m) _Pragma("unroll") for (int n = 0; n < 2; ++n) _Pragma("unroll") for (int k = 0; k < 2; ++k) \
        acc[ai][bj][m][n] = __builtin_amdgcn_mfma_f32_16x16x32_bf16(Bt[n][k], At[m][k], acc[ai][bj][m][n], 0, 0, 0); __builtin_amdgcn_s_setprio(0); } while (0)
#define PG8_WAIT_V(n) asm volatile("s_waitcnt vmcnt(" #n ")" ::: "memory")
#define PG8_WAIT_L(n) asm volatile("s_waitcnt lgkmcnt(" #n ")" ::: "memory")
#define PG8_BAR __builtin_amdgcn_s_barrier()
#define PG8_SCHED __builtin_amdgcn_sched_barrier(0)
    Unit cur, nxt; int ui = 0;
    if (!S.next(0, cur)) return;
    f32x4 acc[2][2][4][2];
#pragma unroll
    for (int a = 0; a < 2; ++a)
#pragma unroll
        for (int b = 0; b < 2; ++b)
#pragma unroll
            for (int m = 0; m < 4; ++m)
#pragma unroll
                for (int n = 0; n < 2; ++n) acc[a][b][m][n] = (f32x4){0.f, 0.f, 0.f, 0.f};
    bf16x8 At[4][2], B0[2][2], B1[2][2];
    const char* cA = (const char*)g.A + (size_t)cur.pm * tstep; const char* cB = (const char*)g.Bt + (size_t)cur.pn * tstep;
    S.a_ready(cur);
    if constexpr (SP2) {
        PG8_STAGE(PG8_SB(0, 0), cB, voffB); PG8_STAGE(PG8_SB(0, 1), cB + hstep, voffB); PG8_STAGE(PG8_SA(0, 0), cA, voffA); PG8_STAGE(PG8_SA(0, 1), cA + hstep, voffA);
        if (wr == 1) PG8_BAR;
        PG8_WAIT_V(2); PG8_BAR;
        PG8_STAGE(PG8_SB(1, 0), cB + kstep, voffB); PG8_STAGE(PG8_SA(1, 0), cA + kstep, voffA); PG8_STAGE(PG8_SB(1, 1), cB + hstep + kstep, voffB);
        PG8_WAIT_V(6); PG8_BAR;
    } else {
        PG8_STAGE(PG8_SB(0, 0), cB, voffB); PG8_STAGE(PG8_SA(0, 0), cA, voffA); PG8_STAGE(PG8_SB(0, 1), cB + hstep, voffB); PG8_STAGE(PG8_SA(0, 1), cA + hstep, voffA);
        if (wr == 1) PG8_BAR;
        PG8_WAIT_V(4); PG8_BAR;
        PG8_STAGE(PG8_SB(1, 0), cB + kstep, voffB); PG8_STAGE(PG8_SA(1, 0), cA + kstep, voffA); PG8_STAGE(PG8_SB(1, 1), cB + hstep + kstep, voffB);
        PG8_WAIT_V(6); PG8_BAR;
    }
    for (;;) {
        const bool has_next = S.next(ui + 1, nxt);
        const char* nA = has_next ? (const char*)g.A + (size_t)nxt.pm * tstep : cA; const char* nB = has_next ? (const char*)g.Bt + (size_t)nxt.pn * tstep : cB;
        for (int t = 0; t < nt; t += 2) {
            const bool last = (t == nt - 2);
            const char* a1 = cA + (size_t)(t + 1) * kstep;
            const char* a2 = last ? nA : cA + (size_t)(t + 2) * kstep; const char* b2 = last ? nB : cB + (size_t)(t + 2) * kstep;
            const char* a3 = a2 + kstep; const char* b3 = b2 + kstep;
            if (last && has_next) S.a_ready(nxt);
            if constexpr (SP2) {
            PG8_LDB(B0, 0, 0); PG8_LDB(B1, 0, 1); PG8_SCHED; PG8_LDA(At, 0, 0); PG8_STAGE(PG8_SA(1, 1), a1 + hstep, voffA);
            PG8_WAIT_V(8); PG8_WAIT_L(0); PG8_BAR; PG8_MMA(0, 0, At, B0); PG8_MMA(0, 1, At, B1); PG8_BAR; PG8_SCHED;
            PG8_LDA(At, 0, 1); PG8_STAGE(PG8_SB(0, 0), b2, voffB); PG8_STAGE(PG8_SB(0, 1), b2 + hstep, voffB); PG8_STAGE(PG8_SA(0, 0), a2, voffA);
            PG8_WAIT_V(8); PG8_WAIT_L(0); PG8_BAR; PG8_MMA(1, 0, At, B0); PG8_MMA(1, 1, At, B1); PG8_BAR; PG8_SCHED;
            PG8_LDB(B0, 1, 0); PG8_LDB(B1, 1, 1); PG8_SCHED; PG8_LDA(At, 1, 0); PG8_STAGE(PG8_SA(0, 1), a2 + hstep, voffA);
            PG8_WAIT_V(8); PG8_WAIT_L(0); PG8_BAR; PG8_MMA(0, 0, At, B0); PG8_MMA(0, 1, At, B1); PG8_BAR; PG8_SCHED;
            PG8_LDA(At, 1, 1); PG8_STAGE(PG8_SB(1, 0), b3, voffB); PG8_STAGE(PG8_SB(1, 1), b3 + hstep, voffB); PG8_STAGE(PG8_SA(1, 0), a3, voffA);
            PG8_WAIT_V(8); PG8_WAIT_L(0); PG8_BAR; PG8_MMA(1, 0, At, B0); PG8_MMA(1, 1, At, B1); PG8_BAR; PG8_SCHED;
            } else {
            PG8_LDB(B0, 0, 0); PG8_SCHED; PG8_LDA(At, 0, 0); PG8_STAGE(PG8_SA(1, 1), a1 + hstep, voffA);
            PG8_WAIT_L(8); PG8_BAR; PG8_WAIT_L(0); PG8_MMA(0, 0, At, B0); PG8_BAR; PG8_SCHED;
            PG8_LDB(B1, 0, 1); PG8_STAGE(PG8_SB(0, 0), b2, voffB);
            PG8_BAR; PG8_WAIT_L(0); PG8_MMA(0, 1, At, B1); PG8_BAR;
            PG8_LDA(At, 0, 1); PG8_STAGE(PG8_SA(0, 0), a2, voffA);
            PG8_BAR; PG8_WAIT_L(0); PG8_MMA(1, 0, At, B0); PG8_BAR; PG8_SCHED;
            PG8_STAGE(PG8_SB(0, 1), b2 + hstep, voffB);
            PG8_WAIT_V(6); PG8_BAR; PG8_MMA(1, 1, At, B1); PG8_BAR;
            PG8_LDB(B0, 1, 0); PG8_SCHED; PG8_LDA(At, 1, 0); PG8_STAGE(PG8_SA(0, 1), a2 + hstep, voffA);
            PG8_WAIT_L(8); PG8_BAR; PG8_WAIT_L(0); PG8_MMA(0, 0, At, B0); PG8_BAR; PG8_SCHED;
            PG8_LDB(B1, 1, 1); PG8_STAGE(PG8_SB(1, 0), b3, voffB);
            PG8_BAR; PG8_WAIT_L(0); PG8_MMA(0, 1, At, B1); PG8_BAR;
            PG8_LDA(At, 1, 1); PG8_STAGE(PG8_SA(1, 0), a3, voffA);
            PG8_BAR; PG8_WAIT_L(0); PG8_MMA(1, 0, At, B0); PG8_BAR; PG8_SCHED;
            PG8_STAGE(PG8_SB(1, 1), b3 + hstep, voffB);
            PG8_WAIT_V(6); PG8_BAR; PG8_MMA(1, 1, At, B1); PG8_BAR;
            }
        }
        if constexpr (ALIGN_EPI) { if (wr == 0) PG8_BAR; }
        if constexpr (!Epi::AFTER_DRAIN) { E(acc, cur, wr, wc, fr, fq); S.done(cur); }
        if (!has_next) break;
        if (!(Epi::CHAIN && (ui & 1) == 0)) {
#pragma unroll
        for (int a = 0; a < 2; ++a)
#pragma unroll
            for (int b = 0; b < 2; ++b)
#pragma unroll
                for (int m = 0; m < 4; ++m)
#pragma unroll
                    for (int n = 0; n < 2; ++n) acc[a][b][m][n] = (f32x4){0.f, 0.f, 0.f, 0.f};
        }
        cur = nxt; cA = nA; cB = nB; ++ui;
        if constexpr (ALIGN_EPI) { if (wr == 1) PG8_BAR; }
    }
    PG8_WAIT_V(0);
    if constexpr (!ALIGN_EPI) { if (wr == 0) PG8_BAR; }
    PG8_BAR;
    if constexpr (Epi::AFTER_DRAIN) { E.fused(acc, cur, wr, wc, fr, fq, lds, wid, lane); S.done(cur); }
#undef PG8_SA
#undef PG8_SB
#undef PG8_STAGE
#undef PG8_LDA
#undef PG8_LDB
#undef PG8_MMA
#undef PG8_WAIT_V
#undef PG8_WAIT_L
#undef PG8_BAR
#undef PG8_SCHED
}
}
#define XB_TMO      128
#define XB_XCNT(j)  (256  + 64 * (j))
#define XB_XSUB(j)  (1280 + 64 * (j))
#define XB_XGEN(j)  (2304 + 64 * (j))
#define XB_TOP      3328
#define XB_TOPGEN   3392
#define XCD_BAR_WORDS 3456
#define XB_SPIN_CAP (1u << 18)
#define LAS __attribute__((address_space(3)))

__device__ __forceinline__ unsigned xb_ld(unsigned* p)              { return __hip_atomic_load(p, __ATOMIC_RELAXED, __HIP_MEMORY_SCOPE_AGENT); }
__device__ __forceinline__ unsigned xb_add(unsigned* p, unsigned v) { return __hip_atomic_fetch_add(p, v, __ATOMIC_RELAXED, __HIP_MEMORY_SCOPE_AGENT); }
__device__ __forceinline__ unsigned xb_xcc_id() { return (unsigned)__builtin_amdgcn_s_getreg((3 << 11) | 20) & 0xFu; }
#define XB_SPIN(cond, bar) do { unsigned _sp = 0; while (cond) { __builtin_amdgcn_s_sleep(1); \
    if ((++_sp & 255u) == 0u) { if (xb_ld(&(bar)[XB_TMO])) break; if (_sp > XB_SPIN_CAP) { atomicAdd(&(bar)[XB_TMO], 1u); break; } } } } while (0)

struct XcdBarrier {
    unsigned* bar; unsigned x;
    volatile LAS unsigned* st;
};

__device__ __forceinline__ XcdBarrier xcd_barrier_post(unsigned* bar, volatile LAS unsigned* st) {
    XcdBarrier b; b.bar = bar; b.x = xb_xcc_id(); b.st = st;
    if (threadIdx.x == 0) (void)xb_add(&bar[XB_XCNT(b.x)], 1u);
    return b;
}
__device__ __forceinline__ void xcd_barrier_complete(unsigned* bar, unsigned x, unsigned& nloc, unsigned& nx) {
    const unsigned G = gridDim.x * gridDim.y * gridDim.z;
    unsigned sum, cnt, mine, sp = 0u;
    for (;;) {
        sum = 0u; cnt = 0u; mine = 0u;
#pragma unroll
        for (unsigned j = 0; j < 16; ++j) { const unsigned c = xb_ld(&bar[XB_XCNT(j)]); sum += c; cnt += (c > 0u) ? 1u : 0u; mine = (j == x) ? c : mine; }
        if (sum == G) break;
        __builtin_amdgcn_s_sleep(1);
        if ((++sp & 255u) == 0u) { if (xb_ld(&bar[XB_TMO])) break; if (sp > XB_SPIN_CAP) { atomicAdd(&bar[XB_TMO], 1u); break; } }
    }
    nloc = mine > 0u ? mine : 1u; nx = cnt > 0u ? cnt : 1u;
}

__device__ __forceinline__ void xcd_barrier(const XcdBarrier& b) {
    asm volatile("s_waitcnt vmcnt(0)" ::: "memory");
    __syncthreads();
    if (threadIdx.x == 0) {
        unsigned* bar = b.bar;
        __builtin_amdgcn_s_waitcnt(0);
        unsigned nloc = b.st[0], nx = b.st[1];
        if (nloc == 0u) { xcd_barrier_complete(bar, b.x, nloc, nx); b.st[0] = nloc; b.st[1] = nx; }
        const unsigned old = xb_add(&bar[XB_XSUB(b.x)], 1u);
        const unsigned gen = old / nloc;
        if (old + 1u == (gen + 1u) * nloc) {
            __builtin_amdgcn_fence(__ATOMIC_RELEASE, "agent");
            asm volatile("s_waitcnt vmcnt(0)" ::: "memory");
            const unsigned og = xb_add(&bar[XB_TOP], 1u);
            const unsigned tg = og / nx;
            if (og + 1u == (tg + 1u) * nx) xb_add(&bar[XB_TOPGEN], 1u);
            else XB_SPIN(xb_ld(&bar[XB_TOPGEN]) == tg, bar);
            __builtin_amdgcn_fence(__ATOMIC_ACQUIRE, "agent");
            xb_add(&bar[XB_XGEN(b.x)], 1u);
            asm volatile("s_waitcnt vmcnt(0)" ::: "memory");
        } else {
            XB_SPIN(xb_ld(&bar[XB_XGEN(b.x)]) == gen, bar);
            __builtin_amdgcn_fence(__ATOMIC_ACQUIRE, "agent");
            asm volatile("s_waitcnt vmcnt(0)" ::: "memory");
        }
    }
    __syncthreads();
}

using pg8::bf16_t; using pg8::bf16x8; using pg8::f32x4; using pg8::u32x4; using pg8::Unit;
typedef unsigned u32x2 __attribute__((ext_vector_type(2)));
typedef float f32x2v __attribute__((ext_vector_type(2)));
typedef __bf16 bf16x2v __attribute__((ext_vector_type(2)));

constexpr int DM = 1024, SEQ = 8192, MP = 16384, MS = 1024, MT = MP + MS;
constexpr int NIN = 4880, NINP = 5120;
constexpr float EPS = 1e-6f;
constexpr float LOG2E = 1.4426950408889634f;

constexpr size_t WS_MOD = 0;
constexpr size_t WS_ROPE = WS_MOD + 1597440;
constexpr size_t WS_WIN = WS_ROPE + 2099200;
constexpr size_t WS_WBA = WS_WIN + 10485760;
constexpr size_t WS_WBG = WS_WBA + 1048576;
constexpr size_t WS_WOUT = WS_WBG + 1048576;
constexpr size_t WS_H = WS_WOUT + 2097152;
constexpr size_t WS_OA = WS_H;
constexpr size_t WS_OG = WS_H + 17825792;
constexpr size_t WS_QA = WS_H + 35651584;
constexpr size_t WS_KA = WS_QA + 17825792;
constexpr size_t WS_VA = WS_KA + 4456448;
constexpr size_t WS_QG = WS_VA + 4456448;
constexpr size_t WS_TMP = WS_QA;
constexpr size_t WS_KG = WS_QG + 8912896;
constexpr size_t WS_VG = WS_KG + 8912896;
constexpr size_t WS_ZG = WS_VG + 17825792;
constexpr size_t WS_MRG = WS_KG;
constexpr size_t WS_ZA = WS_ZG + 17825792;
constexpr size_t WS_MA = WS_ZA + 17825792;
constexpr size_t WS_MG = WS_MA + 35651584;
constexpr size_t WS_LR = WS_MG + 35651584;
constexpr size_t WS_DS = WS_LR + 4456448;
constexpr size_t WS_DEC = WS_DS + 33554432;
constexpr size_t WS_BAR = WS_DEC + 262144;
constexpr size_t WS_CS = WS_BAR + 16384;
constexpr size_t WS_END = WS_CS + 294912;

constexpr size_t O_Y = 0;
constexpr size_t O_PWK = 17825792;
constexpr size_t O_PWV = O_PWK + 32768;
constexpr size_t O_PGS = O_PWV + 32768;
constexpr size_t O_SWK = O_PGS + 65536;
constexpr size_t O_SWV = O_SWK + 2097152;
constexpr size_t O_SGS = O_SWV + 2097152;

struct Params {
    const float* in[20];
    float* out; unsigned char* ws;
    float inv[32];
    int ph_lo, ph_hi;
};

__device__ __forceinline__ unsigned pk2(float lo, float hi) { f32x2v v = {lo, hi}; bf16x2v b = __builtin_convertvector(v, bf16x2v); return __builtin_bit_cast(unsigned, b); }
__device__ __forceinline__ float bflo(unsigned w) { return __uint_as_float(w << 16); }
__device__ __forceinline__ float bfhi(unsigned w) { return __uint_as_float(w & 0xffff0000u); }
__device__ __forceinline__ float bf2f(bf16_t h) { return __uint_as_float((unsigned)h << 16); }
__device__ __forceinline__ float fast_rcp(float x) { return __builtin_amdgcn_rcpf(x); }
__device__ __forceinline__ float sigmoidf_(float x) { return fast_rcp(1.f + __expf(-x)); }
__device__ __forceinline__ float siluf_(float x) { return x * fast_rcp(1.f + __expf(-x)); }
__device__ __forceinline__ float wave_sum(float v) {
#pragma unroll
    for (int o = 1; o < 64; o <<= 1) v += __shfl_xor(v, o);
    return v;
}
__device__ __forceinline__ f32x4 mfma16(bf16x8 a, bf16x8 b, f32x4 c) { return __builtin_amdgcn_mfma_f32_16x16x32_bf16(a, b, c, 0, 0, 0); }
__device__ __forceinline__ void unpack8(const u32x4 w, float (&a)[8]) {
    a[0] = bflo(w.x); a[1] = bfhi(w.x); a[2] = bflo(w.y); a[3] = bfhi(w.y); a[4] = bflo(w.z); a[5] = bfhi(w.z); a[6] = bflo(w.w); a[7] = bfhi(w.w);
}
__device__ __forceinline__ u32x4 pack8(const float (&a)[8]) { u32x4 w; w.x = pk2(a[0], a[1]); w.y = pk2(a[2], a[3]); w.z = pk2(a[4], a[5]); w.w = pk2(a[6], a[7]); return w; }
__device__ __forceinline__ u32x4 pack8s(const float (&a)[8], float sc) { u32x4 w; w.x = pk2(a[0] * sc, a[1] * sc); w.y = pk2(a[2] * sc, a[3] * sc); w.z = pk2(a[4] * sc, a[5] * sc); w.w = pk2(a[6] * sc, a[7] * sc); return w; }
__device__ __forceinline__ int mod_row(int r) { return r < MP ? (r >> 13) : 2 + ((r - MP) >> 3); }

struct EpiProj {
    static constexpr bool PERM = true, AFTER_DRAIN = false, CHAIN = false;
    unsigned char* ws;
    __device__ __forceinline__ void operator()(const f32x4 (&acc)[2][2][4][2], const Unit& u, int wr, int wc, int fr, int fq) const {
        const int row0 = u.pm * 256 + wr * 64 + fr;
#pragma unroll
        for (int bj = 0; bj < 2; ++bj) {
            const int cb = u.pn * 2 + bj;
            size_t off; int ld, cbase, act;
            if (cb < 4) { off = WS_QA; ld = 512; cbase = cb * 128; act = 0; }
            else if (cb == 4) { off = WS_KA; ld = 128; cbase = 0; act = 0; }
            else if (cb == 5) { off = WS_VA; ld = 128; cbase = 0; act = 0; }
            else if (cb < 10) { off = WS_ZA; ld = 512; cbase = (cb - 6) * 128; act = 1; }
            else if (cb < 12) { off = WS_QG; ld = 256; cbase = (cb - 10) * 128; act = 3; }
            else if (cb < 14) { off = WS_KG; ld = 256; cbase = (cb - 12) * 128; act = 0; }
            else if (cb < 18) { off = WS_VG; ld = 512; cbase = (cb - 14) * 128; act = 0; }
            else if (cb < 22) { off = WS_ZG; ld = 512; cbase = (cb - 18) * 128; act = 1; }
            else if (cb < 30) { off = WS_MA; ld = 1024; cbase = (cb - 22) * 128; act = 2; }
            else if (cb < 38) { off = WS_MG; ld = 1024; cbase = (cb - 30) * 128; act = 2; }
            else if (cb == 38) { off = WS_LR; ld = 128; cbase = 0; act = 0; }
            else continue;
            bf16_t* base = (bf16_t*)(ws + off) + cbase + wc * 32 + 8 * fq;
#pragma unroll
            for (int ai = 0; ai < 2; ++ai)
#pragma unroll
                for (int m = 0; m < 4; ++m) {
                    f32x4 v0 = acc[ai][bj][m][0], v1 = acc[ai][bj][m][1];
                    if (act == 1) { for (int j = 0; j < 4; ++j) { v0[j] = siluf_(v0[j]); v1[j] = siluf_(v1[j]); } }
                    else if (act == 2) { for (int j = 0; j < 4; ++j) { v0[j] = sigmoidf_(v0[j]); v1[j] = sigmoidf_(v1[j]); } }
                    else if (act == 3) { v0 = v0 * 0.125f; v1 = v1 * 0.125f; }
                    u32x4 w; w.x = pk2(v0[0], v0[1]); w.y = pk2(v0[2], v0[3]); w.z = pk2(v1[0], v1[1]); w.w = pk2(v1[2], v1[3]);
                    if (cb >= 22 && cb < 38) __builtin_nontemporal_store(w, (u32x4*)(base + (size_t)(row0 + ai * 128 + m * 16) * ld)); else *(u32x4*)(base + (size_t)(row0 + ai * 128 + m * 16) * ld) = w;
                }
        }
    }
};
struct EpiBranch {
    static constexpr bool PERM = true, AFTER_DRAIN = false, CHAIN = true;
    unsigned char* ws;
    __device__ __forceinline__ void operator()(f32x4 (&acc)[2][2][4][2], const Unit& u, int wr, int wc, int fr, int fq) const {
        const bool second = u.pm >= 68;
        const int pm = second ? u.pm - 68 : u.pm, pn = second ? u.pn - 4 : u.pn;
        const size_t o0 = (size_t)(pm * 256 + wr * 64 + fr) * 1024 + pn * 256 + wc * 32 + 8 * fq;
        const bf16_t* ma = (const bf16_t*)(ws + WS_MA) + o0; const bf16_t* mg = (const bf16_t*)(ws + WS_MG) + o0;
        bf16_t* dst = (bf16_t*)(ws + WS_MRG) + o0;
#pragma unroll
        for (int ai = 0; ai < 2; ++ai) {
            u32x4 g[4][2], t[4][2];
#pragma unroll
            for (int m = 0; m < 4; ++m)
#pragma unroll
                for (int bj = 0; bj < 2; ++bj) { const size_t o = (size_t)(ai * 128 + m * 16) * 1024 + bj * 128;
                    g[m][bj] = __builtin_nontemporal_load((const u32x4*)(mg + o)); t[m][bj] = (u32x4){0u, 0u, 0u, 0u}; if (!second) t[m][bj] = __builtin_nontemporal_load((const u32x4*)(ma + o)); }
#pragma unroll
            for (int m = 0; m < 4; ++m)
#pragma unroll
                for (int bj = 0; bj < 2; ++bj) { const size_t o = (size_t)(ai * 128 + m * 16) * 1024 + bj * 128;
                    const u32x4 gg = g[m][bj], tt = t[m][bj];
                    f32x4& v0 = acc[ai][bj][m][0]; f32x4& v1 = acc[ai][bj][m][1];
                    if (!second) {
                        v0[0] *= bflo(tt.x) * fast_rcp(bflo(gg.x)); v0[1] *= bfhi(tt.x) * fast_rcp(bfhi(gg.x)); v0[2] *= bflo(tt.y) * fast_rcp(bflo(gg.y)); v0[3] *= bfhi(tt.y) * fast_rcp(bfhi(gg.y));
                        v1[0] *= bflo(tt.z) * fast_rcp(bflo(gg.z)); v1[1] *= bfhi(tt.z) * fast_rcp(bfhi(gg.z)); v1[2] *= bflo(tt.w) * fast_rcp(bflo(gg.w)); v1[3] *= bfhi(tt.w) * fast_rcp(bfhi(gg.w));
                    } else {
                        u32x4 w; w.x = pk2(v0[0] * bflo(gg.x), v0[1] * bfhi(gg.x)); w.y = pk2(v0[2] * bflo(gg.y), v0[3] * bfhi(gg.y));
                        w.z = pk2(v1[0] * bflo(gg.z), v1[1] * bfhi(gg.z)); w.w = pk2(v1[2] * bflo(gg.w), v1[3] * bfhi(gg.w));
                        *(u32x4*)(dst + o) = w; }
                }
        }
    }
};
struct BranchOrder {
    pg8::StaticOrder base;
    __device__ __forceinline__ bool next(int i, Unit& u) const { if (i >= 2) return false; if (!base.next(0, u)) return false; if (i == 1) { u.pm += 68; u.pn += 4; } return true; }
    __device__ __forceinline__ void a_ready(const Unit&) const {}
    __device__ __forceinline__ void done(const Unit&) const {}
};
struct EpiOut {
    static constexpr bool PERM = false, AFTER_DRAIN = false, CHAIN = false;
    const float* xp; const float* mod; float* out;
    __device__ __forceinline__ void operator()(const f32x4 (&acc)[2][2][4][2], const Unit& u, int wr, int wc, int fr, int fq) const {
        const int col0 = u.pn * 256 + wc * 32 + 4 * fq;
        const float* grow = mod + (size_t)((u.pm * 256) >> 13) * 3072 + 2048 + col0;
        f32x4 g4[2][2];
#pragma unroll
        for (int bj = 0; bj < 2; ++bj)
#pragma unroll
            for (int n = 0; n < 2; ++n) g4[bj][n] = *(const f32x4*)(grow + bj * 128 + n * 16);
        const size_t r0 = (size_t)(u.pm * 256 + wr * 64 + fr) * 1024 + col0;
        f32x4 xb[8][2][2];
#pragma unroll
        for (int rg = 0; rg < 4; ++rg)
#pragma unroll
            for (int bj = 0; bj < 2; ++bj)
#pragma unroll
                for (int n = 0; n < 2; ++n) xb[rg][bj][n] = __builtin_nontemporal_load((const f32x4*)(xp + r0 + (size_t)((rg >> 2) * 128 + (rg & 3) * 16) * 1024 + bj * 128 + n * 16));
#pragma unroll
        for (int rg = 0; rg < 8; ++rg) {
            if (rg + 4 < 8) {
#pragma unroll
                for (int bj = 0; bj < 2; ++bj)
#pragma unroll
                    for (int n = 0; n < 2; ++n) xb[rg + 4][bj][n] = __builtin_nontemporal_load((const f32x4*)(xp + r0 + (size_t)(((rg + 4) >> 2) * 128 + ((rg + 4) & 3) * 16) * 1024 + bj * 128 + n * 16));
            }
            const int ai = rg >> 2, m = rg & 3;
#pragma unroll
            for (int bj = 0; bj < 2; ++bj)
#pragma unroll
                for (int n = 0; n < 2; ++n)
                    __builtin_nontemporal_store(xb[rg][bj][n] + g4[bj][n] * acc[ai][bj][m][n], (f32x4*)(out + r0 + (size_t)(ai * 128 + m * 16) * 1024 + bj * 128 + n * 16));
        }
    }
};

__device__ __forceinline__ void p0_ada(const Params& p, unsigned char* lds, int unit) {
    const int tid = opaque_tid(), lane = tid & 63, w = tid >> 6, fr = lane & 15, fq = lane >> 4;
    const int c0 = unit * 16;
    const float* wa = p.in[8];
    f32x4 acc[9];
#pragma unroll
    for (int i = 0; i < 9; ++i) acc[i] = (f32x4){0.f, 0.f, 0.f, 0.f};
    const bf16_t* cs = (const bf16_t*)(p.ws + WS_CS);
#pragma unroll 2
    for (int ks = 0; ks < 4; ++ks) {
        const int k0 = w * 128 + ks * 32 + fq * 8;
        float bv[8];
#pragma unroll
        for (int j = 0; j < 8; ++j) bv[j] = wa[(size_t)(k0 + j) * 3072 + c0 + fr];
        const bf16x8 bfrag = __builtin_bit_cast(bf16x8, pack8(bv));
#pragma unroll
        for (int rt = 0; rt < 9; ++rt) acc[rt] = mfma16(*(const bf16x8*)(cs + (size_t)(rt * 16 + fr) * 1024 + k0), bfrag, acc[rt]);
    }
    f32x4* red = (f32x4*)lds;
#pragma unroll
    for (int rt = 0; rt < 9; ++rt) red[(w * 9 + rt) * 64 + lane] = acc[rt];
    __syncthreads();
    float* mod = (float*)(p.ws + WS_MOD);
    for (int idx = tid; idx < 576; idx += 512) { const int rt = idx >> 6, ln = idx & 63;
        f32x4 sum = red[rt * 64 + ln];
#pragma unroll
        for (int ww = 1; ww < 8; ++ww) sum = sum + red[(ww * 9 + rt) * 64 + ln];
        const int col = c0 + (ln & 15); const float bias = p.in[9][col];
#pragma unroll
        for (int r = 0; r < 4; ++r) { const int row = rt * 16 + (ln >> 4) * 4 + r; if (row < 130) mod[(size_t)row * 3072 + col] = sum[r] + bias; } }
    __syncthreads();
}
__device__ __forceinline__ void p0_transpose_item(const float* W, int N, int n0, int nvalid, bf16_t* WT, int K, int n0p, int k0, float* scr, int lane) {
    const int c = lane & 31; const bool ok = c < nvalid;
    float tv[32];
#pragma unroll
    for (int i = 0; i < 32; ++i) { const int kk = 2 * i + (lane >> 5); tv[i] = ok ? W[(size_t)(k0 + kk) * N + n0 + c] : 0.f; }
#pragma unroll
    for (int i = 0; i < 32; ++i) { const int kk = 2 * i + (lane >> 5); scr[kk * 33 + c] = tv[i]; }
    asm volatile("s_waitcnt lgkmcnt(0)" ::: "memory");
    const int c8 = lane & 7;
#pragma unroll
    for (int j = 0; j < 4; ++j) { const int n = (lane >> 3) + 8 * j; const float* s = scr + (8 * c8) * 33 + n;
        u32x4 o; o.x = pk2(s[0], s[33]); o.y = pk2(s[66], s[99]); o.z = pk2(s[132], s[165]); o.w = pk2(s[198], s[231]);
        *(u32x4*)(WT + (size_t)(n0p + n) * K + k0 + 8 * c8) = o; }
    asm volatile("s_waitcnt lgkmcnt(0)" ::: "memory");
}
__device__ __forceinline__ void phase0a(const Params& p) {
    bf16_t* cs = (bf16_t*)(p.ws + WS_CS);
    for (int e = blockIdx.x * 512 + opaque_tid(); e < 144 * 256; e += gridDim.x * 512) {
        const int r = e >> 8, c4 = (e & 255) * 4;
        f32x4 v = {0.f, 0.f, 0.f, 0.f};
        if (r < 130) v = *(const f32x4*)((r < 2 ? p.in[5] + r * 1024 : p.in[6] + (r - 2) * 1024) + c4);
        u32x2 w; w.x = pk2(v.x * fast_rcp(1.f + __expf(-v.x)), v.y * fast_rcp(1.f + __expf(-v.y))); w.y = pk2(v.z * fast_rcp(1.f + __expf(-v.z)), v.w * fast_rcp(1.f + __expf(-v.w)));
        *(u32x2*)(cs + (size_t)r * 1024 + c4) = w; }
}
__device__ __forceinline__ void phase0(const Params& p, unsigned char* lds) {
    { int u0 = gridDim.x >= 192 ? (int)blockIdx.x - ((int)gridDim.x - 192) : (int)blockIdx.x;
      for (int u = u0; u < 192; u += gridDim.x) if (u >= 0) p0_ada(p, lds, u); }
}
__device__ __forceinline__ void phase0b(const Params& p, unsigned char* lds, int first, int last, int stride) {
    const int tid_ = opaque_tid(); const int lane = tid_ & 63, wave = tid_ >> 6;
    float* scr = (float*)(lds + wave * 8448);
    for (int it = first + wave; it < last; it += stride) {
        const int kb = it / 160, nb = it % 160; int n0, nv;
        if (nb < 72) { n0 = nb * 32; nv = 32; } else if (nb < 152) { n0 = nb * 32 + 16; nv = 32; } else if (nb == 152) { n0 = 2304; nv = 16; } else { n0 = 0; nv = 0; }
        p0_transpose_item(p.in[10], NIN, n0, nv, (bf16_t*)(p.ws + WS_WIN), 1024, nb * 32, kb * 64, scr, lane);
    }
    __syncthreads();
}
__device__ __forceinline__ void phase0c(const Params& p, unsigned char* lds, int myIdx, int nIdle) {
    const int tid_ = opaque_tid(); const int lane = tid_ & 63, wave = tid_ >> 6;
    float* scr = (float*)(lds + wave * 8448);
    constexpr int I_B = 8 * 32, I_O = 16 * 32, TOT = 2 * I_B + I_O;
    for (int it = myIdx * 8 + wave; it < TOT; it += nIdle * 8) {
        int r = it;
        if (r < I_B) { p0_transpose_item(p.in[17], 1024, (r % 32) * 32, 32, (bf16_t*)(p.ws + WS_WBA), 512, (r % 32) * 32, (r / 32) * 64, scr, lane); continue; } r -= I_B;
        if (r < I_B) { p0_transpose_item(p.in[18], 1024, (r % 32) * 32, 32, (bf16_t*)(p.ws + WS_WBG), 512, (r % 32) * 32, (r / 32) * 64, scr, lane); continue; } r -= I_B;
        p0_transpose_item(p.in[19], 1024, (r % 32) * 32, 32, (bf16_t*)(p.ws + WS_WOUT), 1024, (r % 32) * 32, (r / 32) * 64, scr, lane);
    }
    __syncthreads();
}
__device__ __forceinline__ void phase_rope(const Params& p) {
    float* rope = (float*)(p.ws + WS_ROPE);
    for (int e = blockIdx.x * 512 + opaque_tid(); e < 8200 * 32; e += gridDim.x * 512) {
        const int pp = e >> 5, i = e & 31; const int pos = pp < 8192 ? pp : pp + 8192;
        const float ang = (float)pos * p.inv[i];
        const double a = (double)ang; const double n = rint(a * 0.15915494309189535);
        const float r = (float)fma(-n, 6.283185307179586, a);
        rope[(size_t)pp * 64 + i] = __cosf(r); rope[(size_t)pp * 64 + 32 + i] = __sinf(r); }
}

__device__ __forceinline__ void p1_loadx(const Params& p, int r, int lane, f32x4 (&x)[4]) {
    const float* xrow = r < MP ? p.in[0] + (size_t)r * 1024 : p.in[1] + (size_t)(r - MP) * 1024;
#pragma unroll
    for (int j = 0; j < 4; ++j) x[j] = __builtin_nontemporal_load((const f32x4*)(xrow + 4 * lane + 256 * j));
}
__device__ __forceinline__ void phase1(const Params& p) {
    const int tid_ = opaque_tid(); const int lane = tid_ & 63, wave = tid_ >> 6;
    bf16_t* H = (bf16_t*)(p.ws + WS_H);
    const float* mod = (const float*)(p.ws + WS_MOD);
    const int step = gridDim.x * 8;
    int r = blockIdx.x * 8 + wave;
    if (r >= MT) return;
    f32x4 g[4];
#pragma unroll
    for (int j = 0; j < 4; ++j) g[j] = *(const f32x4*)(p.in[7] + 4 * lane + 256 * j);
    f32x4 x0[4], x1[4], x2[4];
    p1_loadx(p, r, lane, x0);
    p1_loadx(p, min(r + step, MT - 1), lane, x1);
    f32x4 sh[4], sc[4]; int mrow = -1;
    for (; r < MT; r += step) {
        p1_loadx(p, min(r + 2 * step, MT - 1), lane, x2);
        const int mr_i = mod_row(r);
        if (mr_i != mrow) { mrow = mr_i; const float* mr = mod + (size_t)mr_i * 3072;
#pragma unroll
            for (int j = 0; j < 4; ++j) { const int c = 4 * lane + 256 * j; sh[j] = *(const f32x4*)(mr + c); sc[j] = *(const f32x4*)(mr + 1024 + c); } }
        float ss = 0.f;
#pragma unroll
        for (int j = 0; j < 4; ++j) ss += (x0[j].x * x0[j].x + x0[j].y * x0[j].y) + (x0[j].z * x0[j].z + x0[j].w * x0[j].w);
        const float rstd = rsqrtf(wave_sum(ss) * (1.f / 1024.f) + EPS);
#pragma unroll
        for (int j = 0; j < 4; ++j) { const int c = 4 * lane + 256 * j;
            const f32x4 h = x0[j] * rstd * g[j] * (sc[j] + 1.f) + sh[j];
            u32x2 w; w.x = pk2(h.x, h.y); w.y = pk2(h.z, h.w);
            *(u32x2*)(H + (size_t)r * 1024 + c) = w; }
#pragma unroll
        for (int j = 0; j < 4; ++j) { x0[j] = x1[j]; x1[j] = x2[j]; }
    }
}

constexpr int KS_STRIDE = 72, VT_STRIDE = 264, ATT_VT_OFF = 256 * 72 * 2;
constexpr float QSCALE = 0.125f * LOG2E;

__device__ __forceinline__ void attn_group(const bf16_t* Ks, const bf16_t* Vt, int kt0, int lo, int hi, bool mid_full, bf16x8 qf0, bf16x8 qf1, float sinkv, f32x4 (&o)[4], int lane) {
    const int fr = lane & 15, fq = lane >> 4;
    f32x4 s[9];
#pragma unroll
    for (int t = 0; t < 9; ++t) {
        const bf16_t* kp = Ks + ((kt0 + t) * 16 + fr) * KS_STRIDE + fq * 8;
        const bf16x8 k0 = *(const bf16x8*)kp, k1 = *(const bf16x8*)(kp + 32);
        f32x4 a = {0.f, 0.f, 0.f, 0.f};
        a = mfma16(k0, qf0, a); a = mfma16(k1, qf1, a);
        s[t] = a;
    }
    float m = sinkv;
#pragma unroll
    for (int t = 0; t < 9; ++t) {
        if (t == 0 || t == 8 || !mid_full) {
#pragma unroll
            for (int r = 0; r < 4; ++r) { const int j = (kt0 + t) * 16 + fq * 4 + r; s[t][r] = (j >= lo && j <= hi) ? s[t][r] : -1e30f; } }
        m = fmaxf(m, fmaxf(fmaxf(s[t][0], s[t][1]), fmaxf(s[t][2], s[t][3])));
    }
    m = fmaxf(m, __shfl_xor(m, 16)); m = fmaxf(m, __shfl_xor(m, 32));
    float l = 0.f;
#pragma unroll
    for (int t = 0; t < 9; ++t)
#pragma unroll
        for (int r = 0; r < 4; ++r) { const float pv = __builtin_amdgcn_exp2f(s[t][r] - m); l += pv; s[t][r] = pv; }
    l += __shfl_xor(l, 16); l += __shfl_xor(l, 32);
    l += __builtin_amdgcn_exp2f(sinkv - m);
#pragma unroll
    for (int dt = 0; dt < 4; ++dt) o[dt] = (f32x4){0.f, 0.f, 0.f, 0.f};
#pragma unroll
    for (int ks = 0; ks < 5; ++ks) {
        u32x4 pw; pw.x = pk2(s[2 * ks][0], s[2 * ks][1]); pw.y = pk2(s[2 * ks][2], s[2 * ks][3]);
        if (ks < 4) { pw.z = pk2(s[2 * ks + 1][0], s[2 * ks + 1][1]); pw.w = pk2(s[2 * ks + 1][2], s[2 * ks + 1][3]); } else { pw.z = 0u; pw.w = 0u; }
        const bf16x8 pb = __builtin_bit_cast(bf16x8, pw);
#pragma unroll
        for (int dt = 0; dt < 4; ++dt) {
            const bf16_t* vp = Vt + (dt * 16 + fr) * VT_STRIDE + (kt0 + 2 * ks) * 16 + fq * 4;
            const u32x2 a0 = *(const u32x2*)vp; u32x2 a1 = {0u, 0u};
            if (ks < 4) a1 = *(const u32x2*)(vp + 16);
            u32x4 aw; aw.x = a0.x; aw.y = a0.y; aw.z = a1.x; aw.w = a1.y;
            o[dt] = mfma16(__builtin_bit_cast(bf16x8, aw), pb, o[dt]);
        }
    }
    const float inv = 1.f / l;
#pragma unroll
    for (int dt = 0; dt < 4; ++dt) o[dt] = o[dt] * inv;
}
__device__ __forceinline__ void norm_rope16(float (&a)[8], float (&b)[8], const float* g, const float* rp, int f, int sx1, int sx2) {
    float ss = 0.f;
#pragma unroll
    for (int j = 0; j < 8; ++j) ss += a[j] * a[j] + b[j] * b[j];
    ss += __shfl_xor(ss, sx1); ss += __shfl_xor(ss, sx2);
    const float rstd = rsqrtf(ss * (1.f / 64.f) + EPS);
#pragma unroll
    for (int j = 0; j < 8; ++j) {
        const float y1 = a[j] * rstd * g[f * 8 + j], y2 = b[j] * rstd * g[32 + f * 8 + j];
        const float c = rp[f * 8 + j], s = rp[32 + f * 8 + j];
        a[j] = y1 * c - y2 * s; b[j] = y2 * c + y1 * s;
    }
}

__device__ __forceinline__ void attn_rows(const Params& p, const bf16_t* Ks, const bf16_t* Vt, size_t tok, int head, int prow, int kt0, int lo, int hi, bool mid_full, const u32x4 q0, const u32x4 q1, const u32x2 (&z)[4], int lane) {
    const int fq = lane >> 4;
    float a[8], b[8];
    unpack8(q0, a); unpack8(q1, b);
    norm_rope16(a, b, p.in[11], (const float*)(p.ws + WS_ROPE) + (size_t)prow * 64, fq, 16, 32);
    const bf16x8 qf0 = __builtin_bit_cast(bf16x8, pack8s(a, QSCALE)), qf1 = __builtin_bit_cast(bf16x8, pack8s(b, QSCALE));
    f32x4 o[4];
    attn_group(Ks, Vt, kt0, lo, hi, mid_full, qf0, qf1, p.in[13][head] * LOG2E, o, lane);
    bf16_t* op = (bf16_t*)(p.ws + WS_OA) + tok * 512 + head * 64 + fq * 4;
#pragma unroll
    for (int dt = 0; dt < 4; ++dt) {
        u32x2 w; w.x = pk2(o[dt][0] * bflo(z[dt].x), o[dt][1] * bfhi(z[dt].x)); w.y = pk2(o[dt][2] * bflo(z[dt].y), o[dt][3] * bfhi(z[dt].y));
        *(u32x2*)(op + dt * 16) = w; }
}
__device__ __forceinline__ void attn_load_qz(const Params& p, size_t tok, int head, int fq, u32x4& q0, u32x4& q1, u32x2 (&z)[4]) {
    const bf16_t* qp = (const bf16_t*)(p.ws + WS_QA) + tok * 512 + head * 64 + fq * 8;
    q0 = *(const u32x4*)qp; q1 = *(const u32x4*)(qp + 32);
    const bf16_t* zp = (const bf16_t*)(p.ws + WS_ZA) + tok * 512 + head * 64 + fq * 4;
#pragma unroll
    for (int dt = 0; dt < 4; ++dt) z[dt] = *(const u32x2*)(zp + dt * 16);
}

__device__ __forceinline__ void attn_prompt_unit(const Params& p, unsigned char* lds, int u) {
    bf16_t* Ks = (bf16_t*)lds; bf16_t* Vt = (bf16_t*)(lds + ATT_VT_OFF);
    const int tid = opaque_tid(), lane = tid & 63, w = tid >> 6;
    const int b = u >> 7, qb = (u & 127) >> 1, kvh = u & 1;
    const bf16_t* KA = (const bf16_t*)(p.ws + WS_KA); const bf16_t* VA = (const bf16_t*)(p.ws + WS_VA);
    const float* rope = (const float*)(p.ws + WS_ROPE);
    const int head = kvh * 4 + (w >> 1), half = w & 1;
    u32x4 pq0[4], pq1[4]; u32x2 pz[4][4];
#pragma unroll
    for (int g = 0; g < 4; ++g) attn_load_qz(p, (size_t)b * SEQ + qb * 128 + half * 64 + g * 16 + (lane & 15), head, lane >> 4, pq0[g], pq1[g], pz[g]);
#pragma unroll
    for (int it = 0; it < 2; ++it) {
        const int j = it * 128 + w * 16 + (lane >> 2), f = lane & 3;
        const int t = (qb - 1) * 128 + j; const int tc = t < 0 ? 0 : t;
        const bf16_t* kp = KA + ((size_t)b * SEQ + tc) * 128 + kvh * 64 + f * 8;
        float a[8], c[8];
        unpack8(*(const u32x4*)kp, a); unpack8(*(const u32x4*)(kp + 32), c);
        norm_rope16(a, c, p.in[12], rope + (size_t)tc * 64, f, 1, 2);
        if (t < 0) {
#pragma unroll
            for (int q = 0; q < 8; ++q) { a[q] = 0.f; c[q] = 0.f; } }
        *(u32x4*)(Ks + j * KS_STRIDE + f * 8) = pack8(a); *(u32x4*)(Ks + j * KS_STRIDE + 32 + f * 8) = pack8(c);
        if (t >= SEQ - 128) { float* op = p.out + O_PWK + (((size_t)b * 128 + (t - (SEQ - 128))) * 2 + kvh) * 64 + f * 8;
            *(f32x4*)op = (f32x4){a[0], a[1], a[2], a[3]}; *(f32x4*)(op + 4) = (f32x4){a[4], a[5], a[6], a[7]};
            *(f32x4*)(op + 32) = (f32x4){c[0], c[1], c[2], c[3]}; *(f32x4*)(op + 36) = (f32x4){c[4], c[5], c[6], c[7]}; }
    }
#pragma unroll
    for (int it = 0; it < 2; ++it) {
        const int idx = tid + 512 * it, jp = idx & 127, ch = idx >> 7, j = 2 * jp;
        const int t = (qb - 1) * 128 + j; const int tc = t < 0 ? 0 : t;
        const bf16_t* vsrc = VA + ((size_t)b * SEQ + tc) * 128 + kvh * 64 + ch * 8;
        u32x4 v0 = *(const u32x4*)vsrc, v1 = *(const u32x4*)(vsrc + 128);
        if (t < 0) { v0 = (u32x4){0u, 0u, 0u, 0u}; v1 = v0; }
        unsigned* vp = (unsigned*)(Vt + (ch * 8) * VT_STRIDE + j);
        vp[0] = (v0.x & 0xffffu) | (v1.x << 16); vp[VT_STRIDE / 2] = (v0.x >> 16) | (v1.x & 0xffff0000u);
        vp[2 * (VT_STRIDE / 2)] = (v0.y & 0xffffu) | (v1.y << 16); vp[3 * (VT_STRIDE / 2)] = (v0.y >> 16) | (v1.y & 0xffff0000u);
        vp[4 * (VT_STRIDE / 2)] = (v0.z & 0xffffu) | (v1.z << 16); vp[5 * (VT_STRIDE / 2)] = (v0.z >> 16) | (v1.z & 0xffff0000u);
        vp[6 * (VT_STRIDE / 2)] = (v0.w & 0xffffu) | (v1.w << 16); vp[7 * (VT_STRIDE / 2)] = (v0.w >> 16) | (v1.w & 0xffff0000u);
        if (t >= SEQ - 128) { float* op = p.out + O_PWV + (((size_t)b * 128 + (t - (SEQ - 128))) * 2 + kvh) * 64 + ch * 8;
            *(f32x4*)op = (f32x4){bflo(v0.x), bfhi(v0.x), bflo(v0.y), bfhi(v0.y)}; *(f32x4*)(op + 4) = (f32x4){bflo(v0.z), bfhi(v0.z), bflo(v0.w), bfhi(v0.w)};
            *(f32x4*)(op + 128) = (f32x4){bflo(v1.x), bfhi(v1.x), bflo(v1.y), bfhi(v1.y)}; *(f32x4*)(op + 132) = (f32x4){bflo(v1.z), bfhi(v1.z), bflo(v1.w), bfhi(v1.w)}; }
    }
    __syncthreads();
#pragma unroll
    for (int g = 0; g < 4; ++g) {
        const int i0 = half * 64 + g * 16, i = i0 + (lane & 15), t = qb * 128 + i;
        attn_rows(p, Ks, Vt, (size_t)b * SEQ + t, head, t, i0 >> 4, qb == 0 ? 128 : i, i + 128, qb != 0, pq0[g], pq1[g], pz[g], lane);
    }
    __syncthreads();
}

__device__ __forceinline__ void attn_sample_unit(const Params& p, unsigned char* lds, int u) {
    bf16_t* Ks = (bf16_t*)lds; bf16_t* Vt = (bf16_t*)(lds + ATT_VT_OFF);
    const int tid = opaque_tid(), lane = tid & 63, w = tid >> 6;
    const int sb = u >> 1, kvh = u & 1;
    const bf16_t* KA = (const bf16_t*)(p.ws + WS_KA); const bf16_t* VA = (const bf16_t*)(p.ws + WS_VA);
    const float* rope = (const float*)(p.ws + WS_ROPE);
    u32x4 sq0 = {0u, 0u, 0u, 0u}, sq1 = sq0; u32x2 sz[4] = {{0u, 0u}, {0u, 0u}, {0u, 0u}, {0u, 0u}};
    if (w < 2) { const int q = lane & 15; attn_load_qz(p, (size_t)MP + sb * 8 + (q & 7), kvh * 4 + w * 2 + (q >> 3), lane >> 4, sq0, sq1, sz); }
#pragma unroll
    for (int it = 0; it < 2; ++it) {
        const int j = it * 128 + w * 16 + (lane >> 2), f = lane & 3;
        if (j < 144) {
            const int l = (j >= 128 && j < 136) ? j - 128 : 0;
            const bf16_t* kp = KA + ((size_t)MP + sb * 8 + l) * 128 + kvh * 64 + f * 8;
            float a[8], c[8];
            unpack8(*(const u32x4*)kp, a); unpack8(*(const u32x4*)(kp + 32), c);
            norm_rope16(a, c, p.in[12], rope + (size_t)(8192 + l) * 64, f, 1, 2);
            if (j < 128) { const float* cp = p.in[2] + (((size_t)sb * 128 + j) * 2 + kvh) * 64 + f * 8;
                const f32x4 c0 = __builtin_nontemporal_load((const f32x4*)cp), c1 = __builtin_nontemporal_load((const f32x4*)(cp + 4)), c2 = __builtin_nontemporal_load((const f32x4*)(cp + 32)), c3 = __builtin_nontemporal_load((const f32x4*)(cp + 36));
                a[0] = c0.x; a[1] = c0.y; a[2] = c0.z; a[3] = c0.w; a[4] = c1.x; a[5] = c1.y; a[6] = c1.z; a[7] = c1.w;
                c[0] = c2.x; c[1] = c2.y; c[2] = c2.z; c[3] = c2.w; c[4] = c3.x; c[5] = c3.y; c[6] = c3.z; c[7] = c3.w; }
            else if (j >= 136) {
#pragma unroll
                for (int q = 0; q < 8; ++q) { a[q] = 0.f; c[q] = 0.f; } }
            *(u32x4*)(Ks + j * KS_STRIDE + f * 8) = pack8(a); *(u32x4*)(Ks + j * KS_STRIDE + 32 + f * 8) = pack8(c);
            if (j >= 8 && j < 136) { float* op = p.out + O_SWK + (((size_t)sb * 128 + (j - 8)) * 2 + kvh) * 64 + f * 8;
                *(f32x4*)op = (f32x4){a[0], a[1], a[2], a[3]}; *(f32x4*)(op + 4) = (f32x4){a[4], a[5], a[6], a[7]};
                *(f32x4*)(op + 32) = (f32x4){c[0], c[1], c[2], c[3]}; *(f32x4*)(op + 36) = (f32x4){c[4], c[5], c[6], c[7]}; }
        }
    }
#pragma unroll
    for (int it = 0; it < 3; ++it) {
        const int idx = tid + 512 * it, j = idx >> 3, ch = idx & 7;
        if (j < 144) {
            float v[8];
            if (j < 128) { const float* cp = p.in[3] + (((size_t)sb * 128 + j) * 2 + kvh) * 64 + ch * 8;
                const f32x4 c0 = __builtin_nontemporal_load((const f32x4*)cp), c1 = __builtin_nontemporal_load((const f32x4*)(cp + 4));
                v[0] = c0.x; v[1] = c0.y; v[2] = c0.z; v[3] = c0.w; v[4] = c1.x; v[5] = c1.y; v[6] = c1.z; v[7] = c1.w; }
            else if (j < 136) unpack8(*(const u32x4*)(VA + ((size_t)MP + sb * 8 + (j - 128)) * 128 + kvh * 64 + ch * 8), v);
            else {
#pragma unroll
                for (int q = 0; q < 8; ++q) v[q] = 0.f; }
            const u32x4 pv = pack8(v);
            bf16_t* vp = Vt + (ch * 8) * VT_STRIDE + j;
            vp[0] = (bf16_t)(pv.x & 0xffff); vp[VT_STRIDE] = (bf16_t)(pv.x >> 16); vp[2 * VT_STRIDE] = (bf16_t)(pv.y & 0xffff); vp[3 * VT_STRIDE] = (bf16_t)(pv.y >> 16);
            vp[4 * VT_STRIDE] = (bf16_t)(pv.z & 0xffff); vp[5 * VT_STRIDE] = (bf16_t)(pv.z >> 16); vp[6 * VT_STRIDE] = (bf16_t)(pv.w & 0xffff); vp[7 * VT_STRIDE] = (bf16_t)(pv.w >> 16);
            if (j >= 8 && j < 136) { float* op = p.out + O_SWV + (((size_t)sb * 128 + (j - 8)) * 2 + kvh) * 64 + ch * 8;
                *(f32x4*)op = (f32x4){v[0], v[1], v[2], v[3]}; *(f32x4*)(op + 4) = (f32x4){v[4], v[5], v[6], v[7]}; }
        }
    }
    __syncthreads();
    if (w < 2) {
        const int q = lane & 15, l = q & 7, head = kvh * 4 + w * 2 + (q >> 3);
        attn_rows(p, Ks, Vt, (size_t)MP + sb * 8 + l, head, 8192 + l, 0, l, l + 128, true, sq0, sq1, sz, lane);
    }
    __syncthreads();
}

constexpr int G_BC = 0, G_TOT = 16640, G_QT = 18688, G_KT = 27904, G_VT = 37120, G_ST = 55552, G_AM = 73984, G_RED = 83200, G_KT2 = 83712, G_VS = 92928, G_LRS = 110336;
constexpr int GS = 72, VSS = 136;

__device__ __forceinline__ void gla_unit_info(int u, size_t& tok0, int& L, int& h) {
    if (u < 1024) { const int b = u >> 9, c = (u >> 2) & 127; h = u & 3; tok0 = (size_t)b * SEQ + c * 64; L = 64; }
    else { const int v = u - 1024; h = v & 3; tok0 = (size_t)MP + (v >> 2) * 8; L = 8; }
}
struct GlaRaw { u32x4 lr, q, k, v0, v1; float s[16]; u32x2 z[4]; f32x4 b0, b1; };
template <int MODE> __device__ __forceinline__ void gla_load(const Params& p, int u, GlaRaw& R, int tid) {
    size_t tok0; int L, h; gla_unit_info(u, tok0, L, h);
    const int tok = tid >> 3, c = tid & 7; const bool ok = tok < L; const u32x4 z4 = {0u, 0u, 0u, 0u};
    R.lr = z4;
    if (MODE == 2) {
        const float* bp = p.out + O_Y + (size_t)u * 4096 + tok * 64 + c * 8;
        R.b0 = *(const f32x4*)bp; R.b1 = *(const f32x4*)(bp + 4);
    } else if (tid < 128 && (tid >> 1) < L) R.lr = *(const u32x4*)((const bf16_t*)(p.ws + WS_LR) + (tok0 + (tid >> 1)) * 128 + (tid & 1) * 8);
    R.k = z4; R.v0 = z4; R.v1 = z4; R.q = z4;
    if (ok) { R.k = *(const u32x4*)((const bf16_t*)(p.ws + WS_KG) + (tok0 + tok) * 256 + h * 64 + c * 8);
        const bf16_t* vp = (const bf16_t*)(p.ws + WS_VG) + (tok0 + tok) * 512 + h * 128 + c * 16;
        R.v0 = *(const u32x4*)vp; R.v1 = *(const u32x4*)(vp + 8);
        if (MODE & 2) R.q = *(const u32x4*)((const bf16_t*)(p.ws + WS_QG) + (tok0 + tok) * 256 + h * 64 + c * 8); }
    if (MODE & 2) {
        const float* Sp = (u < 1024 ? (const float*)(p.ws + WS_DS) + (size_t)u * 8192 : p.in[4] + (size_t)(u - 1024) * 8192) + (tid & 127) + (tid >> 7) * 16 * 128;
#pragma unroll
        for (int i = 0; i < 16; ++i) R.s[i] = Sp[i * 128];
        const int lane = tid & 63, w = tid >> 6, ti = (w & 3) * 16 + (lane & 15);
        const bf16_t* zp = (const bf16_t*)(p.ws + WS_ZG) + (tok0 + min(ti, L - 1)) * 512 + h * 128 + (w >> 2) * 64 + (lane >> 4) * 4;
#pragma unroll
        for (int d4 = 0; d4 < 4; ++d4) R.z[d4] = *(const u32x2*)(zp + d4 * 16);
    }
}
struct GlaConst { bf16x8 wgf[2]; float biasv[2]; f32x4 g[4]; };
__device__ __forceinline__ void gla_const_load(const Params& p, int h, int tid, GlaConst& C) {
    const int lane = tid & 63, w = tid >> 6, fr = lane & 15, fq = lane >> 4;
#pragma unroll
    for (int q = 0; q < 2; ++q) { const int kc = h * 64 + ((w >> 2) * 2 + q) * 16 + fr;
        float v[8];
#pragma unroll
        for (int j = 0; j < 8; ++j) v[j] = fq < 2 ? p.in[14][(fq * 8 + j) * 256 + kc] : 0.f;
        C.wgf[q] = __builtin_bit_cast(bf16x8, pack8(v)); C.biasv[q] = p.in[15][kc]; }
#pragma unroll
    for (int d4 = 0; d4 < 4; ++d4) C.g[d4] = *(const f32x4*)(p.in[16] + ((w >> 2) * 4 + d4) * 16 + (lane >> 4) * 4);
}
template <int MODE> __device__ __forceinline__ void gla_process(const Params& p, unsigned char* lds, int u, GlaRaw& R, int unext, const GlaConst& C) {
    size_t tok0; int L, h; gla_unit_info(u, tok0, L, h);
    const int tid = opaque_tid(), lane = tid & 63, w = tid >> 6, fr = lane & 15, fq = lane >> 4;
    float* Bc = (float*)(lds + G_BC); float* TOT = (float*)(lds + G_TOT);
    bf16_t* QS = (bf16_t*)(lds + G_QT); bf16_t* KS = (bf16_t*)(lds + G_KT); bf16_t* VS = (bf16_t*)(lds + G_VS); bf16_t* LRS = (bf16_t*)(lds + G_LRS);
    { const int tok = tid >> 3, c = tid & 7;
      if (MODE == 2) { float* bc = Bc + tok * 65 + c * 8;
          bc[0] = R.b0[0]; bc[1] = R.b0[1]; bc[2] = R.b0[2]; bc[3] = R.b0[3]; bc[4] = R.b1[0]; bc[5] = R.b1[1]; bc[6] = R.b1[2]; bc[7] = R.b1[3]; }
      else if (tid < 128) *(u32x4*)(LRS + (tid >> 1) * 16 + (tid & 1) * 8) = R.lr;
      *(u32x4*)(KS + tok * GS + c * 8) = R.k;
      if (MODE & 2) *(u32x4*)(QS + tok * GS + c * 8) = R.q;
      *(u32x4*)(VS + tok * VSS + c * 16) = R.v0; *(u32x4*)(VS + tok * VSS + c * 16 + 8) = R.v1; }
    float sreg[16]; u32x2 zreg[4];
    if (MODE & 2) {
#pragma unroll
        for (int i = 0; i < 16; ++i) sreg[i] = R.s[i];
#pragma unroll
        for (int i = 0; i < 4; ++i) zreg[i] = R.z[i]; }
    __syncthreads();
    const int k = tid & 63, tg = tid >> 6;
    if (MODE != 2)
    {
      const int tt = w & 3, kh = w >> 2;
      u32x4 az = {0u, 0u, 0u, 0u};
      if (fq < 2) az = *(const u32x4*)(LRS + (tt * 16 + fr) * 16 + fq * 8);
      const bf16x8 afr = __builtin_bit_cast(bf16x8, az);
      float inc[2][4], excl[2], tot[2];
#pragma unroll
      for (int q = 0; q < 2; ++q) {
          const f32x4 acc = mfma16(afr, C.wgf[q], (f32x4){0.f, 0.f, 0.f, 0.f});
          float run = 0.f;
#pragma unroll
          for (int r = 0; r < 4; ++r) { const int t = tt * 16 + fq * 4 + r; const float g = acc[r] + C.biasv[q];
              const float la = t < L ? (fminf(g, 0.f) - __logf(1.f + __expf(-fabsf(g)))) * (1.f / 16.f) : 0.f;
              run += la; inc[q][r] = run; }
          const float t0 = __shfl(run, fr), t1 = __shfl(run, fr + 16), t2 = __shfl(run, fr + 32), t3 = __shfl(run, fr + 48);
          excl[q] = (fq > 0 ? t0 : 0.f) + (fq > 1 ? t1 : 0.f) + (fq > 2 ? t2 : 0.f); tot[q] = (t0 + t1) + (t2 + t3);
          if (fq == 0) TOT[tt * 64 + (kh * 2 + q) * 16 + fr] = tot[q];
      }
      __syncthreads();
#pragma unroll
      for (int q = 0; q < 2; ++q) { const int kc = (kh * 2 + q) * 16 + fr; float pre = excl[q];
#pragma unroll
          for (int j = 0; j < 3; ++j) if (j < tt) pre += TOT[j * 64 + kc];
#pragma unroll
          for (int r = 0; r < 4; ++r) { const float bv = pre + inc[q][r]; Bc[(tt * 16 + fq * 4 + r) * 65 + kc] = bv;
              if (MODE == 1) p.out[O_Y + (size_t)u * 4096 + (tt * 16 + fq * 4 + r) * 64 + kc] = bv; } }
      __syncthreads(); }
    if (MODE == 3 && tg != 0) {
      *(u32x4*)((bf16_t*)(lds + G_KT2) + k * GS + tg * 8) = (u32x4){0u, 0u, 0u, 0u};
    } else
    { const float bl = Bc[63 * 65 + k], bm = Bc[31 * 65 + k];
      float kd[8];
#pragma unroll
      for (int i = 0; i < 8; ++i) { const int tt = tg * 8 + i; const float bb = Bc[tt * 65 + k]; const float kv = bf2f(KS[tt * GS + k]);
          if (MODE & 1) kd[i] = kv * __expf(bl - bb);
          if (MODE & 2) { const float qv = bf2f(QS[tt * GS + k]);
              QS[tt * GS + k] = (bf16_t)(pk2(qv * __expf(bb - bm), 0.f) & 0xffff); KS[tt * GS + k] = (bf16_t)(pk2(kv * __expf(bm - bb), 0.f) & 0xffff); } }
      if (MODE & 1) *(u32x4*)((bf16_t*)(lds + G_KT2) + k * GS + tg * 8) = pack8(kd); }
    { const int dv = tid & 127, t4 = tid >> 7; unsigned wv[8];
#pragma unroll
      for (int i = 0; i < 8; ++i) wv[i] = (unsigned)VS[(t4 * 16 + 2 * i) * VSS + dv] | ((unsigned)VS[(t4 * 16 + 2 * i + 1) * VSS + dv] << 16);
      bf16_t* VT = (bf16_t*)(lds + G_VT) + dv * GS + t4 * 16;
      *(u32x4*)VT = (u32x4){wv[0], wv[1], wv[2], wv[3]}; *(u32x4*)(VT + 8) = (u32x4){wv[4], wv[5], wv[6], wv[7]};
      if (MODE & 2) { float v[16];
#pragma unroll
          for (int i = 0; i < 16; ++i) v[i] = sreg[i] * __expf(Bc[31 * 65 + t4 * 16 + i]);
          bf16_t* ST = (bf16_t*)(lds + G_ST) + dv * GS + t4 * 16;
          u32x4 w0, w1; w0.x = pk2(v[0], v[1]); w0.y = pk2(v[2], v[3]); w0.z = pk2(v[4], v[5]); w0.w = pk2(v[6], v[7]);
          w1.x = pk2(v[8], v[9]); w1.y = pk2(v[10], v[11]); w1.z = pk2(v[12], v[13]); w1.w = pk2(v[14], v[15]);
          *(u32x4*)ST = w0; *(u32x4*)(ST + 8) = w1; } }
    if (unext >= 0) gla_load<MODE>(p, unext, R, tid);
    __syncthreads();
    if (MODE & 1) {
        const bf16_t* VT = (const bf16_t*)(lds + G_VT) + (w * 16 + fr) * GS + fq * 8;
        const bf16x8 a0 = *(const bf16x8*)VT, a1 = *(const bf16x8*)(VT + 32);
#pragma unroll
        for (int kt = 0; kt < 4; ++kt) {
            const bf16_t* KT = (const bf16_t*)(lds + G_KT2) + (kt * 16 + fr) * GS + fq * 8;
            f32x4 acc = {0.f, 0.f, 0.f, 0.f};
            acc = mfma16(a0, *(const bf16x8*)KT, acc); acc = mfma16(a1, *(const bf16x8*)(KT + 32), acc);
            const int kk = kt * 16 + fr, dv = w * 16 + fq * 4;
            if (MODE == 1) *(f32x4*)((float*)(p.ws + WS_DS) + (size_t)u * 8192 + kk * 128 + dv) = acc;
            else *(f32x4*)((float*)(lds + G_VS) + kk * 128 + dv) = acc;
        }
        if (u < 1024 && tid < 64) ((float*)(p.ws + WS_DEC))[(size_t)u * 64 + tid] = __expf(Bc[63 * 65 + tid]);
    }
    if (MODE & 2) {
        const int tt = w & 3, hh = w >> 2;
        const bool live = (MODE != 3) || tt == 0;
        const bf16_t* QTr = QS + (tt * 16 + fr) * GS + fq * 8;
        const bf16x8 bq0 = *(const bf16x8*)QTr, bq1 = *(const bf16x8*)(QTr + 32);
#pragma unroll
        for (int q = 0; q < 2; ++q) { if (!live) break; const int st = hh * 2 + q;
            const bf16_t* KTr = KS + (st * 16 + fr) * GS + fq * 8;
            f32x4 acc = {0.f, 0.f, 0.f, 0.f};
            if (st <= tt) { acc = mfma16(*(const bf16x8*)KTr, bq0, acc); acc = mfma16(*(const bf16x8*)(KTr + 32), bq1, acc); }
            const int ti = tt * 16 + fr, s0 = st * 16 + fq * 4;
            u32x2 wv; wv.x = pk2(s0 <= ti ? acc[0] : 0.f, s0 + 1 <= ti ? acc[1] : 0.f); wv.y = pk2(s0 + 2 <= ti ? acc[2] : 0.f, s0 + 3 <= ti ? acc[3] : 0.f);
            *(u32x2*)((bf16_t*)(lds + G_AM) + ti * GS + s0) = wv; }
        __syncthreads();
        if (MODE == 3) {
            const int dv = tid & 127, t4 = tid >> 7; const float* dsl = (const float*)(lds + G_VS) + dv;
            float* so = p.out + O_SGS + (size_t)(u - 1024) * 8192 + (size_t)(t4 * 16) * 128 + dv;
#pragma unroll
            for (int i = 0; i < 16; ++i) __builtin_nontemporal_store(__expf(Bc[63 * 65 + t4 * 16 + i]) * sreg[i] + dsl[(t4 * 16 + i) * 128], so + i * 128);
        }
        const bf16_t* AMr = (const bf16_t*)(lds + G_AM) + (tt * 16 + fr) * GS + fq * 8;
        const bf16x8 ba0 = *(const bf16x8*)AMr, ba1 = *(const bf16x8*)(AMr + 32);
        f32x4 o[4]; float ss = 0.f;
#pragma unroll
        for (int d4 = 0; d4 < 4; ++d4) { o[d4] = (f32x4){0.f, 0.f, 0.f, 0.f}; if (!live) continue; const int row = (hh * 4 + d4) * 16 + fr;
            const bf16_t* VT = (const bf16_t*)(lds + G_VT) + row * GS + fq * 8; const bf16_t* ST = (const bf16_t*)(lds + G_ST) + row * GS + fq * 8;
            f32x4 acc = {0.f, 0.f, 0.f, 0.f};
            acc = mfma16(*(const bf16x8*)VT, ba0, acc); acc = mfma16(*(const bf16x8*)(VT + 32), ba1, acc);
            acc = mfma16(*(const bf16x8*)ST, bq0, acc); acc = mfma16(*(const bf16x8*)(ST + 32), bq1, acc);
            o[d4] = acc; ss += (acc[0] * acc[0] + acc[1] * acc[1]) + (acc[2] * acc[2] + acc[3] * acc[3]); }
        ss += __shfl_xor(ss, 16); ss += __shfl_xor(ss, 32);
        float* RED = (float*)(lds + G_RED);
        if (fq == 0) RED[hh * 64 + tt * 16 + fr] = ss;
        __syncthreads();
        const float rstd = rsqrtf((RED[tt * 16 + fr] + RED[64 + tt * 16 + fr]) * (1.f / 128.f) + EPS);
        const int ti = tt * 16 + fr;
        if (ti < L) {
            const size_t tok = tok0 + ti;
#pragma unroll
            for (int d4 = 0; d4 < 4; ++d4) { const int dv = (hh * 4 + d4) * 16 + fq * 4;
                const f32x4 g = C.g[d4];
                const u32x2 z = zreg[d4];
                u32x2 wv; wv.x = pk2(o[d4][0] * rstd * g.x * bflo(z.x), o[d4][1] * rstd * g.y * bfhi(z.x));
                wv.y = pk2(o[d4][2] * rstd * g.z * bflo(z.y), o[d4][3] * rstd * g.w * bfhi(z.y));
                *(u32x2*)((bf16_t*)(p.ws + WS_OG) + tok * 512 + h * 128 + dv) = wv; }
        }
    }
    __syncthreads();
}
template <int MODE> __device__ __forceinline__ void gla_units_run(const Params& p, unsigned char* lds, int ufirst, int uend, int ustride, GlaRaw& R) {
    const int tid = opaque_tid();
    int u = ufirst;
    if (u >= uend) return;
    if ((ustride & 3) == 0) {
        GlaConst C; gla_const_load(p, u & 3, tid, C);
        for (; u < uend; u += ustride) { const int un = u + ustride; gla_process<MODE>(p, lds, u, R, un < uend ? un : -1, C); }
    } else {
        for (; u < uend; u += ustride) { const int un = u + ustride; GlaConst C; gla_const_load(p, u & 3, tid, C); gla_process<MODE>(p, lds, u, R, un < uend ? un : -1, C); }
    }
}
template <int MODE> __device__ __forceinline__ void gla_units(const Params& p, unsigned char* lds, int ufirst, int uend, int ustride) {
    if (ufirst >= uend) return;
    GlaRaw R; gla_load<MODE>(p, ufirst, R, opaque_tid());
    gla_units_run<MODE>(p, lds, ufirst, uend, ustride, R);
}
struct SampleOrder {
    int c;
    __device__ __forceinline__ bool next(int i, Unit& u) const { if (i > 0 || c >= 80) return false; u.pm = 64 + c / 20; u.pn = c % 20; return true; }
    __device__ __forceinline__ void a_ready(const Unit&) const {}
    __device__ __forceinline__ void done(const Unit&) const {}
};
__device__ __forceinline__ void gla_scan_dummy(const Params& p) {
    if (threadIdx.x >= 256) return;
    const int e = blockIdx.x * 256 + threadIdx.x;
    if (e >= 65536) return;
    const int b = e >> 15, h = (e >> 13) & 3, k = (e >> 7) & 63, dv = e & 127;
    float* DS = (float*)(p.ws + WS_DS); const float* DEC = (const float*)(p.ws + WS_DEC);
    float S = 0.f;
#pragma unroll 8
    for (int c = 0; c < 128; ++c) { const size_t u = (size_t)b * 512 + c * 4 + h;
        const float d = DEC[u * 64 + k]; float* sp = DS + u * 8192 + k * 128 + dv; const float ds = *sp; *sp = ds; S = d * S + ds; }
    if (S == 123.456f) p.out[O_PGS + e] = S;
}
__device__ __forceinline__ void gla_scan(const Params& p) {
    if (threadIdx.x >= 256) return;
    const int e = blockIdx.x * 256 + threadIdx.x;
    if (e >= 65536) return;
    const int b = e >> 15, h = (e >> 13) & 3, k = (e >> 7) & 63, dv = e & 127;
    float* DS = (float*)(p.ws + WS_DS); const float* DEC = (const float*)(p.ws + WS_DEC);
    float S = 0.f;
#pragma unroll 1
    for (int c0 = 0; c0 < 128; c0 += 32) {
        float d[32], ds[32];
#pragma unroll
        for (int i = 0; i < 32; ++i) { const size_t u = (size_t)b * 512 + (c0 + i) * 4 + h; d[i] = DEC[u * 64 + k]; ds[i] = DS[u * 8192 + k * 128 + dv]; }
#pragma unroll
        for (int i = 0; i < 32; ++i) { const size_t u = (size_t)b * 512 + (c0 + i) * 4 + h; DS[u * 8192 + k * 128 + dv] = S; S = d[i] * S + ds[i]; }
    }
    p.out[O_PGS + e] = S;
}

template <int KK> __device__ __forceinline__ void splitk_tile(const bf16_t* A, int lda, const bf16_t* Bt, int ldb, int row0, int col0, unsigned char* lds, f32x4 (&res)[2], int tid) {
    const int lane = tid & 63, w = tid >> 6, fr = lane & 15, fq = lane >> 4;
    constexpr int KS = KK / 8 / 32;
    f32x4 acc[4][4];
#pragma unroll
    for (int i = 0; i < 4; ++i)
#pragma unroll
        for (int j = 0; j < 4; ++j) acc[i][j] = (f32x4){0.f, 0.f, 0.f, 0.f};
    const bf16_t* ap = A + (size_t)(row0 + fr) * lda + w * (KK / 8) + fq * 8;
    const bf16_t* bp = Bt + (size_t)(col0 + fr) * ldb + w * (KK / 8) + fq * 8;
    bf16x8 af[KS][4], bfr[KS][4];
#pragma unroll
    for (int ks = 0; ks < KS; ++ks)
#pragma unroll
        for (int i = 0; i < 4; ++i) { af[ks][i] = *(const bf16x8*)(ap + (size_t)(i * 16) * lda + ks * 32); bfr[ks][i] = *(const bf16x8*)(bp + (size_t)(i * 16) * ldb + ks * 32); }
#pragma unroll
    for (int ks = 0; ks < KS; ++ks)
#pragma unroll
        for (int i = 0; i < 4; ++i)
#pragma unroll
            for (int j = 0; j < 4; ++j) acc[i][j] = mfma16(bfr[ks][j], af[ks][i], acc[i][j]);
    f32x4* red = (f32x4*)lds;
#pragma unroll
    for (int i = 0; i < 4; ++i)
#pragma unroll
        for (int j = 0; j < 4; ++j) red[(w * 16 + i * 4 + j) * 64 + lane] = acc[i][j];
    __syncthreads();
#pragma unroll
    for (int i = 0; i < 2; ++i) { const int item = tid + 512 * i;
        f32x4 sum = red[item];
#pragma unroll
        for (int ww = 1; ww < 8; ++ww) sum = sum + red[ww * 1024 + item];
        res[i] = sum; }
    __syncthreads();
}
__device__ __forceinline__ void small_merge_tiles(const Params& p, unsigned char* lds) {
    const int tid = opaque_tid();
    for (int t = blockIdx.x; t < 256; t += gridDim.x) {
        const int row0 = MP + (t >> 4) * 64, col0 = (t & 15) * 64;
        f32x4 ra[2], rg[2];
        splitk_tile<512>((const bf16_t*)(p.ws + WS_OA), 512, (const bf16_t*)(p.ws + WS_WBA), 512, row0, col0, lds, ra, tid);
        splitk_tile<512>((const bf16_t*)(p.ws + WS_OG), 512, (const bf16_t*)(p.ws + WS_WBG), 512, row0, col0, lds, rg, tid);
#pragma unroll
        for (int i = 0; i < 2; ++i) { const int item = tid + 512 * i, tile = item >> 6, ln = item & 63;
            const size_t o = (size_t)(row0 + (tile >> 2) * 16 + (ln & 15)) * 1024 + col0 + (tile & 3) * 16 + (ln >> 4) * 4;
            const u32x2 ma = *(const u32x2*)((const bf16_t*)(p.ws + WS_MA) + o), mg = *(const u32x2*)((const bf16_t*)(p.ws + WS_MG) + o);
            u32x2 wv; wv.x = pk2(bflo(ma.x) * ra[i][0] + bflo(mg.x) * rg[i][0], bfhi(ma.x) * ra[i][1] + bfhi(mg.x) * rg[i][1]);
            wv.y = pk2(bflo(ma.y) * ra[i][2] + bflo(mg.y) * rg[i][2], bfhi(ma.y) * ra[i][3] + bfhi(mg.y) * rg[i][3]);
            *(u32x2*)((bf16_t*)(p.ws + WS_MRG) + o) = wv; }
    }
}
__device__ __forceinline__ void small_out_tiles(const Params& p, unsigned char* lds) {
    const int tid = opaque_tid();
    for (int t = blockIdx.x; t < 256; t += gridDim.x) {
        const int row0 = MP + (t >> 4) * 64, col0 = (t & 15) * 64;
        f32x4 r[2];
        splitk_tile<1024>((const bf16_t*)(p.ws + WS_MRG), 1024, (const bf16_t*)(p.ws + WS_WOUT), 1024, row0, col0, lds, r, tid);
#pragma unroll
        for (int i = 0; i < 2; ++i) { const int item = tid + 512 * i, tile = item >> 6, ln = item & 63;
            const int row = row0 + (tile >> 2) * 16 + (ln & 15), c = col0 + (tile & 3) * 16 + (ln >> 4) * 4;
            const f32x4 x4 = __builtin_nontemporal_load((const f32x4*)(p.in[1] + (size_t)(row - MP) * 1024 + c)), g4 = *(const f32x4*)((const float*)(p.ws + WS_MOD) + (size_t)mod_row(row) * 3072 + 2048 + c);
            __builtin_nontemporal_store(x4 + g4 * r[i], (f32x4*)(p.out + O_Y + (size_t)row * 1024 + c)); }
    }
}

__global__ void __launch_bounds__(512) mega_fwd(Params p) {
    extern __shared__ __attribute__((aligned(16))) unsigned char lds[];
    cg::grid_group grid = cg::this_grid();
    const int lo = p.ph_lo, hi = p.ph_hi;
#define IN(k) (lo <= (k) && (k) < hi)
    PG8_LAS unsigned char* glds = (PG8_LAS unsigned char*)lds;
    volatile LAS unsigned* xst = (volatile LAS unsigned*)(glds + 131072);
    if (threadIdx.x == 0) { xst[0] = 0u; xst[1] = 0u; }
    __syncthreads();
    const XcdBarrier xbar = xcd_barrier_post((unsigned*)(p.ws + WS_BAR), xst);
#ifndef PROBE_T
#define PROBE_T -1
#endif
    volatile LAS unsigned long long* tsl = (volatile LAS unsigned long long*)(glds + 131072 + 16);
#define STAMP(i) do { if (PROBE_T >= 0 && blockIdx.x == 0 && threadIdx.x == 0) tsl[i] = __builtin_amdgcn_s_memrealtime(); } while (0)
#define SEAM(k) do { if (IN(k) && IN((k) + 1)) xcd_barrier(xbar); STAMP((k) + 1); } while (0)
    STAMP(0);
#ifndef PROBE_MASK
#define PROBE_MASK 0
#endif
#define REP(bit) ((((PROBE_MASK) >> (bit)) & 1) + 1)
    if (IN(0)) { phase0a(p); xcd_barrier(xbar); for (int rep = 0; rep < REP(0); ++rep) phase0(p, lds);
        constexpr int I_IN = 16 * 160;
        if (gridDim.x == 256) { if (blockIdx.x < 64) phase0b(p, lds, blockIdx.x * 8, 1536, 512); else phase0b(p, lds, 1536 + (blockIdx.x - 64) * 8, I_IN, 1536); }
        else phase0b(p, lds, blockIdx.x * 8, I_IN, gridDim.x * 8); }
    SEAM(0);
    if (REP(11) > 1) { grid.sync(); grid.sync(); grid.sync(); grid.sync(); }
    if (REP(12) > 1) { xcd_barrier(xbar); xcd_barrier(xbar); xcd_barrier(xbar); xcd_barrier(xbar); }
    if (IN(1)) for (int rep = 0; rep < REP(1); ++rep) { phase1(p); phase_rope(p); }
    SEAM(1);
    const bool split = gridDim.x > 80 && ((gridDim.x - 80) & 3) == 0;
    if (IN(2)) { pg8::Gemm g{(const bf16_t*)(p.ws + WS_H), (const bf16_t*)(p.ws + WS_WIN), MT, NINP, 1024}; pg8::StaticOrder S; S.init(split ? MP : MT, NINP, gridDim.x, blockIdx.x);
        EpiProj E{p.ws}; pg8::gemm_phase<EpiProj, pg8::StaticOrder, true, true>(glds, g, S, E); STAMP(15);
        if (!split) phase0c(p, lds, blockIdx.x, gridDim.x); }
    SEAM(2);
    if (IN(3)) {
        if (split) {
            if (blockIdx.x < 80) { pg8::Gemm g{(const bf16_t*)(p.ws + WS_H), (const bf16_t*)(p.ws + WS_WIN), MT, NINP, 1024}; SampleOrder S{(int)blockIdx.x};
                EpiProj E{p.ws}; pg8::gemm_phase<EpiProj, SampleOrder, true, true>(glds, g, S, E); }
            else phase0c(p, lds, blockIdx.x - 80, gridDim.x - 80);
            GlaRaw R1; const int u1 = (int)blockIdx.x - 80;
            if (u1 >= 0 && u1 < 1024) gla_load<1>(p, u1, R1, opaque_tid());
            for (int u = blockIdx.x; u < 256; u += gridDim.x) attn_prompt_unit(p, lds, u);
            STAMP(12);
            if (u1 >= 0) gla_units_run<1>(p, lds, u1, 1024, gridDim.x - 80, R1);
            STAMP(13);
            xcd_barrier(xbar);
            gla_scan(p);
            for (int u = blockIdx.x; u < 256; u += gridDim.x) attn_sample_unit(p, lds, u);
            gla_units<3>(p, lds, 1024 + blockIdx.x, 1536, gridDim.x);
            STAMP(14);
        } else {
            for (int u = blockIdx.x; u < 512; u += gridDim.x) { if (u < 256) attn_prompt_unit(p, lds, u); else attn_sample_unit(p, lds, u - 256); }
            gla_units<1>(p, lds, blockIdx.x, 1024, gridDim.x);
            gla_units<3>(p, lds, 1024 + blockIdx.x, 1536, gridDim.x);
        }
    }
    if (!split) { SEAM(3); if (IN(4)) gla_scan(p); }
    SEAM(4);
    if (IN(5)) gla_units<2>(p, lds, blockIdx.x, 1024, gridDim.x);
    SEAM(5);
    if (IN(6)) for (int rep = 0; rep < REP(7); ++rep) {
        BranchOrder S; S.base.init(MP, 1024, gridDim.x, blockIdx.x);
        pg8::Gemm g{(const bf16_t*)(p.ws + WS_OA), (const bf16_t*)(p.ws + WS_WBA), 2 * MT, 2048, 512};
        EpiBranch E{p.ws};
        const bool small_first = (blockIdx.x & 4) != 0;
        if (small_first) small_merge_tiles(p, lds);
        pg8::gemm_phase<EpiBranch, BranchOrder, true, true>(glds, g, S, E);
        if (!small_first) small_merge_tiles(p, lds);
    }
    SEAM(6);
    if (IN(7)) for (int rep = 0; rep < REP(8); ++rep) { pg8::Gemm g{(const bf16_t*)(p.ws + WS_MRG), (const bf16_t*)(p.ws + WS_WOUT), MP, 1024, 1024}; pg8::StaticOrder S; S.init(MP, 1024, gridDim.x, blockIdx.x);
        EpiOut E{p.in[0], (const float*)(p.ws + WS_MOD), p.out + O_Y};
        const bool small_first = (blockIdx.x & 4) != 0;
        if (small_first) small_out_tiles(p, lds);
        pg8::gemm_phase<EpiOut, pg8::StaticOrder, false, true>(glds, g, S, E);
        if (!small_first) small_out_tiles(p, lds); }
    STAMP(8);
    if (PROBE_T >= 0 && blockIdx.x == 0 && threadIdx.x == 0) {
#ifndef PROBE_A
#define PROBE_A PROBE_T
#define PROBE_B (PROBE_T + 1)
#endif
        const unsigned long long d = tsl[PROBE_B] - tsl[PROBE_A], t0 = __builtin_amdgcn_s_memrealtime();
        while (__builtin_amdgcn_s_memrealtime() - t0 < 4ull * d) __builtin_amdgcn_s_sleep(16);
    }
    if (hi > 1000) grid.sync();
#undef IN
#undef SEAM
}

constexpr int LDS_BYTES = 131072 + 16 + 128;
#ifndef N_LAUNCH_MODE
#define N_LAUNCH_MODE 1
#endif

extern "C" void kernel_launch(void* const* d_in, const int* in_sizes, int n_in, void* d_out, int out_size, void* d_ws, size_t ws_size, hipStream_t stream) {
    static int grid = 0;
    if (grid == 0) {
        if (n_in != 20 || ws_size < WS_END) { fprintf(stderr, "kernel_launch: unexpected n_in %d / ws_size %zu (need %zu)\n", n_in, ws_size, (size_t)WS_END); grid = -1; return; }
        int dev = 0, cus = 0, per_cu = 0;
        hipGetDevice(&dev);
        hipDeviceGetAttribute(&cus, hipDeviceAttributeMultiprocessorCount, dev);
        if (hipFuncSetAttribute((const void*)mega_fwd, hipFuncAttributeMaxDynamicSharedMemorySize, LDS_BYTES) != hipSuccess) { fprintf(stderr, "kernel_launch: hipFuncSetAttribute failed\n"); grid = -1; return; }
        if (hipOccupancyMaxActiveBlocksPerMultiprocessor(&per_cu, (const void*)mega_fwd, 512, LDS_BYTES) != hipSuccess || per_cu < 1) { fprintf(stderr, "kernel_launch: occupancy query gives %d\n", per_cu); per_cu = 1; }
        (void)hipGetLastError();
        grid = cus * 1;
        if (grid > cus * per_cu) grid = cus * per_cu;
    }
    if (grid < 0) return;
    Params p{};
    for (int i = 0; i < 20; ++i) p.in[i] = (const float*)d_in[i];
    p.out = (float*)d_out; p.ws = (unsigned char*)d_ws;
    for (int i = 0; i < 32; ++i) { const float e = (float)i / 32.0f; const float pw = powf(10000.0f, e); p.inv[i] = 1.0f / pw; }
    if (hipMemsetAsync((unsigned char*)d_ws + WS_BAR, 0, 16384, stream) != hipSuccess) { fprintf(stderr, "kernel_launch: memset of barrier words failed\n"); return; }
#if N_LAUNCH_MODE == 1
    p.ph_lo = 0; p.ph_hi = 8;
    void* args[] = {&p};
    hipError_t e = hipLaunchCooperativeKernel((const void*)mega_fwd, dim3(grid), dim3(512), args, LDS_BYTES, stream);
    if (e != hipSuccess) fprintf(stderr, "cooperative launch failed: %s (grid %d)\n", hipGetErrorString(e), grid);
#else
    for (int ph = 0; ph < 8; ++ph) { p.ph_lo = ph; p.ph_hi = ph + 1;
        hipLaunchKernelGGL(mega_fwd, dim3(grid), dim3(512), LDS_BYTES, stream, p); }
#endif
}
```

```cpp
#include <hip/hip_runtime.h>
#include <hip/hip_cooperative_groups.h>
#include <cstdio>
#include <cstdint>
#include <cmath>
namespace cg = cooperative_groups;
__device__ __forceinline__ int opaque_tid() { int t = threadIdx.x; asm volatile("" : "+v"(t)); return t; }
#define PROBE_MASK 0
#define PROBE_T -1
namespace pg8 {
#define PG8_LAS __attribute__((address_space(3)))
typedef unsigned short bf16_t;
typedef short bf16x8 __attribute__((ext_vector_type(8)));
typedef float f32x4 __attribute__((ext_vector_type(4)));
typedef unsigned u32x4 __attribute__((ext_vector_type(4)));
constexpr int BM = 256, BK = 64, HALF = 128, HTB = HALF * BK * 2  , STAGE_BYTES = 8 * HTB, NXCD = 8, WGM = 8;

__host__ __device__ __forceinline__ int lds_byte(int r, int c) { const int st = (r >> 4) * 2 + (c >> 5), rr = r & 15, cc = c & 31, ob = rr * 64 + cc * 2; return st * 1024 + (ob ^ (((ob >> 9) & 1) << 5)); }
__host__ __device__ __forceinline__ void stage_rc(int b, int& R, int& C) { const int st = b / 1024, sb = b % 1024, swz = sb ^ (((sb >> 9) & 1) << 5); R = (st >> 1) * 16 + swz / 64; C = (st & 1) * 32 + (swz % 64) / 2; }
__host__ __device__ __forceinline__ int perm32(int rho) { const int n = rho >> 4, i = rho & 15; return 8 * (i >> 2) + 4 * n + (i & 3); }

struct Unit { int pm, pn; };
struct Gemm { const bf16_t* A; const bf16_t* Bt; int M, N, K; };

struct StaticOrder {
    int nM, nN, nwg, G, c;
    __host__ __device__ void init(int M, int N, int G_, int c_) { nM = M / BM; nN = N / BM; nwg = nM * nN; G = G_; c = c_; }
    __host__ __device__ bool next(int i, Unit& u) const {
        const long L = (long)i * G + c; if (L >= nwg) return false;
        int wgid = (int)L; { const int q = nwg / NXCD, r = nwg % NXCD, xcd = wgid % NXCD, off = wgid / NXCD; wgid = (xcd < r ? xcd * (q + 1) : r * (q + 1) + (xcd - r) * q) + off; }
        const int nig = WGM * nN, gid = wgid / nig, fm = gid * WGM, gsz = (nM - fm) < WGM ? (nM - fm) : WGM;
        u.pm = fm + ((wgid % nig) % gsz); u.pn = (wgid % nig) / gsz; return true;
    }
    __device__ __forceinline__ void a_ready(const Unit&) const {}
    __device__ __forceinline__ void done(const Unit&) const {}
};
__device__ __forceinline__ unsigned cvt_pk_bf16(float lo, float hi) { unsigned r; asm volatile("v_cvt_pk_bf16_f32 %0, %1, %2" : "=v"(r) : "v"(lo), "v"(hi)); return r; }
typedef float f32x2 __attribute__((ext_vector_type(2)));
template <class Epi, class Sched, bool ALIGN_EPI = false, bool SP2 = false>
__device__ __forceinline__ void gemm_phase(PG8_LAS unsigned char* lds, const Gemm g, const Sched& S, const Epi& E) {
    const int tid = opaque_tid(), wid = __builtin_amdgcn_readfirstlane(tid >> 6), lane = tid & 63, wr = wid >> 2, wc = wid & 3, fr = lane & 15, fq = lane >> 4;
    const int K = g.K, nt = K / BK;
    unsigned voffA[2], voffB[2];
#pragma unroll
    for (int i = 0; i < 2; ++i) { int R, C; stage_rc(tid * 16 + i * 8192, R, C); const int Rb = Epi::PERM ? ((R & ~31) + perm32(R & 31)) : R;
        voffA[i] = (unsigned)(R * K + C) * 2u; voffB[i] = (unsigned)(Rb * K + C) * 2u; }
    const size_t kstep = (size_t)(BK * 2);
    const size_t hstep = (size_t)HALF * K * 2;
    const size_t tstep = 2 * hstep;
    const unsigned ldsw = (unsigned)wid * 1024u;
    const int aoff = lds_byte(wr * 64 + fr, fq * 8), boff = lds_byte(wc * 32 + fr, fq * 8);
#define PG8_SA(b, h) (((b) * 2 + (h)) * HTB)
#define PG8_SB(b, h) ((4 + (b) * 2 + (h)) * HTB)
#define PG8_STAGE(bufoff, gbase, voff) do { _Pragma("unroll") for (int _i = 0; _i < 2; ++_i) \
        __builtin_amdgcn_global_load_lds((const unsigned*)((const char*)(gbase) + (voff)[_i]), (PG8_LAS unsigned*)(lds + (bufoff) + ldsw + _i * 8192), 16, 0, 0); } while (0)
#define PG8_LDA(dst, b, h) do { _Pragma("unroll") for (int m = 0; m < 4; ++m) _Pragma("unroll") for (int k = 0; k < 2; ++k) dst[m][k] = *(const PG8_LAS bf16x8*)(lds + PG8_SA(b, h) + aoff + m * 2048 + k * 1024); } while (0)
#define PG8_LDB(dst, b, h) do { _Pragma("unroll") for (int n = 0; n < 2; ++n) _Pragma("unroll") for (int k = 0; k < 2; ++k) dst[n][k] = *(const PG8_LAS bf16x8*)(lds + PG8_SB(b, h) + boff + n * 2048 + k * 1024); } while (0)
#define PG8_MMA(ai, bj, At, Bt) do { __builtin_amdgcn_s_setprio(1); _Pragma("unroll") for (int m = 0; m < 4; ++m) _Pragma("unroll") for (int n = 0; n < 2; ++n) _Pragma("unroll") for (int k = 0; k < 2; ++k) \
        acc[ai][bj][m][n] = __builtin_amdgcn_mfma_f32_16x16x32_bf16(Bt[n][k], At[m][k], acc[ai][bj][m][n], 0, 0, 0); __builtin_amdgcn_s_setprio(0); } while (0)
#define PG8_WAIT_V(n) asm volatile("s_waitcnt vmcnt(" #n ")" ::: "memory")
#define PG8_WAIT_L(n) asm volatile("s_waitcnt lgkmcnt(" #n ")" ::: "memory")
#define PG8_BAR __builtin_amdgcn_s_barrier()
#define PG8_SCHED __builtin_amdgcn_sched_barrier(0)
    Unit cur, nxt; int ui = 0;
    if (!S.next(0, cur)) return;
    f32x4 acc[2][2][4][2];
#pragma unroll
    for (int a = 0; a < 2; ++a)
#pragma unroll
        for (int b = 0; b < 2; ++b)
#pragma unroll
            for (int m = 0; m < 4; ++m)
#pragma unroll
                for (int n = 0; n < 2; ++n) acc[a][b][m][n] = (f32x4){0.f, 0.f, 0.f, 0.f};
    bf16x8 At[4][2], B0[2][2], B1[2][2];
    const char* cA = (const char*)g.A + (size_t)cur.pm * tstep; const char* cB = (const char*)g.Bt + (size_t)cur.pn * tstep;
    S.a_ready(cur);
    if constexpr (SP2) {
        PG8_STAGE(PG8_SB(0, 0), cB, voffB); PG8_STAGE(PG8_SB(0, 1), cB + hstep, voffB); PG8_STAGE(PG8_SA(0, 0), cA, voffA); PG8_STAGE(PG8_SA(0, 1), cA + hstep, voffA);
        if (wr == 1) PG8_BAR;
        PG8_WAIT_V(2); PG8_BAR;
        PG8_STAGE(PG8_SB(1, 0), cB + kstep, voffB); PG8_STAGE(PG8_SA(1, 0), cA + kstep, voffA); PG8_STAGE(PG8_SB(1, 1), cB + hstep + kstep, voffB);
        PG8_WAIT_V(6); PG8_BAR;
    } else {
        PG8_STAGE(PG8_SB(0, 0), cB, voffB); PG8_STAGE(PG8_SA(0, 0), cA, voffA); PG8_STAGE(PG8_SB(0, 1), cB + hstep, voffB); PG8_STAGE(PG8_SA(0, 1), cA + hstep, voffA);
        if (wr == 1) PG8_BAR;
        PG8_WAIT_V(4); PG8_BAR;
        PG8_STAGE(PG8_SB(1, 0), cB + kstep, voffB); PG8_STAGE(PG8_SA(1, 0), cA + kstep, voffA); PG8_STAGE(PG8_SB(1, 1), cB + hstep + kstep, voffB);
        PG8_WAIT_V(6); PG8_BAR;
    }
    for (;;) {
        const bool has_next = S.next(ui + 1, nxt);
        const char* nA = has_next ? (const char*)g.A + (size_t)nxt.pm * tstep : cA; const char* nB = has_next ? (const char*)g.Bt + (size_t)nxt.pn * tstep : cB;
        for (int t = 0; t < nt; t += 2) {
            const bool last = (t == nt - 2);
            const char* a1 = cA + (size_t)(t + 1) * kstep;
            const char* a2 = last ? nA : cA + (size_t)(t + 2) * kstep; const char* b2 = last ? nB : cB + (size_t)(t + 2) * kstep;
            const char* a3 = a2 + kstep; const char* b3 = b2 + kstep;
            if (last && has_next) S.a_ready(nxt);
            if constexpr (SP2) {
            PG8_LDB(B0, 0, 0); PG8_LDB(B1, 0, 1); PG8_SCHED; PG8_LDA(At, 0, 0); PG8_STAGE(PG8_SA(1, 1), a1 + hstep, voffA);
            PG8_WAIT_V(8); PG8_WAIT_L(0); PG8_BAR; PG8_MMA(0, 0, At, B0); PG8_MMA(0, 1, At, B1); PG8_BAR; PG8_SCHED;
            PG8_LDA(At, 0, 1); PG8_STAGE(PG8_SB(0, 0), b2, voffB); PG8_STAGE(PG8_SB(0, 1), b2 + hstep, voffB); PG8_STAGE(PG8_SA(0, 0), a2, voffA);
            PG8_WAIT_V(8); PG8_WAIT_L(0); PG8_BAR; PG8_MMA(1, 0, At, B0); PG8_MMA(1, 1, At, B1); PG8_BAR; PG8_SCHED;
            PG8_LDB(B0, 1, 0); PG8_LDB(B1, 1, 1); PG8_SCHED; PG8_LDA(At, 1, 0); PG8_STAGE(PG8_SA(0, 1), a2 + hstep, voffA);
            PG8_WAIT_V(8); PG8_WAIT_L(0); PG8_BAR; PG8_MMA(0, 0, At, B0); PG8_MMA(0, 1, At, B1); PG8_BAR; PG8_SCHED;
            PG8_LDA(At, 1, 1); PG8_STAGE(PG8_SB(1, 0), b3, voffB); PG8_STAGE(PG8_SB(1, 1), b3 + hstep, voffB); PG8_STAGE(PG8_SA(1, 0), a3, voffA);
            PG8_WAIT_V(8); PG8_WAIT_L(0); PG8_BAR; PG8_MMA(1, 0, At, B0); PG8_MMA(1, 1, At, B1); PG8_BAR; PG8_SCHED;
            } else {
            PG8_LDB(B0, 0, 0); PG8_SCHED; PG8_LDA(At, 0, 0); PG8_STAGE(PG8_SA(1, 1), a1 + hstep, voffA);
            PG8_WAIT_L(8); PG8_BAR; PG8_WAIT_L(0); PG8_MMA(0, 0, At, B0); PG8_BAR; PG8_SCHED;
            PG8_LDB(B1, 0, 1); PG8_STAGE(PG8_SB(0, 0), b2, voffB);
            PG8_BAR; PG8_WAIT_L(0); PG8_MMA(0, 1, At, B1); PG8_BAR;
            PG8_LDA(At, 0, 1); PG8_STAGE(PG8_SA(0, 0), a2, voffA);
            PG8_BAR; PG8_WAIT_L(0); PG8_MMA(1, 0, At, B0); PG8_BAR; PG8_SCHED;
            PG8_STAGE(PG8_SB(0, 1), b2 + hstep, voffB);
            PG8_WAIT_V(6); PG8_BAR; PG8_MMA(1, 1, At, B1); PG8_BAR;
            PG8_LDB(B0, 1, 0); PG8_SCHED; PG8_LDA(At, 1, 0); PG8_STAGE(PG8_SA(0, 1), a2 + hstep, voffA);
            PG8_WAIT_L(8); PG8_BAR; PG8_WAIT_L(0); PG8_MMA(0, 0, At, B0); PG8_BAR; PG8_SCHED;
            PG8_LDB(B1, 1, 1); PG8_STAGE(PG8_SB(1, 0), b3, voffB);
            PG8_BAR; PG8_WAIT_L(0); PG8_MMA(0, 1, At, B1); PG8_BAR;
            PG8_LDA(At, 1, 1); PG8_STAGE(PG8_SA(1, 0), a3, voffA);
            PG8_BAR; PG8_WAIT_L(0); PG8_MMA(1, 0, At, B0); PG8_BAR; PG8_SCHED;
            PG8_STAGE(PG8_SB(1, 1), b3 + hstep, voffB);
            PG8_WAIT_V(6); PG8_BAR; PG8_MMA(1, 1, At, B1); PG8_BAR;
            }
        }
        if constexpr (ALIGN_EPI) { if (wr == 0) PG8_BAR; }
        if constexpr (!Epi::AFTER_DRAIN) { E(acc, cur, wr, wc, fr, fq); S.done(cur); }
        if (!has_next) break;
        if (!(Epi::CHAIN && (ui & 1) == 0)) {
#pragma unroll
        for (int a = 0; a < 2; ++a)
#pragma unroll
            for (int b = 0; b < 2; ++b)
#pragma unroll
                for (int m = 0; m < 4; ++m)
#pragma unroll
                    for (int n = 0; n < 2; ++n) acc[a][b][m][n] = (f32x4){0.f, 0.f, 0.f, 0.f};
        }
        cur = nxt; cA = nA; cB = nB; ++ui;
        if constexpr (ALIGN_EPI) { if (wr == 1) PG8_BAR; }
    }
    PG8_WAIT_V(0);
    if constexpr (!ALIGN_EPI) { if (wr == 0) PG8_BAR; }
    PG8_BAR;
    if constexpr (Epi::AFTER_DRAIN) { E.fused(acc, cur, wr, wc, fr, fq, lds, wid, lane); S.done(cur); }
#undef PG8_SA
#undef PG8_SB
#undef PG8_STAGE
#undef PG8_LDA
#undef PG8_LDB
#undef PG8_MMA
#undef PG8_WAIT_V
#undef PG8_WAIT_L
#undef PG8_BAR
#undef PG8_SCHED
}
}
#define XB_TMO      128
#define XB_XCNT(j)  (256  + 64 * (j))
#define XB_XSUB(j)  (1280 + 64 * (j))
#define XB_XGEN(j)  (2304 + 64 * (j))
#define XB_TOP      3328
#define XB_TOPGEN   3392
#define XCD_BAR_WORDS 3456
#define XB_SPIN_CAP (1u << 18)
#define LAS __attribute__((address_space(3)))

__device__ __forceinline__ unsigned xb_ld(unsigned* p)              { return __hip_atomic_load(p, __ATOMIC_RELAXED, __HIP_MEMORY_SCOPE_AGENT); }
__device__ __forceinline__ unsigned xb_add(unsigned* p, unsigned v) { return __hip_atomic_fetch_add(p, v, __ATOMIC_RELAXED, __HIP_MEMORY_SCOPE_AGENT); }
__device__ __forceinline__ unsigned xb_xcc_id() { return (unsigned)__builtin_amdgcn_s_getreg((3 << 11) | 20) & 0xFu; }
#define XB_SPIN(cond, bar) do { unsigned _sp = 0; while (cond) { __builtin_amdgcn_s_sleep(1); \
    if ((++_sp & 255u) == 0u) { if (xb_ld(&(bar)[XB_TMO])) break; if (_sp > XB_SPIN_CAP) { atomicAdd(&(bar)[XB_TMO], 1u); break; } } } } while (0)

struct XcdBarrier {
    unsigned* bar; unsigned x;
    volatile LAS unsigned* st;
};

__device__ __forceinline__ XcdBarrier xcd_barrier_post(unsigned* bar, volatile LAS unsigned* st) {
    XcdBarrier b; b.bar = bar; b.x = xb_xcc_id(); b.st = st;
    if (threadIdx.x == 0) (void)xb_add(&bar[XB_XCNT(b.x)], 1u);
    return b;
}
__device__ __forceinline__ void xcd_barrier_complete(unsigned* bar, unsigned x, unsigned& nloc, unsigned& nx) {
    const unsigned G = gridDim.x * gridDim.y * gridDim.z;
    unsigned sum, cnt, mine, sp = 0u;
    for (;;) {
        sum = 0u; cnt = 0u; mine = 0u;
#pragma unroll
        for (unsigned j = 0; j < 16; ++j) { const unsigned c = xb_ld(&bar[XB_XCNT(j)]); sum += c; cnt += (c > 0u) ? 1u : 0u; mine = (j == x) ? c : mine; }
        if (sum == G) break;
        __builtin_amdgcn_s_sleep(1);
        if ((++sp & 255u) == 0u) { if (xb_ld(&bar[XB_TMO])) break; if (sp > XB_SPIN_CAP) { atomicAdd(&bar[XB_TMO], 1u); break; } }
    }
    nloc = mine > 0u ? mine : 1u; nx = cnt > 0u ? cnt : 1u;
}

__device__ __forceinline__ void xcd_barrier(const XcdBarrier& b) {
    asm volatile("s_waitcnt vmcnt(0)" ::: "memory");
    __syncthreads();
    if (threadIdx.x == 0) {
        unsigned* bar = b.bar;
        __builtin_amdgcn_s_waitcnt(0);
        unsigned nloc = b.st[0], nx = b.st[1];
        if (nloc == 0u) { xcd_barrier_complete(bar, b.x, nloc, nx); b.st[0] = nloc; b.st[1] = nx; }
        const unsigned old = xb_add(&bar[XB_XSUB(b.x)], 1u);
        const unsigned gen = old / nloc;
        if (old + 1u == (gen + 1u) * nloc) {
            __builtin_amdgcn_fence(__ATOMIC_RELEASE, "agent");
            asm volatile("s_waitcnt vmcnt(0)" ::: "memory");
            const unsigned og = xb_add(&bar[XB_TOP], 1u);
            const unsigned tg = og / nx;
            if (og + 1u == (tg + 1u) * nx) xb_add(&bar[XB_TOPGEN], 1u);
            else XB_SPIN(xb_ld(&bar[XB_TOPGEN]) == tg, bar);
            __builtin_amdgcn_fence(__ATOMIC_ACQUIRE, "agent");
            xb_add(&bar[XB_XGEN(b.x)], 1u);
            asm volatile("s_waitcnt vmcnt(0)" ::: "memory");
        } else {
            XB_SPIN(xb_ld(&bar[XB_XGEN(b.x)]) == gen, bar);
            __builtin_amdgcn_fence(__ATOMIC_ACQUIRE, "agent");
            asm volatile("s_waitcnt vmcnt(0)" ::: "memory");
        }
    }
    __syncthreads();
}

using pg8::bf16_t; using pg8::bf16x8; using pg8::f32x4; using pg8::u32x4; using pg8::Unit;
typedef unsigned u32x2 __attribute__((ext_vector_type(2)));
typedef float f32x2v __attribute__((ext_vector_type(2)));
typedef __bf16 bf16x2v __attribute__((ext_vector_type(2)));

constexpr int DM = 1024, SEQ = 8192, MP = 16384, MS = 1024, MT = MP + MS;
constexpr int NIN = 4880, NINP = 5120;
constexpr float EPS = 1e-6f;
constexpr float LOG2E = 1.4426950408889634f;

constexpr size_t WS_MOD = 0;
constexpr size_t WS_ROPE = WS_MOD + 1597440;
constexpr size_t WS_WIN = WS_ROPE + 2099200;
constexpr size_t WS_WBA = WS_WIN + 10485760;
constexpr size_t WS_WBG = WS_WBA + 1048576;
constexpr size_t WS_WOUT = WS_WBG + 1048576;
constexpr size_t WS_H = WS_WOUT + 2097152;
constexpr size_t WS_OA = WS_H;
constexpr size_t WS_OG = WS_H + 17825792;
constexpr size_t WS_QA = WS_H + 35651584;
constexpr size_t WS_KA = WS_QA + 17825792;
constexpr size_t WS_VA = WS_KA + 4456448;
constexpr size_t WS_QG = WS_VA + 4456448;
constexpr size_t WS_TMP = WS_QA;
constexpr size_t WS_KG = WS_QG + 8912896;
constexpr size_t WS_VG = WS_KG + 8912896;
constexpr size_t WS_ZG = WS_VG + 17825792;
constexpr size_t WS_MRG = WS_KG;
constexpr size_t WS_ZA = WS_ZG + 17825792;
constexpr size_t WS_MA = WS_ZA + 17825792;
constexpr size_t WS_MG = WS_MA + 35651584;
constexpr size_t WS_LR = WS_MG + 35651584;
constexpr size_t WS_DS = WS_LR + 4456448;
constexpr size_t WS_DEC = WS_DS + 33554432;
constexpr size_t WS_BAR = WS_DEC + 262144;
constexpr size_t WS_CS = WS_BAR + 16384;
constexpr size_t WS_END = WS_CS + 294912;

constexpr size_t O_Y = 0;
constexpr size_t O_PWK = 17825792;
constexpr size_t O_PWV = O_PWK + 32768;
constexpr size_t O_PGS = O_PWV + 32768;
constexpr size_t O_SWK = O_PGS + 65536;
constexpr size_t O_SWV = O_SWK + 2097152;
constexpr size_t O_SGS = O_SWV + 2097152;

struct Params {
    const float* in[20];
    float* out; unsigned char* ws;
    float inv[32];
    int ph_lo, ph_hi;
};

__device__ __forceinline__ unsigned pk2(float lo, float hi) { f32x2v v = {lo, hi}; bf16x2v b = __builtin_convertvector(v, bf16x2v); return __builtin_bit_cast(unsigned, b); }
__device__ __forceinline__ float bflo(unsigned w) { return __uint_as_float(w << 16); }
__device__ __forceinline__ float bfhi(unsigned w) { return __uint_as_float(w & 0xffff0000u); }
__device__ __forceinline__ float bf2f(bf16_t h) { return __uint_as_float((unsigned)h << 16); }
__device__ __forceinline__ float fast_rcp(float x) { return __builtin_amdgcn_rcpf(x); }
__device__ __forceinline__ float sigmoidf_(float x) { return fast_rcp(1.f + __expf(-x)); }
__device__ __forceinline__ float siluf_(float x) { return x * fast_rcp(1.f + __expf(-x)); }
__device__ __forceinline__ float wave_sum(float v) {
#pragma unroll
    for (int o = 1; o < 64; o <<= 1) v += __shfl_xor(v, o);
    return v;
}
__device__ __forceinline__ f32x4 mfma16(bf16x8 a, bf16x8 b, f32x4 c) { return __builtin_amdgcn_mfma_f32_16x16x32_bf16(a, b, c, 0, 0, 0); }
__device__ __forceinline__ void unpack8(const u32x4 w, float (&a)[8]) {
    a[0] = bflo(w.x); a[1] = bfhi(w.x); a[2] = bflo(w.y); a[3] = bfhi(w.y); a[4] = bflo(w.z); a[5] = bfhi(w.z); a[6] = bflo(w.w); a[7] = bfhi(w.w);
}
__device__ __forceinline__ u32x4 pack8(const float (&a)[8]) { u32x4 w; w.x = pk2(a[0], a[1]); w.y = pk2(a[2], a[3]); w.z = pk2(a[4], a[5]); w.w = pk2(a[6], a[7]); return w; }
__device__ __forceinline__ u32x4 pack8s(const float (&a)[8], float sc) { u32x4 w; w.x = pk2(a[0] * sc, a[1] * sc); w.y = pk2(a[2] * sc, a[3] * sc); w.z = pk2(a[4] * sc, a[5] * sc); w.w = pk2(a[6] * sc, a[7] * sc); return w; }
__device__ __forceinline__ int mod_row(int r) { return r < MP ? (r >> 13) : 2 + ((r - MP) >> 3); }

struct EpiProj {
    static constexpr bool PERM = true, AFTER_DRAIN = false, CHAIN = false;
    unsigned char* ws;
    __device__ __forceinline__ void operator()(const f32x4 (&acc)[2][2][4][2], const Unit& u, int wr, int wc, int fr, int fq) const {
        const int row0 = u.pm * 256 + wr * 64 + fr;
#pragma unroll
        for (int bj = 0; bj < 2; ++bj) {
            const int cb = u.pn * 2 + bj;
            size_t off; int ld, cbase, act;
            if (cb < 4) { off = WS_QA; ld = 512; cbase = cb * 128; act = 0; }
            else if (cb == 4) { off = WS_KA; ld = 128; cbase = 0; act = 0; }
            else if (cb == 5) { off = WS_VA; ld = 128; cbase = 0; act = 0; }
            else if (cb < 10) { off = WS_ZA; ld = 512; cbase = (cb - 6) * 128; act = 1; }
            else if (cb < 12) { off = WS_QG; ld = 256; cbase = (cb - 10) * 128; act = 3; }
            else if (cb < 14) { off = WS_KG; ld = 256; cbase = (cb - 12) * 128; act = 0; }
            else if (cb < 18) { off = WS_VG; ld = 512; cbase = (cb - 14) * 128; act = 0; }
            else if (cb < 22) { off = WS_ZG; ld = 512; cbase = (cb - 18) * 128; act = 1; }
            else if (cb < 30) { off = WS_MA; ld = 1024; cbase = (cb - 22) * 128; act = 2; }
            else if (cb < 38) { off = WS_MG; ld = 1024; cbase = (cb - 30) * 128; act = 2; }
            else if (cb == 38) { off = WS_LR; ld = 128; cbase = 0; act = 0; }
            else continue;
            bf16_t* base = (bf16_t*)(ws + off) + cbase + wc * 32 + 8 * fq;
#pragma unroll
            for (int ai = 0; ai < 2; ++ai)
#pragma unroll
                for (int m = 0; m < 4; ++m) {
                    f32x4 v0 = acc[ai][bj][m][0], v1 = acc[ai][bj][m][1];
                    if (act == 1) { for (int j = 0; j < 4; ++j) { v0[j] = siluf_(v0[j]); v1[j] = siluf_(v1[j]); } }
                    else if (act == 2) { for (int j = 0; j < 4; ++j) { v0[j] = sigmoidf_(v0[j]); v1[j] = sigmoidf_(v1[j]); } }
                    else if (act == 3) { v0 = v0 * 0.125f; v1 = v1 * 0.125f; }
                    u32x4 w; w.x = pk2(v0[0], v0[1]); w.y = pk2(v0[2], v0[3]); w.z = pk2(v1[0], v1[1]); w.w = pk2(v1[2], v1[3]);
                    if (cb >= 22 && cb < 38) __builtin_nontemporal_store(w, (u32x4*)(base + (size_t)(row0 + ai * 128 + m * 16) * ld)); else *(u32x4*)(base + (size_t)(row0 + ai * 128 + m * 16) * ld) = w;
                }
        }
    }
};
struct EpiBranch {
    static constexpr bool PERM = true, AFTER_DRAIN = false, CHAIN = true;
    unsigned char* ws;
    __device__ __forceinline__ void operator()(f32x4 (&acc)[2][2][4][2], const Unit& u, int wr, int wc, int fr, int fq) const {
        const bool second = u.pm >= 68;
        const int pm = second ? u.pm - 68 : u.pm, pn = second ? u.pn - 4 : u.pn;
        const size_t o0 = (size_t)(pm * 256 + wr * 64 + fr) * 1024 + pn * 256 + wc * 32 + 8 * fq;
        const bf16_t* ma = (const bf16_t*)(ws + WS_MA) + o0; const bf16_t* mg = (const bf16_t*)(ws + WS_MG) + o0;
        bf16_t* dst = (bf16_t*)(ws + WS_MRG) + o0;
#pragma unroll
        for (int ai = 0; ai < 2; ++ai) {
            u32x4 g[4][2], t[4][2];
#pragma unroll
            for (int m = 0; m < 4; ++m)
#pragma unroll
                for (int bj = 0; bj < 2; ++bj) { const size_t o = (size_t)(ai * 128 + m * 16) * 1024 + bj * 128;
                    g[m][bj] = *(const u32x4*)(mg + o);     t[m][bj] = (u32x4){0u, 0u, 0u, 0u}; if (!second) t[m][bj] = __builtin_nontemporal_load((const u32x4*)(ma + o)); }
#pragma unroll
            for (int m = 0; m < 4; ++m)
#pragma unroll
                for (int bj = 0; bj < 2; ++bj) { const size_t o = (size_t)(ai * 128 + m * 16) * 1024 + bj * 128;
                    const u32x4 gg = g[m][bj], tt = t[m][bj];
                    f32x4& v0 = acc[ai][bj][m][0]; f32x4& v1 = acc[ai][bj][m][1];
                    if (!second) {
                        v0[0] *= bflo(tt.x) * fast_rcp(bflo(gg.x)); v0[1] *= bfhi(tt.x) * fast_rcp(bfhi(gg.x)); v0[2] *= bflo(tt.y) * fast_rcp(bflo(gg.y)); v0[3] *= bfhi(tt.y) * fast_rcp(bfhi(gg.y));
                        v1[0] *= bflo(tt.z) * fast_rcp(bflo(gg.z)); v1[1] *= bfhi(tt.z) * fast_rcp(bfhi(gg.z)); v1[2] *= bflo(tt.w) * fast_rcp(bflo(gg.w)); v1[3] *= bfhi(tt.w) * fast_rcp(bfhi(gg.w));
                    } else {
                        u32x4 w; w.x = pk2(v0[0] * bflo(gg.x), v0[1] * bfhi(gg.x)); w.y = pk2(v0[2] * bflo(gg.y), v0[3] * bfhi(gg.y));
                        w.z = pk2(v1[0] * bflo(gg.z), v1[1] * bfhi(gg.z)); w.w = pk2(v1[2] * bflo(gg.w), v1[3] * bfhi(gg.w));
                        *(u32x4*)(dst + o) = w; }
                }
        }
    }
};
struct BranchOrder {
    pg8::StaticOrder base;
    __device__ __forceinline__ bool next(int i, Unit& u) const { if (i >= 2) return false; if (!base.next(0, u)) return false; if (i == 1) { u.pm += 68; u.pn += 4; } return true; }
    __device__ __forceinline__ void a_ready(const Unit&) const {}
    __device__ __forceinline__ void done(const Unit&) const {}
};
struct EpiOut {
    static constexpr bool PERM = false, AFTER_DRAIN = false, CHAIN = false;
    const float* xp; const float* mod; float* out;
    __device__ __forceinline__ void operator()(const f32x4 (&acc)[2][2][4][2], const Unit& u, int wr, int wc, int fr, int fq) const {
        const int col0 = u.pn * 256 + wc * 32 + 4 * fq;
        const float* grow = mod + (size_t)((u.pm * 256) >> 13) * 3072 + 2048 + col0;
        f32x4 g4[2][2];
#pragma unroll
        for (int bj = 0; bj < 2; ++bj)
#pragma unroll
            for (int n = 0; n < 2; ++n) g4[bj][n] = *(const f32x4*)(grow + bj * 128 + n * 16);
        const size_t r0 = (size_t)(u.pm * 256 + wr * 64 + fr) * 1024 + col0;
        f32x4 xb[8][2][2];
#pragma unroll
        for (int rg = 0; rg < 4; ++rg)
#pragma unroll
            for (int bj = 0; bj < 2; ++bj)
#pragma unroll
                for (int n = 0; n < 2; ++n) xb[rg][bj][n] = __builtin_nontemporal_load((const f32x4*)(xp + r0 + (size_t)((rg >> 2) * 128 + (rg & 3) * 16) * 1024 + bj * 128 + n * 16));
#pragma unroll
        for (int rg = 0; rg < 8; ++rg) {
            if (rg + 4 < 8) {
#pragma unroll
                for (int bj = 0; bj < 2; ++bj)
#pragma unroll
                    for (int n = 0; n < 2; ++n) xb[rg + 4][bj][n] = __builtin_nontemporal_load((const f32x4*)(xp + r0 + (size_t)(((rg + 4) >> 2) * 128 + ((rg + 4) & 3) * 16) * 1024 + bj * 128 + n * 16));
            }
            const int ai = rg >> 2, m = rg & 3;
#pragma unroll
            for (int bj = 0; bj < 2; ++bj)
#pragma unroll
                for (int n = 0; n < 2; ++n)
                    __builtin_nontemporal_store(xb[rg][bj][n] + g4[bj][n] * acc[ai][bj][m][n], (f32x4*)(out + r0 + (size_t)(ai * 128 + m * 16) * 1024 + bj * 128 + n * 16));
        }
    }
};

__device__ __forceinline__ void p0_ada(const Params& p, unsigned char* lds, int unit) {
    const int tid = opaque_tid(), lane = tid & 63, w = tid >> 6, fr = lane & 15, fq = lane >> 4;
    const int c0 = unit * 16;
    const float* wa = p.in[8];
    f32x4 acc[9];
#pragma unroll
    for (int i = 0; i < 9; ++i) acc[i] = (f32x4){0.f, 0.f, 0.f, 0.f};
    const bf16_t* cs = (const bf16_t*)(p.ws + WS_CS);
#pragma unroll 2
    for (int ks = 0; ks < 4; ++ks) {
        const int k0 = w * 128 + ks * 32 + fq * 8;
        float bv[8];
#pragma unroll
        for (int j = 0; j < 8; ++j) bv[j] = wa[(size_t)(k0 + j) * 3072 + c0 + fr];
        const bf16x8 bfrag = __builtin_bit_cast(bf16x8, pack8(bv));
#pragma unroll
        for (int rt = 0; rt < 9; ++rt) acc[rt] = mfma16(*(const bf16x8*)(cs + (size_t)(rt * 16 + fr) * 1024 + k0), bfrag, acc[rt]);
    }
    f32x4* red = (f32x4*)lds;
#pragma unroll
    for (int rt = 0; rt < 9; ++rt) red[(w * 9 + rt) * 64 + lane] = acc[rt];
    __syncthreads();
    float* mod = (float*)(p.ws + WS_MOD);
    for (int idx = tid; idx < 576; idx += 512) { const int rt = idx >> 6, ln = idx & 63;
        f32x4 sum = red[rt * 64 + ln];
#pragma unroll
        for (int ww = 1; ww < 8; ++ww) sum = sum + red[(ww * 9 + rt) * 64 + ln];
        const int col = c0 + (ln & 15); const float bias = p.in[9][col];
#pragma unroll
        for (int r = 0; r < 4; ++r) { const int row = rt * 16 + (ln >> 4) * 4 + r; if (row < 130) mod[(size_t)row * 3072 + col] = sum[r] + bias; } }
    __syncthreads();
}
__device__ __forceinline__ void p0_transpose_item(const float* W, int N, int n0, int nvalid, bf16_t* WT, int K, int n0p, int k0, float* scr, int lane) {
    const int c = lane & 31; const bool ok = c < nvalid;
    float tv[32];
#pragma unroll
    for (int i = 0; i < 32; ++i) { const int kk = 2 * i + (lane >> 5); tv[i] = ok ? W[(size_t)(k0 + kk) * N + n0 + c] : 0.f; }
#pragma unroll
    for (int i = 0; i < 32; ++i) { const int kk = 2 * i + (lane >> 5); scr[kk * 33 + c] = tv[i]; }
    asm volatile("s_waitcnt lgkmcnt(0)" ::: "memory");
    const int c8 = lane & 7;
#pragma unroll
    for (int j = 0; j < 4; ++j) { const int n = (lane >> 3) + 8 * j; const float* s = scr + (8 * c8) * 33 + n;
        u32x4 o; o.x = pk2(s[0], s[33]); o.y = pk2(s[66], s[99]); o.z = pk2(s[132], s[165]); o.w = pk2(s[198], s[231]);
        *(u32x4*)(WT + (size_t)(n0p + n) * K + k0 + 8 * c8) = o; }
    asm volatile("s_waitcnt lgkmcnt(0)" ::: "memory");
}
__device__ __forceinline__ void phase0a(const Params& p) {
    bf16_t* cs = (bf16_t*)(p.ws + WS_CS);
    for (int e = blockIdx.x * 512 + opaque_tid(); e < 144 * 256; e += gridDim.x * 512) {
        const int r = e >> 8, c4 = (e & 255) * 4;
        f32x4 v = {0.f, 0.f, 0.f, 0.f};
        if (r < 130) v = *(const f32x4*)((r < 2 ? p.in[5] + r * 1024 : p.in[6] + (r - 2) * 1024) + c4);
        u32x2 w; w.x = pk2(v.x * fast_rcp(1.f + __expf(-v.x)), v.y * fast_rcp(1.f + __expf(-v.y))); w.y = pk2(v.z * fast_rcp(1.f + __expf(-v.z)), v.w * fast_rcp(1.f + __expf(-v.w)));
        *(u32x2*)(cs + (size_t)r * 1024 + c4) = w; }
}
__device__ __forceinline__ void phase0(const Params& p, unsigned char* lds) {
    { int u0 = gridDim.x >= 192 ? (int)blockIdx.x - ((int)gridDim.x - 192) : (int)blockIdx.x;
      for (int u = u0; u < 192; u += gridDim.x) if (u >= 0) p0_ada(p, lds, u); }
}
__device__ __forceinline__ void phase0b(const Params& p, unsigned char* lds, int first, int last, int stride) {
    const int tid_ = opaque_tid(); const int lane = tid_ & 63, wave = tid_ >> 6;
    float* scr = (float*)(lds + wave * 8448);
    for (int it = first + wave; it < last; it += stride) {
        const int kb = it / 160, nb = it % 160; int n0, nv;
        if (nb < 72) { n0 = nb * 32; nv = 32; } else if (nb < 152) { n0 = nb * 32 + 16; nv = 32; } else if (nb == 152) { n0 = 2304; nv = 16; } else { n0 = 0; nv = 0; }
        p0_transpose_item(p.in[10], NIN, n0, nv, (bf16_t*)(p.ws + WS_WIN), 1024, nb * 32, kb * 64, scr, lane);
    }
    __syncthreads();
}
__device__ __forceinline__ void phase0c(const Params& p, unsigned char* lds, int myIdx, int nIdle) {
    const int tid_ = opaque_tid(); const int lane = tid_ & 63, wave = tid_ >> 6;
    float* scr = (float*)(lds + wave * 8448);
    constexpr int I_B = 8 * 32, I_O = 16 * 32, TOT = 2 * I_B + I_O;
    for (int it = myIdx * 8 + wave; it < TOT; it += nIdle * 8) {
        int r = it;
        if (r < I_B) { p0_transpose_item(p.in[17], 1024, (r % 32) * 32, 32, (bf16_t*)(p.ws + WS_WBA), 512, (r % 32) * 32, (r / 32) * 64, scr, lane); continue; } r -= I_B;
        if (r < I_B) { p0_transpose_item(p.in[18], 1024, (r % 32) * 32, 32, (bf16_t*)(p.ws + WS_WBG), 512, (r % 32) * 32, (r / 32) * 64, scr, lane); continue; } r -= I_B;
        p0_transpose_item(p.in[19], 1024, (r % 32) * 32, 32, (bf16_t*)(p.ws + WS_WOUT), 1024, (r % 32) * 32, (r / 32) * 64, scr, lane);
    }
    __syncthreads();
}
__device__ __forceinline__ void phase_rope(const Params& p) {
    float* rope = (float*)(p.ws + WS_ROPE);
    for (int e = blockIdx.x * 512 + opaque_tid(); e < 8200 * 32; e += gridDim.x * 512) {
        const int pp = e >> 5, i = e & 31; const int pos = pp < 8192 ? pp : pp + 8192;
        const float ang = (float)pos * p.inv[i];
        const double a = (double)ang; const double n = rint(a * 0.15915494309189535);
        const float r = (float)fma(-n, 6.283185307179586, a);
        rope[(size_t)pp * 64 + i] = __cosf(r); rope[(size_t)pp * 64 + 32 + i] = __sinf(r); }
}

__device__ __forceinline__ void p1_loadx(const Params& p, int r, int lane, f32x4 (&x)[4]) {
    const float* xrow = r < MP ? p.in[0] + (size_t)r * 1024 : p.in[1] + (size_t)(r - MP) * 1024;
#pragma unroll
    for (int j = 0; j < 4; ++j) x[j] = __builtin_nontemporal_load((const f32x4*)(xrow + 4 * lane + 256 * j));
}
__device__ __forceinline__ void phase1(const Params& p) {
    const int tid_ = opaque_tid(); const int lane = tid_ & 63, wave = tid_ >> 6;
    bf16_t* H = (bf16_t*)(p.ws + WS_H);
    const float* mod = (const float*)(p.ws + WS_MOD);
    const int step = gridDim.x * 8;
    int r = blockIdx.x * 8 + wave;
    if (r >= MT) return;
    f32x4 g[4];
#pragma unroll
    for (int j = 0; j < 4; ++j) g[j] = *(const f32x4*)(p.in[7] + 4 * lane + 256 * j);
    f32x4 x0[4], x1[4], x2[4];
    p1_loadx(p, r, lane, x0);
    p1_loadx(p, min(r + step, MT - 1), lane, x1);
    f32x4 sh[4], sc[4]; int mrow = -1;
    for (; r < MT; r += step) {
        p1_loadx(p, min(r + 2 * step, MT - 1), lane, x2);
        const int mr_i = mod_row(r);
        if (mr_i != mrow) { mrow = mr_i; const float* mr = mod + (size_t)mr_i * 3072;
#pragma unroll
            for (int j = 0; j < 4; ++j) { const int c = 4 * lane + 256 * j; sh[j] = *(const f32x4*)(mr + c); sc[j] = *(const f32x4*)(mr + 1024 + c); } }
        float ss = 0.f;
#pragma unroll
        for (int j = 0; j < 4; ++j) ss += (x0[j].x * x0[j].x + x0[j].y * x0[j].y) + (x0[j].z * x0[j].z + x0[j].w * x0[j].w);
        const float rstd = rsqrtf(wave_sum(ss) * (1.f / 1024.f) + EPS);
#pragma unroll
        for (int j = 0; j < 4; ++j) { const int c = 4 * lane + 256 * j;
            const f32x4 h = x0[j] * rstd * g[j] * (sc[j] + 1.f) + sh[j];
            u32x2 w; w.x = pk2(h.x, h.y); w.y = pk2(h.z, h.w);
            *(u32x2*)(H + (size_t)r * 1024 + c) = w; }
#pragma unroll
        for (int j = 0; j < 4; ++j) { x0[j] = x1[j]; x1[j] = x2[j]; }
    }
}

constexpr int KS_STRIDE = 72, VT_STRIDE = 264, ATT_VT_OFF = 256 * 72 * 2;
constexpr float QSCALE = 0.125f * LOG2E;

__device__ __forceinline__ void attn_group(const bf16_t* Ks, const bf16_t* Vt, int kt0, int lo, int hi, bool mid_full, bf16x8 qf0, bf16x8 qf1, float sinkv, f32x4 (&o)[4], int lane) {
    const int fr = lane & 15, fq = lane >> 4;
    f32x4 s[9];
#pragma unroll
    for (int t = 0; t < 9; ++t) {
        const bf16_t* kp = Ks + ((kt0 + t) * 16 + fr) * KS_STRIDE + fq * 8;
        const bf16x8 k0 = *(const bf16x8*)kp, k1 = *(const bf16x8*)(kp + 32);
        f32x4 a = {0.f, 0.f, 0.f, 0.f};
        a = mfma16(k0, qf0, a); a = mfma16(k1, qf1, a);
        s[t] = a;
    }
    float m = sinkv;
#pragma unroll
    for (int t = 0; t < 9; ++t) {
        if (t == 0 || t == 8 || !mid_full) {
#pragma unroll
            for (int r = 0; r < 4; ++r) { const int j = (kt0 + t) * 16 + fq * 4 + r; s[t][r] = (j >= lo && j <= hi) ? s[t][r] : -1e30f; } }
        m = fmaxf(m, fmaxf(fmaxf(s[t][0], s[t][1]), fmaxf(s[t][2], s[t][3])));
    }
    m = fmaxf(m, __shfl_xor(m, 16)); m = fmaxf(m, __shfl_xor(m, 32));
    float l = 0.f;
#pragma unroll
    for (int t = 0; t < 9; ++t)
#pragma unroll
        for (int r = 0; r < 4; ++r) { const float pv = __builtin_amdgcn_exp2f(s[t][r] - m); l += pv; s[t][r] = pv; }
    l += __shfl_xor(l, 16); l += __shfl_xor(l, 32);
    l += __builtin_amdgcn_exp2f(sinkv - m);
#pragma unroll
    for (int dt = 0; dt < 4; ++dt) o[dt] = (f32x4){0.f, 0.f, 0.f, 0.f};
#pragma unroll
    for (int ks = 0; ks < 5; ++ks) {
        u32x4 pw; pw.x = pk2(s[2 * ks][0], s[2 * ks][1]); pw.y = pk2(s[2 * ks][2], s[2 * ks][3]);
        if (ks < 4) { pw.z = pk2(s[2 * ks + 1][0], s[2 * ks + 1][1]); pw.w = pk2(s[2 * ks + 1][2], s[2 * ks + 1][3]); } else { pw.z = 0u; pw.w = 0u; }
        const bf16x8 pb = __builtin_bit_cast(bf16x8, pw);
#pragma unroll
        for (int dt = 0; dt < 4; ++dt) {
            const bf16_t* vp = Vt + (dt * 16 + fr) * VT_STRIDE + (kt0 + 2 * ks) * 16 + fq * 4;
            const u32x2 a0 = *(const u32x2*)vp; u32x2 a1 = {0u, 0u};
            if (ks < 4) a1 = *(const u32x2*)(vp + 16);
            u32x4 aw; aw.x = a0.x; aw.y = a0.y; aw.z = a1.x; aw.w = a1.y;
            o[dt] = mfma16(__builtin_bit_cast(bf16x8, aw), pb, o[dt]);
        }
    }
    const float inv = 1.f / l;
#pragma unroll
    for (int dt = 0; dt < 4; ++dt) o[dt] = o[dt] * inv;
}
__device__ __forceinline__ void norm_rope16(float (&a)[8], float (&b)[8], const float* g, const float* rp, int f, int sx1, int sx2) {
    float ss = 0.f;
#pragma unroll
    for (int j = 0; j < 8; ++j) ss += a[j] * a[j] + b[j] * b[j];
    ss += __shfl_xor(ss, sx1); ss += __shfl_xor(ss, sx2);
    const float rstd = rsqrtf(ss * (1.f / 64.f) + EPS);
#pragma unroll
    for (int j = 0; j < 8; ++j) {
        const float y1 = a[j] * rstd * g[f * 8 + j], y2 = b[j] * rstd * g[32 + f * 8 + j];
        const float c = rp[f * 8 + j], s = rp[32 + f * 8 + j];
        a[j] = y1 * c - y2 * s; b[j] = y2 * c + y1 * s;
    }
}

__device__ __forceinline__ void attn_rows(const Params& p, const bf16_t* Ks, const bf16_t* Vt, size_t tok, int head, int prow, int kt0, int lo, int hi, bool mid_full, const u32x4 q0, const u32x4 q1, const u32x2 (&z)[4], int lane) {
    const int fq = lane >> 4;
    float a[8], b[8];
    unpack8(q0, a); unpack8(q1, b);
    norm_rope16(a, b, p.in[11], (const float*)(p.ws + WS_ROPE) + (size_t)prow * 64, fq, 16, 32);
    const bf16x8 qf0 = __builtin_bit_cast(bf16x8, pack8s(a, QSCALE)), qf1 = __builtin_bit_cast(bf16x8, pack8s(b, QSCALE));
    f32x4 o[4];
    attn_group(Ks, Vt, kt0, lo, hi, mid_full, qf0, qf1, p.in[13][head] * LOG2E, o, lane);
    bf16_t* op = (bf16_t*)(p.ws + WS_OA) + tok * 512 + head * 64 + fq * 4;
#pragma unroll
    for (int dt = 0; dt < 4; ++dt) {
        u32x2 w; w.x = pk2(o[dt][0] * bflo(z[dt].x), o[dt][1] * bfhi(z[dt].x)); w.y = pk2(o[dt][2] * bflo(z[dt].y), o[dt][3] * bfhi(z[dt].y));
        *(u32x2*)(op + dt * 16) = w; }
}
__device__ __forceinline__ void attn_load_qz(const Params& p, size_t tok, int head, int fq, u32x4& q0, u32x4& q1, u32x2 (&z)[4]) {
    const bf16_t* qp = (const bf16_t*)(p.ws + WS_QA) + tok * 512 + head * 64 + fq * 8;
    q0 = *(const u32x4*)qp; q1 = *(const u32x4*)(qp + 32);
    const bf16_t* zp = (const bf16_t*)(p.ws + WS_ZA) + tok * 512 + head * 64 + fq * 4;
#pragma unroll
    for (int dt = 0; dt < 4; ++dt) z[dt] = *(const u32x2*)(zp + dt * 16);
}

__device__ __forceinline__ void attn_prompt_unit(const Params& p, unsigned char* lds, int u) {
    bf16_t* Ks = (bf16_t*)lds; bf16_t* Vt = (bf16_t*)(lds + ATT_VT_OFF);
    const int tid = opaque_tid(), lane = tid & 63, w = tid >> 6;
    const int b = u >> 7, qb = (u & 127) >> 1, kvh = u & 1;
    const bf16_t* KA = (const bf16_t*)(p.ws + WS_KA); const bf16_t* VA = (const bf16_t*)(p.ws + WS_VA);
    const float* rope = (const float*)(p.ws + WS_ROPE);
    const int head = kvh * 4 + (w >> 1), half = w & 1;
    u32x4 pq0[4], pq1[4]; u32x2 pz[4][4];
#pragma unroll
    for (int g = 0; g < 4; ++g) attn_load_qz(p, (size_t)b * SEQ + qb * 128 + half * 64 + g * 16 + (lane & 15), head, lane >> 4, pq0[g], pq1[g], pz[g]);
#pragma unroll
    for (int it = 0; it < 2; ++it) {
        const int j = it * 128 + w * 16 + (lane >> 2), f = lane & 3;
        const int t = (qb - 1) * 128 + j; const int tc = t < 0 ? 0 : t;
        const bf16_t* kp = KA + ((size_t)b * SEQ + tc) * 128 + kvh * 64 + f * 8;
        float a[8], c[8];
        unpack8(*(const u32x4*)kp, a); unpack8(*(const u32x4*)(kp + 32), c);
        norm_rope16(a, c, p.in[12], rope + (size_t)tc * 64, f, 1, 2);
        if (t < 0) {
#pragma unroll
            for (int q = 0; q < 8; ++q) { a[q] = 0.f; c[q] = 0.f; } }
        *(u32x4*)(Ks + j * KS_STRIDE + f * 8) = pack8(a); *(u32x4*)(Ks + j * KS_STRIDE + 32 + f * 8) = pack8(c);
        if (t >= SEQ - 128) { float* op = p.out + O_PWK + (((size_t)b * 128 + (t - (SEQ - 128))) * 2 + kvh) * 64 + f * 8;
            *(f32x4*)op = (f32x4){a[0], a[1], a[2], a[3]}; *(f32x4*)(op + 4) = (f32x4){a[4], a[5], a[6], a[7]};
            *(f32x4*)(op + 32) = (f32x4){c[0], c[1], c[2], c[3]}; *(f32x4*)(op + 36) = (f32x4){c[4], c[5], c[6], c[7]}; }
    }
#pragma unroll
    for (int it = 0; it < 2; ++it) {
        const int idx = tid + 512 * it, jp = idx & 127, ch = idx >> 7, j = 2 * jp;
        const int t = (qb - 1) * 128 + j; const int tc = t < 0 ? 0 : t;
        const bf16_t* vsrc = VA + ((size_t)b * SEQ + tc) * 128 + kvh * 64 + ch * 8;
        u32x4 v0 = *(const u32x4*)vsrc, v1 = *(const u32x4*)(vsrc + 128);
        if (t < 0) { v0 = (u32x4){0u, 0u, 0u, 0u}; v1 = v0; }
        unsigned* vp = (unsigned*)(Vt + (ch * 8) * VT_STRIDE + j);
        vp[0] = (v0.x & 0xffffu) | (v1.x << 16); vp[VT_STRIDE / 2] = (v0.x >> 16) | (v1.x & 0xffff0000u);
        vp[2 * (VT_STRIDE / 2)] = (v0.y & 0xffffu) | (v1.y << 16); vp[3 * (VT_STRIDE / 2)] = (v0.y >> 16) | (v1.y & 0xffff0000u);
        vp[4 * (VT_STRIDE / 2)] = (v0.z & 0xffffu) | (v1.z << 16); vp[5 * (VT_STRIDE / 2)] = (v0.z >> 16) | (v1.z & 0xffff0000u);
        vp[6 * (VT_STRIDE / 2)] = (v0.w & 0xffffu) | (v1.w << 16); vp[7 * (VT_STRIDE / 2)] = (v0.w >> 16) | (v1.w & 0xffff0000u);
        if (t >= SEQ - 128) { float* op = p.out + O_PWV + (((size_t)b * 128 + (t - (SEQ - 128))) * 2 + kvh) * 64 + ch * 8;
            *(f32x4*)op = (f32x4){bflo(v0.x), bfhi(v0.x), bflo(v0.y), bfhi(v0.y)}; *(f32x4*)(op + 4) = (f32x4){bflo(v0.z), bfhi(v0.z), bflo(v0.w), bfhi(v0.w)};
            *(f32x4*)(op + 128) = (f32x4){bflo(v1.x), bfhi(v1.x), bflo(v1.y), bfhi(v1.y)}; *(f32x4*)(op + 132) = (f32x4){bflo(v1.z), bfhi(v1.z), bflo(v1.w), bfhi(v1.w)}; }
    }
    __syncthreads();
#pragma unroll
    for (int g = 0; g < 4; ++g) {
        const int i0 = half * 64 + g * 16, i = i0 + (lane & 15), t = qb * 128 + i;
        attn_rows(p, Ks, Vt, (size_t)b * SEQ + t, head, t, i0 >> 4, qb == 0 ? 128 : i, i + 128, qb != 0, pq0[g], pq1[g], pz[g], lane);
    }
    __syncthreads();
}

__device__ __forceinline__ void attn_sample_unit(const Params& p, unsigned char* lds, int u) {
    bf16_t* Ks = (bf16_t*)lds; bf16_t* Vt = (bf16_t*)(lds + ATT_VT_OFF);
    const int tid = opaque_tid(), lane = tid & 63, w = tid >> 6;
    const int sb = u >> 1, kvh = u & 1;
    const bf16_t* KA = (const bf16_t*)(p.ws + WS_KA); const bf16_t* VA = (const bf16_t*)(p.ws + WS_VA);
    const float* rope = (const float*)(p.ws + WS_ROPE);
    u32x4 sq0 = {0u, 0u, 0u, 0u}, sq1 = sq0; u32x2 sz[4] = {{0u, 0u}, {0u, 0u}, {0u, 0u}, {0u, 0u}};
    if (w < 2) { const int q = lane & 15; attn_load_qz(p, (size_t)MP + sb * 8 + (q & 7), kvh * 4 + w * 2 + (q >> 3), lane >> 4, sq0, sq1, sz); }
#pragma unroll
    for (int it = 0; it < 2; ++it) {
        const int j = it * 128 + w * 16 + (lane >> 2), f = lane & 3;
        if (j < 144) {
            const int l = (j >= 128 && j < 136) ? j - 128 : 0;
            const bf16_t* kp = KA + ((size_t)MP + sb * 8 + l) * 128 + kvh * 64 + f * 8;
            float a[8], c[8];
            unpack8(*(const u32x4*)kp, a); unpack8(*(const u32x4*)(kp + 32), c);
            norm_rope16(a, c, p.in[12], rope + (size_t)(8192 + l) * 64, f, 1, 2);
            if (j < 128) { const float* cp = p.in[2] + (((size_t)sb * 128 + j) * 2 + kvh) * 64 + f * 8;
                const f32x4 c0 = __builtin_nontemporal_load((const f32x4*)cp), c1 = __builtin_nontemporal_load((const f32x4*)(cp + 4)), c2 = __builtin_nontemporal_load((const f32x4*)(cp + 32)), c3 = __builtin_nontemporal_load((const f32x4*)(cp + 36));
                a[0] = c0.x; a[1] = c0.y; a[2] = c0.z; a[3] = c0.w; a[4] = c1.x; a[5] = c1.y; a[6] = c1.z; a[7] = c1.w;
                c[0] = c2.x; c[1] = c2.y; c[2] = c2.z; c[3] = c2.w; c[4] = c3.x; c[5] = c3.y; c[6] = c3.z; c[7] = c3.w; }
            else if (j >= 136) {
#pragma unroll
                for (int q = 0; q < 8; ++q) { a[q] = 0.f; c[q] = 0.f; } }
            *(u32x4*)(Ks + j * KS_STRIDE + f * 8) = pack8(a); *(u32x4*)(Ks + j * KS_STRIDE + 32 + f * 8) = pack8(c);
            if (j >= 8 && j < 136) { float* op = p.out + O_SWK + (((size_t)sb * 128 + (j - 8)) * 2 + kvh) * 64 + f * 8;
                *(f32x4*)op = (f32x4){a[0], a[1], a[2], a[3]}; *(f32x4*)(op + 4) = (f32x4){a[4], a[5], a[6], a[7]};
                *(f32x4*)(op + 32) = (f32x4){c[0], c[1], c[2], c[3]}; *(f32x4*)(op + 36) = (f32x4){c[4], c[5], c[6], c[7]}; }
        }
    }
#pragma unroll
    for (int it = 0; it < 3; ++it) {
        const int idx = tid + 512 * it, j = idx >> 3, ch = idx & 7;
        if (j < 144) {
            float v[8];
            if (j < 128) { const float* cp = p.in[3] + (((size_t)sb * 128 + j) * 2 + kvh) * 64 + ch * 8;
                const f32x4 c0 = __builtin_nontemporal_load((const f32x4*)cp), c1 = __builtin_nontemporal_load((const f32x4*)(cp + 4));
                v[0] = c0.x; v[1] = c0.y; v[2] = c0.z; v[3] = c0.w; v[4] = c1.x; v[5] = c1.y; v[6] = c1.z; v[7] = c1.w; }
            else if (j < 136) unpack8(*(const u32x4*)(VA + ((size_t)MP + sb * 8 + (j - 128)) * 128 + kvh * 64 + ch * 8), v);
            else {
#pragma unroll
                for (int q = 0; q < 8; ++q) v[q] = 0.f; }
            const u32x4 pv = pack8(v);
            bf16_t* vp = Vt + (ch * 8) * VT_STRIDE + j;
            vp[0] = (bf16_t)(pv.x & 0xffff); vp[VT_STRIDE] = (bf16_t)(pv.x >> 16); vp[2 * VT_STRIDE] = (bf16_t)(pv.y & 0xffff); vp[3 * VT_STRIDE] = (bf16_t)(pv.y >> 16);
            vp[4 * VT_STRIDE] = (bf16_t)(pv.z & 0xffff); vp[5 * VT_STRIDE] = (bf16_t)(pv.z >> 16); vp[6 * VT_STRIDE] = (bf16_t)(pv.w & 0xffff); vp[7 * VT_STRIDE] = (bf16_t)(pv.w >> 16);
            if (j >= 8 && j < 136) { float* op = p.out + O_SWV + (((size_t)sb * 128 + (j - 8)) * 2 + kvh) * 64 + ch * 8;
                *(f32x4*)op = (f32x4){v[0], v[1], v[2], v[3]}; *(f32x4*)(op + 4) = (f32x4){v[4], v[5], v[6], v[7]}; }
        }
    }
    __syncthreads();
    if (w < 2) {
        const int q = lane & 15, l = q & 7, head = kvh * 4 + w * 2 + (q >> 3);
        attn_rows(p, Ks, Vt, (size_t)MP + sb * 8 + l, head, 8192 + l, 0, l, l + 128, true, sq0, sq1, sz, lane);
    }
    __syncthreads();
}

constexpr int G_BC = 0, G_TOT = 16640, G_QT = 18688, G_KT = 27904, G_VT = 37120, G_ST = 55552, G_AM = 73984, G_RED = 83200, G_KT2 = 83712, G_VS = 92928, G_LRS = 110336;
constexpr int GS = 72, VSS = 136;

__device__ __forceinline__ void gla_unit_info(int u, size_t& tok0, int& L, int& h) {
    if (u < 1024) { const int b = u >> 9, c = (u >> 2) & 127; h = u & 3; tok0 = (size_t)b * SEQ + c * 64; L = 64; }
    else { const int v = u - 1024; h = v & 3; tok0 = (size_t)MP + (v >> 2) * 8; L = 8; }
}
struct GlaRaw { u32x4 lr, q, k, v0, v1; float s[16]; u32x2 z[4]; f32x4 b0, b1; };
template <int MODE> __device__ __forceinline__ void gla_load(const Params& p, int u, GlaRaw& R, int tid) {
    size_t tok0; int L, h; gla_unit_info(u, tok0, L, h);
    const int tok = tid >> 3, c = tid & 7; const bool ok = tok < L; const u32x4 z4 = {0u, 0u, 0u, 0u};
    R.lr = z4;
    if (MODE == 2) {
        const float* bp = p.out + O_Y + (size_t)u * 4096 + tok * 64 + c * 8;
        R.b0 = *(const f32x4*)bp; R.b1 = *(const f32x4*)(bp + 4);
    } else if (tid < 128 && (tid >> 1) < L) R.lr = *(const u32x4*)((const bf16_t*)(p.ws + WS_LR) + (tok0 + (tid >> 1)) * 128 + (tid & 1) * 8);
    R.k = z4; R.v0 = z4; R.v1 = z4; R.q = z4;
    if (ok) { R.k = *(const u32x4*)((const bf16_t*)(p.ws + WS_KG) + (tok0 + tok) * 256 + h * 64 + c * 8);
        const bf16_t* vp = (const bf16_t*)(p.ws + WS_VG) + (tok0 + tok) * 512 + h * 128 + c * 16;
        R.v0 = *(const u32x4*)vp; R.v1 = *(const u32x4*)(vp + 8);
        if (MODE & 2) R.q = *(const u32x4*)((const bf16_t*)(p.ws + WS_QG) + (tok0 + tok) * 256 + h * 64 + c * 8); }
    if (MODE & 2) {
        const float* Sp = (u < 1024 ? (const float*)(p.ws + WS_DS) + (size_t)u * 8192 : p.in[4] + (size_t)(u - 1024) * 8192) + (tid & 127) + (tid >> 7) * 16 * 128;
#pragma unroll
        for (int i = 0; i < 16; ++i) R.s[i] = Sp[i * 128];
        const int lane = tid & 63, w = tid >> 6, ti = (w & 3) * 16 + (lane & 15);
        const bf16_t* zp = (const bf16_t*)(p.ws + WS_ZG) + (tok0 + min(ti, L - 1)) * 512 + h * 128 + (w >> 2) * 64 + (lane >> 4) * 4;
#pragma unroll
        for (int d4 = 0; d4 < 4; ++d4) R.z[d4] = *(const u32x2*)(zp + d4 * 16);
    }
}
struct GlaConst { bf16x8 wgf[2]; float biasv[2]; f32x4 g[4]; };
__device__ __forceinline__ void gla_const_load(const Params& p, int h, int tid, GlaConst& C) {
    const int lane = tid & 63, w = tid >> 6, fr = lane & 15, fq = lane >> 4;
#pragma unroll
    for (int q = 0; q < 2; ++q) { const int kc = h * 64 + ((w >> 2) * 2 + q) * 16 + fr;
        float v[8];
#pragma unroll
        for (int j = 0; j < 8; ++j) v[j] = fq < 2 ? p.in[14][(fq * 8 + j) * 256 + kc] : 0.f;
        C.wgf[q] = __builtin_bit_cast(bf16x8, pack8(v)); C.biasv[q] = p.in[15][kc]; }
#pragma unroll
    for (int d4 = 0; d4 < 4; ++d4) C.g[d4] = *(const f32x4*)(p.in[16] + ((w >> 2) * 4 + d4) * 16 + (lane >> 4) * 4);
}
template <int MODE> __device__ __forceinline__ void gla_process(const Params& p, unsigned char* lds, int u, GlaRaw& R, int unext, const GlaConst& C) {
    size_t tok0; int L, h; gla_unit_info(u, tok0, L, h);
    const int tid = opaque_tid(), lane = tid & 63, w = tid >> 6, fr = lane & 15, fq = lane >> 4;
    float* Bc = (float*)(lds + G_BC); float* TOT = (float*)(lds + G_TOT);
    bf16_t* QS = (bf16_t*)(lds + G_QT); bf16_t* KS = (bf16_t*)(lds + G_KT); bf16_t* VS = (bf16_t*)(lds + G_VS); bf16_t* LRS = (bf16_t*)(lds + G_LRS);
    { const int tok = tid >> 3, c = tid & 7;
      if (MODE == 2) { float* bc = Bc + tok * 65 + c * 8;
          bc[0] = R.b0[0]; bc[1] = R.b0[1]; bc[2] = R.b0[2]; bc[3] = R.b0[3]; bc[4] = R.b1[0]; bc[5] = R.b1[1]; bc[6] = R.b1[2]; bc[7] = R.b1[3]; }
      else if (tid < 128) *(u32x4*)(LRS + (tid >> 1) * 16 + (tid & 1) * 8) = R.lr;
      *(u32x4*)(KS + tok * GS + c * 8) = R.k;
      if (MODE & 2) *(u32x4*)(QS + tok * GS + c * 8) = R.q;
      *(u32x4*)(VS + tok * VSS + c * 16) = R.v0; *(u32x4*)(VS + tok * VSS + c * 16 + 8) = R.v1; }
    float sreg[16]; u32x2 zreg[4];
    if (MODE & 2) {
#pragma unroll
        for (int i = 0; i < 16; ++i) sreg[i] = R.s[i];
#pragma unroll
        for (int i = 0; i < 4; ++i) zreg[i] = R.z[i]; }
    __syncthreads();
    const int k = tid & 63, tg = tid >> 6;
    if (MODE != 2)
    {
      const int tt = w & 3, kh = w >> 2;
      u32x4 az = {0u, 0u, 0u, 0u};
      if (fq < 2) az = *(const u32x4*)(LRS + (tt * 16 + fr) * 16 + fq * 8);
      const bf16x8 afr = __builtin_bit_cast(bf16x8, az);
      float inc[2][4], excl[2], tot[2];
#pragma unroll
      for (int q = 0; q < 2; ++q) {
          const f32x4 acc = mfma16(afr, C.wgf[q], (f32x4){0.f, 0.f, 0.f, 0.f});
          float run = 0.f;
#pragma unroll
          for (int r = 0; r < 4; ++r) { const int t = tt * 16 + fq * 4 + r; const float g = acc[r] + C.biasv[q];
              const float la = t < L ? (fminf(g, 0.f) - __logf(1.f + __expf(-fabsf(g)))) * (1.f / 16.f) : 0.f;
              run += la; inc[q][r] = run; }
          const float t0 = __shfl(run, fr), t1 = __shfl(run, fr + 16), t2 = __shfl(run, fr + 32), t3 = __shfl(run, fr + 48);
          excl[q] = (fq > 0 ? t0 : 0.f) + (fq > 1 ? t1 : 0.f) + (fq > 2 ? t2 : 0.f); tot[q] = (t0 + t1) + (t2 + t3);
          if (fq == 0) TOT[tt * 64 + (kh * 2 + q) * 16 + fr] = tot[q];
      }
      __syncthreads();
#pragma unroll
      for (int q = 0; q < 2; ++q) { const int kc = (kh * 2 + q) * 16 + fr; float pre = excl[q];
#pragma unroll
          for (int j = 0; j < 3; ++j) if (j < tt) pre += TOT[j * 64 + kc];
#pragma unroll
          for (int r = 0; r < 4; ++r) { const float bv = pre + inc[q][r]; Bc[(tt * 16 + fq * 4 + r) * 65 + kc] = bv;
              if (MODE == 1) p.out[O_Y + (size_t)u * 4096 + (tt * 16 + fq * 4 + r) * 64 + kc] = bv; } }
      __syncthreads(); }
    if (MODE == 3 && tg != 0) {
      *(u32x4*)((bf16_t*)(lds + G_KT2) + k * GS + tg * 8) = (u32x4){0u, 0u, 0u, 0u};
    } else
    { const float bl = Bc[63 * 65 + k], bm = Bc[31 * 65 + k];
      float kd[8];
#pragma unroll
      for (int i = 0; i < 8; ++i) { const int tt = tg * 8 + i; const float bb = Bc[tt * 65 + k]; const float kv = bf2f(KS[tt * GS + k]);
          if (MODE & 1) kd[i] = kv * __expf(bl - bb);
          if (MODE & 2) { const float qv = bf2f(QS[tt * GS + k]);
              QS[tt * GS + k] = (bf16_t)(pk2(qv * __expf(bb - bm), 0.f) & 0xffff); KS[tt * GS + k] = (bf16_t)(pk2(kv * __expf(bm - bb), 0.f) & 0xffff); } }
      if (MODE & 1) *(u32x4*)((bf16_t*)(lds + G_KT2) + k * GS + tg * 8) = pack8(kd); }
    { const int dv = tid & 127, t4 = tid >> 7; unsigned wv[8];
#pragma unroll
      for (int i = 0; i < 8; ++i) wv[i] = (unsigned)VS[(t4 * 16 + 2 * i) * VSS + dv] | ((unsigned)VS[(t4 * 16 + 2 * i + 1) * VSS + dv] << 16);
      bf16_t* VT = (bf16_t*)(lds + G_VT) + dv * GS + t4 * 16;
      *(u32x4*)VT = (u32x4){wv[0], wv[1], wv[2], wv[3]}; *(u32x4*)(VT + 8) = (u32x4){wv[4], wv[5], wv[6], wv[7]};
      if (MODE & 2) { float v[16];
#pragma unroll
          for (int i = 0; i < 16; ++i) v[i] = sreg[i] * __expf(Bc[31 * 65 + t4 * 16 + i]);
          bf16_t* ST = (bf16_t*)(lds + G_ST) + dv * GS + t4 * 16;
          u32x4 w0, w1; w0.x = pk2(v[0], v[1]); w0.y = pk2(v[2], v[3]); w0.z = pk2(v[4], v[5]); w0.w = pk2(v[6], v[7]);
          w1.x = pk2(v[8], v[9]); w1.y = pk2(v[10], v[11]); w1.z = pk2(v[12], v[13]); w1.w = pk2(v[14], v[15]);
          *(u32x4*)ST = w0; *(u32x4*)(ST + 8) = w1; } }
    if (unext >= 0) gla_load<MODE>(p, unext, R, tid);
    __syncthreads();
    if (MODE & 1) {
        const bf16_t* VT = (const bf16_t*)(lds + G_VT) + (w * 16 + fr) * GS + fq * 8;
        const bf16x8 a0 = *(const bf16x8*)VT, a1 = *(const bf16x8*)(VT + 32);
#pragma unroll
        for (int kt = 0; kt < 4; ++kt) {
            const bf16_t* KT = (const bf16_t*)(lds + G_KT2) + (kt * 16 + fr) * GS + fq * 8;
            f32x4 acc = {0.f, 0.f, 0.f, 0.f};
            acc = mfma16(a0, *(const bf16x8*)KT, acc); acc = mfma16(a1, *(const bf16x8*)(KT + 32), acc);
            const int kk = kt * 16 + fr, dv = w * 16 + fq * 4;
            if (MODE == 1) *(f32x4*)((float*)(p.ws + WS_DS) + (size_t)u * 8192 + kk * 128 + dv) = acc;
            else *(f32x4*)((float*)(lds + G_VS) + kk * 128 + dv) = acc;
        }
        if (u < 1024 && tid < 64) ((float*)(p.ws + WS_DEC))[(size_t)u * 64 + tid] = __expf(Bc[63 * 65 + tid]);
    }
    if (MODE & 2) {
        const int tt = w & 3, hh = w >> 2;
        const bool live = (MODE != 3) || tt == 0;
        const bf16_t* QTr = QS + (tt * 16 + fr) * GS + fq * 8;
        const bf16x8 bq0 = *(const bf16x8*)QTr, bq1 = *(const bf16x8*)(QTr + 32);
#pragma unroll
        for (int q = 0; q < 2; ++q) { if (!live) break; const int st = hh * 2 + q;
            const bf16_t* KTr = KS + (st * 16 + fr) * GS + fq * 8;
            f32x4 acc = {0.f, 0.f, 0.f, 0.f};
            if (st <= tt) { acc = mfma16(*(const bf16x8*)KTr, bq0, acc); acc = mfma16(*(const bf16x8*)(KTr + 32), bq1, acc); }
            const int ti = tt * 16 + fr, s0 = st * 16 + fq * 4;
            u32x2 wv; wv.x = pk2(s0 <= ti ? acc[0] : 0.f, s0 + 1 <= ti ? acc[1] : 0.f); wv.y = pk2(s0 + 2 <= ti ? acc[2] : 0.f, s0 + 3 <= ti ? acc[3] : 0.f);
            *(u32x2*)((bf16_t*)(lds + G_AM) + ti * GS + s0) = wv; }
        __syncthreads();
        if (MODE == 3) {
            const int dv = tid & 127, t4 = tid >> 7; const float* dsl = (const float*)(lds + G_VS) + dv;
            float* so = p.out + O_SGS + (size_t)(u - 1024) * 8192 + (size_t)(t4 * 16) * 128 + dv;
#pragma unroll
            for (int i = 0; i < 16; ++i) __builtin_nontemporal_store(__expf(Bc[63 * 65 + t4 * 16 + i]) * sreg[i] + dsl[(t4 * 16 + i) * 128], so + i * 128);
        }
        const bf16_t* AMr = (const bf16_t*)(lds + G_AM) + (tt * 16 + fr) * GS + fq * 8;
        const bf16x8 ba0 = *(const bf16x8*)AMr, ba1 = *(const bf16x8*)(AMr + 32);
        f32x4 o[4]; float ss = 0.f;
#pragma unroll
        for (int d4 = 0; d4 < 4; ++d4) { o[d4] = (f32x4){0.f, 0.f, 0.f, 0.f}; if (!live) continue; const int row = (hh * 4 + d4) * 16 + fr;
            const bf16_t* VT = (const bf16_t*)(lds + G_VT) + row * GS + fq * 8; const bf16_t* ST = (const bf16_t*)(lds + G_ST) + row * GS + fq * 8;
            f32x4 acc = {0.f, 0.f, 0.f, 0.f};
            acc = mfma16(*(const bf16x8*)VT, ba0, acc); acc = mfma16(*(const bf16x8*)(VT + 32), ba1, acc);
            acc = mfma16(*(const bf16x8*)ST, bq0, acc); acc = mfma16(*(const bf16x8*)(ST + 32), bq1, acc);
            o[d4] = acc; ss += (acc[0] * acc[0] + acc[1] * acc[1]) + (acc[2] * acc[2] + acc[3] * acc[3]); }
        ss += __shfl_xor(ss, 16); ss += __shfl_xor(ss, 32);
        float* RED = (float*)(lds + G_RED);
        if (fq == 0) RED[hh * 64 + tt * 16 + fr] = ss;
        __syncthreads();
        const float rstd = rsqrtf((RED[tt * 16 + fr] + RED[64 + tt * 16 + fr]) * (1.f / 128.f) + EPS);
        const int ti = tt * 16 + fr;
        if (ti < L) {
            const size_t tok = tok0 + ti;
#pragma unroll
            for (int d4 = 0; d4 < 4; ++d4) { const int dv = (hh * 4 + d4) * 16 + fq * 4;
                const f32x4 g = C.g[d4];
                const u32x2 z = zreg[d4];
                u32x2 wv; wv.x = pk2(o[d4][0] * rstd * g.x * bflo(z.x), o[d4][1] * rstd * g.y * bfhi(z.x));
                wv.y = pk2(o[d4][2] * rstd * g.z * bflo(z.y), o[d4][3] * rstd * g.w * bfhi(z.y));
                *(u32x2*)((bf16_t*)(p.ws + WS_OG) + tok * 512 + h * 128 + dv) = wv; }
        }
    }
    __syncthreads();
}
template <int MODE> __device__ __forceinline__ void gla_units_run(const Params& p, unsigned char* lds, int ufirst, int uend, int ustride, GlaRaw& R) {
    const int tid = opaque_tid();
    int u = ufirst;
    if (u >= uend) return;
    if ((ustride & 3) == 0) {
        GlaConst C; gla_const_load(p, u & 3, tid, C);
        for (; u < uend; u += ustride) { const int un = u + ustride; gla_process<MODE>(p, lds, u, R, un < uend ? un : -1, C); }
    } else {
        for (; u < uend; u += ustride) { const int un = u + ustride; GlaConst C; gla_const_load(p, u & 3, tid, C); gla_process<MODE>(p, lds, u, R, un < uend ? un : -1, C); }
    }
}
template <int MODE> __device__ __forceinline__ void gla_units(const Params& p, unsigned char* lds, int ufirst, int uend, int ustride) {
    if (ufirst >= uend) return;
    GlaRaw R; gla_load<MODE>(p, ufirst, R, opaque_tid());
    gla_units_run<MODE>(p, lds, ufirst, uend, ustride, R);
}
struct SampleOrder {
    int c;
    __device__ __forceinline__ bool next(int i, Unit& u) const { if (i > 0 || c >= 80) return false; u.pm = 64 + c / 20; u.pn = c % 20; return true; }
    __device__ __forceinline__ void a_ready(const Unit&) const {}
    __device__ __forceinline__ void done(const Unit&) const {}
};
__device__ __forceinline__ void gla_scan_dummy(const Params& p) {
    if (threadIdx.x >= 256) return;
    const int e = blockIdx.x * 256 + threadIdx.x;
    if (e >= 65536) return;
    const int b = e >> 15, h = (e >> 13) & 3, k = (e >> 7) & 63, dv = e & 127;
    float* DS = (float*)(p.ws + WS_DS); const float* DEC = (const float*)(p.ws + WS_DEC);
    float S = 0.f;
#pragma unroll 8
    for (int c = 0; c < 128; ++c) { const size_t u = (size_t)b * 512 + c * 4 + h;
        const float d = DEC[u * 64 + k]; float* sp = DS + u * 8192 + k * 128 + dv; const float ds = *sp; *sp = ds; S = d * S + ds; }
    if (S == 123.456f) p.out[O_PGS + e] = S;
}
__device__ __forceinline__ void gla_scan(const Params& p) {
    if (threadIdx.x >= 256) return;
    const int e = blockIdx.x * 256 + threadIdx.x;
    if (e >= 65536) return;
    const int b = e >> 15, h = (e >> 13) & 3, k = (e >> 7) & 63, dv = e & 127;
    float* DS = (float*)(p.ws + WS_DS); const float* DEC = (const float*)(p.ws + WS_DEC);
    float S = 0.f;
#pragma unroll 1
    for (int c0 = 0; c0 < 128; c0 += 32) {
        float d[32], ds[32];
#pragma unroll
        for (int i = 0; i < 32; ++i) { const size_t u = (size_t)b * 512 + (c0 + i) * 4 + h; d[i] = DEC[u * 64 + k]; ds[i] = DS[u * 8192 + k * 128 + dv]; }
#pragma unroll
        for (int i = 0; i < 32; ++i) { const size_t u = (size_t)b * 512 + (c0 + i) * 4 + h; DS[u * 8192 + k * 128 + dv] = S; S = d[i] * S + ds[i]; }
    }
    p.out[O_PGS + e] = S;
}

template <int KK> __device__ __forceinline__ void splitk_tile(const bf16_t* A, int lda, const bf16_t* Bt, int ldb, int row0, int col0, unsigned char* lds, f32x4 (&res)[2], int tid) {
    const int lane = tid & 63, w = tid >> 6, fr = lane & 15, fq = lane >> 4;
    constexpr int KS = KK / 8 / 32;
    f32x4 acc[4][4];
#pragma unroll
    for (int i = 0; i < 4; ++i)
#pragma unroll
        for (int j = 0; j < 4; ++j) acc[i][j] = (f32x4){0.f, 0.f, 0.f, 0.f};
    const bf16_t* ap = A + (size_t)(row0 + fr) * lda + w * (KK / 8) + fq * 8;
    const bf16_t* bp = Bt + (size_t)(col0 + fr) * ldb + w * (KK / 8) + fq * 8;
    bf16x8 af[KS][4], bfr[KS][4];
#pragma unroll
    for (int ks = 0; ks < KS; ++ks)
#pragma unroll
        for (int i = 0; i < 4; ++i) { af[ks][i] = *(const bf16x8*)(ap + (size_t)(i * 16) * lda + ks * 32); bfr[ks][i] = *(const bf16x8*)(bp + (size_t)(i * 16) * ldb + ks * 32); }
#pragma unroll
    for (int ks = 0; ks < KS; ++ks)
#pragma unroll
        for (int i = 0; i < 4; ++i)
#pragma unroll
            for (int j = 0; j < 4; ++j) acc[i][j] = mfma16(bfr[ks][j], af[ks][i], acc[i][j]);
    f32x4* red = (f32x4*)lds;
#pragma unroll
    for (int i = 0; i < 4; ++i)
#pragma unroll
        for (int j = 0; j < 4; ++j) red[(w * 16 + i * 4 + j) * 64 + lane] = acc[i][j];
    __syncthreads();
#pragma unroll
    for (int i = 0; i < 2; ++i) { const int item = tid + 512 * i;
        f32x4 sum = red[item];
#pragma unroll
        for (int ww = 1; ww < 8; ++ww) sum = sum + red[ww * 1024 + item];
        res[i] = sum; }
    __syncthreads();
}
__device__ __forceinline__ void small_merge_tiles(const Params& p, unsigned char* lds) {
    const int tid = opaque_tid();
    for (int t = blockIdx.x; t < 256; t += gridDim.x) {
        const int row0 = MP + (t >> 4) * 64, col0 = (t & 15) * 64;
        f32x4 ra[2], rg[2];
        splitk_tile<512>((const bf16_t*)(p.ws + WS_OA), 512, (const bf16_t*)(p.ws + WS_WBA), 512, row0, col0, lds, ra, tid);
        splitk_tile<512>((const bf16_t*)(p.ws + WS_OG), 512, (const bf16_t*)(p.ws + WS_WBG), 512, row0, col0, lds, rg, tid);
#pragma unroll
        for (int i = 0; i < 2; ++i) { const int item = tid + 512 * i, tile = item >> 6, ln = item & 63;
            const size_t o = (size_t)(row0 + (tile >> 2) * 16 + (ln & 15)) * 1024 + col0 + (tile & 3) * 16 + (ln >> 4) * 4;
            const u32x2 ma = *(const u32x2*)((const bf16_t*)(p.ws + WS_MA) + o), mg = *(const u32x2*)((const bf16_t*)(p.ws + WS_MG) + o);
            u32x2 wv; wv.x = pk2(bflo(ma.x) * ra[i][0] + bflo(mg.x) * rg[i][0], bfhi(ma.x) * ra[i][1] + bfhi(mg.x) * rg[i][1]);
            wv.y = pk2(bflo(ma.y) * ra[i][2] + bflo(mg.y) * rg[i][2], bfhi(ma.y) * ra[i][3] + bfhi(mg.y) * rg[i][3]);
            *(u32x2*)((bf16_t*)(p.ws + WS_MRG) + o) = wv; }
    }
}
__device__ __forceinline__ void small_out_tiles(const Params& p, unsigned char* lds) {
    const int tid = opaque_tid();
    for (int t = blockIdx.x; t < 256; t += gridDim.x) {
        const int row0 = MP + (t >> 4) * 64, col0 = (t & 15) * 64;
        f32x4 r[2];
        splitk_tile<1024>((const bf16_t*)(p.ws + WS_MRG), 1024, (const bf16_t*)(p.ws + WS_WOUT), 1024, row0, col0, lds, r, tid);
#pragma unroll
        for (int i = 0; i < 2; ++i) { const int item = tid + 512 * i, tile = item >> 6, ln = item & 63;
            const int row = row0 + (tile >> 2) * 16 + (ln & 15), c = col0 + (tile & 3) * 16 + (ln >> 4) * 4;
            const f32x4 x4 = __builtin_nontemporal_load((const f32x4*)(p.in[1] + (size_t)(row - MP) * 1024 + c)), g4 = *(const f32x4*)((const float*)(p.ws + WS_MOD) + (size_t)mod_row(row) * 3072 + 2048 + c);
            __builtin_nontemporal_store(x4 + g4 * r[i], (f32x4*)(p.out + O_Y + (size_t)row * 1024 + c)); }
    }
}

__global__ void __launch_bounds__(512) mega_fwd(Params p) {
    extern __shared__ __attribute__((aligned(16))) unsigned char lds[];
    cg::grid_group grid = cg::this_grid();
    const int lo = p.ph_lo, hi = p.ph_hi;
#define IN(k) (lo <= (k) && (k) < hi)
    PG8_LAS unsigned char* glds = (PG8_LAS unsigned char*)lds;
    volatile LAS unsigned* xst = (volatile LAS unsigned*)(glds + 131072);
    if (threadIdx.x == 0) { xst[0] = 0u; xst[1] = 0u; }
    __syncthreads();
    const XcdBarrier xbar = xcd_barrier_post((unsigned*)(p.ws + WS_BAR), xst);
#ifndef PROBE_T
#define PROBE_T -1
#endif
    volatile LAS unsigned long long* tsl = (volatile LAS unsigned long long*)(glds + 131072 + 16);
#define STAMP(i) do { if (PROBE_T >= 0 && blockIdx.x == 0 && threadIdx.x == 0) tsl[i] = __builtin_amdgcn_s_memrealtime(); } while (0)
#define SEAM(k) do { if (IN(k) && IN((k) + 1)) xcd_barrier(xbar); STAMP((k) + 1); } while (0)
    STAMP(0);
#ifndef PROBE_MASK
#define PROBE_MASK 0
#endif
#define REP(bit) ((((PROBE_MASK) >> (bit)) & 1) + 1)
    if (IN(0)) { phase0a(p); xcd_barrier(xbar); for (int rep = 0; rep < REP(0); ++rep) phase0(p, lds);
        constexpr int I_IN = 16 * 160;
        if (gridDim.x == 256) { if (blockIdx.x < 64) phase0b(p, lds, blockIdx.x * 8, 1536, 512); else phase0b(p, lds, 1536 + (blockIdx.x - 64) * 8, I_IN, 1536); }
        else phase0b(p, lds, blockIdx.x * 8, I_IN, gridDim.x * 8); }
    SEAM(0);
    if (REP(11) > 1) { grid.sync(); grid.sync(); grid.sync(); grid.sync(); }
    if (REP(12) > 1) { xcd_barrier(xbar); xcd_barrier(xbar); xcd_barrier(xbar); xcd_barrier(xbar); }
    if (IN(1)) for (int rep = 0; rep < REP(1); ++rep) { phase1(p); phase_rope(p); }
    SEAM(1);
    const bool split = gridDim.x > 80 && ((gridDim.x - 80) & 3) == 0;
    if (IN(2)) { pg8::Gemm g{(const bf16_t*)(p.ws + WS_H), (const bf16_t*)(p.ws + WS_WIN), MT, NINP, 1024}; pg8::StaticOrder S; S.init(split ? MP : MT, NINP, gridDim.x, blockIdx.x);
        EpiProj E{p.ws}; pg8::gemm_phase<EpiProj, pg8::StaticOrder, true, true>(glds, g, S, E); STAMP(15);
        if (!split) phase0c(p, lds, blockIdx.x, gridDim.x); }
    SEAM(2);
    if (IN(3)) {
        if (split) {
            if (blockIdx.x < 80) { pg8::Gemm g{(const bf16_t*)(p.ws + WS_H), (const bf16_t*)(p.ws + WS_WIN), MT, NINP, 1024}; SampleOrder S{(int)blockIdx.x};
                EpiProj E{p.ws}; pg8::gemm_phase<EpiProj, SampleOrder, true, true>(glds, g, S, E); }
            else phase0c(p, lds, blockIdx.x - 80, gridDim.x - 80);
            GlaRaw R1; const int u1 = (int)blockIdx.x - 80;
            if (u1 >= 0 && u1 < 1024) gla_load<1>(p, u1, R1, opaque_tid());
            for (int u = blockIdx.x; u < 256; u += gridDim.x) attn_prompt_unit(p, lds, u);
            STAMP(12);
            if (u1 >= 0) gla_units_run<1>(p, lds, u1, 1024, gridDim.x - 80, R1);
            STAMP(13);
            xcd_barrier(xbar);
            gla_scan(p);
            for (int u = blockIdx.x; u < 256; u += gridDim.x) attn_sample_unit(p, lds, u);
            gla_units<3>(p, lds, 1024 + blockIdx.x, 1536, gridDim.x);
            STAMP(14);
        } else {
            for (int u = blockIdx.x; u < 512; u += gridDim.x) { if (u < 256) attn_prompt_unit(p, lds, u); else attn_sample_unit(p, lds, u - 256); }
            gla_units<1>(p, lds, blockIdx.x, 1024, gridDim.x);
            gla_units<3>(p, lds, 1024 + blockIdx.x, 1536, gridDim.x);
        }
    }
    if (!split) { SEAM(3); if (IN(4)) gla_scan(p); }
    SEAM(4);
    if (IN(5)) gla_units<2>(p, lds, blockIdx.x, 1024, gridDim.x);
    SEAM(5);
    if (IN(6)) for (int rep = 0; rep < REP(7); ++rep) {
        BranchOrder S; S.base.init(MP, 1024, gridDim.x, blockIdx.x);
        pg8::Gemm g{(const bf16_t*)(p.ws + WS_OA), (const bf16_t*)(p.ws + WS_WBA), 2 * MT, 2048, 512};
        EpiBranch E{p.ws};
        const bool small_first = (blockIdx.x & 4) != 0;
        if (small_first) small_merge_tiles(p, lds);
        pg8::gemm_phase<EpiBranch, BranchOrder, true, true>(glds, g, S, E);
        if (!small_first) small_merge_tiles(p, lds);
    }
    SEAM(6);
    if (IN(7)) for (int rep = 0; rep < REP(8); ++rep) { pg8::Gemm g{(const bf16_t*)(p.ws + WS_MRG), (const bf16_t*)(p.ws + WS_WOUT), MP, 1024, 1024}; pg8::StaticOrder S; S.init(MP, 1024, gridDim.x, blockIdx.x);
        EpiOut E{p.in[0], (const float*)(p.ws + WS_MOD), p.out + O_Y};
        const bool small_first = (blockIdx.x & 4) != 0;
        if (small_first) small_out_tiles(p, lds);
        pg8::gemm_phase<EpiOut, pg8::StaticOrder, false, true>(glds, g, S, E);
        if (!small_first) small_out_tiles(p, lds); }
    STAMP(8);
    if (PROBE_T >= 0 && blockIdx.x == 0 && threadIdx.x == 0) {
#ifndef PROBE_A
#define PROBE_A PROBE_T
#define PROBE_B (PROBE_T + 1)
#endif
        const unsigned long long d = tsl[PROBE_B] - tsl[PROBE_A], t0 = __builtin_amdgcn_s_memrealtime();
        while (__builtin_amdgcn_s_memrealtime() - t0 < 4ull * d) __builtin_amdgcn_s_sleep(16);
    }
    if (hi > 1000) grid.sync();
#undef IN
#undef SEAM
}

constexpr int LDS_BYTES = 131072 + 16 + 128;
#ifndef N_LAUNCH_MODE
#define N_LAUNCH_MODE 1
#endif

extern "C" void kernel_launch(void* const* d_in, const int* in_sizes, int n_in, void* d_out, int out_size, void* d_ws, size_t ws_size, hipStream_t stream) {
    static int grid = 0;
    if (grid == 0) {
        if (n_in != 20 || ws_size < WS_END) { fprintf(stderr, "kernel_launch: unexpected n_in %d / ws_size %zu (need %zu)\n", n_in, ws_size, (size_t)WS_END); grid = -1; return; }
        int dev = 0, cus = 0, per_cu = 0;
        hipGetDevice(&dev);
        hipDeviceGetAttribute(&cus, hipDeviceAttributeMultiprocessorCount, dev);
        if (hipFuncSetAttribute((const void*)mega_fwd, hipFuncAttributeMaxDynamicSharedMemorySize, LDS_BYTES) != hipSuccess) { fprintf(stderr, "kernel_launch: hipFuncSetAttribute failed\n"); grid = -1; return; }
        if (hipOccupancyMaxActiveBlocksPerMultiprocessor(&per_cu, (const void*)mega_fwd, 512, LDS_BYTES) != hipSuccess || per_cu < 1) { fprintf(stderr, "kernel_launch: occupancy query gives %d\n", per_cu); per_cu = 1; }
        (void)hipGetLastError();
        grid = cus * 1;
        if (grid > cus * per_cu) grid = cus * per_cu;
    }
    if (grid < 0) return;
    Params p{};
    for (int i = 0; i < 20; ++i) p.in[i] = (const float*)d_in[i];
    p.out = (float*)d_out; p.ws = (unsigned char*)d_ws;
    for (int i = 0; i < 32; ++i) { const float e = (float)i / 32.0f; const float pw = powf(10000.0f, e); p.inv[i] = 1.0f / pw; }
    if (hipMemsetAsync((unsigned char*)d_ws + WS_BAR, 0, 16384, stream) != hipSuccess) { fprintf(stderr, "kernel_launch: memset of barrier words failed\n"); return; }
#if N_LAUNCH_MODE == 1
    p.ph_lo = 0; p.ph_hi = 8;
    void* args[] = {&p};
    hipError_t e = hipLaunchCooperativeKernel((const void*)mega_fwd, dim3(grid), dim3(512), args, LDS_BYTES, stream);
    if (e != hipSuccess) fprintf(stderr, "cooperative launch failed: %s (grid %d)\n", hipGetErrorString(e), grid);
#else
    for (int ph = 0; ph < 8; ++ph) { p.ph_lo = ph; p.ph_hi = ph + 1;
        hipLaunchKernelGGL(mega_fwd, dim3(grid), dim3(512), LDS_BYTES, stream, p); }
#endif
}
```
